# Optimizing an MI355X kernel written in HIP

```python
import jax, jax.numpy as jnp
from jax import lax
import numpy as np

D_MODEL = 1024
BATCH = 2
SEQ = 16384
DEPTH = 2
DEC_BATCH = 16
DEC_SEQ = 32
PAST_LEN = 2048

CHUNK = 64
Q_BLOCK = 128
EPS = 1e-6
MLA_HEADS = 8
QK_NOPE = 64
QK_ROPE = 32
V_HEAD = 64
Q_LORA = 256
KV_LORA = 256
ROPE_THETA = 10000.0
QK_DIM = QK_NOPE + QK_ROPE
ATTN_SCALE = QK_DIM ** -0.5
GLA_HEADS = 4
GLA_DK = 64
GLA_DV = 128
GATE_LR = 16
GATE_TAU = 16.0
MIX_WIDTH = MLA_HEADS * V_HEAD + GLA_HEADS * GLA_DV
IN_SIZES = (Q_LORA, KV_LORA, QK_ROPE, GLA_HEADS * GLA_DK, GLA_HEADS * GLA_DK,
            GLA_HEADS * GLA_DV, GLA_HEADS * GLA_DV, GATE_LR)
IN_WIDTH = int(sum(IN_SIZES))
IN_SPLITS = tuple(int(s) for s in np.cumsum(IN_SIZES)[:-1])
D_FF = -(-8 * D_MODEL // (3 * 256)) * 256

kernel_name = "hymba_mla_gla_streaming_step"


def rmsnorm(x, g):
    xf = x.astype(jnp.float32)
    y = xf * lax.rsqrt(jnp.mean(xf * xf, axis=-1, keepdims=True) + EPS)
    return (y * g.astype(jnp.float32)).astype(x.dtype)


def rope(x, pos):
    half = QK_ROPE // 2
    inv = ROPE_THETA ** (-jnp.arange(half, dtype=jnp.float32) / half)
    ang = pos.astype(jnp.float32)[:, None] * inv[None, :]
    ang = ang.reshape((ang.shape[0],) + (1,) * (x.ndim - 3) + (half,))
    cos, sin = jnp.cos(ang), jnp.sin(ang)
    x1 = x[..., :half].astype(jnp.float32)
    x2 = x[..., half:].astype(jnp.float32)
    return jnp.concatenate([x1 * cos - x2 * sin, x1 * sin + x2 * cos], axis=-1).astype(x.dtype)


def mixer_proj(h, pos, w_in, g_qn, w_uq, g_kvn, w_a2, b_a2):
    B, T, _ = h.shape
    z = h @ w_in
    c_q, c_kv, k_r, gq, gk, gv, gg, ga = jnp.split(z, IN_SPLITS, axis=-1)
    q = (rmsnorm(c_q, g_qn) @ w_uq).reshape(B, T, MLA_HEADS, QK_DIM)
    q = jnp.concatenate([q[..., :QK_NOPE], rope(q[..., QK_NOPE:], pos)], axis=-1)
    c_kv = rmsnorm(c_kv, g_kvn)
    k_r = rope(k_r, pos)
    gq = gq.reshape(B, T, GLA_HEADS, GLA_DK) * (GLA_DK ** -0.5)
    gk = gk.reshape(B, T, GLA_HEADS, GLA_DK)
    gv = gv.reshape(B, T, GLA_HEADS, GLA_DV)
    gg = gg.reshape(B, T, GLA_HEADS, GLA_DV)
    lg = jax.nn.log_sigmoid((ga @ w_a2 + b_a2).astype(jnp.float32)) / GATE_TAU
    lg = lg.reshape(B, T, GLA_HEADS, GLA_DK)
    return q, c_kv, k_r, gq, gk, gv, gg, lg


def mla_kv(c_kv, k_r, w_ukv):
    B, T, _ = c_kv.shape
    kv = (c_kv @ w_ukv).reshape(B, T, MLA_HEADS, QK_NOPE + V_HEAD)
    k_nope, v = kv[..., :QK_NOPE], kv[..., QK_NOPE:]
    k = jnp.concatenate([k_nope, jnp.broadcast_to(k_r[:, :, None, :], (B, T, MLA_HEADS, QK_ROPE))], axis=-1)
    return k, v


def chunk_causal_attn(q, k, v, q_pos, k_pos):
    s = jnp.einsum('bqhd,bkhd->bhqk', q, k, preferred_element_type=jnp.float32) * ATTN_SCALE
    allowed = (k_pos[None, :] // CHUNK) <= (q_pos[:, None] // CHUNK)
    s = jnp.where(allowed[None, None], s, -jnp.inf)
    p = jax.nn.softmax(s, axis=-1).astype(v.dtype)
    return jnp.einsum('bhqk,bkhv->bqhv', p, v)


def mla_prompt(q, k, v, pos):
    B, T, H, D = q.shape
    nb = T // Q_BLOCK
    qb = q.reshape(B, nb, Q_BLOCK, H, D).swapaxes(0, 1)
    pb = pos.reshape(nb, Q_BLOCK)
    o = lax.map(lambda a: chunk_causal_attn(a[0], k, v, a[1], pos), (qb, pb))
    return o.swapaxes(0, 1).reshape(B, T, H, V_HEAD)


def gla_chunk(S, q, k, v, lg):
    q = q.astype(jnp.float32)
    k = k.astype(jnp.float32)
    v = v.astype(jnp.float32)
    L = q.shape[1]
    b = jnp.cumsum(lg, axis=1)
    o_inter = jnp.einsum('blhk,bhkv->blhv', q * jnp.exp(b), S)
    mask = jnp.tril(jnp.ones((L, L), dtype=bool))
    diff = b[:, :, None] - b[:, None, :]
    decay = jnp.exp(jnp.where(mask[None, :, :, None, None], diff, -jnp.inf))
    a = jnp.einsum('bihk,bjhk,bijhk->bhij', q, k, decay)
    o_intra = jnp.einsum('bhij,bjhv->bihv', a, v)
    b_last = b[:, -1]
    S_new = jnp.exp(b_last)[..., None] * S + jnp.einsum(
        'bjhk,bjhv->bhkv', k * jnp.exp(b_last[:, None] - b), v)
    return S_new, o_inter + o_intra


def gla_prompt(q, k, v, lg):
    B, T, H, DK = q.shape
    nc = T // CHUNK

    def to_chunks(a):
        return a.reshape((B, nc, CHUNK) + a.shape[2:]).swapaxes(0, 1)

    S0 = jnp.zeros((B, H, DK, GLA_DV), jnp.float32)
    S_fin, o = lax.scan(lambda S, xs: gla_chunk(S, *xs), S0,
                        (to_chunks(q), to_chunks(k), to_chunks(v), to_chunks(lg)))
    return S_fin, o.swapaxes(0, 1).reshape(B, T, H, GLA_DV)


def mixer_out(o_mla, o_gla, gate, g_on, w_o):
    B, T = o_mla.shape[:2]
    o_g = (rmsnorm(o_gla, g_on) * jax.nn.silu(gate.astype(jnp.float32))).astype(o_mla.dtype)
    cat = jnp.concatenate([o_mla.reshape(B, T, MLA_HEADS * V_HEAD),
                           o_g.reshape(B, T, GLA_HEADS * GLA_DV)], axis=-1)
    return cat @ w_o


def swiglu(h, w_gu, w_down):
    a, u = jnp.split(h @ w_gu, 2, axis=-1)
    return (jax.nn.silu(a) * u) @ w_down


def setup_inputs(seed: int = 0) -> dict:
    key = jax.random.key(seed)
    ks = jax.random.split(key, 20)

    def nrm(k, shape, scale):
        return jax.random.normal(k, shape, jnp.float32) * scale

    def gain(k, shape):
        return 1.0 + 0.05 * jax.random.normal(k, shape, jnp.float32)

    return {
        "x_prompt": nrm(ks[0], (BATCH, SEQ, D_MODEL), 1.0),
        "x_sample": nrm(ks[1], (DEC_BATCH, DEC_SEQ, D_MODEL), 1.0),
        "cache_ckv": nrm(ks[2], (DEPTH, DEC_BATCH, PAST_LEN, KV_LORA), 1.0),
        "cache_krope": nrm(ks[3], (DEPTH, DEC_BATCH, PAST_LEN, QK_ROPE), 1.0),
        "state_gla": nrm(ks[4], (DEPTH, DEC_BATCH, GLA_HEADS, GLA_DK, GLA_DV), 0.5),
        "g_attn": gain(ks[5], (DEPTH, D_MODEL)),
        "w_in": nrm(ks[6], (DEPTH, D_MODEL, IN_WIDTH), D_MODEL ** -0.5),
        "g_qn": gain(ks[7], (DEPTH, Q_LORA)),
        "w_uq": nrm(ks[8], (DEPTH, Q_LORA, MLA_HEADS * QK_DIM), Q_LORA ** -0.5),
        "g_kvn": gain(ks[9], (DEPTH, KV_LORA)),
        "w_ukv": nrm(ks[10], (DEPTH, KV_LORA, MLA_HEADS * (QK_NOPE + V_HEAD)), KV_LORA ** -0.5),
        "w_a2": nrm(ks[11], (DEPTH, GATE_LR, GLA_HEADS * GLA_DK), GATE_LR ** -0.5),
        "b_a2": nrm(ks[12], (DEPTH, GLA_HEADS * GLA_DK), 0.1),
        "g_gla_on": gain(ks[13], (DEPTH, GLA_DV)),
        "w_o": nrm(ks[14], (DEPTH, MIX_WIDTH, D_MODEL), MIX_WIDTH ** -0.5),
        "g_ffn": gain(ks[15], (DEPTH, D_MODEL)),
        "w_gu": nrm(ks[16], (DEPTH, D_MODEL, 2 * D_FF), D_MODEL ** -0.5),
        "w_down": nrm(ks[17], (DEPTH, D_FF, D_MODEL), D_FF ** -0.5),
        "g_final": gain(ks[18], (D_MODEL,)),
    }


def reference(x_prompt, x_sample, cache_ckv, cache_krope, state_gla,
              g_attn, w_in, g_qn, w_uq, g_kvn, w_ukv, w_a2, b_a2, g_gla_on, w_o,
              g_ffn, w_gu, w_down, g_final):
    seq = x_prompt.shape[1]
    dec_seq = x_sample.shape[1]
    past = cache_ckv.shape[2]
    pos_p = jnp.arange(seq, dtype=jnp.int32)
    pos_s = past + jnp.arange(dec_seq, dtype=jnp.int32)
    pos_all = jnp.arange(past + dec_seq, dtype=jnp.int32)

    xp, xs = x_prompt, x_sample
    ckv_p, kr_p, st_p, ckv_s, kr_s, st_s = [], [], [], [], [], []
    for l in range(DEPTH):
        proj = (w_in[l], g_qn[l], w_uq[l], g_kvn[l], w_a2[l], b_a2[l])
        h = rmsnorm(xp, g_attn[l])
        q, c_kv, k_r, gq, gk, gv, gg, lg = mixer_proj(h, pos_p, *proj)
        k, v = mla_kv(c_kv, k_r, w_ukv[l])
        o_mla = mla_prompt(q, k, v, pos_p)
        S_fin, o_gla = gla_prompt(gq, gk, gv, lg)
        xp = xp + mixer_out(o_mla, o_gla, gg, g_gla_on[l], w_o[l])
        xp = xp + swiglu(rmsnorm(xp, g_ffn[l]), w_gu[l], w_down[l])
        ckv_p.append(c_kv)
        kr_p.append(k_r)
        st_p.append(S_fin)
        h = rmsnorm(xs, g_attn[l])
        q, c_kv, k_r, gq, gk, gv, gg, lg = mixer_proj(h, pos_s, *proj)
        ckv_full = jnp.concatenate([cache_ckv[l].astype(c_kv.dtype), c_kv], axis=1)
        kr_full = jnp.concatenate([cache_krope[l].astype(k_r.dtype), k_r], axis=1)
        k, v = mla_kv(ckv_full, kr_full, w_ukv[l])
        o_mla = chunk_causal_attn(q, k, v, pos_s, pos_all)
        S_new, o_gla = gla_chunk(state_gla[l].astype(jnp.float32), gq, gk, gv, lg)
        xs = xs + mixer_out(o_mla, o_gla, gg, g_gla_on[l], w_o[l])
        xs = xs + swiglu(rmsnorm(xs, g_ffn[l]), w_gu[l], w_down[l])
        ckv_s.append(c_kv)
        kr_s.append(k_r)
        st_s.append(S_new)

    y_prompt = rmsnorm(xp, g_final)
    y_sample = rmsnorm(xs, g_final)
    new_ckv_prompt = jnp.stack(ckv_p)
    new_krope_prompt = jnp.stack(kr_p)
    new_gla_prompt = jnp.stack(st_p)
    new_ckv_sample = jnp.stack(ckv_s)
    new_krope_sample = jnp.stack(kr_s)
    new_gla_sample = jnp.stack(st_s)
    return (y_prompt, y_sample, new_ckv_prompt, new_krope_prompt, new_gla_prompt,
            new_ckv_sample, new_krope_sample, new_gla_sample)
```

```cpp
#include <hip/hip_runtime.h>
#include <hip/hip_cooperative_groups.h>
#include <cstdio>
#include <cstdint>
namespace cg = cooperative_groups;
namespace pg8 {
#define PG8_LAS __attribute__((address_space(3)))
typedef unsigned short bf16_t;
typedef short bf16x8 __attribute__((ext_vector_type(8)));
typedef float f32x4 __attribute__((ext_vector_type(4)));
typedef unsigned u32x4 __attribute__((ext_vector_type(4)));
constexpr int BM = 256, BK = 64, HALF = 128, HTB = HALF * BK * 2  , STAGE_BYTES = 8 * HTB, NXCD = 8, WGM = 8;

__host__ __device__ __forceinline__ int lds_byte(int r, int c) { const int st = (r >> 4) * 2 + (c >> 5), rr = r & 15, cc = c & 31, ob = rr * 64 + cc * 2; return st * 1024 + (ob ^ (((ob >> 9) & 1) << 5)); }
__host__ __device__ __forceinline__ void stage_rc(int b, int& R, int& C) { const int st = b / 1024, sb = b % 1024, swz = sb ^ (((sb >> 9) & 1) << 5); R = (st >> 1) * 16 + swz / 64; C = (st & 1) * 32 + (swz % 64) / 2; }
__host__ __device__ __forceinline__ int perm32(int rho) { const int n = rho >> 4, i = rho & 15; return 8 * (i >> 2) + 4 * n + (i & 3); }

struct Unit { int pm, pn; };
struct Gemm { const bf16_t* A; const bf16_t* Bt; int M, N, K; };

struct StaticOrder {
    int nM, nN, nwg, G, c;
    __host__ __device__ void init(int M, int N, int G_, int c_) { nM = M / BM; nN = N / BM; nwg = nM * nN; G = G_; c = c_; }
    __host__ __device__ bool next(int i, Unit& u) const {
        const long L = (long)i * G + c; if (L >= nwg) return false;
        int wgid = (int)L; { const int q = nwg / NXCD, r = nwg % NXCD, xcd = wgid % NXCD, off = wgid / NXCD; wgid = (xcd < r ? xcd * (q + 1) : r * (q + 1) + (xcd - r) * q) + off; }
        const int nig = WGM * nN, gid = wgid / nig, fm = gid * WGM, gsz = (nM - fm) < WGM ? (nM - fm) : WGM;
        u.pm = fm + ((wgid % nig) % gsz); u.pn = (wgid % nig) / gsz; return true;
    }
    __device__ __forceinline__ void a_ready(const Unit&) const {}
    __device__ __forceinline__ void done(const Unit&) const {}
};

__device__ __forceinline__ unsigned cvt_pk_bf16(float lo, float hi) { unsigned r; asm volatile("v_cvt_pk_bf16_f32 %0, %1, %2" : "=v"(r) : "v"(lo), "v"(hi)); return r; }
typedef float f32x2 __attribute__((ext_vector_type(2)));
struct EpiBf16 {
    static constexpr bool PERM = true, AFTER_DRAIN = false;
    bf16_t* O; int ldc; int split_cols; size_t split_stride;
    __device__ __forceinline__ void operator()(const f32x4 (&acc)[2][2][4][2], const Unit& u, int wr, int wc, int fr, int fq) const {
        const int row0 = u.pm * BM + wr * 64 + fr; int colt = u.pn * BM; bf16_t* base = O;
        if (split_cols) { const int t = colt / split_cols; base += (size_t)t * split_stride; colt -= t * split_cols; }
        const int col0 = colt + wc * 32 + 8 * fq;
#pragma unroll
        for (int ai = 0; ai < 2; ++ai)
#pragma unroll
            for (int m = 0; m < 4; ++m) { bf16_t* rowp = base + (size_t)(row0 + ai * HALF + m * 16) * ldc + col0;
#pragma unroll
                for (int bj = 0; bj < 2; ++bj) { const f32x4 v0 = acc[ai][bj][m][0], v1 = acc[ai][bj][m][1];
                    u32x4 w; w.x = cvt_pk_bf16(v0[0], v0[1]); w.y = cvt_pk_bf16(v0[2], v0[3]); w.z = cvt_pk_bf16(v1[0], v1[1]); w.w = cvt_pk_bf16(v1[2], v1[3]);
                    *(u32x4*)(rowp + bj * HALF) = w; } }
    }
};
struct EpiSwiglu {
    static constexpr bool PERM = true, AFTER_DRAIN = false;
    bf16_t* O; int ldc;
    __device__ __forceinline__ void operator()(const f32x4 (&acc)[2][2][4][2], const Unit& u, int wr, int wc, int fr, int fq) const {
        const int row0 = u.pm * BM + wr * 64 + fr; const int col0 = u.pn * HALF + wc * 32 + 8 * fq;
#pragma unroll
        for (int ai = 0; ai < 2; ++ai)
#pragma unroll
            for (int m = 0; m < 4; ++m) { bf16_t* rowp = O + (size_t)(row0 + ai * HALF + m * 16) * ldc + col0;
                float r[8];
#pragma unroll
                for (int n = 0; n < 2; ++n)
#pragma unroll
                    for (int i = 0; i < 4; ++i) { const float a = acc[ai][0][m][n][i], uu = acc[ai][1][m][n][i];
                        r[n * 4 + i] = a * __builtin_amdgcn_rcpf(1.0f + __expf(-a)) * uu; }
                u32x4 w; w.x = cvt_pk_bf16(r[0], r[1]); w.y = cvt_pk_bf16(r[2], r[3]); w.z = cvt_pk_bf16(r[4], r[5]); w.w = cvt_pk_bf16(r[6], r[7]);
                *(u32x4*)rowp = w; }
    }
};
struct EpiRes {
    static constexpr bool PERM = false, AFTER_DRAIN = false;
    float* X; int ldc;
    __device__ __forceinline__ void operator()(const f32x4 (&acc)[2][2][4][2], const Unit& u, int wr, int wc, int fr, int fq) const {
        const int col0 = u.pn * BM + wc * 32 + 4 * fq;
#pragma unroll
        for (int ai = 0; ai < 2; ++ai)
#pragma unroll
            for (int m = 0; m < 4; ++m) { float* rowp = X + (size_t)(u.pm * BM + ai * HALF + wr * 64 + m * 16 + fr) * ldc + col0;
#pragma unroll
                for (int bj = 0; bj < 2; ++bj)
#pragma unroll
                    for (int n = 0; n < 2; ++n) { f32x4* p = (f32x4*)(rowp + bj * HALF + n * 16); *p = *p + acc[ai][bj][m][n]; }
                asm volatile("" ::: "memory"); }
    }
};
template <class Epi, class Sched, bool ALIGN_EPI = false, bool SP2 = false>
__device__ __forceinline__ void gemm_phase(PG8_LAS unsigned char* lds, const Gemm g, const Sched& S, const Epi& E) {
    int tid_ = threadIdx.x; asm volatile("" : "+v"(tid_));
    const int tid = tid_, wid = __builtin_amdgcn_readfirstlane(tid >> 6), lane = tid & 63, wr = wid >> 2, wc = wid & 3, fr = lane & 15, fq = lane >> 4;
    const int K = g.K, nt = K / BK;
    unsigned voffA[2], voffB[2];
#pragma unroll
    for (int i = 0; i < 2; ++i) { int R, C; stage_rc(tid * 16 + i * 8192, R, C); const int Rb = Epi::PERM ? ((R & ~31) + perm32(R & 31)) : R;
        voffA[i] = (unsigned)(R * K + C) * 2u; voffB[i] = (unsigned)(Rb * K + C) * 2u; }
    const size_t kstep = (size_t)(BK * 2);
    const size_t hstep = (size_t)HALF * K * 2;
    const size_t tstep = 2 * hstep;
    const unsigned ldsw = (unsigned)wid * 1024u;
    const int aoff = lds_byte(wr * 64 + fr, fq * 8), boff = lds_byte(wc * 32 + fr, fq * 8);
#define PG8_SA(b, h) (((b) * 2 + (h)) * HTB)
#define PG8_SB(b, h) ((4 + (b) * 2 + (h)) * HTB)
#define PG8_STAGE(bufoff, gbase, voff) do { _Pragma("unroll") for (int _i = 0; _i < 2; ++_i) \
        __builtin_amdgcn_global_load_lds((const unsigned*)((const char*)(gbase) + (voff)[_i]), (PG8_LAS unsigned*)(lds + (bufoff) + ldsw + _i * 8192), 16, 0, 0); } while (0)
#define PG8_LDA(dst, b, h) do { _Pragma("unroll") for (int m = 0; m < 4; ++m) _Pragma("unroll") for (int k = 0; k < 2; ++k) dst[m][k] = *(const PG8_LAS bf16x8*)(lds + PG8_SA(b, h) + aoff + m * 2048 + k * 1024); } while (0)
#define PG8_LDB(dst, b, h) do { _Pragma("unroll") for (int n = 0; n < 2; ++n) _Pragma("unroll") for (int k = 0; k < 2; ++k) dst[n][k] = *(const PG8_LAS bf16x8*)(lds + PG8_SB(b, h) + boff + n * 2048 + k * 1024); } while (0)
#define PG8_MMA(ai, bj, At, Bt) do { __builtin_amdgcn_s_setprio(1); _Pragma("unroll") for (int m = 0; m < 4; ++m) _Pragma("unroll") for (int n = 0; n < 2; ++n) _Pragma("unroll") for (int k = 0; k < 2; ++k) \
        acc[ai][bj][m][n] = __builtin_amdgcn_mfma_f32_16x16x32_bf16(Bt[n][k], At[m][k], acc[ai][bj][m][n], 0, 0, 0); __builtin_amdgcn_s_setprio(0); } while (0)
#define PG8_WAIT_V(n) asm volatile("s_waitcnt vmcnt(" #n ")" ::: "memory")
#define PG8_WAIT_L(n) asm volatile("s_waitcnt lgkmcnt(" #n ")" ::: "memory")
#define PG8_BAR __builtin_amdgcn_s_barrier()
#define PG8_SCHED __builtin_amdgcn_sched_barrier(0)
    Unit cur, nxt; int ui = 0;
    if (!S.next(0, cur)) return;
    f32x4 acc[2][2][4][2];
#pragma unroll
    for (int a = 0; a < 2; ++a)
#pragma unroll
        for (int b = 0; b < 2; ++b)
#pragma unroll
            for (int m = 0; m < 4; ++m)
#pragma unroll
                for (int n = 0; n < 2; ++n) acc[a][b][m][n] = (f32x4){0.f, 0.f, 0.f, 0.f};
    bf16x8 At[4][2], B0[2][2], B1[2][2];
    const char* cA = (const char*)g.A + (size_t)cur.pm * tstep; const char* cB = (const char*)g.Bt + (size_t)cur.pn * tstep;
    S.a_ready(cur);
    if constexpr (SP2) {
        PG8_STAGE(PG8_SB(0, 0), cB, voffB); PG8_STAGE(PG8_SB(0, 1), cB + hstep, voffB); PG8_STAGE(PG8_SA(0, 0), cA, voffA); PG8_STAGE(PG8_SA(0, 1), cA + hstep, voffA);
        if (wr == 1) PG8_BAR;
        PG8_WAIT_V(2); PG8_BAR;
        PG8_STAGE(PG8_SB(1, 0), cB + kstep, voffB); PG8_STAGE(PG8_SA(1, 0), cA + kstep, voffA); PG8_STAGE(PG8_SB(1, 1), cB + hstep + kstep, voffB);
        PG8_WAIT_V(6); PG8_BAR;
    } else {
        PG8_STAGE(PG8_SB(0, 0), cB, voffB); PG8_STAGE(PG8_SA(0, 0), cA, voffA); PG8_STAGE(PG8_SB(0, 1), cB + hstep, voffB); PG8_STAGE(PG8_SA(0, 1), cA + hstep, voffA);
        if (wr == 1) PG8_BAR;
        PG8_WAIT_V(4); PG8_BAR;
        PG8_STAGE(PG8_SB(1, 0), cB + kstep, voffB); PG8_STAGE(PG8_SA(1, 0), cA + kstep, voffA); PG8_STAGE(PG8_SB(1, 1), cB + hstep + kstep, voffB);
        PG8_WAIT_V(6); PG8_BAR;
    }
    for (;;) {
        const bool has_next = S.next(ui + 1, nxt);
        const char* nA = has_next ? (const char*)g.A + (size_t)nxt.pm * tstep : cA; const char* nB = has_next ? (const char*)g.Bt + (size_t)nxt.pn * tstep : cB;
        for (int t = 0; t < nt; t += 2) {
            const bool last = (t == nt - 2);
            const char* a1 = cA + (size_t)(t + 1) * kstep;
            const char* a2 = last ? nA : cA + (size_t)(t + 2) * kstep; const char* b2 = last ? nB : cB + (size_t)(t + 2) * kstep;
            const char* a3 = a2 + kstep; const char* b3 = b2 + kstep;
            if (last && has_next) S.a_ready(nxt);
            if constexpr (SP2) {
            PG8_LDB(B0, 0, 0); PG8_LDB(B1, 0, 1); PG8_SCHED; PG8_LDA(At, 0, 0); PG8_STAGE(PG8_SA(1, 1), a1 + hstep, voffA);
            PG8_WAIT_V(8); PG8_WAIT_L(0); PG8_BAR; PG8_MMA(0, 0, At, B0); PG8_MMA(0, 1, At, B1); PG8_BAR; PG8_SCHED;
            PG8_LDA(At, 0, 1); PG8_STAGE(PG8_SB(0, 0), b2, voffB); PG8_STAGE(PG8_SB(0, 1), b2 + hstep, voffB); PG8_STAGE(PG8_SA(0, 0), a2, voffA);
            PG8_WAIT_V(8); PG8_WAIT_L(0); PG8_BAR; PG8_MMA(1, 0, At, B0); PG8_MMA(1, 1, At, B1); PG8_BAR; PG8_SCHED;
            PG8_LDB(B0, 1, 0); PG8_LDB(B1, 1, 1); PG8_SCHED; PG8_LDA(At, 1, 0); PG8_STAGE(PG8_SA(0, 1), a2 + hstep, voffA);
            PG8_WAIT_V(8); PG8_WAIT_L(0); PG8_BAR; PG8_MMA(0, 0, At, B0); PG8_MMA(0, 1, At, B1); PG8_BAR; PG8_SCHED;
            PG8_LDA(At, 1, 1); PG8_STAGE(PG8_SB(1, 0), b3, voffB); PG8_STAGE(PG8_SB(1, 1), b3 + hstep, voffB); PG8_STAGE(PG8_SA(1, 0), a3, voffA);
            PG8_WAIT_V(8); PG8_WAIT_L(0); PG8_BAR; PG8_MMA(1, 0, At, B0); PG8_MMA(1, 1, At, B1); PG8_BAR; PG8_SCHED;
            } else {
            PG8_LDB(B0, 0, 0); PG8_SCHED; PG8_LDA(At, 0, 0); PG8_STAGE(PG8_SA(1, 1), a1 + hstep, voffA);
            PG8_WAIT_L(8); PG8_BAR; PG8_WAIT_L(0); PG8_MMA(0, 0, At, B0); PG8_BAR; PG8_SCHED;
            PG8_LDB(B1, 0, 1); PG8_STAGE(PG8_SB(0, 0), b2, voffB);
            PG8_BAR; PG8_WAIT_L(0); PG8_MMA(0, 1, At, B1); PG8_BAR;
            PG8_LDA(At, 0, 1); PG8_STAGE(PG8_SA(0, 0), a2, voffA);
            PG8_BAR; PG8_WAIT_L(0); PG8_MMA(1, 0, At, B0); PG8_BAR; PG8_SCHED;
            PG8_STAGE(PG8_SB(0, 1), b2 + hstep, voffB);
            PG8_WAIT_V(6); PG8_BAR; PG8_MMA(1, 1, At, B1); PG8_BAR;
            PG8_LDB(B0, 1, 0); PG8_SCHED; PG8_LDA(At, 1, 0); PG8_STAGE(PG8_SA(0, 1), a2 + hstep, voffA);
            PG8_WAIT_L(8); PG8_BAR; PG8_WAIT_L(0); PG8_MMA(0, 0, At, B0); PG8_BAR; PG8_SCHED;
            PG8_LDB(B1, 1, 1); PG8_STAGE(PG8_SB(1, 0), b3, voffB);
            PG8_BAR; PG8_WAIT_L(0); PG8_MMA(0, 1, At, B1); PG8_BAR;
            PG8_LDA(At, 1, 1); PG8_STAGE(PG8_SA(1, 0), a3, voffA);
            PG8_BAR; PG8_WAIT_L(0); PG8_MMA(1, 0, At, B0); PG8_BAR; PG8_SCHED;
            PG8_STAGE(PG8_SB(1, 1), b3 + hstep, voffB);
            PG8_WAIT_V(6); PG8_BAR; PG8_MMA(1, 1, At, B1); PG8_BAR;
            }
        }
        if constexpr (ALIGN_EPI) { if (wr == 0) PG8_BAR; }
        if constexpr (!Epi::AFTER_DRAIN) { E(acc, cur, wr, wc, fr, fq); S.done(cur); }
        if (!has_next) break;
#pragma unroll
        for (int a = 0; a < 2; ++a)
#pragma unroll
            for (int b = 0; b < 2; ++b)
#pragma unroll
                for (int m = 0; m < 4; ++m)
#pragma unroll
                    for (int n = 0; n < 2; ++n) acc[a][b][m][n] = (f32x4){0.f, 0.f, 0.f, 0.f};
        cur = nxt; cA = nA; cB = nB; ++ui;
        if constexpr (ALIGN_EPI) { if (wr == 1) PG8_BAR; }
    }
    PG8_WAIT_V(0);
    if constexpr (!ALIGN_EPI) { if (wr == 0) PG8_BAR; }
    PG8_BAR;
    if constexpr (Epi::AFTER_DRAIN) { E.fused(acc, cur, wr, wc, fr, fq, lds, wid, lane); S.done(cur); }
#undef PG8_SA
#undef PG8_SB
#undef PG8_STAGE
#undef PG8_LDA
#undef PG8_LDB
#undef PG8_MMA
#undef PG8_WAIT_V
#undef PG8_WAIT_L
#undef PG8_BAR
#undef PG8_SCHED
}
}
constexpr int DM = 1024, SEQ = 16384, NBATCH = 2, NP = NBATCH * SEQ, DEC_B = 16, DEC_T = 32, PAST = 2048, SKV = PAST + DEC_T;
constexpr int NSQ = DEC_B * DEC_T, NTOK = NP + NSQ, NKVS = DEC_B * SKV;
constexpr int DFF = 2816, INW = 2096, DEPTH = 2;
constexpr float EPS = 1e-6f;
constexpr float QSCALE = 0.10206207261596575f * 1.4426950408889634f;
constexpr int NITEM_P = NBATCH * 256 * 4, NITEM = NITEM_P + DEC_B * 4;

typedef unsigned short bf16;
typedef short bf16x8 __attribute__((ext_vector_type(8)));
typedef float f32x4 __attribute__((ext_vector_type(4)));
typedef float f32x16 __attribute__((ext_vector_type(16)));
typedef unsigned u32x4 __attribute__((ext_vector_type(4)));
typedef unsigned u32x2 __attribute__((ext_vector_type(2)));
#define LAS __attribute__((address_space(3)))

constexpr size_t T256 = (size_t)NTOK * 256 * 2;
constexpr size_t al(size_t x) { return (x + 4095) & ~(size_t)4095; }
constexpr size_t WS_ROPE = 4096;
constexpr size_t WS_GA = al(WS_ROPE + (size_t)SEQ * 32 * 4);
constexpr size_t WS_DECAY = al(WS_GA + (size_t)NTOK * 16 * 4);
constexpr size_t WS_WIN = al(WS_DECAY + (size_t)NITEM * 64 * 4);
constexpr size_t WS_WGV = al(WS_WIN + (size_t)1792 * 1024 * 2);
constexpr size_t WS_WUQ = al(WS_WGV + (size_t)512 * 1024 * 2);
constexpr size_t WS_WUK = al(WS_WUQ + (size_t)768 * 256 * 2);
constexpr size_t WS_WUV = al(WS_WUK + (size_t)512 * 256 * 2);
constexpr size_t WS_WO = al(WS_WUV + (size_t)512 * 256 * 2);
constexpr size_t WS_WGU = al(WS_WO + (size_t)1024 * 1024 * 2);
constexpr size_t WS_WD = al(WS_WGU + (size_t)5632 * 1024 * 2);
constexpr size_t WS_H = al(WS_WD + (size_t)1024 * 2816 * 2);
constexpr size_t WS_Z = al(WS_H + (size_t)NTOK * 1024 * 2);
constexpr size_t WS_GVT = al(WS_Z + 7 * T256);
constexpr size_t WS_CQN = al(WS_GVT + (size_t)512 * NTOK * 2);
constexpr size_t WS_CKVN = al(WS_CQN + T256);
constexpr size_t WS_CKVS = al(WS_CKVN + (size_t)NP * 256 * 2);
constexpr size_t WS_KR = al(WS_CKVS + (size_t)NKVS * 256 * 2);
constexpr size_t WS_KRS = al(WS_KR + (size_t)NP * 32 * 2);
constexpr size_t WS_KN = al(WS_KRS + (size_t)NKVS * 32 * 2);
constexpr size_t WS_VT = al(WS_KN + (size_t)NP * 512 * 2);
constexpr size_t WS_KNS = al(WS_VT + (size_t)512 * NP * 2);
constexpr size_t WS_VTS = al(WS_KNS + (size_t)NKVS * 512 * 2);
constexpr size_t WS_DS = al(WS_VTS + (size_t)512 * NKVS * 2);
constexpr size_t WS_END = al(WS_DS + (size_t)NITEM_P * 8192 * 4);
constexpr size_t WS_ACT = WS_Z;
static_assert(WS_ACT + (size_t)NTOK * DFF * 2 <= WS_END, "ACT overlay");
static_assert(WS_END <= (size_t)536870912, "ws budget");

constexpr size_t O_Y = 0, O_CKVP = (size_t)NTOK * DM, O_KRP = O_CKVP + (size_t)DEPTH * NP * 256, O_GLAP = O_KRP + (size_t)DEPTH * NP * 32,
                 O_CKVS = O_GLAP + (size_t)DEPTH * NBATCH * 4 * 8192, O_KRS = O_CKVS + (size_t)DEPTH * NSQ * 256, O_GLAS = O_KRS + (size_t)DEPTH * NSQ * 32,
                 O_END = O_GLAS + (size_t)DEPTH * DEC_B * 4 * 8192;

constexpr int LDS_BYTES = 147456;

struct Args {
    const float *xp, *xs, *cckv, *ckr, *sgla, *g_attn, *w_in, *g_qn, *w_uq, *g_kvn, *w_ukv, *w_a2, *b_a2, *g_on, *w_o, *g_ffn, *w_gu, *w_down, *g_final;
    float* out; unsigned char* ws;
};

__device__ __forceinline__ unsigned f2bf(float f) { unsigned u = __builtin_bit_cast(unsigned, f); return (u + 0x7fffu + ((u >> 16) & 1u)) >> 16; }
__device__ __forceinline__ unsigned pk2(float lo, float hi) { return f2bf(lo) | (f2bf(hi) << 16); }
__device__ __forceinline__ float bf2f(unsigned short b) { return __builtin_bit_cast(float, (unsigned)b << 16); }
__device__ __forceinline__ float bflo(unsigned w) { return __builtin_bit_cast(float, w << 16); }
__device__ __forceinline__ float bfhi(unsigned w) { return __builtin_bit_cast(float, w & 0xffff0000u); }
__device__ __forceinline__ float wave_sum(float v) {
#pragma unroll
    for (int o = 1; o < 64; o <<= 1) v += __shfl_xor(v, o);
    return v;
}
__device__ __forceinline__ int crow(int r, int hi) { return (r & 3) + 8 * (r >> 2) + 4 * hi; }
__device__ __forceinline__ float logsig(float x) { return fminf(x, 0.f) - __logf(1.0f + __expf(-fabsf(x))); }
#define LDS_WAIT() asm volatile("s_waitcnt lgkmcnt(0)" ::: "memory")
#define MFMA32(a, b, c) __builtin_amdgcn_mfma_f32_32x32x16_bf16((a), (b), (c), 0, 0, 0)

struct Ctx {
    int tid, lane, wave, G, vcu, gw, NGW;
    LAS unsigned char* lds;
};

__device__ __forceinline__ void tr_item(const float* W, int K, int N, int k0, int src0, int nvalid, bf16* WT, int dst_row0, float scale, LAS float* scr, int lane) {
#pragma unroll 8
    for (int i = 0; i < 32; ++i) { const int kk = 2 * i + (lane >> 5), c = lane & 31;
        float v = 0.f; if (c < nvalid) v = W[(size_t)(k0 + kk) * N + src0 + c] * scale;
        scr[kk * 33 + c] = v; }
    LDS_WAIT(); asm volatile("" ::: "memory");
    const int c8 = lane & 7;
#pragma unroll
    for (int j = 0; j < 4; ++j) { const int n = (lane >> 3) + 8 * j; const LAS float* s = scr + (8 * c8) * 33 + n;
        u32x4 o; o.x = pk2(s[0 * 33], s[1 * 33]); o.y = pk2(s[2 * 33], s[3 * 33]); o.z = pk2(s[4 * 33], s[5 * 33]); o.w = pk2(s[6 * 33], s[7 * 33]);
        *(u32x4*)(WT + (size_t)(dst_row0 + n) * K + k0 + 8 * c8) = o; }
    LDS_WAIT(); asm volatile("" ::: "memory");
}
__device__ __forceinline__ void convert_weights(const Ctx& C, const Args& A, int l) {
    LAS float* scr = (LAS float*)(C.lds + C.wave * 16384);
    unsigned char* ws = A.ws;
    const float* w_in = A.w_in + (size_t)l * DM * INW; const float* w_uq = A.w_uq + (size_t)l * 256 * 768; const float* w_ukv = A.w_ukv + (size_t)l * 256 * 1024;
    const float* w_o = A.w_o + (size_t)l * DM * DM; const float* w_gu = A.w_gu + (size_t)l * DM * 2 * DFF; const float* w_d = A.w_down + (size_t)l * DFF * DM;
    constexpr int I0 = 56 * 16, I1 = 16 * 16, I2 = 24 * 4, I3 = 16 * 4, I4 = 16 * 4, I5 = 32 * 16, I6 = 176 * 16, I7 = 32 * 44;
    constexpr int NIT = I0 + I1 + I2 + I3 + I4 + I5 + I6 + I7;
    for (int it = C.gw; it < NIT; it += C.NGW) {
        int r = it;
        if (r < I0) { const int db = r >> 4, kb = r & 15; int src = 0, nv = 32;
            if (db < 16) src = 32 * db; else if (db == 16) src = 512; else if (db == 17) { src = 2080; nv = 16; } else if (db < 24) { src = 0; nv = 0; }
            else if (db < 32) src = 544 + 32 * (db - 24); else if (db < 40) src = 800 + 32 * (db - 32); else src = 1568 + 32 * (db - 40);
            tr_item(w_in, DM, INW, 64 * kb, src, nv, (bf16*)(ws + WS_WIN), 32 * db, 1.f, scr, C.lane); continue; } r -= I0;
        if (r < I1) { const int db = r >> 4, kb = r & 15; tr_item(w_in, DM, INW, 64 * kb, 1056 + 32 * db, 32, (bf16*)(ws + WS_WGV), 32 * db, 1.f, scr, C.lane); continue; } r -= I1;
        if (r < I2) { const int db = r >> 2, kb = r & 3; tr_item(w_uq, 256, 768, 64 * kb, 32 * db, 32, (bf16*)(ws + WS_WUQ), 32 * db, QSCALE, scr, C.lane); continue; } r -= I2;
        if (r < I3) { const int db = r >> 2, kb = r & 3; tr_item(w_ukv, 256, 1024, 64 * kb, (db >> 1) * 128 + (db & 1) * 32, 32, (bf16*)(ws + WS_WUK), 32 * db, 1.f, scr, C.lane); continue; } r -= I3;
        if (r < I4) { const int db = r >> 2, kb = r & 3; tr_item(w_ukv, 256, 1024, 64 * kb, (db >> 1) * 128 + 64 + (db & 1) * 32, 32, (bf16*)(ws + WS_WUV), 32 * db, 1.f, scr, C.lane); continue; } r -= I4;
        if (r < I5) { const int db = r >> 4, kb = r & 15; tr_item(w_o, DM, DM, 64 * kb, 32 * db, 32, (bf16*)(ws + WS_WO), 32 * db, 1.f, scr, C.lane); continue; } r -= I5;
        if (r < I6) { const int db = r >> 4, kb = r & 15; const int pn = db >> 3, t = db & 7; const int src = (t < 4) ? 128 * pn + 32 * t : DFF + 128 * pn + 32 * (t - 4);
            tr_item(w_gu, DM, 2 * DFF, 64 * kb, src, 32, (bf16*)(ws + WS_WGU), 32 * db, 1.f, scr, C.lane); continue; } r -= I6;
        { const int db = r / 44, kb = r % 44; tr_item(w_d, DFF, DM, 64 * kb, 32 * db, 32, (bf16*)(ws + WS_WD), 32 * db, 1.f, scr, C.lane); }
    }
}

__device__ __forceinline__ void norm_row(const float* xrow, const float* g, bf16* orow, float* copy, int lane) {
    const f32x4* xr = (const f32x4*)xrow + lane; const f32x4* gr = (const f32x4*)g + lane;
    f32x4 v[4]; float s = 0.f;
#pragma unroll
    for (int j = 0; j < 4; ++j) { v[j] = xr[64 * j]; s += (v[j].x * v[j].x + v[j].y * v[j].y) + (v[j].z * v[j].z + v[j].w * v[j].w); }
    const float rstd = 1.0f / sqrtf(wave_sum(s) * (1.f / DM) + EPS);
    if (copy) {
#pragma unroll
        for (int j = 0; j < 4; ++j) ((f32x4*)copy + lane)[64 * j] = v[j]; }
    u32x2* o8 = (u32x2*)orow + lane;
#pragma unroll
    for (int j = 0; j < 4; ++j) { const f32x4 gg = gr[64 * j]; u32x2 w; w.x = pk2(v[j].x * rstd * gg.x, v[j].y * rstd * gg.y); w.y = pk2(v[j].z * rstd * gg.z, v[j].w * rstd * gg.w); o8[64 * j] = w; }
}
__device__ __forceinline__ void final_norm_row(float* xrow, const float* g, int lane) {
    f32x4* xr = (f32x4*)xrow + lane; const f32x4* gr = (const f32x4*)g + lane;
    f32x4 v[4]; float s = 0.f;
#pragma unroll
    for (int j = 0; j < 4; ++j) { v[j] = xr[64 * j]; s += (v[j].x * v[j].x + v[j].y * v[j].y) + (v[j].z * v[j].z + v[j].w * v[j].w); }
    const float rstd = 1.0f / sqrtf(wave_sum(s) * (1.f / DM) + EPS);
#pragma unroll
    for (int j = 0; j < 4; ++j) { const f32x4 gg = gr[64 * j]; xr[64 * j] = v[j] * rstd * gg; }
}

__device__ __forceinline__ void p3_token(const Args& A, int l, int m, int lane) {
    unsigned char* ws = A.ws;
    const bf16* CQ = (const bf16*)(ws + WS_Z); const bf16* CKV = (const bf16*)(ws + WS_Z + T256); const bf16* MISC = (const bf16*)(ws + WS_Z + 2 * T256);
    const float* ROPE = (const float*)(ws + WS_ROPE);
    { const u32x2 w = *((const u32x2*)(CQ + (size_t)m * 256) + lane); const float a = bflo(w.x), b = bfhi(w.x), c = bflo(w.y), d = bfhi(w.y);
      const float rstd = 1.0f / sqrtf(wave_sum((a * a + b * b) + (c * c + d * d)) * (1.f / 256) + EPS);
      const f32x4 g = *((const f32x4*)(A.g_qn + l * 256) + lane);
      u32x2 o; o.x = pk2(a * rstd * g.x, b * rstd * g.y); o.y = pk2(c * rstd * g.z, d * rstd * g.w);
      *((u32x2*)((bf16*)(ws + WS_CQN) + (size_t)m * 256) + lane) = o; }
    int pos; float* ockv; float* okr; bf16* bckv; bf16* bkr;
    if (m < NP) { pos = m & (SEQ - 1); ockv = A.out + O_CKVP + ((size_t)l * NP + m) * 256; okr = A.out + O_KRP + ((size_t)l * NP + m) * 32;
        bckv = (bf16*)(ws + WS_CKVN) + (size_t)m * 256; bkr = (bf16*)(ws + WS_KR) + (size_t)m * 32; }
    else { const int s = m - NP, b = s >> 5, t = s & 31; pos = PAST + t; ockv = A.out + O_CKVS + ((size_t)l * NSQ + s) * 256; okr = A.out + O_KRS + ((size_t)l * NSQ + s) * 32;
        const size_t r = (size_t)b * SKV + PAST + t; bckv = (bf16*)(ws + WS_CKVS) + r * 256; bkr = (bf16*)(ws + WS_KRS) + r * 32; }
    { const u32x2 w = *((const u32x2*)(CKV + (size_t)m * 256) + lane); const float a = bflo(w.x), b = bfhi(w.x), c = bflo(w.y), d = bfhi(w.y);
      const float rstd = 1.0f / sqrtf(wave_sum((a * a + b * b) + (c * c + d * d)) * (1.f / 256) + EPS);
      const f32x4 g = *((const f32x4*)(A.g_kvn + l * 256) + lane);
      const f32x4 o = (f32x4){a * rstd * g.x, b * rstd * g.y, c * rstd * g.z, d * rstd * g.w};
      *((f32x4*)ockv + lane) = o;
      u32x2 ob; ob.x = pk2(o.x, o.y); ob.y = pk2(o.z, o.w); *((u32x2*)bckv + lane) = ob; }
    if (lane < 16) { const float x1 = bf2f(MISC[(size_t)m * 256 + lane]), x2 = bf2f(MISC[(size_t)m * 256 + 16 + lane]);
        const float c = ROPE[pos * 32 + lane], s = ROPE[pos * 32 + 16 + lane];
        const float o1 = x1 * c - x2 * s, o2 = x1 * s + x2 * c;
        okr[lane] = o1; okr[16 + lane] = o2; bkr[lane] = (bf16)f2bf(o1); bkr[16 + lane] = (bf16)f2bf(o2); }
    else if (lane < 32) { ((float*)(ws + WS_GA))[(size_t)m * 16 + (lane - 16)] = bf2f(MISC[(size_t)m * 256 + 32 + (lane - 16)]); }
}
__device__ __forceinline__ void cache_row(const Args& A, int l, int r, int lane) {
    const int b = r >> 11, p = r & (PAST - 1); const size_t dr = (size_t)b * SKV + p;
    const f32x4 v = *((const f32x4*)(A.cckv + ((size_t)l * DEC_B * PAST + r) * 256) + lane);
    u32x2 o; o.x = pk2(v.x, v.y); o.y = pk2(v.z, v.w); *((u32x2*)((bf16*)(A.ws + WS_CKVS) + dr * 256) + lane) = o;
    if (lane < 32) ((bf16*)(A.ws + WS_KRS))[dr * 32 + lane] = (bf16)f2bf(A.ckr[((size_t)l * DEC_B * PAST + r) * 32 + lane]);
}

struct GlaItem { int tok0, L, hd, sb; bool sample; };
__device__ __forceinline__ GlaItem gla_decode(int it) {
    GlaItem g;
    if (it < NITEM_P) { g.hd = it & 3; const int bc = it >> 2; g.tok0 = bc * 64; g.L = 64; g.sample = false; g.sb = 0; }
    else { const int j = it - NITEM_P; g.hd = j & 3; g.sb = j >> 2; g.tok0 = NP + g.sb * 32; g.L = 32; g.sample = true; }
    return g;
}
constexpr int KT_PITCH = 72;
__device__ __forceinline__ void gla_g1(const Args& A, int l, int it, LAS unsigned char* wl, int lane) {
    const GlaItem g = gla_decode(it); unsigned char* ws = A.ws;
    const int col = g.hd * 64 + lane, r32 = lane & 31, hi = lane >> 5;
    const float* GA = (const float*)(ws + WS_GA); const bf16* GK = (const bf16*)(ws + WS_Z + 4 * T256); const bf16* GVT = (const bf16*)(ws + WS_GVT);
    LAS bf16* kT = (LAS bf16*)wl; LAS float* dsm = (LAS float*)(wl + 64 * KT_PITCH * 2);
    float w[16];
#pragma unroll
    for (int r = 0; r < 16; ++r) w[r] = A.w_a2[(size_t)l * 16 * 256 + r * 256 + col];
    const float bias = A.b_a2[l * 256 + col];
    float blast = 0.f;
    for (int p = 0; p < g.L; ++p) { const float* ga = GA + (size_t)(g.tok0 + p) * 16; float x = bias;
#pragma unroll
        for (int r = 0; r < 16; ++r) x += ga[r] * w[r];
        blast += logsig(x) * (1.f / 16.f); }
    float bc = 0.f;
    for (int p = 0; p < g.L; ++p) { const float* ga = GA + (size_t)(g.tok0 + p) * 16; float x = bias;
#pragma unroll
        for (int r = 0; r < 16; ++r) x += ga[r] * w[r];
        bc += logsig(x) * (1.f / 16.f);
        const float kk = bf2f(GK[(size_t)(g.tok0 + p) * 256 + col]) * __expf(blast - bc);
        kT[lane * KT_PITCH + p] = (bf16)f2bf(kk); }
    const float decay = __expf(blast);
    if (!g.sample) ((float*)(ws + WS_DECAY))[(size_t)it * 64 + lane] = decay;
    dsm[lane] = decay;
    LDS_WAIT(); asm volatile("" ::: "memory");
    const int nks = g.L >> 4;
#pragma unroll 1
    for (int nb = 0; nb < 4; ++nb) {
        f32x16 acc[2]; acc[0] = (f32x16){}; acc[1] = (f32x16){};
        for (int s = 0; s < nks; ++s) {
            const bf16x8 bfr = *(const bf16x8*)(GVT + (size_t)(g.hd * 128 + 32 * nb + r32) * NTOK + g.tok0 + 16 * s + 8 * hi);
#pragma unroll
            for (int mb = 0; mb < 2; ++mb) { const bf16x8 af = *(const LAS bf16x8*)(kT + (32 * mb + r32) * KT_PITCH + 16 * s + 8 * hi); acc[mb] = MFMA32(af, bfr, acc[mb]); }
        }
        const int dv = 32 * nb + r32;
        if (!g.sample) { float* dsp = (float*)(ws + WS_DS) + (size_t)it * 8192 + dv;
#pragma unroll
            for (int mb = 0; mb < 2; ++mb)
#pragma unroll
                for (int r = 0; r < 16; ++r) dsp[(32 * mb + crow(r, hi)) * 128] = acc[mb][r]; }
        else { const size_t so = (((size_t)l * DEC_B + g.sb) * 4 + g.hd) * 8192 + dv;
#pragma unroll
            for (int mb = 0; mb < 2; ++mb) {
#pragma unroll
                for (int r = 0; r < 16; ++r) { const int dk = 32 * mb + crow(r, hi); A.out[O_GLAS + so + dk * 128] = dsm[dk] * A.sgla[so + dk * 128] + acc[mb][r]; }
                asm volatile("" ::: "memory"); } }
    }
    LDS_WAIT(); asm volatile("" ::: "memory");
}
constexpr int NSCAN = 64;
__device__ __forceinline__ void gla_scan(const Args& A, int l, int sblock, int tid) {
    const int gth = sblock * 512 + tid;
    const int seq = gth >> 12, e0 = (gth & 4095) * 2;
    const int b = seq >> 2, hd = seq & 3, dk = e0 >> 7;
    float* DS = (float*)(A.ws + WS_DS); const float* DEC = (const float*)(A.ws + WS_DECAY);
    float s0 = 0.f, s1 = 0.f;
    for (int c0 = 0; c0 < 256; c0 += 8) {
        float2 ds[8]; float dc[8];
#pragma unroll
        for (int j = 0; j < 8; ++j) { const size_t it = (size_t)((b * 256 + c0 + j) * 4 + hd); ds[j] = *(const float2*)(DS + it * 8192 + e0); dc[j] = DEC[it * 64 + dk]; }
#pragma unroll
        for (int j = 0; j < 8; ++j) { const size_t it = (size_t)((b * 256 + c0 + j) * 4 + hd); *(float2*)(DS + it * 8192 + e0) = make_float2(s0, s1);
            s0 = dc[j] * s0 + ds[j].x; s1 = dc[j] * s1 + ds[j].y; }
    }
    *(float2*)(A.out + O_GLAP + (((size_t)l * NBATCH + b) * 4 + hd) * 8192 + e0) = make_float2(s0, s1);
}
constexpr int BS_PITCH = 65;
__device__ __forceinline__ void gla_g3(const Args& A, int l, int it, LAS unsigned char* wl, int lane) {
    const GlaItem g = gla_decode(it); unsigned char* ws = A.ws;
    const int col = g.hd * 64 + lane, r32 = lane & 31, hi = lane >> 5;
    const float* GA = (const float*)(ws + WS_GA); const bf16* GQ = (const bf16*)(ws + WS_Z + 3 * T256); const bf16* GK = (const bf16*)(ws + WS_Z + 4 * T256);
    const bf16* GG = (const bf16*)(ws + WS_Z + 5 * T256); const bf16* GVT = (const bf16*)(ws + WS_GVT); bf16* CAT = (bf16*)(ws + WS_H);
    LAS float* bsm = (LAS float*)wl;
    {   float w[16];
#pragma unroll
        for (int r = 0; r < 16; ++r) w[r] = A.w_a2[(size_t)l * 16 * 256 + r * 256 + col];
        const float bias = A.b_a2[l * 256 + col];
        float bc = 0.f;
        for (int p = 0; p < g.L; ++p) { const float* ga = GA + (size_t)(g.tok0 + p) * 16; float x = bias;
#pragma unroll
            for (int r = 0; r < 16; ++r) x += ga[r] * w[r];
            bc += logsig(x) * (1.f / 16.f); bsm[p * BS_PITCH + lane] = bc; }
    }
    LDS_WAIT(); asm volatile("" ::: "memory");
    const int nib = g.L >> 5;
    bf16x8 qf[2][4], kf[2][4];
#pragma unroll
    for (int ib = 0; ib < 2; ++ib)
#pragma unroll
        for (int s = 0; s < 4; ++s) {
            if (ib < nib) { const int i = 32 * ib + r32, dk0 = 16 * s + 8 * hi;
                const u32x4 rq = *(const u32x4*)(GQ + (size_t)(g.tok0 + i) * 256 + g.hd * 64 + dk0);
                const u32x4 rk = *(const u32x4*)(GK + (size_t)(g.tok0 + i) * 256 + g.hd * 64 + dk0);
                u32x4 oq, ok;
#pragma unroll
                for (int jj = 0; jj < 4; ++jj) { const float b0 = bsm[i * BS_PITCH + dk0 + 2 * jj], b1 = bsm[i * BS_PITCH + dk0 + 2 * jj + 1];
                    oq[jj] = pk2(bflo(rq[jj]) * 0.125f * __expf(b0), bfhi(rq[jj]) * 0.125f * __expf(b1));
                    ok[jj] = pk2(bflo(rk[jj]) * __expf(-b0), bfhi(rk[jj]) * __expf(-b1)); }
                qf[ib][s] = __builtin_bit_cast(bf16x8, oq); kf[ib][s] = __builtin_bit_cast(bf16x8, ok); }
            else { qf[ib][s] = (bf16x8){}; kf[ib][s] = (bf16x8){}; }
        }
    bf16x8 xp[2][2][2];
#pragma unroll
    for (int jb = 0; jb < 2; ++jb)
#pragma unroll
        for (int ib = 0; ib < 2; ++ib) {
            if (jb > ib || ib >= nib) { xp[jb][ib][0] = (bf16x8){}; xp[jb][ib][1] = (bf16x8){}; continue; }
            f32x16 X = (f32x16){};
#pragma unroll
            for (int s = 0; s < 4; ++s) X = MFMA32(kf[jb][s], qf[ib][s], X);
            if (jb == ib) {
#pragma unroll
                for (int r = 0; r < 16; ++r) if (crow(r, hi) > r32) X[r] = 0.f; }
#pragma unroll
            for (int s2 = 0; s2 < 2; ++s2) { u32x4 pw;
#pragma unroll
                for (int jj = 0; jj < 4; ++jj) pw[jj] = pk2(X[8 * s2 + 2 * jj], X[8 * s2 + 2 * jj + 1]);
                xp[jb][ib][s2] = __builtin_bit_cast(bf16x8, pw); }
        }
    const float* Sp = g.sample ? A.sgla + (((size_t)l * DEC_B + g.sb) * 4 + g.hd) * 8192 : (const float*)(ws + WS_DS) + (size_t)it * 8192;
#pragma unroll
    for (int ib = 0; ib < 2; ++ib) {
        if (ib < nib) {
            f32x16 o[4];
#pragma unroll
            for (int nb = 0; nb < 4; ++nb) {
                const int dv = 32 * nb + r32;
                o[nb] = (f32x16){};
#pragma unroll
                for (int s = 0; s < 4; ++s) { u32x4 pw;
#pragma unroll
                    for (int jj = 0; jj < 4; ++jj) pw[jj] = pk2(Sp[(16 * s + 8 * hi + 2 * jj) * 128 + dv], Sp[(16 * s + 8 * hi + 2 * jj + 1) * 128 + dv]);
                    o[nb] = MFMA32(__builtin_bit_cast(bf16x8, pw), qf[ib][s], o[nb]); }
#pragma unroll
                for (int jb = 0; jb <= ib; ++jb)
#pragma unroll
                    for (int s2 = 0; s2 < 2; ++s2) { const bf16* vp = GVT + (size_t)(g.hd * 128 + dv) * NTOK + g.tok0 + 32 * jb + 16 * s2 + 4 * hi;
                        const u32x2 lo = *(const u32x2*)vp, hi8 = *(const u32x2*)(vp + 8);
                        o[nb] = MFMA32(__builtin_bit_cast(bf16x8, (u32x4){lo.x, lo.y, hi8.x, hi8.y}), xp[jb][ib][s2], o[nb]); }
            }
            float ss = 0.f;
#pragma unroll
            for (int nb = 0; nb < 4; ++nb)
#pragma unroll
                for (int r = 0; r < 16; ++r) ss += o[nb][r] * o[nb][r];
            ss += __shfl_xor(ss, 32);
            const float rstd = 1.0f / sqrtf(ss * (1.f / 128) + EPS);
            const int tok = g.tok0 + 32 * ib + r32;
#pragma unroll
            for (int nb = 0; nb < 4; ++nb)
#pragma unroll
                for (int q = 0; q < 4; ++q) { const int dv0 = 32 * nb + 8 * q + 4 * hi; const int gc = g.hd * 128 + dv0;
                    const u32x2 gw = *(const u32x2*)(GG + (size_t)(gc >> 8) * ((size_t)NTOK * 256) + (size_t)tok * 256 + (gc & 255));
                    const f32x4 gon = *(const f32x4*)(A.g_on + l * 128 + dv0);
                    const float g0 = bflo(gw.x), g1 = bfhi(gw.x), g2 = bflo(gw.y), g3 = bfhi(gw.y);
                    const float v0 = o[nb][4 * q + 0] * rstd * gon.x * (g0 / (1.0f + __expf(-g0)));
                    const float v1 = o[nb][4 * q + 1] * rstd * gon.y * (g1 / (1.0f + __expf(-g1)));
                    const float v2 = o[nb][4 * q + 2] * rstd * gon.z * (g2 / (1.0f + __expf(-g2)));
                    const float v3 = o[nb][4 * q + 3] * rstd * gon.w * (g3 / (1.0f + __expf(-g3)));
                    u32x2 ow; ow.x = pk2(v0, v1); ow.y = pk2(v2, v3);
                    *(u32x2*)(CAT + (size_t)tok * 1024 + 512 + g.hd * 128 + dv0) = ow; }
            asm volatile("" ::: "memory");
        }
    }
    LDS_WAIT(); asm volatile("" ::: "memory");
}

template <class LD> __device__ __forceinline__ void attn_tile(const LD& ld, const bf16x8 (&qr)[6], f32x16 (&o)[2], float& m, float& l, bool half_only) {
    const int hi = (threadIdx.x >> 5) & 1;
    f32x16 p0 = (f32x16){}, p1 = (f32x16){};
#pragma unroll
    for (int s = 0; s < 6; ++s) p0 = MFMA32(ld.k(0, s), qr[s], p0);
    if (!half_only) {
#pragma unroll
        for (int s = 0; s < 6; ++s) p1 = MFMA32(ld.k(1, s), qr[s], p1); }
    float mx = p0[0];
#pragma unroll
    for (int r = 1; r < 16; ++r) mx = fmaxf(mx, p0[r]);
    if (!half_only) {
#pragma unroll
        for (int r = 0; r < 16; ++r) mx = fmaxf(mx, p1[r]); }
    mx = fmaxf(mx, __shfl_xor(mx, 32));
    const float mn = fmaxf(m, mx); const float f = __builtin_amdgcn_exp2f(m - mn); m = mn;
    float rs = 0.f;
#pragma unroll
    for (int r = 0; r < 16; ++r) { p0[r] = __builtin_amdgcn_exp2f(p0[r] - mn); rs += p0[r]; }
    if (!half_only) {
#pragma unroll
        for (int r = 0; r < 16; ++r) { p1[r] = __builtin_amdgcn_exp2f(p1[r] - mn); rs += p1[r]; } }
    l = l * f + rs;
#pragma unroll
    for (int r = 0; r < 16; ++r) { o[0][r] *= f; o[1][r] *= f; }
    bf16x8 pa[4];
#pragma unroll
    for (int s = 0; s < 2; ++s) { u32x4 w0, w1;
#pragma unroll
        for (int jj = 0; jj < 4; ++jj) { w0[jj] = pk2(p0[8 * s + 2 * jj], p0[8 * s + 2 * jj + 1]); w1[jj] = pk2(p1[8 * s + 2 * jj], p1[8 * s + 2 * jj + 1]); }
        pa[s] = __builtin_bit_cast(bf16x8, w0); pa[2 + s] = __builtin_bit_cast(bf16x8, w1); }
#pragma unroll
    for (int db = 0; db < 2; ++db) {
#pragma unroll
        for (int s = 0; s < 2; ++s) o[db] = MFMA32(ld.v(db, s), pa[s], o[db]);
        if (!half_only) {
#pragma unroll
            for (int s = 2; s < 4; ++s) o[db] = MFMA32(ld.v(db, s), pa[s], o[db]); }
    }
    (void)hi;
}
constexpr int K_PITCH = 208, V_PITCH = 136, KBUF = 64 * K_PITCH, VBUF = 64 * V_PITCH, ABUF = KBUF + VBUF;
struct LdsLoader {
    LAS const unsigned char* kb; LAS const unsigned char* vb; int r32, hi;
    __device__ __forceinline__ bf16x8 k(int half, int s) const { return *(LAS const bf16x8*)(kb + (r32 + 32 * half) * K_PITCH + s * 32 + hi * 16); }
    __device__ __forceinline__ bf16x8 v(int db, int s) const { LAS const unsigned char* p = vb + (r32 + 32 * db) * V_PITCH + s * 32 + hi * 8;
        const u32x2 lo = *(LAS const u32x2*)p, h8 = *(LAS const u32x2*)(p + 16); return __builtin_bit_cast(bf16x8, (u32x4){lo.x, lo.y, h8.x, h8.y}); }
};
struct GlbLoader {
    const bf16* kn; const bf16* kr; const bf16* vt; int r32, hi;
    __device__ __forceinline__ bf16x8 k(int half, int s) const { const int kv = r32 + 32 * half;
        return (s < 4) ? *(const bf16x8*)(kn + (size_t)kv * 512 + 16 * s + 8 * hi) : *(const bf16x8*)(kr + (size_t)kv * 32 + 16 * (s - 4) + 8 * hi); }
    __device__ __forceinline__ bf16x8 v(int db, int s) const { const bf16* p = vt + (size_t)(r32 + 32 * db) * NKVS + 16 * s + 4 * hi;
        const u32x2 lo = *(const u32x2*)p, h8 = *(const u32x2*)(p + 8); return __builtin_bit_cast(bf16x8, (u32x4){lo.x, lo.y, h8.x, h8.y}); }
};
__device__ __forceinline__ void load_q(bf16x8 (&qr)[6], const bf16* qp, const float* rope_row, int hi) {
#pragma unroll
    for (int s = 0; s < 6; ++s) qr[s] = *(const bf16x8*)(qp + 16 * s + 8 * hi);
    const u32x4 a = __builtin_bit_cast(u32x4, qr[4]), b = __builtin_bit_cast(u32x4, qr[5]); u32x4 oa, ob;
    const f32x4 c0 = *(const f32x4*)(rope_row + 8 * hi), c1 = *(const f32x4*)(rope_row + 8 * hi + 4), s0 = *(const f32x4*)(rope_row + 16 + 8 * hi), s1 = *(const f32x4*)(rope_row + 16 + 8 * hi + 4);
#pragma unroll
    for (int jj = 0; jj < 4; ++jj) {
        const float x1l = bflo(a[jj]), x1h = bfhi(a[jj]), x2l = bflo(b[jj]), x2h = bfhi(b[jj]);
        const float cl = (jj < 2) ? c0[2 * jj] : c1[2 * jj - 4], ch = (jj < 2) ? c0[2 * jj + 1] : c1[2 * jj - 3];
        const float sl = (jj < 2) ? s0[2 * jj] : s1[2 * jj - 4], sh = (jj < 2) ? s0[2 * jj + 1] : s1[2 * jj - 3];
        oa[jj] = pk2(x1l * cl - x2l * sl, x1h * ch - x2h * sh); ob[jj] = pk2(x1l * sl + x2l * cl, x1h * sh + x2h * ch); }
    qr[4] = __builtin_bit_cast(bf16x8, oa); qr[5] = __builtin_bit_cast(bf16x8, ob);
}
__device__ __forceinline__ void attn_prompt_unit(const Args& A, const Ctx& C, int b, int hd, int qb) {
    unsigned char* ws = A.ws; const int tid = C.tid, lane = C.lane, wid = C.wave, r32 = lane & 31, hi = lane >> 5;
    const bf16* Q = (const bf16*)(ws + WS_Z); const bf16* KN = (const bf16*)(ws + WS_KN); const bf16* KR = (const bf16*)(ws + WS_KR); const bf16* VT = (const bf16*)(ws + WS_VT);
    bf16* CAT = (bf16*)(ws + WS_H); const float* ROPE = (const float*)(ws + WS_ROPE);
    const int pos = qb * 256 + wid * 32 + r32; const size_t qrow = (size_t)b * SEQ + pos;
    bf16x8 qr[6]; load_q(qr, Q + qrow * 768 + hd * 96, ROPE + (size_t)pos * 32, hi);
    const int ntiles = 4 * qb + 4, my_last = 4 * qb + (wid >> 1);
    const int krow = tid >> 3, kch = tid & 7, rrow = (tid & 255) >> 2, rch = tid & 3;
    const bf16* kn_src = KN + ((size_t)b * SEQ + krow) * 512 + hd * 64 + kch * 8;
    const bf16* kr_src = KR + ((size_t)b * SEQ + rrow) * 32 + rch * 8;
    const bf16* vt_src = VT + (size_t)(hd * 64 + krow) * NP + (size_t)b * SEQ + kch * 8;
    const int kn_dst = krow * K_PITCH + kch * 16, kr_dst = rrow * K_PITCH + 128 + rch * 16, vt_dst = KBUF + krow * V_PITCH + kch * 16;
    u32x4 sk, sr, sv;
    sk = *(const u32x4*)kn_src; sv = *(const u32x4*)vt_src; if (tid < 256) sr = *(const u32x4*)kr_src;
    { LAS unsigned char* bufp = C.lds; *(LAS u32x4*)(bufp + kn_dst) = sk; if (tid < 256) *(LAS u32x4*)(bufp + kr_dst) = sr;
      *(LAS u32x2*)(bufp + vt_dst) = (u32x2){sv.x, sv.y}; *(LAS u32x2*)(bufp + vt_dst + 8) = (u32x2){sv.z, sv.w}; }
    __syncthreads();
    f32x16 o[2]; o[0] = (f32x16){}; o[1] = (f32x16){}; float m = -INFINITY, l = 0.f;
    for (int t = 0; t < ntiles; ++t) {
        const bool more = (t + 1 < ntiles);
        if (more) { sk = *(const u32x4*)(kn_src + (size_t)(t + 1) * 64 * 512); sv = *(const u32x4*)(vt_src + (size_t)(t + 1) * 64); if (tid < 256) sr = *(const u32x4*)(kr_src + (size_t)(t + 1) * 64 * 32); }
        if (t <= my_last) { LdsLoader ld{C.lds + (t & 1) * ABUF, C.lds + (t & 1) * ABUF + KBUF, r32, hi}; attn_tile(ld, qr, o, m, l, false); }
        if (more) { LAS unsigned char* bufp = C.lds + ((t + 1) & 1) * ABUF; *(LAS u32x4*)(bufp + kn_dst) = sk; if (tid < 256) *(LAS u32x4*)(bufp + kr_dst) = sr;
            *(LAS u32x2*)(bufp + vt_dst) = (u32x2){sv.x, sv.y}; *(LAS u32x2*)(bufp + vt_dst + 8) = (u32x2){sv.z, sv.w}; }
        __syncthreads();
    }
    const float lt = l + __shfl_xor(l, 32); const float inv = 1.0f / lt;
    bf16* orow = CAT + qrow * 1024 + hd * 64;
#pragma unroll
    for (int db = 0; db < 2; ++db)
#pragma unroll
        for (int q = 0; q < 4; ++q) { u32x2 w; w.x = pk2(o[db][4 * q] * inv, o[db][4 * q + 1] * inv); w.y = pk2(o[db][4 * q + 2] * inv, o[db][4 * q + 3] * inv);
            *(u32x2*)(orow + 32 * db + 8 * q + 4 * hi) = w; }
}
__device__ __forceinline__ void attn_sample_unit(const Args& A, const Ctx& C, int b, int hd) {
    unsigned char* ws = A.ws; const int tid = C.tid, lane = C.lane, wid = C.wave, r32 = lane & 31, hi = lane >> 5;
    const bf16* Q = (const bf16*)(ws + WS_Z); const bf16* KNS = (const bf16*)(ws + WS_KNS); const bf16* KRS = (const bf16*)(ws + WS_KRS); const bf16* VTS = (const bf16*)(ws + WS_VTS);
    bf16* CAT = (bf16*)(ws + WS_H); const float* ROPE = (const float*)(ws + WS_ROPE);
    const size_t qrow = (size_t)NP + b * 32 + r32;
    bf16x8 qr[6]; load_q(qr, Q + qrow * 768 + hd * 96, ROPE + (size_t)(PAST + r32) * 32, hi);
    f32x16 o[2]; o[0] = (f32x16){}; o[1] = (f32x16){}; float m = -INFINITY, l = 0.f;
    for (int t = wid; t < 33; t += 8) {
        const size_t key0 = (size_t)b * SKV + 64 * t;
        GlbLoader ld{KNS + key0 * 512 + hd * 64, KRS + key0 * 32, VTS + (size_t)(hd * 64) * NKVS + key0, r32, hi};
        attn_tile(ld, qr, o, m, l, t == 32);
    }
    const float lt = l + __shfl_xor(l, 32);
    LAS float* cm = (LAS float*)C.lds; LAS float* cl = cm + 256; LAS float* co = cm + 512;
    if (hi == 0) { cm[wid * 32 + r32] = m; cl[wid * 32 + r32] = lt; }
#pragma unroll
    for (int db = 0; db < 2; ++db)
#pragma unroll
        for (int r = 0; r < 16; ++r) co[(wid * 64 + 32 * db + crow(r, hi)) * 32 + r32] = o[db][r];
    __syncthreads();
    { const int q = tid & 31, d0 = (tid >> 5) * 4;
      float M = cm[q];
#pragma unroll
      for (int w = 1; w < 8; ++w) M = fmaxf(M, cm[w * 32 + q]);
      float L = 0.f, acc[4] = {0.f, 0.f, 0.f, 0.f};
#pragma unroll
      for (int w = 0; w < 8; ++w) { const float f = __builtin_amdgcn_exp2f(cm[w * 32 + q] - M); L += cl[w * 32 + q] * f;
#pragma unroll
          for (int i = 0; i < 4; ++i) acc[i] += co[(w * 64 + d0 + i) * 32 + q] * f; }
      const float inv = 1.0f / L;
      u32x2 wv; wv.x = pk2(acc[0] * inv, acc[1] * inv); wv.y = pk2(acc[2] * inv, acc[3] * inv);
      *(u32x2*)(CAT + ((size_t)NP + b * 32 + q) * 1024 + hd * 64 + d0) = wv; }
    __syncthreads();
}

__global__ void __launch_bounds__(512, 2) fwd_mega(Args A) {
    extern __shared__ __attribute__((aligned(16))) unsigned char lds_raw[];
    cg::grid_group grid = cg::this_grid();
    Ctx C; C.lds = (LAS unsigned char*)lds_raw; C.tid = threadIdx.x; C.lane = C.tid & 63; C.wave = __builtin_amdgcn_readfirstlane(C.tid >> 6);
    C.G = gridDim.x; { const int bx = blockIdx.x; C.vcu = (C.G % 8 == 0) ? (bx % 8) * (C.G / 8) + bx / 8 : bx; }
    C.gw = blockIdx.x * 8 + C.wave; C.NGW = C.G * 8;
    unsigned char* ws = A.ws;
    float* X = A.out + O_Y;
    { float* ROPE = (float*)(ws + WS_ROPE);
      for (int e = blockIdx.x * 512 + C.tid; e < SEQ * 16; e += C.G * 512) { const int p = e >> 4, i = e & 15;
          const double base = (i & 3) == 0 ? 1.0 : (i & 3) == 1 ? 0.5623413251903491 : (i & 3) == 2 ? 0.31622776601683794 : 0.1778279410038923;
          const double sc = (i >> 2) == 0 ? 1.0 : (i >> 2) == 1 ? 0.1 : (i >> 2) == 2 ? 0.01 : 0.001;
          const float inv = (float)(base * sc); const float ang = (float)p * inv;
          const double rev = (double)ang * 0.15915494309189535; const float fr = (float)(rev - __builtin_rint(rev));
          ROPE[p * 32 + i] = __builtin_amdgcn_cosf(fr); ROPE[p * 32 + 16 + i] = __builtin_amdgcn_sinf(fr); } }
#define REFRESH() do { int t_ = threadIdx.x; asm volatile("" : "+v"(t_)); C.tid = t_; C.lane = t_ & 63; C.wave = __builtin_amdgcn_readfirstlane(t_ >> 6); C.gw = blockIdx.x * 8 + C.wave; } while (0)
#pragma unroll 1
    for (int l = 0; l < DEPTH; ++l) {
        REFRESH();
        convert_weights(C, A, l);
        for (int mrow = C.gw; mrow < NTOK; mrow += C.NGW) {
            const float* xr = (l == 0) ? (mrow < NP ? A.xp + (size_t)mrow * DM : A.xs + (size_t)(mrow - NP) * DM) : X + (size_t)mrow * DM;
            norm_row(xr, A.g_attn + l * DM, (bf16*)(ws + WS_H) + (size_t)mrow * DM, (l == 0) ? X + (size_t)mrow * DM : nullptr, C.lane); }
        for (int r = C.gw; r < DEC_B * PAST; r += C.NGW) cache_row(A, l, r, C.lane);
        grid.sync();
#ifndef NO_P2
        { pg8::EpiBf16 E{(pg8::bf16_t*)(ws + WS_Z), 256, 256, (size_t)NTOK * 256};
          pg8::Gemm g{(const pg8::bf16_t*)(ws + WS_H), (const pg8::bf16_t*)(ws + WS_WIN), NTOK, 1792, DM}; pg8::StaticOrder S; S.init(NTOK, 1792, C.G, (int)blockIdx.x);
          pg8::gemm_phase<pg8::EpiBf16, pg8::StaticOrder, true, true>(C.lds, g, S, E); }
        { pg8::EpiBf16 E{(pg8::bf16_t*)(ws + WS_GVT), NTOK, 0, 0};
          pg8::Gemm g{(const pg8::bf16_t*)(ws + WS_WGV), (const pg8::bf16_t*)(ws + WS_H), 512, NTOK, DM}; pg8::StaticOrder S; S.init(512, NTOK, C.G, (int)((blockIdx.x + 146) % C.G));
          pg8::gemm_phase<pg8::EpiBf16, pg8::StaticOrder, true, true>(C.lds, g, S, E); }
        grid.sync();
#endif
        REFRESH();
        for (int mrow = C.gw; mrow < NTOK; mrow += C.NGW) p3_token(A, l, mrow, C.lane);
        grid.sync();
        #ifndef NO_G1
        for (int it = C.gw; it < NITEM; it += C.NGW) gla_g1(A, l, it, C.lds + C.wave * 16384, C.lane);
#endif
        grid.sync();
#ifndef NO_P4
        if ((int)blockIdx.x < NSCAN) gla_scan(A, l, blockIdx.x, C.tid);
        else {
            const int G2 = C.G - NSCAN, c2 = blockIdx.x - NSCAN;
#pragma unroll 1
            for (int gi = 0; gi < 5; ++gi) {
                pg8::Gemm g; pg8::EpiBf16 E; int M_, N_;
                if (gi == 0) { g = pg8::Gemm{(const pg8::bf16_t*)(ws + WS_CQN), (const pg8::bf16_t*)(ws + WS_WUQ), NTOK, 768, 256}; E = pg8::EpiBf16{(pg8::bf16_t*)(ws + WS_Z), 768, 0, 0}; M_ = NTOK; N_ = 768; }
                else if (gi == 1) { g = pg8::Gemm{(const pg8::bf16_t*)(ws + WS_CKVN), (const pg8::bf16_t*)(ws + WS_WUK), NP, 512, 256}; E = pg8::EpiBf16{(pg8::bf16_t*)(ws + WS_KN), 512, 0, 0}; M_ = NP; N_ = 512; }
                else if (gi == 2) { g = pg8::Gemm{(const pg8::bf16_t*)(ws + WS_WUV), (const pg8::bf16_t*)(ws + WS_CKVN), 512, NP, 256}; E = pg8::EpiBf16{(pg8::bf16_t*)(ws + WS_VT), NP, 0, 0}; M_ = 512; N_ = NP; }
                else if (gi == 3) { g = pg8::Gemm{(const pg8::bf16_t*)(ws + WS_CKVS), (const pg8::bf16_t*)(ws + WS_WUK), NKVS, 512, 256}; E = pg8::EpiBf16{(pg8::bf16_t*)(ws + WS_KNS), 512, 0, 0}; M_ = NKVS; N_ = 512; }
                else { g = pg8::Gemm{(const pg8::bf16_t*)(ws + WS_WUV), (const pg8::bf16_t*)(ws + WS_CKVS), 512, NKVS, 256}; E = pg8::EpiBf16{(pg8::bf16_t*)(ws + WS_VTS), NKVS, 0, 0}; M_ = 512; N_ = NKVS; }
                pg8::StaticOrder S; S.init(M_, N_, G2, (c2 + gi * 37) % G2);
                pg8::gemm_phase<pg8::EpiBf16, pg8::StaticOrder, true, true>(C.lds, g, S, E);
            }
        }
        grid.sync();
#endif
        REFRESH();
#ifndef NO_G3
        for (int it = C.gw; it < NITEM; it += C.NGW) gla_g3(A, l, it, C.lds + C.wave * 17408, C.lane);
#endif
        __syncthreads();
#ifndef NO_SAMP
        if (C.vcu >= C.G - 128 && C.vcu < C.G) { const int u = C.vcu - (C.G - 128); attn_sample_unit(A, C, u >> 3, u & 7); }
#endif
#ifndef NO_ATTN
        for (int u = C.vcu; u < 1024; u += C.G) {
            const int bh = (u % 256) >> 4, s = u & 15, i = u >> 8; const int qb = (i == 0) ? 63 - s : (i == 1) ? 32 + s : (i == 2) ? 31 - s : s;
            attn_prompt_unit(A, C, bh >> 3, bh & 7, qb); }
#endif
        grid.sync();
#ifndef NO_P6
        { pg8::EpiRes E{X, DM};
          pg8::Gemm g{(const pg8::bf16_t*)(ws + WS_H), (const pg8::bf16_t*)(ws + WS_WO), NTOK, DM, DM}; pg8::StaticOrder S; S.init(NTOK, DM, C.G, (int)blockIdx.x);
          pg8::gemm_phase<pg8::EpiRes, pg8::StaticOrder, true, true>(C.lds, g, S, E); }
        grid.sync();
#endif
        REFRESH();
        for (int mrow = C.gw; mrow < NTOK; mrow += C.NGW) norm_row(X + (size_t)mrow * DM, A.g_ffn + l * DM, (bf16*)(ws + WS_H) + (size_t)mrow * DM, nullptr, C.lane);
        grid.sync();
#ifndef NO_P8
        { pg8::EpiSwiglu E{(pg8::bf16_t*)(ws + WS_ACT), DFF};
          pg8::Gemm g{(const pg8::bf16_t*)(ws + WS_H), (const pg8::bf16_t*)(ws + WS_WGU), NTOK, 2 * DFF, DM}; pg8::StaticOrder S; S.init(NTOK, 2 * DFF, C.G, (int)blockIdx.x);
          pg8::gemm_phase<pg8::EpiSwiglu, pg8::StaticOrder, true, true>(C.lds, g, S, E); }
        grid.sync();
#endif
#ifndef NO_P9
        { pg8::EpiRes E{X, DM};
          pg8::Gemm g{(const pg8::bf16_t*)(ws + WS_ACT), (const pg8::bf16_t*)(ws + WS_WD), NTOK, DM, DFF}; pg8::StaticOrder S; S.init(NTOK, DM, C.G, (int)blockIdx.x);
          pg8::gemm_phase<pg8::EpiRes, pg8::StaticOrder, true, true>(C.lds, g, S, E); }
        grid.sync();
#endif
    }
    REFRESH();
    for (int mrow = C.gw; mrow < NTOK; mrow += C.NGW) final_norm_row(X + (size_t)mrow * DM, A.g_final, C.lane);
}

extern "C" void kernel_launch(void* const* d_in, const int* in_sizes, int n_in, void* d_out, int out_size, void* d_ws, size_t ws_size, hipStream_t stream) {
    static int grid = 0;
    if (grid == 0) {
        if (n_in != 19 || (size_t)out_size != O_END || ws_size < WS_END) { fprintf(stderr, "kernel_launch: unexpected shapes: n_in %d out %d ws %zu (need %zu)\n", n_in, out_size, ws_size, (size_t)WS_END); grid = -1; return; }
        int dev = 0, cus = 0, per_cu = 0;
        hipGetDevice(&dev); hipDeviceGetAttribute(&cus, hipDeviceAttributeMultiprocessorCount, dev);
        if (hipFuncSetAttribute((const void*)fwd_mega, hipFuncAttributeMaxDynamicSharedMemorySize, LDS_BYTES) != hipSuccess) { fprintf(stderr, "kernel_launch: hipFuncSetAttribute failed\n"); grid = -1; return; }
        if (hipOccupancyMaxActiveBlocksPerMultiprocessor(&per_cu, (const void*)fwd_mega, 512, LDS_BYTES) != hipSuccess || per_cu < 1) { fprintf(stderr, "kernel_launch: occupancy query says %d\n", per_cu); per_cu = 1; }
        (void)hipGetLastError();
        grid = cus;
    }
    if (grid < 0) return;
    Args a{};
    a.xp = (const float*)d_in[0]; a.xs = (const float*)d_in[1]; a.cckv = (const float*)d_in[2]; a.ckr = (const float*)d_in[3]; a.sgla = (const float*)d_in[4];
    a.g_attn = (const float*)d_in[5]; a.w_in = (const float*)d_in[6]; a.g_qn = (const float*)d_in[7]; a.w_uq = (const float*)d_in[8]; a.g_kvn = (const float*)d_in[9];
    a.w_ukv = (const float*)d_in[10]; a.w_a2 = (const float*)d_in[11]; a.b_a2 = (const float*)d_in[12]; a.g_on = (const float*)d_in[13]; a.w_o = (const float*)d_in[14];
    a.g_ffn = (const float*)d_in[15]; a.w_gu = (const float*)d_in[16]; a.w_down = (const float*)d_in[17]; a.g_final = (const float*)d_in[18];
    a.out = (float*)d_out; a.ws = (unsigned char*)d_ws;
    void* args[] = {&a};
    hipError_t e = hipLaunchCooperativeKernel((const void*)fwd_mega, dim3(grid), dim3(512), args, LDS_BYTES, stream);
    if (e != hipSuccess) fprintf(stderr, "kernel_launch: cooperative launch failed: %s (grid %d)\n", hipGetErrorString(e), grid);
}
```

```cpp
#include <hip/hip_runtime.h>
#include <hip/hip_cooperative_groups.h>
#include <cstdio>
#include <cstdint>
namespace cg = cooperative_groups;
namespace pg8 {
#define PG8_LAS __attribute__((address_space(3)))
typedef unsigned short bf16_t;
typedef short bf16x8 __attribute__((ext_vector_type(8)));
typedef float f32x4 __attribute__((ext_vector_type(4)));
typedef unsigned u32x4 __attribute__((ext_vector_type(4)));
constexpr int BM = 256, BK = 64, HALF = 128, HTB = HALF * BK * 2  , STAGE_BYTES = 8 * HTB, NXCD = 8, WGM = 8;

__host__ __device__ __forceinline__ int lds_byte(int r, int c) { const int st = (r >> 4) * 2 + (c >> 5), rr = r & 15, cc = c & 31, ob = rr * 64 + cc * 2; return st * 1024 + (ob ^ (((ob >> 9) & 1) << 5)); }
__host__ __device__ __forceinline__ void stage_rc(int b, int& R, int& C) { const int st = b / 1024, sb = b % 1024, swz = sb ^ (((sb >> 9) & 1) << 5); R = (st >> 1) * 16 + swz / 64; C = (st & 1) * 32 + (swz % 64) / 2; }
__host__ __device__ __forceinline__ int perm32(int rho) { const int n = rho >> 4, i = rho & 15; return 8 * (i >> 2) + 4 * n + (i & 3); }

struct Unit { int pm, pn; };
struct Gemm { const bf16_t* A; const bf16_t* Bt; int M, N, K; };

struct StaticOrder {
    int nM, nN, nwg, G, c;
    __host__ __device__ void init(int M, int N, int G_, int c_) { nM = M / BM; nN = N / BM; nwg = nM * nN; G = G_; c = c_; }
    __host__ __device__ bool next(int i, Unit& u) const {
        const long L = (long)i * G + c; if (L >= nwg) return false;
        int wgid = (int)L; { const int q = nwg / NXCD, r = nwg % NXCD, xcd = wgid % NXCD, off = wgid / NXCD; wgid = (xcd < r ? xcd * (q + 1) : r * (q + 1) + (xcd - r) * q) + off; }
        const int nig = WGM * nN, gid = wgid / nig, fm = gid * WGM, gsz = (nM - fm) < WGM ? (nM - fm) : WGM;
        u.pm = fm + ((wgid % nig) % gsz); u.pn = (wgid % nig) / gsz; return true;
    }
    __device__ __forceinline__ void a_ready(const Unit&) const {}
    __device__ __forceinline__ void done(const Unit&) const {}
};

__device__ __forceinline__ unsigned cvt_pk_bf16(float lo, float hi) { unsigned r; asm volatile("v_cvt_pk_bf16_f32 %0, %1, %2" : "=v"(r) : "v"(lo), "v"(hi)); return r; }
typedef float f32x2 __attribute__((ext_vector_type(2)));
struct EpiBf16 {
    static constexpr bool PERM = true, AFTER_DRAIN = false;
    bf16_t* O; int ldc; int split_cols; size_t split_stride;
    __device__ __forceinline__ void operator()(const f32x4 (&acc)[2][2][4][2], const Unit& u, int wr, int wc, int fr, int fq) const {
        const int row0 = u.pm * BM + wr * 64 + fr; int colt = u.pn * BM; bf16_t* base = O;
        if (split_cols) { const int t = colt / split_cols; base += (size_t)t * split_stride; colt -= t * split_cols; }
        const int col0 = colt + wc * 32 + 8 * fq;
#pragma unroll
        for (int ai = 0; ai < 2; ++ai)
#pragma unroll
            for (int m = 0; m < 4; ++m) { bf16_t* rowp = base + (size_t)(row0 + ai * HALF + m * 16) * ldc + col0;
#pragma unroll
                for (int bj = 0; bj < 2; ++bj) { const f32x4 v0 = acc[ai][bj][m][0], v1 = acc[ai][bj][m][1];
                    u32x4 w; w.x = cvt_pk_bf16(v0[0], v0[1]); w.y = cvt_pk_bf16(v0[2], v0[3]); w.z = cvt_pk_bf16(v1[0], v1[1]); w.w = cvt_pk_bf16(v1[2], v1[3]);
                    *(u32x4*)(rowp + bj * HALF) = w; } }
    }
};
struct EpiSwiglu {
    static constexpr bool PERM = true, AFTER_DRAIN = false;
    bf16_t* O; int ldc;
    __device__ __forceinline__ void operator()(const f32x4 (&acc)[2][2][4][2], const Unit& u, int wr, int wc, int fr, int fq) const {
        const int row0 = u.pm * BM + wr * 64 + fr; const int col0 = u.pn * HALF + wc * 32 + 8 * fq;
#pragma unroll
        for (int ai = 0; ai < 2; ++ai)
#pragma unroll
            for (int m = 0; m < 4; ++m) { bf16_t* rowp = O + (size_t)(row0 + ai * HALF + m * 16) * ldc + col0;
                float r[8];
#pragma unroll
                for (int n = 0; n < 2; ++n)
#pragma unroll
                    for (int i = 0; i < 4; ++i) { const float a = acc[ai][0][m][n][i], uu = acc[ai][1][m][n][i];
                        r[n * 4 + i] = a * __builtin_amdgcn_rcpf(1.0f + __expf(-a)) * uu; }
                u32x4 w; w.x = cvt_pk_bf16(r[0], r[1]); w.y = cvt_pk_bf16(r[2], r[3]); w.z = cvt_pk_bf16(r[4], r[5]); w.w = cvt_pk_bf16(r[6], r[7]);
                *(u32x4*)rowp = w; }
    }
};
struct EpiRes {
    static constexpr bool PERM = false, AFTER_DRAIN = false;
    float* X; int ldc;
    __device__ __forceinline__ void operator()(const f32x4 (&acc)[2][2][4][2], const Unit& u, int wr, int wc, int fr, int fq) const {
        const int col0 = u.pn * BM + wc * 32 + 4 * fq;
#pragma unroll
        for (int ai = 0; ai < 2; ++ai)
#pragma unroll
            for (int m = 0; m < 4; ++m) { float* rowp = X + (size_t)(u.pm * BM + ai * HALF + wr * 64 + m * 16 + fr) * ldc + col0;
#pragma unroll
                for (int bj = 0; bj < 2; ++bj)
#pragma unroll
                    for (int n = 0; n < 2; ++n) { f32x4* p = (f32x4*)(rowp + bj * HALF + n * 16); *p = *p + acc[ai][bj][m][n]; }
                asm volatile("" ::: "memory"); }
    }
};
template <class Epi, class Sched, bool ALIGN_EPI = false, bool SP2 = false>
__device__ __forceinline__ void gemm_phase(PG8_LAS unsigned char* lds, const Gemm g, const Sched& S, const Epi& E) {
    int tid_ = threadIdx.x; asm volatile("" : "+v"(tid_));
    const int tid = tid_, wid = __builtin_amdgcn_readfirstlane(tid >> 6), lane = tid & 63, wr = wid >> 2, wc = wid & 3, fr = lane & 15, fq = lane >> 4;
    const int K = g.K, nt = K / BK;
    unsigned voffA[2], voffB[2];
#pragma unroll
    for (int i = 0; i < 2; ++i) { int R, C; stage_rc(tid * 16 + i * 8192, R, C); const int Rb = Epi::PERM ? ((R & ~31) + perm32(R & 31)) : R;
        voffA[i] = (unsigned)(R * K + C) * 2u; voffB[i] = (unsigned)(Rb * K + C) * 2u; }
    const size_t kstep = (size_t)(BK * 2);
    const size_t hstep = (size_t)HALF * K * 2;
    const size_t tstep = 2 * hstep;
    const unsigned ldsw = (unsigned)wid * 1024u;
    const int aoff = lds_byte(wr * 64 + fr, fq * 8), boff = lds_byte(wc * 32 + fr, fq * 8);
#define PG8_SA(b, h) (((b) * 2 + (h)) * HTB)
#define PG8_SB(b, h) ((4 + (b) * 2 + (h)) * HTB)
#define PG8_STAGE(bufoff, gbase, voff) do { _Pragma("unroll") for (int _i = 0; _i < 2; ++_i) \
        __builtin_amdgcn_global_load_lds((const unsigned*)((const char*)(gbase) + (voff)[_i]), (PG8_LAS unsigned*)(lds + (bufoff) + ldsw + _i * 8192), 16, 0, 0); } while (0)
#define PG8_LDA(dst, b, h) do { _Pragma("unroll") for (int m = 0; m < 4; ++m) _Pragma("unroll") for (int k = 0; k < 2; ++k) dst[m][k] = *(const PG8_LAS bf16x8*)(lds + PG8_SA(b, h) + aoff + m * 2048 + k * 1024); } while (0)
#define PG8_LDB(dst, b, h) do { _Pragma("unroll") for (int n = 0; n < 2; ++n) _Pragma("unroll") for (int k = 0; k < 2; ++k) dst[n][k] = *(const PG8_LAS bf16x8*)(lds + PG8_SB(b, h) + boff + n * 2048 + k * 1024); } while (0)
#define PG8_MMA(ai, bj, At, Bt) do { __builtin_amdgcn_s_setprio(1); _Pragma("unroll") for (int m = 0; m < 4; ++m) _Pragma("unroll") for (int n = 0; n < 2; ++n) _Pragma("unroll") for (int k = 0; k < 2; ++k) \
        acc[ai][bj][m][n] = __builtin_amdgcn_mfma_f32_16x16x32_bf16(Bt[n][k], At[m][k], acc[ai][bj][m][n], 0, 0, 0); __builtin_amdgcn_s_setprio(0); } while (0)
#define PG8_WAIT_V(n) asm volatile("s_waitcnt vmcnt(" #n ")" ::: "memory")
#define PG8_WAIT_L(n) asm volatile("s_waitcnt lgkmcnt(" #n ")" ::: "memory")
#define PG8_BAR __builtin_amdgcn_s_barrier()
#define PG8_SCHED __builtin_amdgcn_sched_barrier(0)
    Unit cur, nxt; int ui = 0;
    if (!S.next(0, cur)) return;
    f32x4 acc[2][2][4][2];
#pragma unroll
    for (int a = 0; a < 2; ++a)
#pragma unroll
        for (int b = 0; b < 2; ++b)
#pragma unroll
            for (int m = 0; m < 4; ++m)
#pragma unroll
                for (int n = 0; n < 2; ++n) acc[a][b][m][n] = (f32x4){0.f, 0.f, 0.f, 0.f};
    bf16x8 At[4][2], B0[2][2], B1[2][2];
    const char* cA = (const char*)g.A + (size_t)cur.pm * tstep; const char* cB = (const char*)g.Bt + (size_t)cur.pn * tstep;
    S.a_ready(cur);
    if constexpr (SP2) {
        PG8_STAGE(PG8_SB(0, 0), cB, voffB); PG8_STAGE(PG8_SB(0, 1), cB + hstep, voffB); PG8_STAGE(PG8_SA(0, 0), cA, voffA); PG8_STAGE(PG8_SA(0, 1), cA + hstep, voffA);
        if (wr == 1) PG8_BAR;
        PG8_WAIT_V(2); PG8_BAR;
        PG8_STAGE(PG8_SB(1, 0), cB + kstep, voffB); PG8_STAGE(PG8_SA(1, 0), cA + kstep, voffA); PG8_STAGE(PG8_SB(1, 1), cB + hstep + kstep, voffB);
        PG8_WAIT_V(6); PG8_BAR;
    } else {
        PG8_STAGE(PG8_SB(0, 0), cB, voffB); PG8_STAGE(PG8_SA(0, 0), cA, voffA); PG8_STAGE(PG8_SB(0, 1), cB + hstep, voffB); PG8_STAGE(PG8_SA(0, 1), cA + hstep, voffA);
        if (wr == 1) PG8_BAR;
        PG8_WAIT_V(4); PG8_BAR;
        PG8_STAGE(PG8_SB(1, 0), cB + kstep, voffB); PG8_STAGE(PG8_SA(1, 0), cA + kstep, voffA); PG8_STAGE(PG8_SB(1, 1), cB + hstep + kstep, voffB);
        PG8_WAIT_V(6); PG8_BAR;
    }
    for (;;) {
        const bool has_next = S.next(ui + 1, nxt);
        const char* nA = has_next ? (const char*)g.A + (size_t)nxt.pm * tstep : cA; const char* nB = has_next ? (const char*)g.Bt + (size_t)nxt.pn * tstep : cB;
        for (int t = 0; t < nt; t += 2) {
            const bool last = (t == nt - 2);
            const char* a1 = cA + (size_t)(t + 1) * kstep;
            const char* a2 = last ? nA : cA + (size_t)(t + 2) * kstep; const char* b2 = last ? nB : cB + (size_t)(t + 2) * kstep;
            const char* a3 = a2 + kstep; const char* b3 = b2 + kstep;
            if (last && has_next) S.a_ready(nxt);
            if constexpr (SP2) {
            PG8_LDB(B0, 0, 0); PG8_LDB(B1, 0, 1); PG8_SCHED; PG8_LDA(At, 0, 0); PG8_STAGE(PG8_SA(1, 1), a1 + hstep, voffA);
            PG8_WAIT_V(8); PG8_WAIT_L(0); PG8_BAR; PG8_MMA(0, 0, At, B0); PG8_MMA(0, 1, At, B1); PG8_BAR; PG8_SCHED;
            PG8_LDA(At, 0, 1); PG8_STAGE(PG8_SB(0, 0), b2, voffB); PG8_STAGE(PG8_SB(0, 1), b2 + hstep, voffB); PG8_STAGE(PG8_SA(0, 0), a2, voffA);
            PG8_WAIT_V(8); PG8_WAIT_L(0); PG8_BAR; PG8_MMA(1, 0, At, B0); PG8_MMA(1, 1, At, B1); PG8_BAR; PG8_SCHED;
            PG8_LDB(B0, 1, 0); PG8_LDB(B1, 1, 1); PG8_SCHED; PG8_LDA(At, 1, 0); PG8_STAGE(PG8_SA(0, 1), a2 + hstep, voffA);
            PG8_WAIT_V(8); PG8_WAIT_L(0); PG8_BAR; PG8_MMA(0, 0, At, B0); PG8_MMA(0, 1, At, B1); PG8_BAR; PG8_SCHED;
            PG8_LDA(At, 1, 1); PG8_STAGE(PG8_SB(1, 0), b3, voffB); PG8_STAGE(PG8_SB(1, 1), b3 + hstep, voffB); PG8_STAGE(PG8_SA(1, 0), a3, voffA);
            PG8_WAIT_V(8); PG8_WAIT_L(0); PG8_BAR; PG8_MMA(1, 0, At, B0); PG8_MMA(1, 1, At, B1); PG8_BAR; PG8_SCHED;
            } else {
            PG8_LDB(B0, 0, 0); PG8_SCHED; PG8_LDA(At, 0, 0); PG8_STAGE(PG8_SA(1, 1), a1 + hstep, voffA);
            PG8_WAIT_L(8); PG8_BAR; PG8_WAIT_L(0); PG8_MMA(0, 0, At, B0); PG8_BAR; PG8_SCHED;
            PG8_LDB(B1, 0, 1); PG8_STAGE(PG8_SB(0, 0), b2, voffB);
            PG8_BAR; PG8_WAIT_L(0); PG8_MMA(0, 1, At, B1); PG8_BAR;
            PG8_LDA(At, 0, 1); PG8_STAGE(PG8_SA(0, 0), a2, voffA);
            PG8_BAR; PG8_WAIT_L(0); PG8_MMA(1, 0, At, B0); PG8_BAR; PG8_SCHED;
            PG8_STAGE(PG8_SB(0, 1), b2 + hstep, voffB);
            PG8_WAIT_V(6); PG8_BAR; PG8_MMA(1, 1, At, B1); PG8_BAR;
            PG8_LDB(B0, 1, 0); PG8_SCHED; PG8_LDA(At, 1, 0); PG8_STAGE(PG8_SA(0, 1), a2 + hstep, voffA);
            PG8_WAIT_L(8); PG8_BAR; PG8_WAIT_L(0); PG8_MMA(0, 0, At, B0); PG8_BAR; PG8_SCHED;
            PG8_LDB(B1, 1, 1); PG8_STAGE(PG8_SB(1, 0), b3, voffB);
            PG8_BAR; PG8_WAIT_L(0); PG8_MMA(0, 1, At, B1); PG8_BAR;
            PG8_LDA(At, 1, 1); PG8_STAGE(PG8_SA(1, 0), a3, voffA);
            PG8_BAR; PG8_WAIT_L(0); PG8_MMA(1, 0, At, B0); PG8_BAR; PG8_SCHED;
            PG8_STAGE(PG8_SB(1, 1), b3 + hstep, voffB);
            PG8_WAIT_V(6); PG8_BAR; PG8_MMA(1, 1, At, B1); PG8_BAR;
            }
        }
        if constexpr (ALIGN_EPI) { if (wr == 0) PG8_BAR; }
        if constexpr (!Epi::AFTER_DRAIN) { E(acc, cur, wr, wc, fr, fq); S.done(cur); }
        if (!has_next) break;
#pragma unroll
        for (int a = 0; a < 2; ++a)
#pragma unroll
            for (int b = 0; b < 2; ++b)
#pragma unroll
                for (int m = 0; m < 4; ++m)
#pragma unroll
                    for (int n = 0; n < 2; ++n) acc[a][b][m][n] = (f32x4){0.f, 0.f, 0.f, 0.f};
        cur = nxt; cA = nA; cB = nB; ++ui;
        if constexpr (ALIGN_EPI) { if (wr == 1) PG8_BAR; }
    }
    PG8_WAIT_V(0);
    if constexpr (!ALIGN_EPI) { if (wr == 0) PG8_BAR; }
    PG8_BAR;
    if constexpr (Epi::AFTER_DRAIN) { E.fused(acc, cur, wr, wc, fr, fq, lds, wid, lane); S.done(cur); }
#undef PG8_SA
#undef PG8_SB
#undef PG8_STAGE
#undef PG8_LDA
#undef PG8_LDB
#undef PG8_MMA
#undef PG8_WAIT_V
#undef PG8_WAIT_L
#undef PG8_BAR
#undef PG8_SCHED
}
}
constexpr int DM = 1024, SEQ = 16384, NBATCH = 2, NP = NBATCH * SEQ, DEC_B = 16, DEC_T = 32, PAST = 2048, SKV = PAST + DEC_T;
constexpr int NSQ = DEC_B * DEC_T, NTOK = NP + NSQ, NKVS = DEC_B * SKV;
constexpr int DFF = 2816, INW = 2096, DEPTH = 2;
constexpr float EPS = 1e-6f;
constexpr float QSCALE = 0.10206207261596575f * 1.4426950408889634f;
constexpr int NITEM_P = NBATCH * 256 * 4, NITEM = NITEM_P + DEC_B * 4;

typedef unsigned short bf16;
typedef short bf16x8 __attribute__((ext_vector_type(8)));
typedef float f32x4 __attribute__((ext_vector_type(4)));
typedef float f32x16 __attribute__((ext_vector_type(16)));
typedef unsigned u32x4 __attribute__((ext_vector_type(4)));
typedef unsigned u32x2 __attribute__((ext_vector_type(2)));
#define LAS __attribute__((address_space(3)))

constexpr size_t T256 = (size_t)NTOK * 256 * 2;
constexpr size_t al(size_t x) { return (x + 4095) & ~(size_t)4095; }
constexpr size_t WS_ROPE = 4096;
constexpr size_t WS_GA = al(WS_ROPE + (size_t)SEQ * 32 * 4);
constexpr size_t WS_DECAY = al(WS_GA + (size_t)NTOK * 16 * 4);
constexpr size_t WS_WIN = al(WS_DECAY + (size_t)NITEM * 64 * 4);
constexpr size_t WS_WGV = al(WS_WIN + (size_t)1792 * 1024 * 2);
constexpr size_t WS_WUQ = al(WS_WGV + (size_t)512 * 1024 * 2);
constexpr size_t WS_WUK = al(WS_WUQ + (size_t)768 * 256 * 2);
constexpr size_t WS_WUV = al(WS_WUK + (size_t)512 * 256 * 2);
constexpr size_t WS_WO = al(WS_WUV + (size_t)512 * 256 * 2);
constexpr size_t WS_WGU = al(WS_WO + (size_t)1024 * 1024 * 2);
constexpr size_t WS_WD = al(WS_WGU + (size_t)5632 * 1024 * 2);
constexpr size_t WS_H = al(WS_WD + (size_t)1024 * 2816 * 2);
constexpr size_t WS_Z = al(WS_H + (size_t)NTOK * 1024 * 2);
constexpr size_t WS_GVT = al(WS_Z + 7 * T256);
constexpr size_t WS_CQN = al(WS_GVT + (size_t)512 * NTOK * 2);
constexpr size_t WS_CKVN = al(WS_CQN + T256);
constexpr size_t WS_CKVS = al(WS_CKVN + (size_t)NP * 256 * 2);
constexpr size_t WS_KR = al(WS_CKVS + (size_t)NKVS * 256 * 2);
constexpr size_t WS_KRS = al(WS_KR + (size_t)NP * 32 * 2);
constexpr size_t WS_KN = al(WS_KRS + (size_t)NKVS * 32 * 2);
constexpr size_t WS_VT = al(WS_KN + (size_t)NP * 512 * 2);
constexpr size_t WS_KNS = al(WS_VT + (size_t)512 * NP * 2);
constexpr size_t WS_VTS = al(WS_KNS + (size_t)NKVS * 512 * 2);
constexpr size_t WS_DS = al(WS_VTS + (size_t)512 * NKVS * 2);
constexpr size_t WS_END = al(WS_DS + (size_t)NITEM_P * 8192 * 4);
constexpr size_t WS_ACT = WS_Z;
static_assert(WS_ACT + (size_t)NTOK * DFF * 2 <= WS_END, "ACT overlay");
static_assert(WS_END <= (size_t)536870912, "ws budget");

constexpr size_t O_Y = 0, O_CKVP = (size_t)NTOK * DM, O_KRP = O_CKVP + (size_t)DEPTH * NP * 256, O_GLAP = O_KRP + (size_t)DEPTH * NP * 32,
                 O_CKVS = O_GLAP + (size_t)DEPTH * NBATCH * 4 * 8192, O_KRS = O_CKVS + (size_t)DEPTH * NSQ * 256, O_GLAS = O_KRS + (size_t)DEPTH * NSQ * 32,
                 O_END = O_GLAS + (size_t)DEPTH * DEC_B * 4 * 8192;

constexpr int LDS_BYTES = 147456;

struct Args {
    const float *xp, *xs, *cckv, *ckr, *sgla, *g_attn, *w_in, *g_qn, *w_uq, *g_kvn, *w_ukv, *w_a2, *b_a2, *g_on, *w_o, *g_ffn, *w_gu, *w_down, *g_final;
    float* out; unsigned char* ws;
};

__device__ __forceinline__ unsigned f2bf(float f) { unsigned u = __builtin_bit_cast(unsigned, f); return (u + 0x7fffu + ((u >> 16) & 1u)) >> 16; }
__device__ __forceinline__ unsigned pk2(float lo, float hi) { return f2bf(lo) | (f2bf(hi) << 16); }
__device__ __forceinline__ float bf2f(unsigned short b) { return __builtin_bit_cast(float, (unsigned)b << 16); }
__device__ __forceinline__ float bflo(unsigned w) { return __builtin_bit_cast(float, w << 16); }
__device__ __forceinline__ float bfhi(unsigned w) { return __builtin_bit_cast(float, w & 0xffff0000u); }
__device__ __forceinline__ float wave_sum(float v) {
#pragma unroll
    for (int o = 1; o < 64; o <<= 1) v += __shfl_xor(v, o);
    return v;
}
__device__ __forceinline__ int crow(int r, int hi) { return (r & 3) + 8 * (r >> 2) + 4 * hi; }
__device__ __forceinline__ float logsig(float x) { return fminf(x, 0.f) - __logf(1.0f + __expf(-fabsf(x))); }
#define LDS_WAIT() asm volatile("s_waitcnt lgkmcnt(0)" ::: "memory")
#define MFMA32(a, b, c) __builtin_amdgcn_mfma_f32_32x32x16_bf16((a), (b), (c), 0, 0, 0)

struct Ctx {
    int tid, lane, wave, G, vcu, gw, NGW;
    LAS unsigned char* lds;
};

__device__ __forceinline__ void tr_item(const float* W, int K, int N, int k0, int src0, int nvalid, bf16* WT, int dst_row0, float scale, LAS float* scr, int lane) {
#pragma unroll 8
    for (int i = 0; i < 32; ++i) { const int kk = 2 * i + (lane >> 5), c = lane & 31;
        float v = 0.f; if (c < nvalid) v = W[(size_t)(k0 + kk) * N + src0 + c] * scale;
        scr[kk * 33 + c] = v; }
    LDS_WAIT(); asm volatile("" ::: "memory");
    const int c8 = lane & 7;
#pragma unroll
    for (int j = 0; j < 4; ++j) { const int n = (lane >> 3) + 8 * j; const LAS float* s = scr + (8 * c8) * 33 + n;
        u32x4 o; o.x = pk2(s[0 * 33], s[1 * 33]); o.y = pk2(s[2 * 33], s[3 * 33]); o.z = pk2(s[4 * 33], s[5 * 33]); o.w = pk2(s[6 * 33], s[7 * 33]);
        *(u32x4*)(WT + (size_t)(dst_row0 + n) * K + k0 + 8 * c8) = o; }
    LDS_WAIT(); asm volatile("" ::: "memory");
}
__device__ __forceinline__ void convert_weights(const Ctx& C, const Args& A, int l) {
    LAS float* scr = (LAS float*)(C.lds + C.wave * 16384);
    unsigned char* ws = A.ws;
    const float* w_in = A.w_in + (size_t)l * DM * INW; const float* w_uq = A.w_uq + (size_t)l * 256 * 768; const float* w_ukv = A.w_ukv + (size_t)l * 256 * 1024;
    const float* w_o = A.w_o + (size_t)l * DM * DM; const float* w_gu = A.w_gu + (size_t)l * DM * 2 * DFF; const float* w_d = A.w_down + (size_t)l * DFF * DM;
    constexpr int I0 = 56 * 16, I1 = 16 * 16, I2 = 24 * 4, I3 = 16 * 4, I4 = 16 * 4, I5 = 32 * 16, I6 = 176 * 16, I7 = 32 * 44;
    constexpr int NIT = I0 + I1 + I2 + I3 + I4 + I5 + I6 + I7;
    for (int it = C.gw; it < NIT; it += C.NGW) {
        int r = it;
        if (r < I0) { const int db = r >> 4, kb = r & 15; int src = 0, nv = 32;
            if (db < 16) src = 32 * db; else if (db == 16) src = 512; else if (db == 17) { src = 2080; nv = 16; } else if (db < 24) { src = 0; nv = 0; }
            else if (db < 32) src = 544 + 32 * (db - 24); else if (db < 40) src = 800 + 32 * (db - 32); else src = 1568 + 32 * (db - 40);
            tr_item(w_in, DM, INW, 64 * kb, src, nv, (bf16*)(ws + WS_WIN), 32 * db, 1.f, scr, C.lane); continue; } r -= I0;
        if (r < I1) { const int db = r >> 4, kb = r & 15; tr_item(w_in, DM, INW, 64 * kb, 1056 + 32 * db, 32, (bf16*)(ws + WS_WGV), 32 * db, 1.f, scr, C.lane); continue; } r -= I1;
        if (r < I2) { const int db = r >> 2, kb = r & 3; tr_item(w_uq, 256, 768, 64 * kb, 32 * db, 32, (bf16*)(ws + WS_WUQ), 32 * db, QSCALE, scr, C.lane); continue; } r -= I2;
        if (r < I3) { const int db = r >> 2, kb = r & 3; tr_item(w_ukv, 256, 1024, 64 * kb, (db >> 1) * 128 + (db & 1) * 32, 32, (bf16*)(ws + WS_WUK), 32 * db, 1.f, scr, C.lane); continue; } r -= I3;
        if (r < I4) { const int db = r >> 2, kb = r & 3; tr_item(w_ukv, 256, 1024, 64 * kb, (db >> 1) * 128 + 64 + (db & 1) * 32, 32, (bf16*)(ws + WS_WUV), 32 * db, 1.f, scr, C.lane); continue; } r -= I4;
        if (r < I5) { const int db = r >> 4, kb = r & 15; tr_item(w_o, DM, DM, 64 * kb, 32 * db, 32, (bf16*)(ws + WS_WO), 32 * db, 1.f, scr, C.lane); continue; } r -= I5;
        if (r < I6) { const int db = r >> 4, kb = r & 15; const int pn = db >> 3, t = db & 7; const int src = (t < 4) ? 128 * pn + 32 * t : DFF + 128 * pn + 32 * (t - 4);
            tr_item(w_gu, DM, 2 * DFF, 64 * kb, src, 32, (bf16*)(ws + WS_WGU), 32 * db, 1.f, scr, C.lane); continue; } r -= I6;
        { const int db = r / 44, kb = r % 44; tr_item(w_d, DFF, DM, 64 * kb, 32 * db, 32, (bf16*)(ws + WS_WD), 32 * db, 1.f, scr, C.lane); }
    }
}

__device__ __forceinline__ void norm_row(const float* xrow, const float* g, bf16* orow, float* copy, int lane) {
    const f32x4* xr = (const f32x4*)xrow + lane; const f32x4* gr = (const f32x4*)g + lane;
    f32x4 v[4]; float s = 0.f;
#pragma unroll
    for (int j = 0; j < 4; ++j) { v[j] = xr[64 * j]; s += (v[j].x * v[j].x + v[j].y * v[j].y) + (v[j].z * v[j].z + v[j].w * v[j].w); }
    const float rstd = 1.0f / sqrtf(wave_sum(s) * (1.f / DM) + EPS);
    if (copy) {
#pragma unroll
        for (int j = 0; j < 4; ++j) ((f32x4*)copy + lane)[64 * j] = v[j]; }
    u32x2* o8 = (u32x2*)orow + lane;
#pragma unroll
    for (int j = 0; j < 4; ++j) { const f32x4 gg = gr[64 * j]; u32x2 w; w.x = pk2(v[j].x * rstd * gg.x, v[j].y * rstd * gg.y); w.y = pk2(v[j].z * rstd * gg.z, v[j].w * rstd * gg.w); o8[64 * j] = w; }
}
__device__ __forceinline__ void final_norm_row(float* xrow, const float* g, int lane) {
    f32x4* xr = (f32x4*)xrow + lane; const f32x4* gr = (const f32x4*)g + lane;
    f32x4 v[4]; float s = 0.f;
#pragma unroll
    for (int j = 0; j < 4; ++j) { v[j] = xr[64 * j]; s += (v[j].x * v[j].x + v[j].y * v[j].y) + (v[j].z * v[j].z + v[j].w * v[j].w); }
    const float rstd = 1.0f / sqrtf(wave_sum(s) * (1.f / DM) + EPS);
#pragma unroll
    for (int j = 0; j < 4; ++j) { const f32x4 gg = gr[64 * j]; xr[64 * j] = v[j] * rstd * gg; }
}

__device__ __forceinline__ void p3_token(const Args& A, int l, int m, int lane) {
    unsigned char* ws = A.ws;
    const bf16* CQ = (const bf16*)(ws + WS_Z); const bf16* CKV = (const bf16*)(ws + WS_Z + T256); const bf16* MISC = (const bf16*)(ws + WS_Z + 2 * T256);
    const float* ROPE = (const float*)(ws + WS_ROPE);
    { const u32x2 w = *((const u32x2*)(CQ + (size_t)m * 256) + lane); const float a = bflo(w.x), b = bfhi(w.x), c = bflo(w.y), d = bfhi(w.y);
      const float rstd = 1.0f / sqrtf(wave_sum((a * a + b * b) + (c * c + d * d)) * (1.f / 256) + EPS);
      const f32x4 g = *((const f32x4*)(A.g_qn + l * 256) + lane);
      u32x2 o; o.x = pk2(a * rstd * g.x, b * rstd * g.y); o.y = pk2(c * rstd * g.z, d * rstd * g.w);
      *((u32x2*)((bf16*)(ws + WS_CQN) + (size_t)m * 256) + lane) = o; }
    int pos; float* ockv; float* okr; bf16* bckv; bf16* bkr;
    if (m < NP) { pos = m & (SEQ - 1); ockv = A.out + O_CKVP + ((size_t)l * NP + m) * 256; okr = A.out + O_KRP + ((size_t)l * NP + m) * 32;
        bckv = (bf16*)(ws + WS_CKVN) + (size_t)m * 256; bkr = (bf16*)(ws + WS_KR) + (size_t)m * 32; }
    else { const int s = m - NP, b = s >> 5, t = s & 31; pos = PAST + t; ockv = A.out + O_CKVS + ((size_t)l * NSQ + s) * 256; okr = A.out + O_KRS + ((size_t)l * NSQ + s) * 32;
        const size_t r = (size_t)b * SKV + PAST + t; bckv = (bf16*)(ws + WS_CKVS) + r * 256; bkr = (bf16*)(ws + WS_KRS) + r * 32; }
    { const u32x2 w = *((const u32x2*)(CKV + (size_t)m * 256) + lane); const float a = bflo(w.x), b = bfhi(w.x), c = bflo(w.y), d = bfhi(w.y);
      const float rstd = 1.0f / sqrtf(wave_sum((a * a + b * b) + (c * c + d * d)) * (1.f / 256) + EPS);
      const f32x4 g = *((const f32x4*)(A.g_kvn + l * 256) + lane);
      const f32x4 o = (f32x4){a * rstd * g.x, b * rstd * g.y, c * rstd * g.z, d * rstd * g.w};
      *((f32x4*)ockv + lane) = o;
      u32x2 ob; ob.x = pk2(o.x, o.y); ob.y = pk2(o.z, o.w); *((u32x2*)bckv + lane) = ob; }
    if (lane < 16) { const float x1 = bf2f(MISC[(size_t)m * 256 + lane]), x2 = bf2f(MISC[(size_t)m * 256 + 16 + lane]);
        const float c = ROPE[pos * 32 + lane], s = ROPE[pos * 32 + 16 + lane];
        const float o1 = x1 * c - x2 * s, o2 = x1 * s + x2 * c;
        okr[lane] = o1; okr[16 + lane] = o2; bkr[lane] = (bf16)f2bf(o1); bkr[16 + lane] = (bf16)f2bf(o2); }
    else if (lane < 32) { ((float*)(ws + WS_GA))[(size_t)m * 16 + (lane - 16)] = bf2f(MISC[(size_t)m * 256 + 32 + (lane - 16)]); }
}
__device__ __forceinline__ void cache_row(const Args& A, int l, int r, int lane) {
    const int b = r >> 11, p = r & (PAST - 1); const size_t dr = (size_t)b * SKV + p;
    const f32x4 v = *((const f32x4*)(A.cckv + ((size_t)l * DEC_B * PAST + r) * 256) + lane);
    u32x2 o; o.x = pk2(v.x, v.y); o.y = pk2(v.z, v.w); *((u32x2*)((bf16*)(A.ws + WS_CKVS) + dr * 256) + lane) = o;
    if (lane < 32) ((bf16*)(A.ws + WS_KRS))[dr * 32 + lane] = (bf16)f2bf(A.ckr[((size_t)l * DEC_B * PAST + r) * 32 + lane]);
}

struct GlaItem { int tok0, L, hd, sb; bool sample; };
__device__ __forceinline__ GlaItem gla_decode(int it) {
    GlaItem g;
    if (it < NITEM_P) { g.hd = it & 3; const int bc = it >> 2; g.tok0 = bc * 64; g.L = 64; g.sample = false; g.sb = 0; }
    else { const int j = it - NITEM_P; g.hd = j & 3; g.sb = j >> 2; g.tok0 = NP + g.sb * 32; g.L = 32; g.sample = true; }
    return g;
}
constexpr int KT_PITCH = 72;
__device__ __forceinline__ void gla_g1(const Args& A, int l, int it, LAS unsigned char* wl, int lane) {
    const GlaItem g = gla_decode(it); unsigned char* ws = A.ws;
    const int col = g.hd * 64 + lane, r32 = lane & 31, hi = lane >> 5;
    const float* GA = (const float*)(ws + WS_GA); const bf16* GK = (const bf16*)(ws + WS_Z + 4 * T256); const bf16* GVT = (const bf16*)(ws + WS_GVT);
    LAS bf16* kT = (LAS bf16*)wl; LAS float* dsm = (LAS float*)(wl + 64 * KT_PITCH * 2);
    float w[16];
#pragma unroll
    for (int r = 0; r < 16; ++r) w[r] = A.w_a2[(size_t)l * 16 * 256 + r * 256 + col];
    const float bias = A.b_a2[l * 256 + col];
    float blast = 0.f;
    for (int p = 0; p < g.L; ++p) { const float* ga = GA + (size_t)(g.tok0 + p) * 16; float x = bias;
#pragma unroll
        for (int r = 0; r < 16; ++r) x += ga[r] * w[r];
        blast += logsig(x) * (1.f / 16.f); }
    float bc = 0.f;
    for (int p = 0; p < g.L; ++p) { const float* ga = GA + (size_t)(g.tok0 + p) * 16; float x = bias;
#pragma unroll
        for (int r = 0; r < 16; ++r) x += ga[r] * w[r];
        bc += logsig(x) * (1.f / 16.f);
        const float kk = bf2f(GK[(size_t)(g.tok0 + p) * 256 + col]) * __expf(blast - bc);
        kT[lane * KT_PITCH + p] = (bf16)f2bf(kk); }
    const float decay = __expf(blast);
    if (!g.sample) ((float*)(ws + WS_DECAY))[(size_t)it * 64 + lane] = decay;
    dsm[lane] = decay;
    LDS_WAIT(); asm volatile("" ::: "memory");
    const int nks = g.L >> 4;
#pragma unroll 1
    for (int nb = 0; nb < 4; ++nb) {
        f32x16 acc[2]; acc[0] = (f32x16){}; acc[1] = (f32x16){};
        for (int s = 0; s < nks; ++s) {
            const bf16x8 bfr = *(const bf16x8*)(GVT + (size_t)(g.hd * 128 + 32 * nb + r32) * NTOK + g.tok0 + 16 * s + 8 * hi);
#pragma unroll
            for (int mb = 0; mb < 2; ++mb) { const bf16x8 af = *(const LAS bf16x8*)(kT + (32 * mb + r32) * KT_PITCH + 16 * s + 8 * hi); acc[mb] = MFMA32(af, bfr, acc[mb]); }
        }
        const int dv = 32 * nb + r32;
        if (!g.sample) { float* dsp = (float*)(ws + WS_DS) + (size_t)it * 8192 + dv;
#pragma unroll
            for (int mb = 0; mb < 2; ++mb)
#pragma unroll
                for (int r = 0; r < 16; ++r) dsp[(32 * mb + crow(r, hi)) * 128] = acc[mb][r]; }
        else { const size_t so = (((size_t)l * DEC_B + g.sb) * 4 + g.hd) * 8192 + dv;
#pragma unroll
            for (int mb = 0; mb < 2; ++mb) {
#pragma unroll
                for (int r = 0; r < 16; ++r) { const int dk = 32 * mb + crow(r, hi); A.out[O_GLAS + so + dk * 128] = dsm[dk] * A.sgla[so + dk * 128] + acc[mb][r]; }
                asm volatile("" ::: "memory"); } }
    }
    LDS_WAIT(); asm volatile("" ::: "memory");
}
constexpr int NSCAN = 64;
__device__ __forceinline__ void gla_scan(const Args& A, int l, int sblock, int tid) {
    const int gth = sblock * 512 + tid;
    const int seq = gth >> 12, e0 = (gth & 4095) * 2;
    const int b = seq >> 2, hd = seq & 3, dk = e0 >> 7;
    float* DS = (float*)(A.ws + WS_DS); const float* DEC = (const float*)(A.ws + WS_DECAY);
    float s0 = 0.f, s1 = 0.f;
    for (int c0 = 0; c0 < 256; c0 += 8) {
        float2 ds[8]; float dc[8];
#pragma unroll
        for (int j = 0; j < 8; ++j) { const size_t it = (size_t)((b * 256 + c0 + j) * 4 + hd); ds[j] = *(const float2*)(DS + it * 8192 + e0); dc[j] = DEC[it * 64 + dk]; }
#pragma unroll
        for (int j = 0; j < 8; ++j) { const size_t it = (size_t)((b * 256 + c0 + j) * 4 + hd); *(float2*)(DS + it * 8192 + e0) = make_float2(s0, s1);
            s0 = dc[j] * s0 + ds[j].x; s1 = dc[j] * s1 + ds[j].y; }
    }
    *(float2*)(A.out + O_GLAP + (((size_t)l * NBATCH + b) * 4 + hd) * 8192 + e0) = make_float2(s0, s1);
}
constexpr int BS_PITCH = 65;
__device__ __forceinline__ void gla_g3(const Args& A, int l, int it, LAS unsigned char* wl, int lane) {
    const GlaItem g = gla_decode(it); unsigned char* ws = A.ws;
    const int col = g.hd * 64 + lane, r32 = lane & 31, hi = lane >> 5;
    const float* GA = (const float*)(ws + WS_GA); const bf16* GQ = (const bf16*)(ws + WS_Z + 3 * T256); const bf16* GK = (const bf16*)(ws + WS_Z + 4 * T256);
    const bf16* GG = (const bf16*)(ws + WS_Z + 5 * T256); const bf16* GVT = (const bf16*)(ws + WS_GVT); bf16* CAT = (bf16*)(ws + WS_H);
    LAS float* bsm = (LAS float*)wl;
    {   float w[16];
#pragma unroll
        for (int r = 0; r < 16; ++r) w[r] = A.w_a2[(size_t)l * 16 * 256 + r * 256 + col];
        const float bias = A.b_a2[l * 256 + col];
        float bc = 0.f;
        for (int p = 0; p < g.L; ++p) { const float* ga = GA + (size_t)(g.tok0 + p) * 16; float x = bias;
#pragma unroll
            for (int r = 0; r < 16; ++r) x += ga[r] * w[r];
            bc += logsig(x) * (1.f / 16.f); bsm[p * BS_PITCH + lane] = bc; }
    }
    LDS_WAIT(); asm volatile("" ::: "memory");
    const int nib = g.L >> 5;
    bf16x8 qf[2][4], kf[2][4];
#pragma unroll
    for (int ib = 0; ib < 2; ++ib)
#pragma unroll
        for (int s = 0; s < 4; ++s) {
            if (ib < nib) { const int i = 32 * ib + r32, dk0 = 16 * s + 8 * hi;
                const u32x4 rq = *(const u32x4*)(GQ + (size_t)(g.tok0 + i) * 256 + g.hd * 64 + dk0);
                const u32x4 rk = *(const u32x4*)(GK + (size_t)(g.tok0 + i) * 256 + g.hd * 64 + dk0);
                u32x4 oq, ok;
#pragma unroll
                for (int jj = 0; jj < 4; ++jj) { const float b0 = bsm[i * BS_PITCH + dk0 + 2 * jj], b1 = bsm[i * BS_PITCH + dk0 + 2 * jj + 1];
                    oq[jj] = pk2(bflo(rq[jj]) * 0.125f * __expf(b0), bfhi(rq[jj]) * 0.125f * __expf(b1));
                    ok[jj] = pk2(bflo(rk[jj]) * __expf(-b0), bfhi(rk[jj]) * __expf(-b1)); }
                qf[ib][s] = __builtin_bit_cast(bf16x8, oq); kf[ib][s] = __builtin_bit_cast(bf16x8, ok); }
            else { qf[ib][s] = (bf16x8){}; kf[ib][s] = (bf16x8){}; }
        }
    bf16x8 xp[2][2][2];
#pragma unroll
    for (int jb = 0; jb < 2; ++jb)
#pragma unroll
        for (int ib = 0; ib < 2; ++ib) {
            if (jb > ib || ib >= nib) { xp[jb][ib][0] = (bf16x8){}; xp[jb][ib][1] = (bf16x8){}; continue; }
            f32x16 X = (f32x16){};
#pragma unroll
            for (int s = 0; s < 4; ++s) X = MFMA32(kf[jb][s], qf[ib][s], X);
            if (jb == ib) {
#pragma unroll
                for (int r = 0; r < 16; ++r) if (crow(r, hi) > r32) X[r] = 0.f; }
#pragma unroll
            for (int s2 = 0; s2 < 2; ++s2) { u32x4 pw;
#pragma unroll
                for (int jj = 0; jj < 4; ++jj) pw[jj] = pk2(X[8 * s2 + 2 * jj], X[8 * s2 + 2 * jj + 1]);
                xp[jb][ib][s2] = __builtin_bit_cast(bf16x8, pw); }
        }
    const float* Sp = g.sample ? A.sgla + (((size_t)l * DEC_B + g.sb) * 4 + g.hd) * 8192 : (const float*)(ws + WS_DS) + (size_t)it * 8192;
#pragma unroll
    for (int ib = 0; ib < 2; ++ib) {
        if (ib < nib) {
            f32x16 o[4];
#pragma unroll
            for (int nb = 0; nb < 4; ++nb) {
                const int dv = 32 * nb + r32;
                o[nb] = (f32x16){};
#pragma unroll
                for (int s = 0; s < 4; ++s) { u32x4 pw;
#pragma unroll
                    for (int jj = 0; jj < 4; ++jj) pw[jj] = pk2(Sp[(16 * s + 8 * hi + 2 * jj) * 128 + dv], Sp[(16 * s + 8 * hi + 2 * jj + 1) * 128 + dv]);
                    o[nb] = MFMA32(__builtin_bit_cast(bf16x8, pw), qf[ib][s], o[nb]); }
#pragma unroll
                for (int jb = 0; jb <= ib; ++jb)
#pragma unroll
                    for (int s2 = 0; s2 < 2; ++s2) { const bf16* vp = GVT + (size_t)(g.hd * 128 + dv) * NTOK + g.tok0 + 32 * jb + 16 * s2 + 4 * hi;
                        const u32x2 lo = *(const u32x2*)vp, hi8 = *(const u32x2*)(vp + 8);
                        o[nb] = MFMA32(__builtin_bit_cast(bf16x8, (u32x4){lo.x, lo.y, hi8.x, hi8.y}), xp[jb][ib][s2], o[nb]); }
            }
            float ss = 0.f;
#pragma unroll
            for (int nb = 0; nb < 4; ++nb)
#pragma unroll
                for (int r = 0; r < 16; ++r) ss += o[nb][r] * o[nb][r];
            ss += __shfl_xor(ss, 32);
            const float rstd = 1.0f / sqrtf(ss * (1.f / 128) + EPS);
            const int tok = g.tok0 + 32 * ib + r32;
#pragma unroll
            for (int nb = 0; nb < 4; ++nb)
#pragma unroll
                for (int q = 0; q < 4; ++q) { const int dv0 = 32 * nb + 8 * q + 4 * hi; const int gc = g.hd * 128 + dv0;
                    const u32x2 gw = *(const u32x2*)(GG + (size_t)(gc >> 8) * ((size_t)NTOK * 256) + (size_t)tok * 256 + (gc & 255));
                    const f32x4 gon = *(const f32x4*)(A.g_on + l * 128 + dv0);
                    const float g0 = bflo(gw.x), g1 = bfhi(gw.x), g2 = bflo(gw.y), g3 = bfhi(gw.y);
                    const float v0 = o[nb][4 * q + 0] * rstd * gon.x * (g0 / (1.0f + __expf(-g0)));
                    const float v1 = o[nb][4 * q + 1] * rstd * gon.y * (g1 / (1.0f + __expf(-g1)));
                    const float v2 = o[nb][4 * q + 2] * rstd * gon.z * (g2 / (1.0f + __expf(-g2)));
                    const float v3 = o[nb][4 * q + 3] * rstd * gon.w * (g3 / (1.0f + __expf(-g3)));
                    u32x2 ow; ow.x = pk2(v0, v1); ow.y = pk2(v2, v3);
                    *(u32x2*)(CAT + (size_t)tok * 1024 + 512 + g.hd * 128 + dv0) = ow; }
            asm volatile("" ::: "memory");
        }
    }
    LDS_WAIT(); asm volatile("" ::: "memory");
}

__device__ __forceinline__ unsigned cvtpk(float lo, float hi) { unsigned r; asm("v_cvt_pk_bf16_f32 %0, %1, %2" : "=v"(r) : "v"(lo), "v"(hi)); return r; }
__device__ __forceinline__ float max3f(float a, float b, float c) { return fmaxf(fmaxf(a, b), c); }
constexpr float ATT_THR = 8.0f;
template <class LD> __device__ __forceinline__ void attn_tile(const LD& ld, const bf16x8 (&qr)[6], f32x16 (&o)[2], float& m, float& l, bool half_only, bool first) {
    f32x16 negm;
#pragma unroll
    for (int r = 0; r < 16; ++r) negm[r] = -m;
    f32x16 p0 = negm, p1 = negm;
#pragma unroll
    for (int s = 0; s < 6; ++s) p0 = MFMA32(ld.k(0, s), qr[s], p0);
    if (!half_only) {
#pragma unroll
        for (int s = 0; s < 6; ++s) p1 = MFMA32(ld.k(1, s), qr[s], p1); }
    float mx = max3f(p0[0], p0[1], p0[2]);
#pragma unroll
    for (int r = 3; r < 15; r += 2) mx = max3f(mx, p0[r], p0[r + 1]);
    mx = fmaxf(mx, p0[15]);
    if (!half_only) {
#pragma unroll
        for (int r = 0; r < 16; r += 2) mx = max3f(mx, p1[r], p1[r + 1]); }
    mx = fmaxf(mx, __shfl_xor(mx, 32));
    if (first || __any(mx > ATT_THR)) {
        const float d = first ? mx : fmaxf(mx, 0.f);
        m += d;
        const float f = first ? 0.f : __builtin_amdgcn_exp2f(-d);
        l *= f;
#pragma unroll
        for (int r = 0; r < 16; ++r) { p0[r] -= d; p1[r] -= d; o[0][r] *= f; o[1][r] *= f; }
    }
    float rs = 0.f, rs1 = 0.f;
#pragma unroll
    for (int r = 0; r < 16; ++r) { p0[r] = __builtin_amdgcn_exp2f(p0[r]); rs += p0[r]; }
    if (!half_only) {
#pragma unroll
        for (int r = 0; r < 16; ++r) { p1[r] = __builtin_amdgcn_exp2f(p1[r]); rs1 += p1[r]; } }
    l += rs + rs1;
    bf16x8 pa[4];
#pragma unroll
    for (int s = 0; s < 2; ++s) { u32x4 w0, w1;
#pragma unroll
        for (int jj = 0; jj < 4; ++jj) { w0[jj] = cvtpk(p0[8 * s + 2 * jj], p0[8 * s + 2 * jj + 1]); w1[jj] = cvtpk(p1[8 * s + 2 * jj], p1[8 * s + 2 * jj + 1]); }
        pa[s] = __builtin_bit_cast(bf16x8, w0); pa[2 + s] = __builtin_bit_cast(bf16x8, w1); }
#pragma unroll
    for (int db = 0; db < 2; ++db) {
#pragma unroll
        for (int s = 0; s < 2; ++s) o[db] = MFMA32(ld.v(db, s), pa[s], o[db]);
        if (!half_only) {
#pragma unroll
            for (int s = 2; s < 4; ++s) o[db] = MFMA32(ld.v(db, s), pa[s], o[db]); }
    }
}
constexpr int K_PITCH = 208, V_PITCH = 136, KBUF = 64 * K_PITCH, VBUF = 64 * V_PITCH, ABUF = KBUF + VBUF;
struct LdsLoader {
    LAS const unsigned char* kb; LAS const unsigned char* vb; int r32, hi;
    __device__ __forceinline__ bf16x8 k(int half, int s) const { return *(LAS const bf16x8*)(kb + (r32 + 32 * half) * K_PITCH + s * 32 + hi * 16); }
    __device__ __forceinline__ bf16x8 v(int db, int s) const { LAS const unsigned char* p = vb + (r32 + 32 * db) * V_PITCH + s * 32 + hi * 8;
        const u32x2 lo = *(LAS const u32x2*)p, h8 = *(LAS const u32x2*)(p + 16); return __builtin_bit_cast(bf16x8, (u32x4){lo.x, lo.y, h8.x, h8.y}); }
};
struct GlbLoader {
    const bf16* kn; const bf16* kr; const bf16* vt; int r32, hi;
    __device__ __forceinline__ bf16x8 k(int half, int s) const { const int kv = r32 + 32 * half;
        return (s < 4) ? *(const bf16x8*)(kn + (size_t)kv * 512 + 16 * s + 8 * hi) : *(const bf16x8*)(kr + (size_t)kv * 32 + 16 * (s - 4) + 8 * hi); }
    __device__ __forceinline__ bf16x8 v(int db, int s) const { const bf16* p = vt + (size_t)(r32 + 32 * db) * NKVS + 16 * s + 4 * hi;
        const u32x2 lo = *(const u32x2*)p, h8 = *(const u32x2*)(p + 8); return __builtin_bit_cast(bf16x8, (u32x4){lo.x, lo.y, h8.x, h8.y}); }
};
__device__ __forceinline__ void load_q(bf16x8 (&qr)[6], const bf16* qp, const float* rope_row, int hi) {
#pragma unroll
    for (int s = 0; s < 6; ++s) qr[s] = *(const bf16x8*)(qp + 16 * s + 8 * hi);
    const u32x4 a = __builtin_bit_cast(u32x4, qr[4]), b = __builtin_bit_cast(u32x4, qr[5]); u32x4 oa, ob;
    const f32x4 c0 = *(const f32x4*)(rope_row + 8 * hi), c1 = *(const f32x4*)(rope_row + 8 * hi + 4), s0 = *(const f32x4*)(rope_row + 16 + 8 * hi), s1 = *(const f32x4*)(rope_row + 16 + 8 * hi + 4);
#pragma unroll
    for (int jj = 0; jj < 4; ++jj) {
        const float x1l = bflo(a[jj]), x1h = bfhi(a[jj]), x2l = bflo(b[jj]), x2h = bfhi(b[jj]);
        const float cl = (jj < 2) ? c0[2 * jj] : c1[2 * jj - 4], ch = (jj < 2) ? c0[2 * jj + 1] : c1[2 * jj - 3];
        const float sl = (jj < 2) ? s0[2 * jj] : s1[2 * jj - 4], sh = (jj < 2) ? s0[2 * jj + 1] : s1[2 * jj - 3];
        oa[jj] = pk2(x1l * cl - x2l * sl, x1h * ch - x2h * sh); ob[jj] = pk2(x1l * sl + x2l * cl, x1h * sh + x2h * ch); }
    qr[4] = __builtin_bit_cast(bf16x8, oa); qr[5] = __builtin_bit_cast(bf16x8, ob);
}
__device__ __forceinline__ void attn_prompt_unit(const Args& A, const Ctx& C, int b, int hd, int qb) {
    unsigned char* ws = A.ws; const int tid = C.tid, lane = C.lane, wid = C.wave, r32 = lane & 31, hi = lane >> 5;
    const bf16* Q = (const bf16*)(ws + WS_Z); const bf16* KN = (const bf16*)(ws + WS_KN); const bf16* KR = (const bf16*)(ws + WS_KR); const bf16* VT = (const bf16*)(ws + WS_VT);
    bf16* CAT = (bf16*)(ws + WS_H); const float* ROPE = (const float*)(ws + WS_ROPE);
    const int pos = qb * 256 + wid * 32 + r32; const size_t qrow = (size_t)b * SEQ + pos;
    bf16x8 qr[6]; load_q(qr, Q + qrow * 768 + hd * 96, ROPE + (size_t)pos * 32, hi);
    const int ntiles = 4 * qb + 4, my_last = 4 * qb + (wid >> 1);
    const int krow = tid >> 3, kch = tid & 7, rrow = (tid & 255) >> 2, rch = tid & 3;
    const bf16* kn_src = KN + ((size_t)b * SEQ + krow) * 512 + hd * 64 + kch * 8;
    const bf16* kr_src = KR + ((size_t)b * SEQ + rrow) * 32 + rch * 8;
    const bf16* vt_src = VT + (size_t)(hd * 64 + krow) * NP + (size_t)b * SEQ + kch * 8;
    const int kn_dst = krow * K_PITCH + kch * 16, kr_dst = rrow * K_PITCH + 128 + rch * 16, vt_dst = KBUF + krow * V_PITCH + kch * 16;
    u32x4 sk, sr, sv;
    sk = *(const u32x4*)kn_src; sv = *(const u32x4*)vt_src; if (tid < 256) sr = *(const u32x4*)kr_src;
    { LAS unsigned char* bufp = C.lds; *(LAS u32x4*)(bufp + kn_dst) = sk; if (tid < 256) *(LAS u32x4*)(bufp + kr_dst) = sr;
      *(LAS u32x2*)(bufp + vt_dst) = (u32x2){sv.x, sv.y}; *(LAS u32x2*)(bufp + vt_dst + 8) = (u32x2){sv.z, sv.w}; }
    __syncthreads();
    f32x16 o[2]; o[0] = (f32x16){}; o[1] = (f32x16){}; float m = 0.f, l = 0.f;
    for (int t = 0; t < ntiles; ++t) {
        const bool more = (t + 1 < ntiles);
        if (more) { sk = *(const u32x4*)(kn_src + (size_t)(t + 1) * 64 * 512); sv = *(const u32x4*)(vt_src + (size_t)(t + 1) * 64); if (tid < 256) sr = *(const u32x4*)(kr_src + (size_t)(t + 1) * 64 * 32); }
        if (t <= my_last) { LdsLoader ld{C.lds + (t & 1) * ABUF, C.lds + (t & 1) * ABUF + KBUF, r32, hi}; attn_tile(ld, qr, o, m, l, false, t == 0); }
        if (more) { LAS unsigned char* bufp = C.lds + ((t + 1) & 1) * ABUF; *(LAS u32x4*)(bufp + kn_dst) = sk; if (tid < 256) *(LAS u32x4*)(bufp + kr_dst) = sr;
            *(LAS u32x2*)(bufp + vt_dst) = (u32x2){sv.x, sv.y}; *(LAS u32x2*)(bufp + vt_dst + 8) = (u32x2){sv.z, sv.w}; }
        __syncthreads();
    }
    const float lt = l + __shfl_xor(l, 32); const float inv = 1.0f / lt;
    bf16* orow = CAT + qrow * 1024 + hd * 64;
#pragma unroll
    for (int db = 0; db < 2; ++db)
#pragma unroll
        for (int q = 0; q < 4; ++q) { u32x2 w; w.x = pk2(o[db][4 * q] * inv, o[db][4 * q + 1] * inv); w.y = pk2(o[db][4 * q + 2] * inv, o[db][4 * q + 3] * inv);
            *(u32x2*)(orow + 32 * db + 8 * q + 4 * hi) = w; }
}
__device__ __forceinline__ void attn_sample_unit(const Args& A, const Ctx& C, int b, int hd) {
    unsigned char* ws = A.ws; const int tid = C.tid, lane = C.lane, wid = C.wave, r32 = lane & 31, hi = lane >> 5;
    const bf16* Q = (const bf16*)(ws + WS_Z); const bf16* KNS = (const bf16*)(ws + WS_KNS); const bf16* KRS = (const bf16*)(ws + WS_KRS); const bf16* VTS = (const bf16*)(ws + WS_VTS);
    bf16* CAT = (bf16*)(ws + WS_H); const float* ROPE = (const float*)(ws + WS_ROPE);
    const size_t qrow = (size_t)NP + b * 32 + r32;
    bf16x8 qr[6]; load_q(qr, Q + qrow * 768 + hd * 96, ROPE + (size_t)(PAST + r32) * 32, hi);
    f32x16 o[2]; o[0] = (f32x16){}; o[1] = (f32x16){}; float m = 0.f, l = 0.f;
    for (int t = wid; t < 33; t += 8) {
        const size_t key0 = (size_t)b * SKV + 64 * t;
        GlbLoader ld{KNS + key0 * 512 + hd * 64, KRS + key0 * 32, VTS + (size_t)(hd * 64) * NKVS + key0, r32, hi};
        attn_tile(ld, qr, o, m, l, t == 32, t == wid);
    }
    const float lt = l + __shfl_xor(l, 32);
    LAS float* cm = (LAS float*)C.lds; LAS float* cl = cm + 256; LAS float* co = cm + 512;
    if (hi == 0) { cm[wid * 32 + r32] = m; cl[wid * 32 + r32] = lt; }
#pragma unroll
    for (int db = 0; db < 2; ++db)
#pragma unroll
        for (int r = 0; r < 16; ++r) co[(wid * 64 + 32 * db + crow(r, hi)) * 32 + r32] = o[db][r];
    __syncthreads();
    { const int q = tid & 31, d0 = (tid >> 5) * 4;
      float M = cm[q];
#pragma unroll
      for (int w = 1; w < 8; ++w) M = fmaxf(M, cm[w * 32 + q]);
      float L = 0.f, acc[4] = {0.f, 0.f, 0.f, 0.f};
#pragma unroll
      for (int w = 0; w < 8; ++w) { const float f = __builtin_amdgcn_exp2f(cm[w * 32 + q] - M); L += cl[w * 32 + q] * f;
#pragma unroll
          for (int i = 0; i < 4; ++i) acc[i] += co[(w * 64 + d0 + i) * 32 + q] * f; }
      const float inv = 1.0f / L;
      u32x2 wv; wv.x = pk2(acc[0] * inv, acc[1] * inv); wv.y = pk2(acc[2] * inv, acc[3] * inv);
      *(u32x2*)(CAT + ((size_t)NP + b * 32 + q) * 1024 + hd * 64 + d0) = wv; }
    __syncthreads();
}

__global__ void __launch_bounds__(512, 2) fwd_mega(Args A) {
    extern __shared__ __attribute__((aligned(16))) unsigned char lds_raw[];
    cg::grid_group grid = cg::this_grid();
    Ctx C; C.lds = (LAS unsigned char*)lds_raw; C.tid = threadIdx.x; C.lane = C.tid & 63; C.wave = __builtin_amdgcn_readfirstlane(C.tid >> 6);
    C.G = gridDim.x; { const int bx = blockIdx.x; C.vcu = (C.G % 8 == 0) ? (bx % 8) * (C.G / 8) + bx / 8 : bx; }
    C.gw = blockIdx.x * 8 + C.wave; C.NGW = C.G * 8;
    unsigned char* ws = A.ws;
    float* X = A.out + O_Y;
    { float* ROPE = (float*)(ws + WS_ROPE);
      for (int e = blockIdx.x * 512 + C.tid; e < SEQ * 16; e += C.G * 512) { const int p = e >> 4, i = e & 15;
          const double base = (i & 3) == 0 ? 1.0 : (i & 3) == 1 ? 0.5623413251903491 : (i & 3) == 2 ? 0.31622776601683794 : 0.1778279410038923;
          const double sc = (i >> 2) == 0 ? 1.0 : (i >> 2) == 1 ? 0.1 : (i >> 2) == 2 ? 0.01 : 0.001;
          const float inv = (float)(base * sc); const float ang = (float)p * inv;
          const double rev = (double)ang * 0.15915494309189535; const float fr = (float)(rev - __builtin_rint(rev));
          ROPE[p * 32 + i] = __builtin_amdgcn_cosf(fr); ROPE[p * 32 + 16 + i] = __builtin_amdgcn_sinf(fr); } }
#define REFRESH() do { int t_ = threadIdx.x; asm volatile("" : "+v"(t_)); C.tid = t_; C.lane = t_ & 63; C.wave = __builtin_amdgcn_readfirstlane(t_ >> 6); C.gw = blockIdx.x * 8 + C.wave; } while (0)
#pragma unroll 1
    for (int l = 0; l < DEPTH; ++l) {
        REFRESH();
        convert_weights(C, A, l);
        for (int mrow = C.gw; mrow < NTOK; mrow += C.NGW) {
            const float* xr = (l == 0) ? (mrow < NP ? A.xp + (size_t)mrow * DM : A.xs + (size_t)(mrow - NP) * DM) : X + (size_t)mrow * DM;
            norm_row(xr, A.g_attn + l * DM, (bf16*)(ws + WS_H) + (size_t)mrow * DM, (l == 0) ? X + (size_t)mrow * DM : nullptr, C.lane); }
        for (int r = C.gw; r < DEC_B * PAST; r += C.NGW) cache_row(A, l, r, C.lane);
        grid.sync();
#ifndef NO_P2
        { pg8::EpiBf16 E{(pg8::bf16_t*)(ws + WS_Z), 256, 256, (size_t)NTOK * 256};
          pg8::Gemm g{(const pg8::bf16_t*)(ws + WS_H), (const pg8::bf16_t*)(ws + WS_WIN), NTOK, 1792, DM}; pg8::StaticOrder S; S.init(NTOK, 1792, C.G, (int)blockIdx.x);
          pg8::gemm_phase<pg8::EpiBf16, pg8::StaticOrder, true, true>(C.lds, g, S, E); }
        { pg8::EpiBf16 E{(pg8::bf16_t*)(ws + WS_GVT), NTOK, 0, 0};
          pg8::Gemm g{(const pg8::bf16_t*)(ws + WS_WGV), (const pg8::bf16_t*)(ws + WS_H), 512, NTOK, DM}; pg8::StaticOrder S; S.init(512, NTOK, C.G, (int)((blockIdx.x + 146) % C.G));
          pg8::gemm_phase<pg8::EpiBf16, pg8::StaticOrder, true, true>(C.lds, g, S, E); }
        grid.sync();
#endif
        REFRESH();
        for (int mrow = C.gw; mrow < NTOK; mrow += C.NGW) p3_token(A, l, mrow, C.lane);
        grid.sync();
        #ifndef NO_G1
        for (int it = C.gw; it < NITEM; it += C.NGW) gla_g1(A, l, it, C.lds + C.wave * 16384, C.lane);
#endif
        grid.sync();
#ifndef NO_P4
        if ((int)blockIdx.x < NSCAN) gla_scan(A, l, blockIdx.x, C.tid);
        else {
            const int G2 = C.G - NSCAN, c2 = blockIdx.x - NSCAN;
#pragma unroll 1
            for (int gi = 0; gi < 5; ++gi) {
                pg8::Gemm g; pg8::EpiBf16 E; int M_, N_;
                if (gi == 0) { g = pg8::Gemm{(const pg8::bf16_t*)(ws + WS_CQN), (const pg8::bf16_t*)(ws + WS_WUQ), NTOK, 768, 256}; E = pg8::EpiBf16{(pg8::bf16_t*)(ws + WS_Z), 768, 0, 0}; M_ = NTOK; N_ = 768; }
                else if (gi == 1) { g = pg8::Gemm{(const pg8::bf16_t*)(ws + WS_CKVN), (const pg8::bf16_t*)(ws + WS_WUK), NP, 512, 256}; E = pg8::EpiBf16{(pg8::bf16_t*)(ws + WS_KN), 512, 0, 0}; M_ = NP; N_ = 512; }
                else if (gi == 2) { g = pg8::Gemm{(const pg8::bf16_t*)(ws + WS_WUV), (const pg8::bf16_t*)(ws + WS_CKVN), 512, NP, 256}; E = pg8::EpiBf16{(pg8::bf16_t*)(ws + WS_VT), NP, 0, 0}; M_ = 512; N_ = NP; }
                else if (gi == 3) { g = pg8::Gemm{(const pg8::bf16_t*)(ws + WS_CKVS), (const pg8::bf16_t*)(ws + WS_WUK), NKVS, 512, 256}; E = pg8::EpiBf16{(pg8::bf16_t*)(ws + WS_KNS), 512, 0, 0}; M_ = NKVS; N_ = 512; }
                else { g = pg8::Gemm{(const pg8::bf16_t*)(ws + WS_WUV), (const pg8::bf16_t*)(ws + WS_CKVS), 512, NKVS, 256}; E = pg8::EpiBf16{(pg8::bf16_t*)(ws + WS_VTS), NKVS, 0, 0}; M_ = 512; N_ = NKVS; }
                pg8::StaticOrder S; S.init(M_, N_, G2, (c2 + gi * 37) % G2);
                pg8::gemm_phase<pg8::EpiBf16, pg8::StaticOrder, true, true>(C.lds, g, S, E);
            }
        }
        grid.sync();
#endif
        REFRESH();
#ifndef NO_G3
        for (int it = C.gw; it < NITEM; it += C.NGW) gla_g3(A, l, it, C.lds + C.wave * 17408, C.lane);
#endif
        __syncthreads();
#ifndef NO_SAMP
        if (C.vcu >= C.G - 128 && C.vcu < C.G) { const int u = C.vcu - (C.G - 128); attn_sample_unit(A, C, u >> 3, u & 7); }
#endif
#ifndef NO_ATTN
        for (int u = C.vcu; u < 1024; u += C.G) {
            const int bh = (u % 256) >> 4, s = u & 15, i = u >> 8; const int qb = (i == 0) ? 63 - s : (i == 1) ? 32 + s : (i == 2) ? 31 - s : s;
            attn_prompt_unit(A, C, bh >> 3, bh & 7, qb); }
#endif
        grid.sync();
#ifndef NO_P6
        { pg8::EpiRes E{X, DM};
          pg8::Gemm g{(const pg8::bf16_t*)(ws + WS_H), (const pg8::bf16_t*)(ws + WS_WO), NTOK, DM, DM}; pg8::StaticOrder S; S.init(NTOK, DM, C.G, (int)blockIdx.x);
          pg8::gemm_phase<pg8::EpiRes, pg8::StaticOrder, true, true>(C.lds, g, S, E); }
        grid.sync();
#endif
        REFRESH();
        for (int mrow = C.gw; mrow < NTOK; mrow += C.NGW) norm_row(X + (size_t)mrow * DM, A.g_ffn + l * DM, (bf16*)(ws + WS_H) + (size_t)mrow * DM, nullptr, C.lane);
        grid.sync();
#ifndef NO_P8
        { pg8::EpiSwiglu E{(pg8::bf16_t*)(ws + WS_ACT), DFF};
          pg8::Gemm g{(const pg8::bf16_t*)(ws + WS_H), (const pg8::bf16_t*)(ws + WS_WGU), NTOK, 2 * DFF, DM}; pg8::StaticOrder S; S.init(NTOK, 2 * DFF, C.G, (int)blockIdx.x);
          pg8::gemm_phase<pg8::EpiSwiglu, pg8::StaticOrder, true, true>(C.lds, g, S, E); }
        grid.sync();
#endif
#ifndef NO_P9
        { pg8::EpiRes E{X, DM};
          pg8::Gemm g{(const pg8::bf16_t*)(ws + WS_ACT), (const pg8::bf16_t*)(ws + WS_WD), NTOK, DM, DFF}; pg8::StaticOrder S; S.init(NTOK, DM, C.G, (int)blockIdx.x);
          pg8::gemm_phase<pg8::EpiRes, pg8::StaticOrder, true, true>(C.lds, g, S, E); }
        grid.sync();
#endif
    }
    REFRESH();
    for (int mrow = C.gw; mrow < NTOK; mrow += C.NGW) final_norm_row(X + (size_t)mrow * DM, A.g_final, C.lane);
}

extern "C" void kernel_launch(void* const* d_in, const int* in_sizes, int n_in, void* d_out, int out_size, void* d_ws, size_t ws_size, hipStream_t stream) {
    static int grid = 0;
    if (grid == 0) {
        if (n_in != 19 || (size_t)out_size != O_END || ws_size < WS_END) { fprintf(stderr, "kernel_launch: unexpected shapes: n_in %d out %d ws %zu (need %zu)\n", n_in, out_size, ws_size, (size_t)WS_END); grid = -1; return; }
        int dev = 0, cus = 0, per_cu = 0;
        hipGetDevice(&dev); hipDeviceGetAttribute(&cus, hipDeviceAttributeMultiprocessorCount, dev);
        if (hipFuncSetAttribute((const void*)fwd_mega, hipFuncAttributeMaxDynamicSharedMemorySize, LDS_BYTES) != hipSuccess) { fprintf(stderr, "kernel_launch: hipFuncSetAttribute failed\n"); grid = -1; return; }
        if (hipOccupancyMaxActiveBlocksPerMultiprocessor(&per_cu, (const void*)fwd_mega, 512, LDS_BYTES) != hipSuccess || per_cu < 1) { fprintf(stderr, "kernel_launch: occupancy query says %d\n", per_cu); per_cu = 1; }
        (void)hipGetLastError();
        grid = cus;
    }
    if (grid < 0) return;
    Args a{};
    a.xp = (const float*)d_in[0]; a.xs = (const float*)d_in[1]; a.cckv = (const float*)d_in[2]; a.ckr = (const float*)d_in[3]; a.sgla = (const float*)d_in[4];
    a.g_attn = (const float*)d_in[5]; a.w_in = (const float*)d_in[6]; a.g_qn = (const float*)d_in[7]; a.w_uq = (const float*)d_in[8]; a.g_kvn = (const float*)d_in[9];
    a.w_ukv = (const float*)d_in[10]; a.w_a2 = (const float*)d_in[11]; a.b_a2 = (const float*)d_in[12]; a.g_on = (const float*)d_in[13]; a.w_o = (const float*)d_in[14];
    a.g_ffn = (const float*)d_in[15]; a.w_gu = (const float*)d_in[16]; a.w_down = (const float*)d_in[17]; a.g_final = (const float*)d_in[18];
    a.out = (float*)d_out; a.ws = (unsigned char*)d_ws;
    void* args[] = {&a};
    hipError_t e = hipLaunchCooperativeKernel((const void*)fwd_mega, dim3(grid), dim3(512), args, LDS_BYTES, stream);
    if (e != hipSuccess) fprintf(stderr, "kernel_launch: cooperative launch failed: %s (grid %d)\n", hipGetErrorString(e), grid);
}
```

```cpp
#include <hip/hip_runtime.h>
#include <hip/hip_cooperative_groups.h>
#include <cstdio>
#include <cstdint>
namespace cg = cooperative_groups;
namespace pg8 {
#define PG8_LAS __attribute__((address_space(3)))
typedef unsigned short bf16_t;
typedef short bf16x8 __attribute__((ext_vector_type(8)));
typedef float f32x4 __attribute__((ext_vector_type(4)));
typedef unsigned u32x4 __attribute__((ext_vector_type(4)));
constexpr int BM = 256, BK = 64, HALF = 128, HTB = HALF * BK * 2  , STAGE_BYTES = 8 * HTB, NXCD = 8, WGM = 8;

__host__ __device__ __forceinline__ int lds_byte(int r, int c) { const int st = (r >> 4) * 2 + (c >> 5), rr = r & 15, cc = c & 31, ob = rr * 64 + cc * 2; return st * 1024 + (ob ^ (((ob >> 9) & 1) << 5)); }
__host__ __device__ __forceinline__ void stage_rc(int b, int& R, int& C) { const int st = b / 1024, sb = b % 1024, swz = sb ^ (((sb >> 9) & 1) << 5); R = (st >> 1) * 16 + swz / 64; C = (st & 1) * 32 + (swz % 64) / 2; }
__host__ __device__ __forceinline__ int perm32(int rho) { const int n = rho >> 4, i = rho & 15; return 8 * (i >> 2) + 4 * n + (i & 3); }

struct Unit { int pm, pn; };
struct Gemm { const bf16_t* A; const bf16_t* Bt; int M, N, K; };

struct StaticOrder {
    int nM, nN, nwg, G, c;
    __host__ __device__ void init(int M, int N, int G_, int c_) { nM = M / BM; nN = N / BM; nwg = nM * nN; G = G_; c = c_; }
    __host__ __device__ bool next(int i, Unit& u) const {
        const long L = (long)i * G + c; if (L >= nwg) return false;
        int wgid = (int)L; { const int q = nwg / NXCD, r = nwg % NXCD, xcd = wgid % NXCD, off = wgid / NXCD; wgid = (xcd < r ? xcd * (q + 1) : r * (q + 1) + (xcd - r) * q) + off; }
        const int nig = WGM * nN, gid = wgid / nig, fm = gid * WGM, gsz = (nM - fm) < WGM ? (nM - fm) : WGM;
        u.pm = fm + ((wgid % nig) % gsz); u.pn = (wgid % nig) / gsz; return true;
    }
    __device__ __forceinline__ void a_ready(const Unit&) const {}
    __device__ __forceinline__ void done(const Unit&) const {}
};

__device__ __forceinline__ unsigned cvt_pk_bf16(float lo, float hi) { unsigned r; asm volatile("v_cvt_pk_bf16_f32 %0, %1, %2" : "=v"(r) : "v"(lo), "v"(hi)); return r; }
typedef float f32x2 __attribute__((ext_vector_type(2)));
struct EpiBf16 {
    static constexpr bool PERM = true, AFTER_DRAIN = false;
    bf16_t* O; int ldc; int split_cols; size_t split_stride;
    __device__ __forceinline__ void operator()(const f32x4 (&acc)[2][2][4][2], const Unit& u, int wr, int wc, int fr, int fq) const {
        const int row0 = u.pm * BM + wr * 64 + fr; int colt = u.pn * BM; bf16_t* base = O;
        if (split_cols) { const int t = colt / split_cols; base += (size_t)t * split_stride; colt -= t * split_cols; }
        const int col0 = colt + wc * 32 + 8 * fq;
#pragma unroll
        for (int ai = 0; ai < 2; ++ai)
#pragma unroll
            for (int m = 0; m < 4; ++m) { bf16_t* rowp = base + (size_t)(row0 + ai * HALF + m * 16) * ldc + col0;
#pragma unroll
                for (int bj = 0; bj < 2; ++bj) { const f32x4 v0 = acc[ai][bj][m][0], v1 = acc[ai][bj][m][1];
                    u32x4 w; w.x = cvt_pk_bf16(v0[0], v0[1]); w.y = cvt_pk_bf16(v0[2], v0[3]); w.z = cvt_pk_bf16(v1[0], v1[1]); w.w = cvt_pk_bf16(v1[2], v1[3]);
                    *(u32x4*)(rowp + bj * HALF) = w; } }
    }
};
struct EpiSwiglu {
    static constexpr bool PERM = true, AFTER_DRAIN = false;
    bf16_t* O; int ldc;
    __device__ __forceinline__ void operator()(const f32x4 (&acc)[2][2][4][2], const Unit& u, int wr, int wc, int fr, int fq) const {
        const int row0 = u.pm * BM + wr * 64 + fr; const int col0 = u.pn * HALF + wc * 32 + 8 * fq;
#pragma unroll
        for (int ai = 0; ai < 2; ++ai)
#pragma unroll
            for (int m = 0; m < 4; ++m) { bf16_t* rowp = O + (size_t)(row0 + ai * HALF + m * 16) * ldc + col0;
                float r[8];
#pragma unroll
                for (int n = 0; n < 2; ++n)
#pragma unroll
                    for (int i = 0; i < 4; ++i) { const float a = acc[ai][0][m][n][i], uu = acc[ai][1][m][n][i];
                        r[n * 4 + i] = a * __builtin_amdgcn_rcpf(1.0f + __expf(-a)) * uu; }
                u32x4 w; w.x = cvt_pk_bf16(r[0], r[1]); w.y = cvt_pk_bf16(r[2], r[3]); w.z = cvt_pk_bf16(r[4], r[5]); w.w = cvt_pk_bf16(r[6], r[7]);
                *(u32x4*)rowp = w; }
    }
};
struct EpiRes {
    static constexpr bool PERM = false, AFTER_DRAIN = false;
    float* X; int ldc;
    __device__ __forceinline__ void operator()(const f32x4 (&acc)[2][2][4][2], const Unit& u, int wr, int wc, int fr, int fq) const {
        const int col0 = u.pn * BM + wc * 32 + 4 * fq;
#pragma unroll
        for (int ai = 0; ai < 2; ++ai)
#pragma unroll
            for (int m = 0; m < 4; ++m) { float* rowp = X + (size_t)(u.pm * BM + ai * HALF + wr * 64 + m * 16 + fr) * ldc + col0;
#pragma unroll
                for (int bj = 0; bj < 2; ++bj)
#pragma unroll
                    for (int n = 0; n < 2; ++n) { f32x4* p = (f32x4*)(rowp + bj * HALF + n * 16); *p = *p + acc[ai][bj][m][n]; }
                asm volatile("" ::: "memory"); }
    }
};
template <class Epi, class Sched, bool ALIGN_EPI = false, bool SP2 = false>
__device__ __forceinline__ void gemm_phase(PG8_LAS unsigned char* lds, const Gemm g, const Sched& S, const Epi& E) {
    int tid_ = threadIdx.x; asm volatile("" : "+v"(tid_));
    const int tid = tid_, wid = __builtin_amdgcn_readfirstlane(tid >> 6), lane = tid & 63, wr = wid >> 2, wc = wid & 3, fr = lane & 15, fq = lane >> 4;
    const int K = g.K, nt = K / BK;
    unsigned voffA[2], voffB[2];
#pragma unroll
    for (int i = 0; i < 2; ++i) { int R, C; stage_rc(tid * 16 + i * 8192, R, C); const int Rb = Epi::PERM ? ((R & ~31) + perm32(R & 31)) : R;
        voffA[i] = (unsigned)(R * K + C) * 2u; voffB[i] = (unsigned)(Rb * K + C) * 2u; }
    const size_t kstep = (size_t)(BK * 2);
    const size_t hstep = (size_t)HALF * K * 2;
    const size_t tstep = 2 * hstep;
    const unsigned ldsw = (unsigned)wid * 1024u;
    const int aoff = lds_byte(wr * 64 + fr, fq * 8), boff = lds_byte(wc * 32 + fr, fq * 8);
#define PG8_SA(b, h) (((b) * 2 + (h)) * HTB)
#define PG8_SB(b, h) ((4 + (b) * 2 + (h)) * HTB)
#define PG8_STAGE(bufoff, gbase, voff) do { _Pragma("unroll") for (int _i = 0; _i < 2; ++_i) \
        __builtin_amdgcn_global_load_lds((const unsigned*)((const char*)(gbase) + (voff)[_i]), (PG8_LAS unsigned*)(lds + (bufoff) + ldsw + _i * 8192), 16, 0, 0); } while (0)
#define PG8_LDA(dst, b, h) do { _Pragma("unroll") for (int m = 0; m < 4; ++m) _Pragma("unroll") for (int k = 0; k < 2; ++k) dst[m][k] = *(const PG8_LAS bf16x8*)(lds + PG8_SA(b, h) + aoff + m * 2048 + k * 1024); } while (0)
#define PG8_LDB(dst, b, h) do { _Pragma("unroll") for (int n = 0; n < 2; ++n) _Pragma("unroll") for (int k = 0; k < 2; ++k) dst[n][k] = *(const PG8_LAS bf16x8*)(lds + PG8_SB(b, h) + boff + n * 2048 + k * 1024); } while (0)
#define PG8_MMA(ai, bj, At, Bt) do { __builtin_amdgcn_s_setprio(1); _Pragma("unroll") for (int m = 0; m < 4; ++m) _Pragma("unroll") for (int n = 0; n < 2; ++n) _Pragma("unroll") for (int k = 0; k < 2; ++k) \
        acc[ai][bj][m][n] = __builtin_amdgcn_mfma_f32_16x16x32_bf16(Bt[n][k], At[m][k], acc[ai][bj][m][n], 0, 0, 0); __builtin_amdgcn_s_setprio(0); } while (0)
#define PG8_WAIT_V(n) asm volatile("s_waitcnt vmcnt(" #n ")" ::: "memory")
#define PG8_WAIT_L(n) asm volatile("s_waitcnt lgkmcnt(" #n ")" ::: "memory")
#define PG8_BAR __builtin_amdgcn_s_barrier()
#define PG8_SCHED __builtin_amdgcn_sched_barrier(0)
    Unit cur, nxt; int ui = 0;
    if (!S.next(0, cur)) return;
    f32x4 acc[2][2][4][2];
#pragma unroll
    for (int a = 0; a < 2; ++a)
#pragma unroll
        for (int b = 0; b < 2; ++b)
#pragma unroll
            for (int m = 0; m < 4; ++m)
#pragma unroll
                for (int n = 0; n < 2; ++n) acc[a][b][m][n] = (f32x4){0.f, 0.f, 0.f, 0.f};
    bf16x8 At[4][2], B0[2][2], B1[2][2];
    const char* cA = (const char*)g.A + (size_t)cur.pm * tstep; const char* cB = (const char*)g.Bt + (size_t)cur.pn * tstep;
    S.a_ready(cur);
    if constexpr (SP2) {
        PG8_STAGE(PG8_SB(0, 0), cB, voffB); PG8_STAGE(PG8_SB(0, 1), cB + hstep, voffB); PG8_STAGE(PG8_SA(0, 0), cA, voffA); PG8_STAGE(PG8_SA(0, 1), cA + hstep, voffA);
        if (wr == 1) PG8_BAR;
        PG8_WAIT_V(2); PG8_BAR;
        PG8_STAGE(PG8_SB(1, 0), cB + kstep, voffB); PG8_STAGE(PG8_SA(1, 0), cA + kstep, voffA); PG8_STAGE(PG8_SB(1, 1), cB + hstep + kstep, voffB);
        PG8_WAIT_V(6); PG8_BAR;
    } else {
        PG8_STAGE(PG8_SB(0, 0), cB, voffB); PG8_STAGE(PG8_SA(0, 0), cA, voffA); PG8_STAGE(PG8_SB(0, 1), cB + hstep, voffB); PG8_STAGE(PG8_SA(0, 1), cA + hstep, voffA);
        if (wr == 1) PG8_BAR;
        PG8_WAIT_V(4); PG8_BAR;
        PG8_STAGE(PG8_SB(1, 0), cB + kstep, voffB); PG8_STAGE(PG8_SA(1, 0), cA + kstep, voffA); PG8_STAGE(PG8_SB(1, 1), cB + hstep + kstep, voffB);
        PG8_WAIT_V(6); PG8_BAR;
    }
    for (;;) {
        const bool has_next = S.next(ui + 1, nxt);
        const char* nA = has_next ? (const char*)g.A + (size_t)nxt.pm * tstep : cA; const char* nB = has_next ? (const char*)g.Bt + (size_t)nxt.pn * tstep : cB;
        for (int t = 0; t < nt; t += 2) {
            const bool last = (t == nt - 2);
            const char* a1 = cA + (size_t)(t + 1) * kstep;
            const char* a2 = last ? nA : cA + (size_t)(t + 2) * kstep; const char* b2 = last ? nB : cB + (size_t)(t + 2) * kstep;
            const char* a3 = a2 + kstep; const char* b3 = b2 + kstep;
            if (last && has_next) S.a_ready(nxt);
            if constexpr (SP2) {
            PG8_LDB(B0, 0, 0); PG8_LDB(B1, 0, 1); PG8_SCHED; PG8_LDA(At, 0, 0); PG8_STAGE(PG8_SA(1, 1), a1 + hstep, voffA);
            PG8_WAIT_V(8); PG8_WAIT_L(0); PG8_BAR; PG8_MMA(0, 0, At, B0); PG8_MMA(0, 1, At, B1); PG8_BAR; PG8_SCHED;
            PG8_LDA(At, 0, 1); PG8_STAGE(PG8_SB(0, 0), b2, voffB); PG8_STAGE(PG8_SB(0, 1), b2 + hstep, voffB); PG8_STAGE(PG8_SA(0, 0), a2, voffA);
            PG8_WAIT_V(8); PG8_WAIT_L(0); PG8_BAR; PG8_MMA(1, 0, At, B0); PG8_MMA(1, 1, At, B1); PG8_BAR; PG8_SCHED;
            PG8_LDB(B0, 1, 0); PG8_LDB(B1, 1, 1); PG8_SCHED; PG8_LDA(At, 1, 0); PG8_STAGE(PG8_SA(0, 1), a2 + hstep, voffA);
            PG8_WAIT_V(8); PG8_WAIT_L(0); PG8_BAR; PG8_MMA(0, 0, At, B0); PG8_MMA(0, 1, At, B1); PG8_BAR; PG8_SCHED;
            PG8_LDA(At, 1, 1); PG8_STAGE(PG8_SB(1, 0), b3, voffB); PG8_STAGE(PG8_SB(1, 1), b3 + hstep, voffB); PG8_STAGE(PG8_SA(1, 0), a3, voffA);
            PG8_WAIT_V(8); PG8_WAIT_L(0); PG8_BAR; PG8_MMA(1, 0, At, B0); PG8_MMA(1, 1, At, B1); PG8_BAR; PG8_SCHED;
            } else {
            PG8_LDB(B0, 0, 0); PG8_SCHED; PG8_LDA(At, 0, 0); PG8_STAGE(PG8_SA(1, 1), a1 + hstep, voffA);
            PG8_WAIT_L(8); PG8_BAR; PG8_WAIT_L(0); PG8_MMA(0, 0, At, B0); PG8_BAR; PG8_SCHED;
            PG8_LDB(B1, 0, 1); PG8_STAGE(PG8_SB(0, 0), b2, voffB);
            PG8_BAR; PG8_WAIT_L(0); PG8_MMA(0, 1, At, B1); PG8_BAR;
            PG8_LDA(At, 0, 1); PG8_STAGE(PG8_SA(0, 0), a2, voffA);
            PG8_BAR; PG8_WAIT_L(0); PG8_MMA(1, 0, At, B0); PG8_BAR; PG8_SCHED;
            PG8_STAGE(PG8_SB(0, 1), b2 + hstep, voffB);
            PG8_WAIT_V(6); PG8_BAR; PG8_MMA(1, 1, At, B1); PG8_BAR;
            PG8_LDB(B0, 1, 0); PG8_SCHED; PG8_LDA(At, 1, 0); PG8_STAGE(PG8_SA(0, 1), a2 + hstep, voffA);
            PG8_WAIT_L(8); PG8_BAR; PG8_WAIT_L(0); PG8_MMA(0, 0, At, B0); PG8_BAR; PG8_SCHED;
            PG8_LDB(B1, 1, 1); PG8_STAGE(PG8_SB(1, 0), b3, voffB);
            PG8_BAR; PG8_WAIT_L(0); PG8_MMA(0, 1, At, B1); PG8_BAR;
            PG8_LDA(At, 1, 1); PG8_STAGE(PG8_SA(1, 0), a3, voffA);
            PG8_BAR; PG8_WAIT_L(0); PG8_MMA(1, 0, At, B0); PG8_BAR; PG8_SCHED;
            PG8_STAGE(PG8_SB(1, 1), b3 + hstep, voffB);
            PG8_WAIT_V(6); PG8_BAR; PG8_MMA(1, 1, At, B1); PG8_BAR;
            }
        }
        if constexpr (ALIGN_EPI) { if (wr == 0) PG8_BAR; }
        if constexpr (!Epi::AFTER_DRAIN) { E(acc, cur, wr, wc, fr, fq); S.done(cur); }
        if (!has_next) break;
#pragma unroll
        for (int a = 0; a < 2; ++a)
#pragma unroll
            for (int b = 0; b < 2; ++b)
#pragma unroll
                for (int m = 0; m < 4; ++m)
#pragma unroll
                    for (int n = 0; n < 2; ++n) acc[a][b][m][n] = (f32x4){0.f, 0.f, 0.f, 0.f};
        cur = nxt; cA = nA; cB = nB; ++ui;
        if constexpr (ALIGN_EPI) { if (wr == 1) PG8_BAR; }
    }
    PG8_WAIT_V(0);
    if constexpr (!ALIGN_EPI) { if (wr == 0) PG8_BAR; }
    PG8_BAR;
    if constexpr (Epi::AFTER_DRAIN) { E.fused(acc, cur, wr, wc, fr, fq, lds, wid, lane); S.done(cur); }
#undef PG8_SA
#undef PG8_SB
#undef PG8_STAGE
#undef PG8_LDA
#undef PG8_LDB
#undef PG8_MMA
#undef PG8_WAIT_V
#undef PG8_WAIT_L
#undef PG8_BAR
#undef PG8_SCHED
}
}
constexpr int DM = 1024, SEQ = 16384, NBATCH = 2, NP = NBATCH * SEQ, DEC_B = 16, DEC_T = 32, PAST = 2048, SKV = PAST + DEC_T;
constexpr int NSQ = DEC_B * DEC_T, NTOK = NP + NSQ, NKVS = DEC_B * SKV;
constexpr int DFF = 2816, INW = 2096, DEPTH = 2;
constexpr float EPS = 1e-6f;
constexpr float QSCALE = 0.10206207261596575f * 1.4426950408889634f;
constexpr int NITEM_P = NBATCH * 256 * 4, NITEM = NITEM_P + DEC_B * 4;

typedef unsigned short bf16;
typedef short bf16x8 __attribute__((ext_vector_type(8)));
typedef float f32x4 __attribute__((ext_vector_type(4)));
typedef float f32x16 __attribute__((ext_vector_type(16)));
typedef unsigned u32x4 __attribute__((ext_vector_type(4)));
typedef unsigned u32x2 __attribute__((ext_vector_type(2)));
#define LAS __attribute__((address_space(3)))

constexpr size_t T256 = (size_t)NTOK * 256 * 2;
constexpr size_t al(size_t x) { return (x + 4095) & ~(size_t)4095; }
constexpr size_t WS_CTL = 0, CTL_BYTES = 65536;
constexpr size_t WS_ROPE = 65536;
constexpr size_t WS_GA = al(WS_ROPE + (size_t)SEQ * 32 * 4);
constexpr size_t WS_DECAY = al(WS_GA + (size_t)NTOK * 16 * 4);
constexpr size_t WS_WIN = al(WS_DECAY + (size_t)NITEM * 64 * 4);
constexpr size_t WS_WGV = al(WS_WIN + (size_t)1792 * 1024 * 2);
constexpr size_t WS_WUQ = al(WS_WGV + (size_t)512 * 1024 * 2);
constexpr size_t WS_WUK = al(WS_WUQ + (size_t)768 * 256 * 2);
constexpr size_t WS_WUV = al(WS_WUK + (size_t)512 * 256 * 2);
constexpr size_t WS_WO = al(WS_WUV + (size_t)512 * 256 * 2);
constexpr size_t WS_WGU = al(WS_WO + (size_t)1024 * 1024 * 2);
constexpr size_t WS_WD = al(WS_WGU + (size_t)5632 * 1024 * 2);
constexpr size_t WS_H = al(WS_WD + (size_t)1024 * 2816 * 2);
constexpr size_t WS_Z = al(WS_H + (size_t)NTOK * 1024 * 2);
constexpr size_t WS_GVT = al(WS_Z + 7 * T256);
constexpr size_t WS_CQN = al(WS_GVT + (size_t)512 * NTOK * 2);
constexpr size_t WS_CKVN = al(WS_CQN + T256);
constexpr size_t WS_CKVS = al(WS_CKVN + (size_t)NP * 256 * 2);
constexpr size_t WS_KR = al(WS_CKVS + (size_t)NKVS * 256 * 2);
constexpr size_t WS_KRS = al(WS_KR + (size_t)NP * 32 * 2);
constexpr size_t WS_KN = al(WS_KRS + (size_t)NKVS * 32 * 2);
constexpr size_t WS_VT = al(WS_KN + (size_t)NP * 512 * 2);
constexpr size_t WS_KNS = al(WS_VT + (size_t)512 * NP * 2);
constexpr size_t WS_VTS = al(WS_KNS + (size_t)NKVS * 512 * 2);
constexpr size_t WS_DS = al(WS_VTS + (size_t)512 * NKVS * 2);
constexpr size_t WS_END = al(WS_DS + (size_t)NITEM_P * 8192 * 4);
constexpr size_t WS_ACT = WS_Z;
static_assert(WS_ACT + (size_t)NTOK * DFF * 2 <= WS_END, "ACT overlay");
static_assert(WS_END <= (size_t)536870912, "ws budget");

constexpr size_t O_Y = 0, O_CKVP = (size_t)NTOK * DM, O_KRP = O_CKVP + (size_t)DEPTH * NP * 256, O_GLAP = O_KRP + (size_t)DEPTH * NP * 32,
                 O_CKVS = O_GLAP + (size_t)DEPTH * NBATCH * 4 * 8192, O_KRS = O_CKVS + (size_t)DEPTH * NSQ * 256, O_GLAS = O_KRS + (size_t)DEPTH * NSQ * 32,
                 O_END = O_GLAS + (size_t)DEPTH * DEC_B * 4 * 8192;

constexpr int LDS_BYTES = 147456;

struct Args {
    const float *xp, *xs, *cckv, *ckr, *sgla, *g_attn, *w_in, *g_qn, *w_uq, *g_kvn, *w_ukv, *w_a2, *b_a2, *g_on, *w_o, *g_ffn, *w_gu, *w_down, *g_final;
    float* out; unsigned char* ws;
};

__device__ __forceinline__ unsigned f2bf(float f) { unsigned u = __builtin_bit_cast(unsigned, f); return (u + 0x7fffu + ((u >> 16) & 1u)) >> 16; }
__device__ __forceinline__ unsigned pk2(float lo, float hi) { return f2bf(lo) | (f2bf(hi) << 16); }
__device__ __forceinline__ float bf2f(unsigned short b) { return __builtin_bit_cast(float, (unsigned)b << 16); }
__device__ __forceinline__ float bflo(unsigned w) { return __builtin_bit_cast(float, w << 16); }
__device__ __forceinline__ float bfhi(unsigned w) { return __builtin_bit_cast(float, w & 0xffff0000u); }
__device__ __forceinline__ float wave_sum(float v) {
#pragma unroll
    for (int o = 1; o < 64; o <<= 1) v += __shfl_xor(v, o);
    return v;
}
__device__ __forceinline__ int crow(int r, int hi) { return (r & 3) + 8 * (r >> 2) + 4 * hi; }
__device__ __forceinline__ float logsig(float x) { return fminf(x, 0.f) - __logf(1.0f + __expf(-fabsf(x))); }
#define LDS_WAIT() asm volatile("s_waitcnt lgkmcnt(0)" ::: "memory")
#define MFMA32(a, b, c) __builtin_amdgcn_mfma_f32_32x32x16_bf16((a), (b), (c), 0, 0, 0)

struct Ctx {
    int tid, lane, wave, G, vcu, gw, NGW;
    LAS unsigned char* lds;
};

__device__ __forceinline__ void tr_item(const float* W, int K, int N, int k0, int src0, int nvalid, bf16* WT, int dst_row0, float scale, LAS float* scr, int lane) {
#pragma unroll 8
    for (int i = 0; i < 32; ++i) { const int kk = 2 * i + (lane >> 5), c = lane & 31;
        float v = 0.f; if (c < nvalid) v = W[(size_t)(k0 + kk) * N + src0 + c] * scale;
        scr[kk * 33 + c] = v; }
    LDS_WAIT(); asm volatile("" ::: "memory");
    const int c8 = lane & 7;
#pragma unroll
    for (int j = 0; j < 4; ++j) { const int n = (lane >> 3) + 8 * j; const LAS float* s = scr + (8 * c8) * 33 + n;
        u32x4 o; o.x = pk2(s[0 * 33], s[1 * 33]); o.y = pk2(s[2 * 33], s[3 * 33]); o.z = pk2(s[4 * 33], s[5 * 33]); o.w = pk2(s[6 * 33], s[7 * 33]);
        *(u32x4*)(WT + (size_t)(dst_row0 + n) * K + k0 + 8 * c8) = o; }
    LDS_WAIT(); asm volatile("" ::: "memory");
}
__device__ __forceinline__ void convert_weights(const Ctx& C, const Args& A, int l) {
    LAS float* scr = (LAS float*)(C.lds + C.wave * 16384);
    unsigned char* ws = A.ws;
    const float* w_in = A.w_in + (size_t)l * DM * INW; const float* w_uq = A.w_uq + (size_t)l * 256 * 768; const float* w_ukv = A.w_ukv + (size_t)l * 256 * 1024;
    const float* w_o = A.w_o + (size_t)l * DM * DM; const float* w_gu = A.w_gu + (size_t)l * DM * 2 * DFF; const float* w_d = A.w_down + (size_t)l * DFF * DM;
    constexpr int I0 = 56 * 16, I1 = 16 * 16, I2 = 24 * 4, I3 = 16 * 4, I4 = 16 * 4, I5 = 32 * 16, I6 = 176 * 16, I7 = 32 * 44;
    constexpr int NIT = I0 + I1 + I2 + I3 + I4 + I5 + I6 + I7;
    for (int it = C.gw; it < NIT; it += C.NGW) {
        int r = it;
        if (r < I0) { const int db = r >> 4, kb = r & 15; int src = 0, nv = 32;
            if (db < 16) src = 32 * db; else if (db == 16) src = 512; else if (db == 17) { src = 2080; nv = 16; } else if (db < 24) { src = 0; nv = 0; }
            else if (db < 32) src = 544 + 32 * (db - 24); else if (db < 40) src = 800 + 32 * (db - 32); else src = 1568 + 32 * (db - 40);
            tr_item(w_in, DM, INW, 64 * kb, src, nv, (bf16*)(ws + WS_WIN), 32 * db, 1.f, scr, C.lane); continue; } r -= I0;
        if (r < I1) { const int db = r >> 4, kb = r & 15; tr_item(w_in, DM, INW, 64 * kb, 1056 + 32 * db, 32, (bf16*)(ws + WS_WGV), 32 * db, 1.f, scr, C.lane); continue; } r -= I1;
        if (r < I2) { const int db = r >> 2, kb = r & 3; tr_item(w_uq, 256, 768, 64 * kb, 32 * db, 32, (bf16*)(ws + WS_WUQ), 32 * db, QSCALE, scr, C.lane); continue; } r -= I2;
        if (r < I3) { const int db = r >> 2, kb = r & 3; tr_item(w_ukv, 256, 1024, 64 * kb, (db >> 1) * 128 + (db & 1) * 32, 32, (bf16*)(ws + WS_WUK), 32 * db, 1.f, scr, C.lane); continue; } r -= I3;
        if (r < I4) { const int db = r >> 2, kb = r & 3; tr_item(w_ukv, 256, 1024, 64 * kb, (db >> 1) * 128 + 64 + (db & 1) * 32, 32, (bf16*)(ws + WS_WUV), 32 * db, 1.f, scr, C.lane); continue; } r -= I4;
        if (r < I5) { const int db = r >> 4, kb = r & 15; tr_item(w_o, DM, DM, 64 * kb, 32 * db, 32, (bf16*)(ws + WS_WO), 32 * db, 1.f, scr, C.lane); continue; } r -= I5;
        if (r < I6) { const int db = r >> 4, kb = r & 15; const int pn = db >> 3, t = db & 7; const int src = (t < 4) ? 128 * pn + 32 * t : DFF + 128 * pn + 32 * (t - 4);
            tr_item(w_gu, DM, 2 * DFF, 64 * kb, src, 32, (bf16*)(ws + WS_WGU), 32 * db, 1.f, scr, C.lane); continue; } r -= I6;
        { const int db = r / 44, kb = r % 44; tr_item(w_d, DFF, DM, 64 * kb, 32 * db, 32, (bf16*)(ws + WS_WD), 32 * db, 1.f, scr, C.lane); }
    }
}

__device__ __forceinline__ void norm_row(const float* xrow, const float* g, bf16* orow, float* copy, int lane) {
    const f32x4* xr = (const f32x4*)xrow + lane; const f32x4* gr = (const f32x4*)g + lane;
    f32x4 v[4]; float s = 0.f;
#pragma unroll
    for (int j = 0; j < 4; ++j) { v[j] = xr[64 * j]; s += (v[j].x * v[j].x + v[j].y * v[j].y) + (v[j].z * v[j].z + v[j].w * v[j].w); }
    const float rstd = 1.0f / sqrtf(wave_sum(s) * (1.f / DM) + EPS);
    if (copy) {
#pragma unroll
        for (int j = 0; j < 4; ++j) ((f32x4*)copy + lane)[64 * j] = v[j]; }
    u32x2* o8 = (u32x2*)orow + lane;
#pragma unroll
    for (int j = 0; j < 4; ++j) { const f32x4 gg = gr[64 * j]; u32x2 w; w.x = pk2(v[j].x * rstd * gg.x, v[j].y * rstd * gg.y); w.y = pk2(v[j].z * rstd * gg.z, v[j].w * rstd * gg.w); o8[64 * j] = w; }
}
__device__ __forceinline__ void final_norm_row(float* xrow, const float* g, int lane) {
    f32x4* xr = (f32x4*)xrow + lane; const f32x4* gr = (const f32x4*)g + lane;
    f32x4 v[4]; float s = 0.f;
#pragma unroll
    for (int j = 0; j < 4; ++j) { v[j] = xr[64 * j]; s += (v[j].x * v[j].x + v[j].y * v[j].y) + (v[j].z * v[j].z + v[j].w * v[j].w); }
    const float rstd = 1.0f / sqrtf(wave_sum(s) * (1.f / DM) + EPS);
#pragma unroll
    for (int j = 0; j < 4; ++j) { const f32x4 gg = gr[64 * j]; xr[64 * j] = v[j] * rstd * gg; }
}

__device__ __forceinline__ void p3_token(const Args& A, int l, int m, int lane) {
    unsigned char* ws = A.ws;
    const bf16* CQ = (const bf16*)(ws + WS_Z); const bf16* CKV = (const bf16*)(ws + WS_Z + T256); const bf16* MISC = (const bf16*)(ws + WS_Z + 2 * T256);
    const float* ROPE = (const float*)(ws + WS_ROPE);
    { const u32x2 w = *((const u32x2*)(CQ + (size_t)m * 256) + lane); const float a = bflo(w.x), b = bfhi(w.x), c = bflo(w.y), d = bfhi(w.y);
      const float rstd = 1.0f / sqrtf(wave_sum((a * a + b * b) + (c * c + d * d)) * (1.f / 256) + EPS);
      const f32x4 g = *((const f32x4*)(A.g_qn + l * 256) + lane);
      u32x2 o; o.x = pk2(a * rstd * g.x, b * rstd * g.y); o.y = pk2(c * rstd * g.z, d * rstd * g.w);
      *((u32x2*)((bf16*)(ws + WS_CQN) + (size_t)m * 256) + lane) = o; }
    int pos; float* ockv; float* okr; bf16* bckv; bf16* bkr;
    if (m < NP) { pos = m & (SEQ - 1); ockv = A.out + O_CKVP + ((size_t)l * NP + m) * 256; okr = A.out + O_KRP + ((size_t)l * NP + m) * 32;
        bckv = (bf16*)(ws + WS_CKVN) + (size_t)m * 256; bkr = (bf16*)(ws + WS_KR) + (size_t)m * 32; }
    else { const int s = m - NP, b = s >> 5, t = s & 31; pos = PAST + t; ockv = A.out + O_CKVS + ((size_t)l * NSQ + s) * 256; okr = A.out + O_KRS + ((size_t)l * NSQ + s) * 32;
        const size_t r = (size_t)b * SKV + PAST + t; bckv = (bf16*)(ws + WS_CKVS) + r * 256; bkr = (bf16*)(ws + WS_KRS) + r * 32; }
    { const u32x2 w = *((const u32x2*)(CKV + (size_t)m * 256) + lane); const float a = bflo(w.x), b = bfhi(w.x), c = bflo(w.y), d = bfhi(w.y);
      const float rstd = 1.0f / sqrtf(wave_sum((a * a + b * b) + (c * c + d * d)) * (1.f / 256) + EPS);
      const f32x4 g = *((const f32x4*)(A.g_kvn + l * 256) + lane);
      const f32x4 o = (f32x4){a * rstd * g.x, b * rstd * g.y, c * rstd * g.z, d * rstd * g.w};
      *((f32x4*)ockv + lane) = o;
      u32x2 ob; ob.x = pk2(o.x, o.y); ob.y = pk2(o.z, o.w); *((u32x2*)bckv + lane) = ob; }
    if (lane < 16) { const float x1 = bf2f(MISC[(size_t)m * 256 + lane]), x2 = bf2f(MISC[(size_t)m * 256 + 16 + lane]);
        const float c = ROPE[pos * 32 + lane], s = ROPE[pos * 32 + 16 + lane];
        const float o1 = x1 * c - x2 * s, o2 = x1 * s + x2 * c;
        okr[lane] = o1; okr[16 + lane] = o2; bkr[lane] = (bf16)f2bf(o1); bkr[16 + lane] = (bf16)f2bf(o2); }
    else if (lane < 32) { ((float*)(ws + WS_GA))[(size_t)m * 16 + (lane - 16)] = bf2f(MISC[(size_t)m * 256 + 32 + (lane - 16)]); }
}
__device__ __forceinline__ void cache_row(const Args& A, int l, int r, int lane) {
    const int b = r >> 11, p = r & (PAST - 1); const size_t dr = (size_t)b * SKV + p;
    const f32x4 v = *((const f32x4*)(A.cckv + ((size_t)l * DEC_B * PAST + r) * 256) + lane);
    u32x2 o; o.x = pk2(v.x, v.y); o.y = pk2(v.z, v.w); *((u32x2*)((bf16*)(A.ws + WS_CKVS) + dr * 256) + lane) = o;
    if (lane < 32) ((bf16*)(A.ws + WS_KRS))[dr * 32 + lane] = (bf16)f2bf(A.ckr[((size_t)l * DEC_B * PAST + r) * 32 + lane]);
}

struct GlaItem { int tok0, L, hd, sb; bool sample; };
__device__ __forceinline__ GlaItem gla_decode(int it) {
    GlaItem g;
    if (it < NITEM_P) { g.hd = it & 3; const int bc = it >> 2; g.tok0 = bc * 64; g.L = 64; g.sample = false; g.sb = 0; }
    else { const int j = it - NITEM_P; g.hd = j & 3; g.sb = j >> 2; g.tok0 = NP + g.sb * 32; g.L = 32; g.sample = true; }
    return g;
}
constexpr int KT_PITCH = 72;
__device__ __forceinline__ void gla_g1(const Args& A, int l, int it, LAS unsigned char* wl, int lane) {
    const GlaItem g = gla_decode(it); unsigned char* ws = A.ws;
    const int col = g.hd * 64 + lane, r32 = lane & 31, hi = lane >> 5;
    const float* GA = (const float*)(ws + WS_GA); const bf16* GK = (const bf16*)(ws + WS_Z + 4 * T256); const bf16* GVT = (const bf16*)(ws + WS_GVT);
    LAS bf16* kT = (LAS bf16*)wl; LAS float* dsm = (LAS float*)(wl + 64 * KT_PITCH * 2);
    float w[16];
#pragma unroll
    for (int r = 0; r < 16; ++r) w[r] = A.w_a2[(size_t)l * 16 * 256 + r * 256 + col];
    const float bias = A.b_a2[l * 256 + col];
    float blast = 0.f;
    for (int p = 0; p < g.L; ++p) { const float* ga = GA + (size_t)(g.tok0 + p) * 16; float x = bias;
#pragma unroll
        for (int r = 0; r < 16; ++r) x += ga[r] * w[r];
        blast += logsig(x) * (1.f / 16.f); }
    float bc = 0.f;
    for (int p = 0; p < g.L; ++p) { const float* ga = GA + (size_t)(g.tok0 + p) * 16; float x = bias;
#pragma unroll
        for (int r = 0; r < 16; ++r) x += ga[r] * w[r];
        bc += logsig(x) * (1.f / 16.f);
        const float kk = bf2f(GK[(size_t)(g.tok0 + p) * 256 + col]) * __expf(blast - bc);
        kT[lane * KT_PITCH + p] = (bf16)f2bf(kk); }
    const float decay = __expf(blast);
    if (!g.sample) ((float*)(ws + WS_DECAY))[(size_t)it * 64 + lane] = decay;
    dsm[lane] = decay;
    LDS_WAIT(); asm volatile("" ::: "memory");
    const int nks = g.L >> 4;
#pragma unroll 1
    for (int nb = 0; nb < 4; ++nb) {
        f32x16 acc[2]; acc[0] = (f32x16){}; acc[1] = (f32x16){};
        for (int s = 0; s < nks; ++s) {
            const bf16x8 bfr = *(const bf16x8*)(GVT + (size_t)(g.hd * 128 + 32 * nb + r32) * NTOK + g.tok0 + 16 * s + 8 * hi);
#pragma unroll
            for (int mb = 0; mb < 2; ++mb) { const bf16x8 af = *(const LAS bf16x8*)(kT + (32 * mb + r32) * KT_PITCH + 16 * s + 8 * hi); acc[mb] = MFMA32(af, bfr, acc[mb]); }
        }
        const int dv = 32 * nb + r32;
        if (!g.sample) { float* dsp = (float*)(ws + WS_DS) + (size_t)it * 8192 + dv;
#pragma unroll
            for (int mb = 0; mb < 2; ++mb)
#pragma unroll
                for (int r = 0; r < 16; ++r) dsp[(32 * mb + crow(r, hi)) * 128] = acc[mb][r]; }
        else { const size_t so = (((size_t)l * DEC_B + g.sb) * 4 + g.hd) * 8192 + dv;
#pragma unroll
            for (int mb = 0; mb < 2; ++mb) {
#pragma unroll
                for (int r = 0; r < 16; ++r) { const int dk = 32 * mb + crow(r, hi); A.out[O_GLAS + so + dk * 128] = dsm[dk] * A.sgla[so + dk * 128] + acc[mb][r]; }
                asm volatile("" ::: "memory"); } }
    }
    LDS_WAIT(); asm volatile("" ::: "memory");
}
constexpr int NSCAN = 64;
__device__ __forceinline__ void gla_scan(const Args& A, int l, int sblock, int tid) {
    const int gth = sblock * 512 + tid;
    const int seq = gth >> 12, e0 = (gth & 4095) * 2;
    const int b = seq >> 2, hd = seq & 3, dk = e0 >> 7;
    float* DS = (float*)(A.ws + WS_DS); const float* DEC = (const float*)(A.ws + WS_DECAY);
    float s0 = 0.f, s1 = 0.f;
    for (int c0 = 0; c0 < 256; c0 += 8) {
        float2 ds[8]; float dc[8];
#pragma unroll
        for (int j = 0; j < 8; ++j) { const size_t it = (size_t)((b * 256 + c0 + j) * 4 + hd); ds[j] = *(const float2*)(DS + it * 8192 + e0); dc[j] = DEC[it * 64 + dk]; }
#pragma unroll
        for (int j = 0; j < 8; ++j) { const size_t it = (size_t)((b * 256 + c0 + j) * 4 + hd); *(float2*)(DS + it * 8192 + e0) = make_float2(s0, s1);
            s0 = dc[j] * s0 + ds[j].x; s1 = dc[j] * s1 + ds[j].y; }
    }
    *(float2*)(A.out + O_GLAP + (((size_t)l * NBATCH + b) * 4 + hd) * 8192 + e0) = make_float2(s0, s1);
}
constexpr int BS_PITCH = 65;
__device__ __forceinline__ void gla_g3(const Args& A, int l, int it, LAS unsigned char* wl, int lane) {
    const GlaItem g = gla_decode(it); unsigned char* ws = A.ws;
    const int col = g.hd * 64 + lane, r32 = lane & 31, hi = lane >> 5;
    const float* GA = (const float*)(ws + WS_GA); const bf16* GQ = (const bf16*)(ws + WS_Z + 3 * T256); const bf16* GK = (const bf16*)(ws + WS_Z + 4 * T256);
    const bf16* GG = (const bf16*)(ws + WS_Z + 5 * T256); const bf16* GVT = (const bf16*)(ws + WS_GVT); bf16* CAT = (bf16*)(ws + WS_H);
    LAS float* bsm = (LAS float*)wl;
    {   float w[16];
#pragma unroll
        for (int r = 0; r < 16; ++r) w[r] = A.w_a2[(size_t)l * 16 * 256 + r * 256 + col];
        const float bias = A.b_a2[l * 256 + col];
        float bc = 0.f;
        for (int p = 0; p < g.L; ++p) { const float* ga = GA + (size_t)(g.tok0 + p) * 16; float x = bias;
#pragma unroll
            for (int r = 0; r < 16; ++r) x += ga[r] * w[r];
            bc += logsig(x) * (1.f / 16.f); bsm[p * BS_PITCH + lane] = bc; }
    }
    LDS_WAIT(); asm volatile("" ::: "memory");
    const int nib = g.L >> 5;
    bf16x8 qf[2][4], kf[2][4];
#pragma unroll
    for (int ib = 0; ib < 2; ++ib)
#pragma unroll
        for (int s = 0; s < 4; ++s) {
            if (ib < nib) { const int i = 32 * ib + r32, dk0 = 16 * s + 8 * hi;
                const u32x4 rq = *(const u32x4*)(GQ + (size_t)(g.tok0 + i) * 256 + g.hd * 64 + dk0);
                const u32x4 rk = *(const u32x4*)(GK + (size_t)(g.tok0 + i) * 256 + g.hd * 64 + dk0);
                u32x4 oq, ok;
#pragma unroll
                for (int jj = 0; jj < 4; ++jj) { const float b0 = bsm[i * BS_PITCH + dk0 + 2 * jj], b1 = bsm[i * BS_PITCH + dk0 + 2 * jj + 1];
                    oq[jj] = pk2(bflo(rq[jj]) * 0.125f * __expf(b0), bfhi(rq[jj]) * 0.125f * __expf(b1));
                    ok[jj] = pk2(bflo(rk[jj]) * __expf(-b0), bfhi(rk[jj]) * __expf(-b1)); }
                qf[ib][s] = __builtin_bit_cast(bf16x8, oq); kf[ib][s] = __builtin_bit_cast(bf16x8, ok); }
            else { qf[ib][s] = (bf16x8){}; kf[ib][s] = (bf16x8){}; }
        }
    bf16x8 xp[2][2][2];
#pragma unroll
    for (int jb = 0; jb < 2; ++jb)
#pragma unroll
        for (int ib = 0; ib < 2; ++ib) {
            if (jb > ib || ib >= nib) { xp[jb][ib][0] = (bf16x8){}; xp[jb][ib][1] = (bf16x8){}; continue; }
            f32x16 X = (f32x16){};
#pragma unroll
            for (int s = 0; s < 4; ++s) X = MFMA32(kf[jb][s], qf[ib][s], X);
            if (jb == ib) {
#pragma unroll
                for (int r = 0; r < 16; ++r) if (crow(r, hi) > r32) X[r] = 0.f; }
#pragma unroll
            for (int s2 = 0; s2 < 2; ++s2) { u32x4 pw;
#pragma unroll
                for (int jj = 0; jj < 4; ++jj) pw[jj] = pk2(X[8 * s2 + 2 * jj], X[8 * s2 + 2 * jj + 1]);
                xp[jb][ib][s2] = __builtin_bit_cast(bf16x8, pw); }
        }
    const float* Sp = g.sample ? A.sgla + (((size_t)l * DEC_B + g.sb) * 4 + g.hd) * 8192 : (const float*)(ws + WS_DS) + (size_t)it * 8192;
#pragma unroll
    for (int ib = 0; ib < 2; ++ib) {
        if (ib < nib) {
            f32x16 o[4];
#pragma unroll
            for (int nb = 0; nb < 4; ++nb) {
                const int dv = 32 * nb + r32;
                o[nb] = (f32x16){};
#pragma unroll
                for (int s = 0; s < 4; ++s) { u32x4 pw;
#pragma unroll
                    for (int jj = 0; jj < 4; ++jj) pw[jj] = pk2(Sp[(16 * s + 8 * hi + 2 * jj) * 128 + dv], Sp[(16 * s + 8 * hi + 2 * jj + 1) * 128 + dv]);
                    o[nb] = MFMA32(__builtin_bit_cast(bf16x8, pw), qf[ib][s], o[nb]); }
#pragma unroll
                for (int jb = 0; jb <= ib; ++jb)
#pragma unroll
                    for (int s2 = 0; s2 < 2; ++s2) { const bf16* vp = GVT + (size_t)(g.hd * 128 + dv) * NTOK + g.tok0 + 32 * jb + 16 * s2 + 4 * hi;
                        const u32x2 lo = *(const u32x2*)vp, hi8 = *(const u32x2*)(vp + 8);
                        o[nb] = MFMA32(__builtin_bit_cast(bf16x8, (u32x4){lo.x, lo.y, hi8.x, hi8.y}), xp[jb][ib][s2], o[nb]); }
            }
            float ss = 0.f;
#pragma unroll
            for (int nb = 0; nb < 4; ++nb)
#pragma unroll
                for (int r = 0; r < 16; ++r) ss += o[nb][r] * o[nb][r];
            ss += __shfl_xor(ss, 32);
            const float rstd = 1.0f / sqrtf(ss * (1.f / 128) + EPS);
            const int tok = g.tok0 + 32 * ib + r32;
#pragma unroll
            for (int nb = 0; nb < 4; ++nb)
#pragma unroll
                for (int q = 0; q < 4; ++q) { const int dv0 = 32 * nb + 8 * q + 4 * hi; const int gc = g.hd * 128 + dv0;
                    const u32x2 gw = *(const u32x2*)(GG + (size_t)(gc >> 8) * ((size_t)NTOK * 256) + (size_t)tok * 256 + (gc & 255));
                    const f32x4 gon = *(const f32x4*)(A.g_on + l * 128 + dv0);
                    const float g0 = bflo(gw.x), g1 = bfhi(gw.x), g2 = bflo(gw.y), g3 = bfhi(gw.y);
                    const float v0 = o[nb][4 * q + 0] * rstd * gon.x * (g0 / (1.0f + __expf(-g0)));
                    const float v1 = o[nb][4 * q + 1] * rstd * gon.y * (g1 / (1.0f + __expf(-g1)));
                    const float v2 = o[nb][4 * q + 2] * rstd * gon.z * (g2 / (1.0f + __expf(-g2)));
                    const float v3 = o[nb][4 * q + 3] * rstd * gon.w * (g3 / (1.0f + __expf(-g3)));
                    u32x2 ow; ow.x = pk2(v0, v1); ow.y = pk2(v2, v3);
                    *(u32x2*)(CAT + (size_t)tok * 1024 + 512 + g.hd * 128 + dv0) = ow; }
            asm volatile("" ::: "memory");
        }
    }
    LDS_WAIT(); asm volatile("" ::: "memory");
}

__device__ __forceinline__ unsigned cvtpk(float lo, float hi) { unsigned r; asm("v_cvt_pk_bf16_f32 %0, %1, %2" : "=v"(r) : "v"(lo), "v"(hi)); return r; }
__device__ __forceinline__ float max3f(float a, float b, float c) { return fmaxf(fmaxf(a, b), c); }
constexpr float ATT_THR = 8.0f;
template <class LD> __device__ __forceinline__ void attn_tile(const LD& ld, const bf16x8 (&qr)[6], f32x16 (&o)[2], float& m, float& l, bool half_only, bool first) {
    f32x16 negm;
#pragma unroll
    for (int r = 0; r < 16; ++r) negm[r] = -m;
    f32x16 p0 = negm, p1 = negm;
#pragma unroll
    for (int s = 0; s < 6; ++s) p0 = MFMA32(ld.k(0, s), qr[s], p0);
    if (!half_only) {
#pragma unroll
        for (int s = 0; s < 6; ++s) p1 = MFMA32(ld.k(1, s), qr[s], p1); }
    float mx = max3f(p0[0], p0[1], p0[2]);
#pragma unroll
    for (int r = 3; r < 15; r += 2) mx = max3f(mx, p0[r], p0[r + 1]);
    mx = fmaxf(mx, p0[15]);
    if (!half_only) {
#pragma unroll
        for (int r = 0; r < 16; r += 2) mx = max3f(mx, p1[r], p1[r + 1]); }
    mx = fmaxf(mx, __shfl_xor(mx, 32));
    if (first || __any(mx > ATT_THR)) {
        const float d = first ? mx : fmaxf(mx, 0.f);
        m += d;
        const float f = first ? 0.f : __builtin_amdgcn_exp2f(-d);
        l *= f;
#pragma unroll
        for (int r = 0; r < 16; ++r) { p0[r] -= d; p1[r] -= d; o[0][r] *= f; o[1][r] *= f; }
    }
    float rs = 0.f, rs1 = 0.f;
#pragma unroll
    for (int r = 0; r < 16; ++r) { p0[r] = __builtin_amdgcn_exp2f(p0[r]); rs += p0[r]; }
    if (!half_only) {
#pragma unroll
        for (int r = 0; r < 16; ++r) { p1[r] = __builtin_amdgcn_exp2f(p1[r]); rs1 += p1[r]; } }
    l += rs + rs1;
    bf16x8 pa[4];
#pragma unroll
    for (int s = 0; s < 2; ++s) { u32x4 w0, w1;
#pragma unroll
        for (int jj = 0; jj < 4; ++jj) { w0[jj] = cvtpk(p0[8 * s + 2 * jj], p0[8 * s + 2 * jj + 1]); w1[jj] = cvtpk(p1[8 * s + 2 * jj], p1[8 * s + 2 * jj + 1]); }
        pa[s] = __builtin_bit_cast(bf16x8, w0); pa[2 + s] = __builtin_bit_cast(bf16x8, w1); }
#pragma unroll
    for (int db = 0; db < 2; ++db) {
#pragma unroll
        for (int s = 0; s < 2; ++s) o[db] = MFMA32(ld.v(db, s), pa[s], o[db]);
        if (!half_only) {
#pragma unroll
            for (int s = 2; s < 4; ++s) o[db] = MFMA32(ld.v(db, s), pa[s], o[db]); }
    }
}
constexpr int K_PITCH = 208, V_PITCH = 136, KBUF = 64 * K_PITCH, VBUF = 64 * V_PITCH, ABUF = KBUF + VBUF;
struct LdsLoader {
    LAS const unsigned char* kb; LAS const unsigned char* vb; int r32, hi;
    __device__ __forceinline__ bf16x8 k(int half, int s) const { return *(LAS const bf16x8*)(kb + (r32 + 32 * half) * K_PITCH + s * 32 + hi * 16); }
    __device__ __forceinline__ bf16x8 v(int db, int s) const { LAS const unsigned char* p = vb + (r32 + 32 * db) * V_PITCH + s * 32 + hi * 8;
        const u32x2 lo = *(LAS const u32x2*)p, h8 = *(LAS const u32x2*)(p + 16); return __builtin_bit_cast(bf16x8, (u32x4){lo.x, lo.y, h8.x, h8.y}); }
};
struct GlbLoader {
    const bf16* kn; const bf16* kr; const bf16* vt; int r32, hi;
    __device__ __forceinline__ bf16x8 k(int half, int s) const { const int kv = r32 + 32 * half;
        return (s < 4) ? *(const bf16x8*)(kn + (size_t)kv * 512 + 16 * s + 8 * hi) : *(const bf16x8*)(kr + (size_t)kv * 32 + 16 * (s - 4) + 8 * hi); }
    __device__ __forceinline__ bf16x8 v(int db, int s) const { const bf16* p = vt + (size_t)(r32 + 32 * db) * NKVS + 16 * s + 4 * hi;
        const u32x2 lo = *(const u32x2*)p, h8 = *(const u32x2*)(p + 8); return __builtin_bit_cast(bf16x8, (u32x4){lo.x, lo.y, h8.x, h8.y}); }
};
__device__ __forceinline__ void load_q(bf16x8 (&qr)[6], const bf16* qp, const float* rope_row, int hi) {
#pragma unroll
    for (int s = 0; s < 6; ++s) qr[s] = *(const bf16x8*)(qp + 16 * s + 8 * hi);
    const u32x4 a = __builtin_bit_cast(u32x4, qr[4]), b = __builtin_bit_cast(u32x4, qr[5]); u32x4 oa, ob;
    const f32x4 c0 = *(const f32x4*)(rope_row + 8 * hi), c1 = *(const f32x4*)(rope_row + 8 * hi + 4), s0 = *(const f32x4*)(rope_row + 16 + 8 * hi), s1 = *(const f32x4*)(rope_row + 16 + 8 * hi + 4);
#pragma unroll
    for (int jj = 0; jj < 4; ++jj) {
        const float x1l = bflo(a[jj]), x1h = bfhi(a[jj]), x2l = bflo(b[jj]), x2h = bfhi(b[jj]);
        const float cl = (jj < 2) ? c0[2 * jj] : c1[2 * jj - 4], ch = (jj < 2) ? c0[2 * jj + 1] : c1[2 * jj - 3];
        const float sl = (jj < 2) ? s0[2 * jj] : s1[2 * jj - 4], sh = (jj < 2) ? s0[2 * jj + 1] : s1[2 * jj - 3];
        oa[jj] = pk2(x1l * cl - x2l * sl, x1h * ch - x2h * sh); ob[jj] = pk2(x1l * sl + x2l * cl, x1h * sh + x2h * ch); }
    qr[4] = __builtin_bit_cast(bf16x8, oa); qr[5] = __builtin_bit_cast(bf16x8, ob);
}
__device__ __forceinline__ void attn_prompt_unit(const Args& A, const Ctx& C, int b, int hd, int qb) {
    unsigned char* ws = A.ws; const int tid = C.tid, lane = C.lane, wid = C.wave, r32 = lane & 31, hi = lane >> 5;
    const bf16* Q = (const bf16*)(ws + WS_Z); const bf16* KN = (const bf16*)(ws + WS_KN); const bf16* KR = (const bf16*)(ws + WS_KR); const bf16* VT = (const bf16*)(ws + WS_VT);
    bf16* CAT = (bf16*)(ws + WS_H); const float* ROPE = (const float*)(ws + WS_ROPE);
    const int pos = qb * 256 + wid * 32 + r32; const size_t qrow = (size_t)b * SEQ + pos;
    bf16x8 qr[6]; load_q(qr, Q + qrow * 768 + hd * 96, ROPE + (size_t)pos * 32, hi);
    const int ntiles = 4 * qb + 4, my_last = 4 * qb + (wid >> 1);
    const int krow = tid >> 3, kch = tid & 7, rrow = (tid & 255) >> 2, rch = tid & 3;
    const bf16* kn_src = KN + ((size_t)b * SEQ + krow) * 512 + hd * 64 + kch * 8;
    const bf16* kr_src = KR + ((size_t)b * SEQ + rrow) * 32 + rch * 8;
    const bf16* vt_src = VT + (size_t)(hd * 64 + krow) * NP + (size_t)b * SEQ + kch * 8;
    const int kn_dst = krow * K_PITCH + kch * 16, kr_dst = rrow * K_PITCH + 128 + rch * 16, vt_dst = KBUF + krow * V_PITCH + kch * 16;
    u32x4 sk, sr, sv;
    sk = *(const u32x4*)kn_src; sv = *(const u32x4*)vt_src; if (tid < 256) sr = *(const u32x4*)kr_src;
    { LAS unsigned char* bufp = C.lds; *(LAS u32x4*)(bufp + kn_dst) = sk; if (tid < 256) *(LAS u32x4*)(bufp + kr_dst) = sr;
      *(LAS u32x2*)(bufp + vt_dst) = (u32x2){sv.x, sv.y}; *(LAS u32x2*)(bufp + vt_dst + 8) = (u32x2){sv.z, sv.w}; }
    __syncthreads();
    f32x16 o[2]; o[0] = (f32x16){}; o[1] = (f32x16){}; float m = 0.f, l = 0.f;
    for (int t = 0; t < ntiles; ++t) {
        const bool more = (t + 1 < ntiles);
        if (more) { sk = *(const u32x4*)(kn_src + (size_t)(t + 1) * 64 * 512); sv = *(const u32x4*)(vt_src + (size_t)(t + 1) * 64); if (tid < 256) sr = *(const u32x4*)(kr_src + (size_t)(t + 1) * 64 * 32); }
        if (t <= my_last) { LdsLoader ld{C.lds + (t & 1) * ABUF, C.lds + (t & 1) * ABUF + KBUF, r32, hi}; attn_tile(ld, qr, o, m, l, false, t == 0); }
        if (more) { LAS unsigned char* bufp = C.lds + ((t + 1) & 1) * ABUF; *(LAS u32x4*)(bufp + kn_dst) = sk; if (tid < 256) *(LAS u32x4*)(bufp + kr_dst) = sr;
            *(LAS u32x2*)(bufp + vt_dst) = (u32x2){sv.x, sv.y}; *(LAS u32x2*)(bufp + vt_dst + 8) = (u32x2){sv.z, sv.w}; }
        __syncthreads();
    }
    const float lt = l + __shfl_xor(l, 32); const float inv = 1.0f / lt;
    bf16* orow = CAT + qrow * 1024 + hd * 64;
#pragma unroll
    for (int db = 0; db < 2; ++db)
#pragma unroll
        for (int q = 0; q < 4; ++q) { u32x2 w; w.x = pk2(o[db][4 * q] * inv, o[db][4 * q + 1] * inv); w.y = pk2(o[db][4 * q + 2] * inv, o[db][4 * q + 3] * inv);
            *(u32x2*)(orow + 32 * db + 8 * q + 4 * hi) = w; }
}
__device__ __forceinline__ void attn_sample_unit(const Args& A, const Ctx& C, int b, int hd) {
    unsigned char* ws = A.ws; const int tid = C.tid, lane = C.lane, wid = C.wave, r32 = lane & 31, hi = lane >> 5;
    const bf16* Q = (const bf16*)(ws + WS_Z); const bf16* KNS = (const bf16*)(ws + WS_KNS); const bf16* KRS = (const bf16*)(ws + WS_KRS); const bf16* VTS = (const bf16*)(ws + WS_VTS);
    bf16* CAT = (bf16*)(ws + WS_H); const float* ROPE = (const float*)(ws + WS_ROPE);
    const size_t qrow = (size_t)NP + b * 32 + r32;
    bf16x8 qr[6]; load_q(qr, Q + qrow * 768 + hd * 96, ROPE + (size_t)(PAST + r32) * 32, hi);
    f32x16 o[2]; o[0] = (f32x16){}; o[1] = (f32x16){}; float m = 0.f, l = 0.f;
    for (int t = wid; t < 33; t += 8) {
        const size_t key0 = (size_t)b * SKV + 64 * t;
        GlbLoader ld{KNS + key0 * 512 + hd * 64, KRS + key0 * 32, VTS + (size_t)(hd * 64) * NKVS + key0, r32, hi};
        attn_tile(ld, qr, o, m, l, t == 32, t == wid);
    }
    const float lt = l + __shfl_xor(l, 32);
    LAS float* cm = (LAS float*)C.lds; LAS float* cl = cm + 256; LAS float* co = cm + 512;
    if (hi == 0) { cm[wid * 32 + r32] = m; cl[wid * 32 + r32] = lt; }
#pragma unroll
    for (int db = 0; db < 2; ++db)
#pragma unroll
        for (int r = 0; r < 16; ++r) co[(wid * 64 + 32 * db + crow(r, hi)) * 32 + r32] = o[db][r];
    __syncthreads();
    { const int q = tid & 31, d0 = (tid >> 5) * 4;
      float M = cm[q];
#pragma unroll
      for (int w = 1; w < 8; ++w) M = fmaxf(M, cm[w * 32 + q]);
      float L = 0.f, acc[4] = {0.f, 0.f, 0.f, 0.f};
#pragma unroll
      for (int w = 0; w < 8; ++w) { const float f = __builtin_amdgcn_exp2f(cm[w * 32 + q] - M); L += cl[w * 32 + q] * f;
#pragma unroll
          for (int i = 0; i < 4; ++i) acc[i] += co[(w * 64 + d0 + i) * 32 + q] * f; }
      const float inv = 1.0f / L;
      u32x2 wv; wv.x = pk2(acc[0] * inv, acc[1] * inv); wv.y = pk2(acc[2] * inv, acc[3] * inv);
      *(u32x2*)(CAT + ((size_t)NP + b * 32 + q) * 1024 + hd * 64 + d0) = wv; }
    __syncthreads();
}

#define XB_TMO      128
#define XB_XCNT(j)  (256  + 64 * (j))
#define XB_XSUB(j)  (1280 + 64 * (j))
#define XB_XGEN(j)  (2304 + 64 * (j))
#define XB_TOP      3328
#define XB_TOPGEN   3392
#define XCD_BAR_WORDS 3456
#define XB_SPIN_CAP (1u << 23)

__device__ __forceinline__ unsigned xb_ld(unsigned* p)              { return __hip_atomic_load(p, __ATOMIC_RELAXED, __HIP_MEMORY_SCOPE_AGENT); }
__device__ __forceinline__ unsigned xb_add(unsigned* p, unsigned v) { return __hip_atomic_fetch_add(p, v, __ATOMIC_RELAXED, __HIP_MEMORY_SCOPE_AGENT); }
__device__ __forceinline__ unsigned xb_xcc_id() { return (unsigned)__builtin_amdgcn_s_getreg((3 << 11) | 20) & 0xFu; }
#define XB_SPIN(cond, bar) do { unsigned _sp = 0; while (cond) { __builtin_amdgcn_s_sleep(1); \
    if ((++_sp & 255u) == 0u) { if (xb_ld(&(bar)[XB_TMO])) break; if (_sp > XB_SPIN_CAP) { atomicAdd(&(bar)[XB_TMO], 1u); break; } } } } while (0)

struct XcdBarrier {
    unsigned* bar; unsigned x;
    volatile LAS unsigned* st;
};

__device__ __forceinline__ XcdBarrier xcd_barrier_post(unsigned* bar, volatile LAS unsigned* st) {
    XcdBarrier b; b.bar = bar; b.x = xb_xcc_id(); b.st = st;
    if (threadIdx.x == 0) (void)xb_add(&bar[XB_XCNT(b.x)], 1u);
    return b;
}
__device__ __forceinline__ void xcd_barrier_complete(unsigned* bar, unsigned x, unsigned& nloc, unsigned& nx) {
    const unsigned G = gridDim.x * gridDim.y * gridDim.z;
    unsigned sum, cnt, mine, sp = 0u;
    for (;;) {
        sum = 0u; cnt = 0u; mine = 0u;
#pragma unroll
        for (unsigned j = 0; j < 16; ++j) { const unsigned c = xb_ld(&bar[XB_XCNT(j)]); sum += c; cnt += (c > 0u) ? 1u : 0u; mine = (j == x) ? c : mine; }
        if (sum == G) break;
        __builtin_amdgcn_s_sleep(1);
        if ((++sp & 255u) == 0u) { if (xb_ld(&bar[XB_TMO])) break; if (sp > XB_SPIN_CAP) { atomicAdd(&bar[XB_TMO], 1u); break; } }
    }
    nloc = mine > 0u ? mine : 1u; nx = cnt > 0u ? cnt : 1u;
}

__device__ __forceinline__ void xcd_barrier(const XcdBarrier& b) {
    asm volatile("s_waitcnt vmcnt(0)" ::: "memory");
    __syncthreads();
    if (threadIdx.x == 0) {
        unsigned* bar = b.bar;
        __builtin_amdgcn_s_waitcnt(0);
        unsigned nloc = b.st[0], nx = b.st[1];
        if (nloc == 0u) { xcd_barrier_complete(bar, b.x, nloc, nx); b.st[0] = nloc; b.st[1] = nx; }
        const unsigned old = xb_add(&bar[XB_XSUB(b.x)], 1u);
        const unsigned gen = old / nloc;
        if (old + 1u == (gen + 1u) * nloc) {
            __builtin_amdgcn_fence(__ATOMIC_RELEASE, "agent");
            asm volatile("s_waitcnt vmcnt(0)" ::: "memory");
            const unsigned og = xb_add(&bar[XB_TOP], 1u);
            const unsigned tg = og / nx;
            if (og + 1u == (tg + 1u) * nx) xb_add(&bar[XB_TOPGEN], 1u);
            else XB_SPIN(xb_ld(&bar[XB_TOPGEN]) == tg, bar);
            __builtin_amdgcn_fence(__ATOMIC_ACQUIRE, "agent");
            xb_add(&bar[XB_XGEN(b.x)], 1u);
            asm volatile("s_waitcnt vmcnt(0)" ::: "memory");
        } else {
            XB_SPIN(xb_ld(&bar[XB_XGEN(b.x)]) == gen, bar);
            __builtin_amdgcn_fence(__ATOMIC_ACQUIRE, "agent");
            asm volatile("s_waitcnt vmcnt(0)" ::: "memory");
        }
    }
    __syncthreads();
}

__global__ void __launch_bounds__(512, 2) fwd_mega(Args A) {
    extern __shared__ __attribute__((aligned(16))) unsigned char lds_raw[];
    cg::grid_group grid = cg::this_grid();
    volatile LAS unsigned* bst = (volatile LAS unsigned*)((LAS unsigned char*)lds_raw + LDS_BYTES - 64);
    if (threadIdx.x < 16) bst[threadIdx.x] = 0u;
    __syncthreads();
    XcdBarrier xbar = xcd_barrier_post((unsigned*)(A.ws + WS_CTL), bst);
#ifdef PROBE_SYNC2
#define GSYNC() do { xcd_barrier(xbar); xcd_barrier(xbar); } while (0)
#else
#define GSYNC() xcd_barrier(xbar)
#endif
    Ctx C; C.lds = (LAS unsigned char*)lds_raw; C.tid = threadIdx.x; C.lane = C.tid & 63; C.wave = __builtin_amdgcn_readfirstlane(C.tid >> 6);
    C.G = gridDim.x; { const int bx = blockIdx.x; C.vcu = (C.G % 8 == 0) ? (bx % 8) * (C.G / 8) + bx / 8 : bx; }
    C.gw = blockIdx.x * 8 + C.wave; C.NGW = C.G * 8;
    unsigned char* ws = A.ws;
    float* X = A.out + O_Y;
    { float* ROPE = (float*)(ws + WS_ROPE);
      for (int e = blockIdx.x * 512 + C.tid; e < SEQ * 16; e += C.G * 512) { const int p = e >> 4, i = e & 15;
          const double base = (i & 3) == 0 ? 1.0 : (i & 3) == 1 ? 0.5623413251903491 : (i & 3) == 2 ? 0.31622776601683794 : 0.1778279410038923;
          const double sc = (i >> 2) == 0 ? 1.0 : (i >> 2) == 1 ? 0.1 : (i >> 2) == 2 ? 0.01 : 0.001;
          const float inv = (float)(base * sc); const float ang = (float)p * inv;
          const double rev = (double)ang * 0.15915494309189535; const float fr = (float)(rev - __builtin_rint(rev));
          ROPE[p * 32 + i] = __builtin_amdgcn_cosf(fr); ROPE[p * 32 + 16 + i] = __builtin_amdgcn_sinf(fr); } }
#define REFRESH() do { int t_ = threadIdx.x; asm volatile("" : "+v"(t_)); C.tid = t_; C.lane = t_ & 63; C.wave = __builtin_amdgcn_readfirstlane(t_ >> 6); C.gw = blockIdx.x * 8 + C.wave; } while (0)
#pragma unroll 1
    for (int l = 0; l < DEPTH; ++l) {
        REFRESH();
#ifdef PROBE_P1
        for (int rep = 0; rep < 2; ++rep) {
#endif
        convert_weights(C, A, l);
        for (int mrow = C.gw; mrow < NTOK; mrow += C.NGW) {
            const float* xr = (l == 0) ? (mrow < NP ? A.xp + (size_t)mrow * DM : A.xs + (size_t)(mrow - NP) * DM) : X + (size_t)mrow * DM;
            norm_row(xr, A.g_attn + l * DM, (bf16*)(ws + WS_H) + (size_t)mrow * DM, (l == 0) ? X + (size_t)mrow * DM : nullptr, C.lane); }
        for (int r = C.gw; r < DEC_B * PAST; r += C.NGW) cache_row(A, l, r, C.lane);
#ifdef PROBE_P1
        }
#endif
        if (l == 0) grid.sync(); else GSYNC();
#ifndef NO_P2
#ifdef PROBE_P2
        for (int rep = 0; rep < 2; ++rep) {
#endif
        { pg8::EpiBf16 E{(pg8::bf16_t*)(ws + WS_Z), 256, 256, (size_t)NTOK * 256};
          pg8::Gemm g{(const pg8::bf16_t*)(ws + WS_H), (const pg8::bf16_t*)(ws + WS_WIN), NTOK, 1792, DM}; pg8::StaticOrder S; S.init(NTOK, 1792, C.G, (int)blockIdx.x);
          pg8::gemm_phase<pg8::EpiBf16, pg8::StaticOrder, true, true>(C.lds, g, S, E); }
        { pg8::EpiBf16 E{(pg8::bf16_t*)(ws + WS_GVT), NTOK, 0, 0};
          pg8::Gemm g{(const pg8::bf16_t*)(ws + WS_WGV), (const pg8::bf16_t*)(ws + WS_H), 512, NTOK, DM}; pg8::StaticOrder S; S.init(512, NTOK, C.G, (int)((blockIdx.x + 146) % C.G));
          pg8::gemm_phase<pg8::EpiBf16, pg8::StaticOrder, true, true>(C.lds, g, S, E); }
#ifdef PROBE_P2
        }
#endif
        GSYNC();
#endif
        REFRESH();
#ifdef PROBE_THIN
        for (int rep = 0; rep < 2; ++rep)
#endif
        for (int mrow = C.gw; mrow < NTOK; mrow += C.NGW) p3_token(A, l, mrow, C.lane);
        GSYNC();
#ifdef PROBE_G1
        for (int rep = 0; rep < 2; ++rep)
#endif
#ifndef NO_G1
        for (int it = C.gw; it < NITEM; it += C.NGW) gla_g1(A, l, it, C.lds + C.wave * 16384, C.lane);
#endif
        GSYNC();
#ifndef NO_P4
        if ((int)blockIdx.x < NSCAN) gla_scan(A, l, blockIdx.x, C.tid);
        else {
            const int G2 = C.G - NSCAN, c2 = blockIdx.x - NSCAN;
#ifdef PROBE_P4G
            for (int rep = 0; rep < 2; ++rep)
#endif
#pragma unroll 1
            for (int gi = 0; gi < 5; ++gi) {
                pg8::Gemm g; pg8::EpiBf16 E; int M_, N_;
                if (gi == 0) { g = pg8::Gemm{(const pg8::bf16_t*)(ws + WS_CQN), (const pg8::bf16_t*)(ws + WS_WUQ), NTOK, 768, 256}; E = pg8::EpiBf16{(pg8::bf16_t*)(ws + WS_Z), 768, 0, 0}; M_ = NTOK; N_ = 768; }
                else if (gi == 1) { g = pg8::Gemm{(const pg8::bf16_t*)(ws + WS_CKVN), (const pg8::bf16_t*)(ws + WS_WUK), NP, 512, 256}; E = pg8::EpiBf16{(pg8::bf16_t*)(ws + WS_KN), 512, 0, 0}; M_ = NP; N_ = 512; }
                else if (gi == 2) { g = pg8::Gemm{(const pg8::bf16_t*)(ws + WS_WUV), (const pg8::bf16_t*)(ws + WS_CKVN), 512, NP, 256}; E = pg8::EpiBf16{(pg8::bf16_t*)(ws + WS_VT), NP, 0, 0}; M_ = 512; N_ = NP; }
                else if (gi == 3) { g = pg8::Gemm{(const pg8::bf16_t*)(ws + WS_CKVS), (const pg8::bf16_t*)(ws + WS_WUK), NKVS, 512, 256}; E = pg8::EpiBf16{(pg8::bf16_t*)(ws + WS_KNS), 512, 0, 0}; M_ = NKVS; N_ = 512; }
                else { g = pg8::Gemm{(const pg8::bf16_t*)(ws + WS_WUV), (const pg8::bf16_t*)(ws + WS_CKVS), 512, NKVS, 256}; E = pg8::EpiBf16{(pg8::bf16_t*)(ws + WS_VTS), NKVS, 0, 0}; M_ = 512; N_ = NKVS; }
                pg8::StaticOrder S; S.init(M_, N_, G2, (c2 + gi * 37) % G2);
                pg8::gemm_phase<pg8::EpiBf16, pg8::StaticOrder, true, true>(C.lds, g, S, E);
            }
        }
        GSYNC();
#endif
        REFRESH();
#ifdef PROBE_G3
#pragma unroll 1
        for (int rep = 0; rep < 2; ++rep)
#endif
#ifndef NO_G3
        for (int it = C.gw; it < NITEM; it += C.NGW) gla_g3(A, l, it, C.lds + C.wave * 17408, C.lane);
#endif
        __syncthreads();
#ifdef PROBE_SAMP
#pragma unroll 1
        for (int rep = 0; rep < 2; ++rep)
#endif
#ifndef NO_SAMP
        if (C.vcu >= C.G - 128 && C.vcu < C.G) { const int u = C.vcu - (C.G - 128); attn_sample_unit(A, C, u >> 3, u & 7); }
#endif
#ifndef NO_ATTN
#ifdef PROBE_ATTN2
        for (int rep = 0; rep < 2; ++rep)
#endif
        for (int u = C.vcu; u < 1024; u += C.G) {
            const int bh = (u % 256) >> 4, s = u & 15, i = u >> 8; const int qb = (i == 0) ? 63 - s : (i == 1) ? 32 + s : (i == 2) ? 31 - s : s;
            attn_prompt_unit(A, C, bh >> 3, bh & 7, qb); }
#endif
        GSYNC();
#ifndef NO_P6
        { pg8::EpiRes E{X, DM};
          pg8::Gemm g{(const pg8::bf16_t*)(ws + WS_H), (const pg8::bf16_t*)(ws + WS_WO), NTOK, DM, DM}; pg8::StaticOrder S; S.init(NTOK, DM, C.G, (int)blockIdx.x);
          pg8::gemm_phase<pg8::EpiRes, pg8::StaticOrder, true, true>(C.lds, g, S, E); }
        GSYNC();
#endif
        REFRESH();
#ifdef PROBE_THIN
        for (int rep = 0; rep < 2; ++rep)
#endif
        for (int mrow = C.gw; mrow < NTOK; mrow += C.NGW) norm_row(X + (size_t)mrow * DM, A.g_ffn + l * DM, (bf16*)(ws + WS_H) + (size_t)mrow * DM, nullptr, C.lane);
        GSYNC();
#ifndef NO_P8
#ifdef PROBE_P8
        for (int rep = 0; rep < 2; ++rep)
#endif
        { pg8::EpiSwiglu E{(pg8::bf16_t*)(ws + WS_ACT), DFF};
          pg8::Gemm g{(const pg8::bf16_t*)(ws + WS_H), (const pg8::bf16_t*)(ws + WS_WGU), NTOK, 2 * DFF, DM}; pg8::StaticOrder S; S.init(NTOK, 2 * DFF, C.G, (int)blockIdx.x);
          pg8::gemm_phase<pg8::EpiSwiglu, pg8::StaticOrder, true, true>(C.lds, g, S, E); }
        GSYNC();
#endif
#ifndef NO_P9
        { pg8::EpiRes E{X, DM};
          pg8::Gemm g{(const pg8::bf16_t*)(ws + WS_ACT), (const pg8::bf16_t*)(ws + WS_WD), NTOK, DM, DFF}; pg8::StaticOrder S; S.init(NTOK, DM, C.G, (int)blockIdx.x);
          pg8::gemm_phase<pg8::EpiRes, pg8::StaticOrder, true, true>(C.lds, g, S, E); }
        GSYNC();
#endif
    }
    REFRESH();
    for (int mrow = C.gw; mrow < NTOK; mrow += C.NGW) final_norm_row(X + (size_t)mrow * DM, A.g_final, C.lane);
}

extern "C" void kernel_launch(void* const* d_in, const int* in_sizes, int n_in, void* d_out, int out_size, void* d_ws, size_t ws_size, hipStream_t stream) {
    static int grid = 0;
    if (grid == 0) {
        if (n_in != 19 || (size_t)out_size != O_END || ws_size < WS_END) { fprintf(stderr, "kernel_launch: unexpected shapes: n_in %d out %d ws %zu (need %zu)\n", n_in, out_size, ws_size, (size_t)WS_END); grid = -1; return; }
        int dev = 0, cus = 0, per_cu = 0;
        hipGetDevice(&dev); hipDeviceGetAttribute(&cus, hipDeviceAttributeMultiprocessorCount, dev);
        if (hipFuncSetAttribute((const void*)fwd_mega, hipFuncAttributeMaxDynamicSharedMemorySize, LDS_BYTES) != hipSuccess) { fprintf(stderr, "kernel_launch: hipFuncSetAttribute failed\n"); grid = -1; return; }
        if (hipOccupancyMaxActiveBlocksPerMultiprocessor(&per_cu, (const void*)fwd_mega, 512, LDS_BYTES) != hipSuccess || per_cu < 1) { fprintf(stderr, "kernel_launch: occupancy query says %d\n", per_cu); per_cu = 1; }
        (void)hipGetLastError();
        grid = cus;
    }
    if (grid < 0) return;
    Args a{};
    a.xp = (const float*)d_in[0]; a.xs = (const float*)d_in[1]; a.cckv = (const float*)d_in[2]; a.ckr = (const float*)d_in[3]; a.sgla = (const float*)d_in[4];
    a.g_attn = (const float*)d_in[5]; a.w_in = (const float*)d_in[6]; a.g_qn = (const float*)d_in[7]; a.w_uq = (const float*)d_in[8]; a.g_kvn = (const float*)d_in[9];
    a.w_ukv = (const float*)d_in[10]; a.w_a2 = (const float*)d_in[11]; a.b_a2 = (const float*)d_in[12]; a.g_on = (const float*)d_in[13]; a.w_o = (const float*)d_in[14];
    a.g_ffn = (const float*)d_in[15]; a.w_gu = (const float*)d_in[16]; a.w_down = (const float*)d_in[17]; a.g_final = (const float*)d_in[18];
    a.out = (float*)d_out; a.ws = (unsigned char*)d_ws;
    if (hipMemsetAsync((char*)d_ws + WS_CTL, 0, CTL_BYTES, stream) != hipSuccess) { fprintf(stderr, "kernel_launch: memset failed\n"); return; }
    void* args[] = {&a};
    hipError_t e = hipLaunchCooperativeKernel((const void*)fwd_mega, dim3(grid), dim3(512), args, LDS_BYTES, stream);
    if (e != hipSuccess) fprintf(stderr, "kernel_launch: cooperative launch failed: %s (grid %d)\n", hipGetErrorString(e), grid);
}
```

```cpp
#include <hip/hip_runtime.h>
#include <hip/hip_cooperative_groups.h>
#include <cstdio>
#include <cstdint>
namespace cg = cooperative_groups;
namespace pg8 {
#define PG8_LAS __attribute__((address_space(3)))
typedef unsigned short bf16_t;
typedef short bf16x8 __attribute__((ext_vector_type(8)));
typedef float f32x4 __attribute__((ext_vector_type(4)));
typedef unsigned u32x4 __attribute__((ext_vector_type(4)));
constexpr int BM = 256, BK = 64, HALF = 128, HTB = HALF * BK * 2  , STAGE_BYTES = 8 * HTB, NXCD = 8, WGM = 8;

__host__ __device__ __forceinline__ int lds_byte(int r, int c) { const int st = (r >> 4) * 2 + (c >> 5), rr = r & 15, cc = c & 31, ob = rr * 64 + cc * 2; return st * 1024 + (ob ^ (((ob >> 9) & 1) << 5)); }
__host__ __device__ __forceinline__ void stage_rc(int b, int& R, int& C) { const int st = b / 1024, sb = b % 1024, swz = sb ^ (((sb >> 9) & 1) << 5); R = (st >> 1) * 16 + swz / 64; C = (st & 1) * 32 + (swz % 64) / 2; }
__host__ __device__ __forceinline__ int perm32(int rho) { const int n = rho >> 4, i = rho & 15; return 8 * (i >> 2) + 4 * n + (i & 3); }

struct Unit { int pm, pn; };
struct Gemm { const bf16_t* A; const bf16_t* Bt; int M, N, K; };

struct StaticOrder {
    int nM, nN, nwg, G, c;
    __host__ __device__ void init(int M, int N, int G_, int c_) { nM = M / BM; nN = N / BM; nwg = nM * nN; G = G_; c = c_; }
    __host__ __device__ bool next(int i, Unit& u) const {
        const long L = (long)i * G + c; if (L >= nwg) return false;
        int wgid = (int)L; { const int q = nwg / NXCD, r = nwg % NXCD, xcd = wgid % NXCD, off = wgid / NXCD; wgid = (xcd < r ? xcd * (q + 1) : r * (q + 1) + (xcd - r) * q) + off; }
        const int nig = WGM * nN, gid = wgid / nig, fm = gid * WGM, gsz = (nM - fm) < WGM ? (nM - fm) : WGM;
        u.pm = fm + ((wgid % nig) % gsz); u.pn = (wgid % nig) / gsz; return true;
    }
    __device__ __forceinline__ void a_ready(const Unit&) const {}
    __device__ __forceinline__ void done(const Unit&) const {}
};

__device__ __forceinline__ unsigned cvt_pk_bf16(float lo, float hi) { unsigned r; asm volatile("v_cvt_pk_bf16_f32 %0, %1, %2" : "=v"(r) : "v"(lo), "v"(hi)); return r; }
typedef float f32x2 __attribute__((ext_vector_type(2)));
typedef float f32x2m_t __attribute__((ext_vector_type(2))); typedef __bf16 bf16x2m_t __attribute__((ext_vector_type(2)));
__device__ __forceinline__ unsigned cvt_pk_m(float lo, float hi) { f32x2m_t v = {lo, hi}; bf16x2m_t b = __builtin_convertvector(v, bf16x2m_t); return __builtin_bit_cast(unsigned, b); }
struct EpiBf16 {
    static constexpr bool PERM = true, AFTER_DRAIN = false;
    bf16_t* O; int ldc; int split_cols; size_t split_stride;
    __device__ __forceinline__ void operator()(const f32x4 (&acc)[2][2][4][2], const Unit& u, int wr, int wc, int fr, int fq) const {
        const int row0 = u.pm * BM + wr * 64 + fr; int colt = u.pn * BM; bf16_t* base = O;
        if (split_cols) { const int t = colt / split_cols; base += (size_t)t * split_stride; colt -= t * split_cols; }
        const int col0 = colt + wc * 32 + 8 * fq;
#pragma unroll
        for (int ai = 0; ai < 2; ++ai)
#pragma unroll
            for (int m = 0; m < 4; ++m) { bf16_t* rowp = base + (size_t)(row0 + ai * HALF + m * 16) * ldc + col0;
#pragma unroll
                for (int bj = 0; bj < 2; ++bj) { const f32x4 v0 = acc[ai][bj][m][0], v1 = acc[ai][bj][m][1];
                    u32x4 w; w.x = cvt_pk_m(v0[0], v0[1]); w.y = cvt_pk_m(v0[2], v0[3]); w.z = cvt_pk_m(v1[0], v1[1]); w.w = cvt_pk_m(v1[2], v1[3]);
                    *(u32x4*)(rowp + bj * HALF) = w; } }
    }
};
struct EpiSwiglu {
    static constexpr bool PERM = true, AFTER_DRAIN = false;
    bf16_t* O; int ldc;
    __device__ __forceinline__ void operator()(const f32x4 (&acc)[2][2][4][2], const Unit& u, int wr, int wc, int fr, int fq) const {
        const int row0 = u.pm * BM + wr * 64 + fr; const int col0 = u.pn * HALF + wc * 32 + 8 * fq;
#pragma unroll
        for (int ai = 0; ai < 2; ++ai)
#pragma unroll
            for (int m = 0; m < 4; ++m) { bf16_t* rowp = O + (size_t)(row0 + ai * HALF + m * 16) * ldc + col0;
                float r[8];
#pragma unroll
                for (int n = 0; n < 2; ++n)
#pragma unroll
                    for (int i = 0; i < 4; ++i) { const float a = acc[ai][0][m][n][i], uu = acc[ai][1][m][n][i];
                        r[n * 4 + i] = a * __builtin_amdgcn_rcpf(1.0f + __expf(-a)) * uu; }
                u32x4 w; w.x = cvt_pk_m(r[0], r[1]); w.y = cvt_pk_m(r[2], r[3]); w.z = cvt_pk_m(r[4], r[5]); w.w = cvt_pk_m(r[6], r[7]);
                *(u32x4*)rowp = w; }
    }
};
struct EpiRes {
    static constexpr bool PERM = false, AFTER_DRAIN = false;
    float* X; int ldc;
    __device__ __forceinline__ void operator()(const f32x4 (&acc)[2][2][4][2], const Unit& u, int wr, int wc, int fr, int fq) const {
        const int col0 = u.pn * BM + wc * 32 + 4 * fq;
#pragma unroll
        for (int ai = 0; ai < 2; ++ai)
#pragma unroll
            for (int m = 0; m < 4; ++m) { float* rowp = X + (size_t)(u.pm * BM + ai * HALF + wr * 64 + m * 16 + fr) * ldc + col0;
#pragma unroll
                for (int bj = 0; bj < 2; ++bj)
#pragma unroll
                    for (int n = 0; n < 2; ++n) { f32x4* p = (f32x4*)(rowp + bj * HALF + n * 16); *p = *p + acc[ai][bj][m][n]; }
                asm volatile("" ::: "memory"); }
    }
};
template <class Epi, class Sched, bool ALIGN_EPI = false, bool SP2 = false>
__device__ __forceinline__ void gemm_phase(PG8_LAS unsigned char* lds, const Gemm g, const Sched& S, const Epi& E) {
    int tid_ = threadIdx.x; asm volatile("" : "+v"(tid_));
    const int tid = tid_, wid = __builtin_amdgcn_readfirstlane(tid >> 6), lane = tid & 63, wr = wid >> 2, wc = wid & 3, fr = lane & 15, fq = lane >> 4;
    const int K = g.K, nt = K / BK;
    unsigned voffA[2], voffB[2];
#pragma unroll
    for (int i = 0; i < 2; ++i) { int R, C; stage_rc(tid * 16 + i * 8192, R, C); const int Rb = Epi::PERM ? ((R & ~31) + perm32(R & 31)) : R;
        voffA[i] = (unsigned)(R * K + C) * 2u; voffB[i] = (unsigned)(Rb * K + C) * 2u; }
    const size_t kstep = (size_t)(BK * 2);
    const size_t hstep = (size_t)HALF * K * 2;
    const size_t tstep = 2 * hstep;
    const unsigned ldsw = (unsigned)wid * 1024u;
    const int aoff = lds_byte(wr * 64 + fr, fq * 8), boff = lds_byte(wc * 32 + fr, fq * 8);
#define PG8_SA(b, h) (((b) * 2 + (h)) * HTB)
#define PG8_SB(b, h) ((4 + (b) * 2 + (h)) * HTB)
#define PG8_STAGE(bufoff, gbase, voff) do { _Pragma("unroll") for (int _i = 0; _i < 2; ++_i) \
        __builtin_amdgcn_global_load_lds((const unsigned*)((const char*)(gbase) + (voff)[_i]), (PG8_LAS unsigned*)(lds + (bufoff) + ldsw + _i * 8192), 16, 0, 0); } while (0)
#define PG8_LDA(dst, b, h) do { _Pragma("unroll") for (int m = 0; m < 4; ++m) _Pragma("unroll") for (int k = 0; k < 2; ++k) dst[m][k] = *(const PG8_LAS bf16x8*)(lds + PG8_SA(b, h) + aoff + m * 2048 + k * 1024); } while (0)
#define PG8_LDB(dst, b, h) do { _Pragma("unroll") for (int n = 0; n < 2; ++n) _Pragma("unroll") for (int k = 0; k < 2; ++k) dst[n][k] = *(const PG8_LAS bf16x8*)(lds + PG8_SB(b, h) + boff + n * 2048 + k * 1024); } while (0)
#define PG8_MMA(ai, bj, At, Bt) do { __builtin_amdgcn_s_setprio(1); _Pragma("unroll") for (int m = 0; m < 4; ++m) _Pragma("unroll") for (int n = 0; n < 2; ++n) _Pragma("unroll") for (int k = 0; k < 2; ++k) \
        acc[ai][bj][m][n] = __builtin_amdgcn_mfma_f32_16x16x32_bf16(Bt[n][k], At[m][k], acc[ai][bj][m][n], 0, 0, 0); __builtin_amdgcn_s_setprio(0); } while (0)
#define PG8_WAIT_V(n) asm volatile("s_waitcnt vmcnt(" #n ")" ::: "memory")
#define PG8_WAIT_L(n) asm volatile("s_waitcnt lgkmcnt(" #n ")" ::: "memory")
#define PG8_BAR __builtin_amdgcn_s_barrier()
#define PG8_SCHED __builtin_amdgcn_sched_barrier(0)
    Unit cur, nxt; int ui = 0;
    if (!S.next(0, cur)) return;
    f32x4 acc[2][2][4][2];
#pragma unroll
    for (int a = 0; a < 2; ++a)
#pragma unroll
        for (int b = 0; b < 2; ++b)
#pragma unroll
            for (int m = 0; m < 4; ++m)
#pragma unroll
                for (int n = 0; n < 2; ++n) acc[a][b][m][n] = (f32x4){0.f, 0.f, 0.f, 0.f};
    bf16x8 At[4][2], B0[2][2], B1[2][2];
    const char* cA = (const char*)g.A + (size_t)cur.pm * tstep; const char* cB = (const char*)g.Bt + (size_t)cur.pn * tstep;
    S.a_ready(cur);
    if constexpr (SP2) {
        PG8_STAGE(PG8_SB(0, 0), cB, voffB); PG8_STAGE(PG8_SB(0, 1), cB + hstep, voffB); PG8_STAGE(PG8_SA(0, 0), cA, voffA); PG8_STAGE(PG8_SA(0, 1), cA + hstep, voffA);
        if (wr == 1) PG8_BAR;
        PG8_WAIT_V(2); PG8_BAR;
        PG8_STAGE(PG8_SB(1, 0), cB + kstep, voffB); PG8_STAGE(PG8_SA(1, 0), cA + kstep, voffA); PG8_STAGE(PG8_SB(1, 1), cB + hstep + kstep, voffB);
        PG8_WAIT_V(6); PG8_BAR;
    } else {
        PG8_STAGE(PG8_SB(0, 0), cB, voffB); PG8_STAGE(PG8_SA(0, 0), cA, voffA); PG8_STAGE(PG8_SB(0, 1), cB + hstep, voffB); PG8_STAGE(PG8_SA(0, 1), cA + hstep, voffA);
        if (wr == 1) PG8_BAR;
        PG8_WAIT_V(4); PG8_BAR;
        PG8_STAGE(PG8_SB(1, 0), cB + kstep, voffB); PG8_STAGE(PG8_SA(1, 0), cA + kstep, voffA); PG8_STAGE(PG8_SB(1, 1), cB + hstep + kstep, voffB);
        PG8_WAIT_V(6); PG8_BAR;
    }
    for (;;) {
        const bool has_next = S.next(ui + 1, nxt);
        const char* nA = has_next ? (const char*)g.A + (size_t)nxt.pm * tstep : cA; const char* nB = has_next ? (const char*)g.Bt + (size_t)nxt.pn * tstep : cB;
        for (int t = 0; t < nt; t += 2) {
            const bool last = (t == nt - 2);
            const char* a1 = cA + (size_t)(t + 1) * kstep;
            const char* a2 = last ? nA : cA + (size_t)(t + 2) * kstep; const char* b2 = last ? nB : cB + (size_t)(t + 2) * kstep;
            const char* a3 = a2 + kstep; const char* b3 = b2 + kstep;
            if (last && has_next) S.a_ready(nxt);
            if constexpr (SP2) {
            PG8_LDB(B0, 0, 0); PG8_LDB(B1, 0, 1); PG8_SCHED; PG8_LDA(At, 0, 0); PG8_STAGE(PG8_SA(1, 1), a1 + hstep, voffA);
            PG8_WAIT_V(8); PG8_WAIT_L(0); PG8_BAR; PG8_MMA(0, 0, At, B0); PG8_MMA(0, 1, At, B1); PG8_BAR; PG8_SCHED;
            PG8_LDA(At, 0, 1); PG8_STAGE(PG8_SB(0, 0), b2, voffB); PG8_STAGE(PG8_SB(0, 1), b2 + hstep, voffB); PG8_STAGE(PG8_SA(0, 0), a2, voffA);
            PG8_WAIT_V(8); PG8_WAIT_L(0); PG8_BAR; PG8_MMA(1, 0, At, B0); PG8_MMA(1, 1, At, B1); PG8_BAR; PG8_SCHED;
            PG8_LDB(B0, 1, 0); PG8_LDB(B1, 1, 1); PG8_SCHED; PG8_LDA(At, 1, 0); PG8_STAGE(PG8_SA(0, 1), a2 + hstep, voffA);
            PG8_WAIT_V(8); PG8_WAIT_L(0); PG8_BAR; PG8_MMA(0, 0, At, B0); PG8_MMA(0, 1, At, B1); PG8_BAR; PG8_SCHED;
            PG8_LDA(At, 1, 1); PG8_STAGE(PG8_SB(1, 0), b3, voffB); PG8_STAGE(PG8_SB(1, 1), b3 + hstep, voffB); PG8_STAGE(PG8_SA(1, 0), a3, voffA);
            PG8_WAIT_V(8); PG8_WAIT_L(0); PG8_BAR; PG8_MMA(1, 0, At, B0); PG8_MMA(1, 1, At, B1); PG8_BAR; PG8_SCHED;
            } else {
            PG8_LDB(B0, 0, 0); PG8_SCHED; PG8_LDA(At, 0, 0); PG8_STAGE(PG8_SA(1, 1), a1 + hstep, voffA);
            PG8_WAIT_L(8); PG8_BAR; PG8_WAIT_L(0); PG8_MMA(0, 0, At, B0); PG8_BAR; PG8_SCHED;
            PG8_LDB(B1, 0, 1); PG8_STAGE(PG8_SB(0, 0), b2, voffB);
            PG8_BAR; PG8_WAIT_L(0); PG8_MMA(0, 1, At, B1); PG8_BAR;
            PG8_LDA(At, 0, 1); PG8_STAGE(PG8_SA(0, 0), a2, voffA);
            PG8_BAR; PG8_WAIT_L(0); PG8_MMA(1, 0, At, B0); PG8_BAR; PG8_SCHED;
            PG8_STAGE(PG8_SB(0, 1), b2 + hstep, voffB);
            PG8_WAIT_V(6); PG8_BAR; PG8_MMA(1, 1, At, B1); PG8_BAR;
            PG8_LDB(B0, 1, 0); PG8_SCHED; PG8_LDA(At, 1, 0); PG8_STAGE(PG8_SA(0, 1), a2 + hstep, voffA);
            PG8_WAIT_L(8); PG8_BAR; PG8_WAIT_L(0); PG8_MMA(0, 0, At, B0); PG8_BAR; PG8_SCHED;
            PG8_LDB(B1, 1, 1); PG8_STAGE(PG8_SB(1, 0), b3, voffB);
            PG8_BAR; PG8_WAIT_L(0); PG8_MMA(0, 1, At, B1); PG8_BAR;
            PG8_LDA(At, 1, 1); PG8_STAGE(PG8_SA(1, 0), a3, voffA);
            PG8_BAR; PG8_WAIT_L(0); PG8_MMA(1, 0, At, B0); PG8_BAR; PG8_SCHED;
            PG8_STAGE(PG8_SB(1, 1), b3 + hstep, voffB);
            PG8_WAIT_V(6); PG8_BAR; PG8_MMA(1, 1, At, B1); PG8_BAR;
            }
        }
        if constexpr (ALIGN_EPI) { if (wr == 0) PG8_BAR; }
        if constexpr (!Epi::AFTER_DRAIN) { E(acc, cur, wr, wc, fr, fq); S.done(cur); }
        if (!has_next) break;
#pragma unroll
        for (int a = 0; a < 2; ++a)
#pragma unroll
            for (int b = 0; b < 2; ++b)
#pragma unroll
                for (int m = 0; m < 4; ++m)
#pragma unroll
                    for (int n = 0; n < 2; ++n) acc[a][b][m][n] = (f32x4){0.f, 0.f, 0.f, 0.f};
        cur = nxt; cA = nA; cB = nB; ++ui;
        if constexpr (ALIGN_EPI) { if (wr == 1) PG8_BAR; }
    }
    PG8_WAIT_V(0);
    if constexpr (!ALIGN_EPI) { if (wr == 0) PG8_BAR; }
    PG8_BAR;
    if constexpr (Epi::AFTER_DRAIN) { E.fused(acc, cur, wr, wc, fr, fq, lds, wid, lane); S.done(cur); }
#undef PG8_SA
#undef PG8_SB
#undef PG8_STAGE
#undef PG8_LDA
#undef PG8_LDB
#undef PG8_MMA
#undef PG8_WAIT_V
#undef PG8_WAIT_L
#undef PG8_BAR
#undef PG8_SCHED
}
}
constexpr int DM = 1024, SEQ = 16384, NBATCH = 2, NP = NBATCH * SEQ, DEC_B = 16, DEC_T = 32, PAST = 2048, SKV = PAST + DEC_T;
constexpr int NSQ = DEC_B * DEC_T, NTOK = NP + NSQ, NKVS = DEC_B * SKV;
constexpr int DFF = 2816, INW = 2096, DEPTH = 2;
constexpr float EPS = 1e-6f;
constexpr float QSCALE = 0.10206207261596575f * 1.4426950408889634f;
constexpr int NITEM_P = NBATCH * 256 * 4, NITEM = NITEM_P + DEC_B * 4;

typedef unsigned short bf16;
typedef short bf16x8 __attribute__((ext_vector_type(8)));
typedef float f32x4 __attribute__((ext_vector_type(4)));
typedef float f32x16 __attribute__((ext_vector_type(16)));
typedef unsigned u32x4 __attribute__((ext_vector_type(4)));
typedef unsigned u32x2 __attribute__((ext_vector_type(2)));
#define LAS __attribute__((address_space(3)))

constexpr size_t T256 = (size_t)NTOK * 256 * 2;
constexpr size_t al(size_t x) { return (x + 4095) & ~(size_t)4095; }
constexpr size_t WS_CTL = 0, CTL_BYTES = 65536;
constexpr size_t WS_ROPE = 65536;
constexpr size_t WS_GA = al(WS_ROPE + (size_t)SEQ * 32 * 4);
constexpr size_t WS_DECAY = al(WS_GA + (size_t)NTOK * 16 * 4);
constexpr size_t WS_WIN = al(WS_DECAY + (size_t)NITEM * 64 * 4);
constexpr size_t WS_WGV = al(WS_WIN + (size_t)1792 * 1024 * 2);
constexpr size_t WS_WUQ = al(WS_WGV + (size_t)512 * 1024 * 2);
constexpr size_t WS_WUK = al(WS_WUQ + (size_t)768 * 256 * 2);
constexpr size_t WS_WUV = al(WS_WUK + (size_t)512 * 256 * 2);
constexpr size_t WS_WO = al(WS_WUV + (size_t)512 * 256 * 2);
constexpr size_t WS_WGU = al(WS_WO + (size_t)1024 * 1024 * 2);
constexpr size_t WS_WD = al(WS_WGU + (size_t)5632 * 1024 * 2);
constexpr size_t WS_H = al(WS_WD + (size_t)1024 * 2816 * 2);
constexpr size_t WS_Z = al(WS_H + (size_t)NTOK * 1024 * 2);
constexpr size_t WS_GVT = al(WS_Z + 7 * T256);
constexpr size_t WS_CQN = al(WS_GVT + (size_t)512 * NTOK * 2);
constexpr size_t WS_CKVN = al(WS_CQN + T256);
constexpr size_t WS_CKVS = al(WS_CKVN + (size_t)NP * 256 * 2);
constexpr size_t WS_KR = al(WS_CKVS + (size_t)NKVS * 256 * 2);
constexpr size_t WS_KRS = al(WS_KR + (size_t)NP * 32 * 2);
constexpr size_t WS_KN = al(WS_KRS + (size_t)NKVS * 32 * 2);
constexpr size_t WS_VT = al(WS_KN + (size_t)NP * 512 * 2);
constexpr size_t WS_KNS = al(WS_VT + (size_t)512 * NP * 2);
constexpr size_t WS_VTS = al(WS_KNS + (size_t)NKVS * 512 * 2);
constexpr size_t WS_DS = al(WS_VTS + (size_t)512 * NKVS * 2);
constexpr size_t WS_END = al(WS_DS + (size_t)NITEM_P * 8192 * 4);
constexpr size_t WS_ACT = WS_Z;
static_assert(WS_ACT + (size_t)NTOK * DFF * 2 <= WS_END, "ACT overlay");
static_assert(WS_END <= (size_t)536870912, "ws budget");

constexpr size_t O_Y = 0, O_CKVP = (size_t)NTOK * DM, O_KRP = O_CKVP + (size_t)DEPTH * NP * 256, O_GLAP = O_KRP + (size_t)DEPTH * NP * 32,
                 O_CKVS = O_GLAP + (size_t)DEPTH * NBATCH * 4 * 8192, O_KRS = O_CKVS + (size_t)DEPTH * NSQ * 256, O_GLAS = O_KRS + (size_t)DEPTH * NSQ * 32,
                 O_END = O_GLAS + (size_t)DEPTH * DEC_B * 4 * 8192;

constexpr int LDS_BYTES = 147456;

struct Args {
    const float *xp, *xs, *cckv, *ckr, *sgla, *g_attn, *w_in, *g_qn, *w_uq, *g_kvn, *w_ukv, *w_a2, *b_a2, *g_on, *w_o, *g_ffn, *w_gu, *w_down, *g_final;
    float* out; unsigned char* ws;
};

__device__ __forceinline__ unsigned f2bf(float f) { unsigned u = __builtin_bit_cast(unsigned, f); return (u + 0x7fffu + ((u >> 16) & 1u)) >> 16; }
__device__ __forceinline__ unsigned pk2(float lo, float hi) { return f2bf(lo) | (f2bf(hi) << 16); }
__device__ __forceinline__ float bf2f(unsigned short b) { return __builtin_bit_cast(float, (unsigned)b << 16); }
__device__ __forceinline__ float bflo(unsigned w) { return __builtin_bit_cast(float, w << 16); }
__device__ __forceinline__ float bfhi(unsigned w) { return __builtin_bit_cast(float, w & 0xffff0000u); }
__device__ __forceinline__ float wave_sum(float v) {
#pragma unroll
    for (int o = 1; o < 64; o <<= 1) v += __shfl_xor(v, o);
    return v;
}
__device__ __forceinline__ int crow(int r, int hi) { return (r & 3) + 8 * (r >> 2) + 4 * hi; }
__device__ __forceinline__ float logsig(float x) { return fminf(x, 0.f) - __logf(1.0f + __expf(-fabsf(x))); }
#define LDS_WAIT() asm volatile("s_waitcnt lgkmcnt(0)" ::: "memory")
#define MFMA32(a, b, c) __builtin_amdgcn_mfma_f32_32x32x16_bf16((a), (b), (c), 0, 0, 0)

struct Ctx {
    int tid, lane, wave, G, vcu, gw, NGW;
    LAS unsigned char* lds;
};

__device__ __forceinline__ void tr_item(const float* W, int K, int N, int k0, int src0, int nvalid, bf16* WT, int dst_row0, float scale, LAS float* scr, int lane) {
#pragma unroll 8
    for (int i = 0; i < 32; ++i) { const int kk = 2 * i + (lane >> 5), c = lane & 31;
        float v = 0.f; if (c < nvalid) v = W[(size_t)(k0 + kk) * N + src0 + c] * scale;
        scr[kk * 33 + c] = v; }
    LDS_WAIT(); asm volatile("" ::: "memory");
    const int c8 = lane & 7;
#pragma unroll
    for (int j = 0; j < 4; ++j) { const int n = (lane >> 3) + 8 * j; const LAS float* s = scr + (8 * c8) * 33 + n;
        u32x4 o; o.x = pk2(s[0 * 33], s[1 * 33]); o.y = pk2(s[2 * 33], s[3 * 33]); o.z = pk2(s[4 * 33], s[5 * 33]); o.w = pk2(s[6 * 33], s[7 * 33]);
        *(u32x4*)(WT + (size_t)(dst_row0 + n) * K + k0 + 8 * c8) = o; }
    LDS_WAIT(); asm volatile("" ::: "memory");
}
__device__ __forceinline__ void convert_weights(const Ctx& C, const Args& A, int l) {
    LAS float* scr = (LAS float*)(C.lds + C.wave * 16384);
    unsigned char* ws = A.ws;
    const float* w_in = A.w_in + (size_t)l * DM * INW; const float* w_uq = A.w_uq + (size_t)l * 256 * 768; const float* w_ukv = A.w_ukv + (size_t)l * 256 * 1024;
    const float* w_o = A.w_o + (size_t)l * DM * DM; const float* w_gu = A.w_gu + (size_t)l * DM * 2 * DFF; const float* w_d = A.w_down + (size_t)l * DFF * DM;
    constexpr int I0 = 56 * 16, I1 = 16 * 16, I2 = 24 * 4, I3 = 16 * 4, I4 = 16 * 4, I5 = 32 * 16, I6 = 176 * 16, I7 = 32 * 44;
    constexpr int NIT = I0 + I1 + I2 + I3 + I4 + I5 + I6 + I7;
    for (int it = C.gw; it < NIT; it += C.NGW) {
        int r = it;
        if (r < I0) { const int db = r >> 4, kb = r & 15; int src = 0, nv = 32;
            if (db < 16) src = 32 * db; else if (db == 16) src = 512; else if (db == 17) { src = 2080; nv = 16; } else if (db < 24) { src = 0; nv = 0; }
            else if (db < 32) src = 544 + 32 * (db - 24); else if (db < 40) src = 800 + 32 * (db - 32); else src = 1568 + 32 * (db - 40);
            tr_item(w_in, DM, INW, 64 * kb, src, nv, (bf16*)(ws + WS_WIN), 32 * db, 1.f, scr, C.lane); continue; } r -= I0;
        if (r < I1) { const int db = r >> 4, kb = r & 15; tr_item(w_in, DM, INW, 64 * kb, 1056 + 32 * db, 32, (bf16*)(ws + WS_WGV), 32 * db, 1.f, scr, C.lane); continue; } r -= I1;
        if (r < I2) { const int db = r >> 2, kb = r & 3; tr_item(w_uq, 256, 768, 64 * kb, 32 * db, 32, (bf16*)(ws + WS_WUQ), 32 * db, QSCALE, scr, C.lane); continue; } r -= I2;
        if (r < I3) { const int db = r >> 2, kb = r & 3; tr_item(w_ukv, 256, 1024, 64 * kb, (db >> 1) * 128 + (db & 1) * 32, 32, (bf16*)(ws + WS_WUK), 32 * db, 1.f, scr, C.lane); continue; } r -= I3;
        if (r < I4) { const int db = r >> 2, kb = r & 3; tr_item(w_ukv, 256, 1024, 64 * kb, (db >> 1) * 128 + 64 + (db & 1) * 32, 32, (bf16*)(ws + WS_WUV), 32 * db, 1.f, scr, C.lane); continue; } r -= I4;
        if (r < I5) { const int db = r >> 4, kb = r & 15; tr_item(w_o, DM, DM, 64 * kb, 32 * db, 32, (bf16*)(ws + WS_WO), 32 * db, 1.f, scr, C.lane); continue; } r -= I5;
        if (r < I6) { const int db = r >> 4, kb = r & 15; const int pn = db >> 3, t = db & 7; const int src = (t < 4) ? 128 * pn + 32 * t : DFF + 128 * pn + 32 * (t - 4);
            tr_item(w_gu, DM, 2 * DFF, 64 * kb, src, 32, (bf16*)(ws + WS_WGU), 32 * db, 1.f, scr, C.lane); continue; } r -= I6;
        { const int db = r / 44, kb = r % 44; tr_item(w_d, DFF, DM, 64 * kb, 32 * db, 32, (bf16*)(ws + WS_WD), 32 * db, 1.f, scr, C.lane); }
    }
}

__device__ __forceinline__ void norm_row(const float* xrow, const float* g, bf16* orow, float* copy, int lane) {
    const f32x4* xr = (const f32x4*)xrow + lane; const f32x4* gr = (const f32x4*)g + lane;
    f32x4 v[4]; float s = 0.f;
#pragma unroll
    for (int j = 0; j < 4; ++j) { v[j] = xr[64 * j]; s += (v[j].x * v[j].x + v[j].y * v[j].y) + (v[j].z * v[j].z + v[j].w * v[j].w); }
    const float rstd = 1.0f / sqrtf(wave_sum(s) * (1.f / DM) + EPS);
    if (copy) {
#pragma unroll
        for (int j = 0; j < 4; ++j) ((f32x4*)copy + lane)[64 * j] = v[j]; }
    u32x2* o8 = (u32x2*)orow + lane;
#pragma unroll
    for (int j = 0; j < 4; ++j) { const f32x4 gg = gr[64 * j]; u32x2 w; w.x = pk2(v[j].x * rstd * gg.x, v[j].y * rstd * gg.y); w.y = pk2(v[j].z * rstd * gg.z, v[j].w * rstd * gg.w); o8[64 * j] = w; }
}
__device__ __forceinline__ void final_norm_row(float* xrow, const float* g, int lane) {
    f32x4* xr = (f32x4*)xrow + lane; const f32x4* gr = (const f32x4*)g + lane;
    f32x4 v[4]; float s = 0.f;
#pragma unroll
    for (int j = 0; j < 4; ++j) { v[j] = xr[64 * j]; s += (v[j].x * v[j].x + v[j].y * v[j].y) + (v[j].z * v[j].z + v[j].w * v[j].w); }
    const float rstd = 1.0f / sqrtf(wave_sum(s) * (1.f / DM) + EPS);
#pragma unroll
    for (int j = 0; j < 4; ++j) { const f32x4 gg = gr[64 * j]; xr[64 * j] = v[j] * rstd * gg; }
}

__device__ __forceinline__ void p3_token(const Args& A, int l, int m, int lane) {
    unsigned char* ws = A.ws;
    const bf16* CQ = (const bf16*)(ws + WS_Z); const bf16* CKV = (const bf16*)(ws + WS_Z + T256); const bf16* MISC = (const bf16*)(ws + WS_Z + 2 * T256);
    const float* ROPE = (const float*)(ws + WS_ROPE);
    { const u32x2 w = *((const u32x2*)(CQ + (size_t)m * 256) + lane); const float a = bflo(w.x), b = bfhi(w.x), c = bflo(w.y), d = bfhi(w.y);
      const float rstd = 1.0f / sqrtf(wave_sum((a * a + b * b) + (c * c + d * d)) * (1.f / 256) + EPS);
      const f32x4 g = *((const f32x4*)(A.g_qn + l * 256) + lane);
      u32x2 o; o.x = pk2(a * rstd * g.x, b * rstd * g.y); o.y = pk2(c * rstd * g.z, d * rstd * g.w);
      *((u32x2*)((bf16*)(ws + WS_CQN) + (size_t)m * 256) + lane) = o; }
    int pos; float* ockv; float* okr; bf16* bckv; bf16* bkr;
    if (m < NP) { pos = m & (SEQ - 1); ockv = A.out + O_CKVP + ((size_t)l * NP + m) * 256; okr = A.out + O_KRP + ((size_t)l * NP + m) * 32;
        bckv = (bf16*)(ws + WS_CKVN) + (size_t)m * 256; bkr = (bf16*)(ws + WS_KR) + (size_t)m * 32; }
    else { const int s = m - NP, b = s >> 5, t = s & 31; pos = PAST + t; ockv = A.out + O_CKVS + ((size_t)l * NSQ + s) * 256; okr = A.out + O_KRS + ((size_t)l * NSQ + s) * 32;
        const size_t r = (size_t)b * SKV + PAST + t; bckv = (bf16*)(ws + WS_CKVS) + r * 256; bkr = (bf16*)(ws + WS_KRS) + r * 32; }
    { const u32x2 w = *((const u32x2*)(CKV + (size_t)m * 256) + lane); const float a = bflo(w.x), b = bfhi(w.x), c = bflo(w.y), d = bfhi(w.y);
      const float rstd = 1.0f / sqrtf(wave_sum((a * a + b * b) + (c * c + d * d)) * (1.f / 256) + EPS);
      const f32x4 g = *((const f32x4*)(A.g_kvn + l * 256) + lane);
      const f32x4 o = (f32x4){a * rstd * g.x, b * rstd * g.y, c * rstd * g.z, d * rstd * g.w};
      *((f32x4*)ockv + lane) = o;
      u32x2 ob; ob.x = pk2(o.x, o.y); ob.y = pk2(o.z, o.w); *((u32x2*)bckv + lane) = ob; }
    if (lane < 16) { const float x1 = bf2f(MISC[(size_t)m * 256 + lane]), x2 = bf2f(MISC[(size_t)m * 256 + 16 + lane]);
        const float c = ROPE[pos * 32 + lane], s = ROPE[pos * 32 + 16 + lane];
        const float o1 = x1 * c - x2 * s, o2 = x1 * s + x2 * c;
        okr[lane] = o1; okr[16 + lane] = o2; bkr[lane] = (bf16)f2bf(o1); bkr[16 + lane] = (bf16)f2bf(o2); }
    else if (lane < 32) { ((float*)(ws + WS_GA))[(size_t)m * 16 + (lane - 16)] = bf2f(MISC[(size_t)m * 256 + 32 + (lane - 16)]); }
}
__device__ __forceinline__ void cache_row(const Args& A, int l, int r, int lane) {
    const int b = r >> 11, p = r & (PAST - 1); const size_t dr = (size_t)b * SKV + p;
    const f32x4 v = *((const f32x4*)(A.cckv + ((size_t)l * DEC_B * PAST + r) * 256) + lane);
    u32x2 o; o.x = pk2(v.x, v.y); o.y = pk2(v.z, v.w); *((u32x2*)((bf16*)(A.ws + WS_CKVS) + dr * 256) + lane) = o;
    if (lane < 32) ((bf16*)(A.ws + WS_KRS))[dr * 32 + lane] = (bf16)f2bf(A.ckr[((size_t)l * DEC_B * PAST + r) * 32 + lane]);
}

struct GlaItem { int tok0, L, hd, sb; bool sample; };
__device__ __forceinline__ GlaItem gla_decode(int it) {
    GlaItem g;
    if (it < NITEM_P) { g.hd = it & 3; const int bc = it >> 2; g.tok0 = bc * 64; g.L = 64; g.sample = false; g.sb = 0; }
    else { const int j = it - NITEM_P; g.hd = j & 3; g.sb = j >> 2; g.tok0 = NP + g.sb * 32; g.L = 32; g.sample = true; }
    return g;
}
typedef float f32x2_t __attribute__((ext_vector_type(2))); typedef __bf16 bf16x2_t __attribute__((ext_vector_type(2)));
__device__ __forceinline__ unsigned cvtpk(float lo, float hi) { f32x2_t v = {lo, hi}; bf16x2_t b = __builtin_convertvector(v, bf16x2_t); return __builtin_bit_cast(unsigned, b); }
__device__ __forceinline__ float gate_lg(const float (&ga)[16], const float (&w)[16], float bias, int p, const float* g_GA_base) {
    float x = bias;
#ifdef GA_OLD
    const float* gp = g_GA_base + (size_t)p * 16;
#pragma unroll
    for (int r = 0; r < 16; ++r) x += gp[r] * w[r];
#else
#pragma unroll
    for (int r = 0; r < 16; ++r) x += __builtin_bit_cast(float, __builtin_amdgcn_readlane(__builtin_bit_cast(int, ga[r]), p)) * w[r];
#endif
    return logsig(x) * (1.f / 16.f);
}
constexpr int KT_PITCH = 72;
template <bool SAMPLE> __device__ __forceinline__ void gla_g1(const Args& A, int l, int it, LAS unsigned char* wl, int lane) {
    const GlaItem g = gla_decode(it); unsigned char* ws = A.ws; constexpr int L = SAMPLE ? 32 : 64;
    const int col = g.hd * 64 + lane, r32 = lane & 31, hi = lane >> 5;
    const float* GA = (const float*)(ws + WS_GA); const bf16* GK = (const bf16*)(ws + WS_Z + 4 * T256); const bf16* GVT = (const bf16*)(ws + WS_GVT);
    LAS bf16* kT = (LAS bf16*)wl; LAS float* dsm = (LAS float*)(wl + 64 * KT_PITCH * 2);
    float w[16], ga[16];
#pragma unroll
    for (int r = 0; r < 16; ++r) w[r] = A.w_a2[(size_t)l * 16 * 256 + r * 256 + col];
    const float bias = A.b_a2[l * 256 + col];
    { const int pl = lane < L ? lane : L - 1;
#pragma unroll
      for (int q = 0; q < 4; ++q) { const f32x4 v = *(const f32x4*)(GA + (size_t)(g.tok0 + pl) * 16 + 4 * q); ga[4 * q] = v.x; ga[4 * q + 1] = v.y; ga[4 * q + 2] = v.z; ga[4 * q + 3] = v.w; } }
    float blast = 0.f;
#pragma unroll 4
    for (int p = 0; p < L; ++p) blast += gate_lg(ga, w, bias, p, GA + (size_t)g.tok0 * 16);
    float bc = 0.f;
#pragma unroll 4
    for (int p = 0; p < L; ++p) { bc += gate_lg(ga, w, bias, p, GA + (size_t)g.tok0 * 16);
        const float kk = bf2f(GK[(size_t)(g.tok0 + p) * 256 + col]) * __expf(blast - bc);
        kT[lane * KT_PITCH + p] = (bf16)(cvtpk(kk, kk) & 0xffffu); }
    const float decay = __expf(blast);
    if (!SAMPLE) ((float*)(ws + WS_DECAY))[(size_t)it * 64 + lane] = decay;
    dsm[lane] = decay;
    LDS_WAIT(); asm volatile("" ::: "memory");
#pragma unroll 1
    for (int nb = 0; nb < 4; ++nb) {
        f32x16 acc[2]; acc[0] = (f32x16){}; acc[1] = (f32x16){};
#pragma unroll
        for (int s = 0; s < L / 16; ++s) {
            const bf16x8 bfr = *(const bf16x8*)(GVT + (size_t)(g.hd * 128 + 32 * nb + r32) * NTOK + g.tok0 + 16 * s + 8 * hi);
#pragma unroll
            for (int mb = 0; mb < 2; ++mb) { const bf16x8 af = *(const LAS bf16x8*)(kT + (32 * mb + r32) * KT_PITCH + 16 * s + 8 * hi); acc[mb] = MFMA32(af, bfr, acc[mb]); }
        }
        const int dv = 32 * nb + r32;
#ifdef DS_OLD
        if (!SAMPLE) { float* dsp = (float*)(ws + WS_DS) + (size_t)it * 8192 + dv;
#pragma unroll
            for (int mb = 0; mb < 2; ++mb)
#pragma unroll
                for (int r = 0; r < 16; ++r) dsp[(32 * mb + crow(r, hi)) * 128] = acc[mb][r]; }
#else
        if (!SAMPLE) { float* dsp = (float*)(ws + WS_DS) + (size_t)it * 8192 + dv * 64 + 4 * hi;
#pragma unroll
            for (int mb = 0; mb < 2; ++mb)
#pragma unroll
                for (int q = 0; q < 4; ++q) *(f32x4*)(dsp + 32 * mb + 8 * q) = (f32x4){acc[mb][4 * q], acc[mb][4 * q + 1], acc[mb][4 * q + 2], acc[mb][4 * q + 3]}; }
#endif
        else { const size_t so = (((size_t)l * DEC_B + g.sb) * 4 + g.hd) * 8192 + dv;
#pragma unroll
            for (int mb = 0; mb < 2; ++mb) {
#pragma unroll
                for (int r = 0; r < 16; ++r) { const int dk = 32 * mb + crow(r, hi); A.out[O_GLAS + so + dk * 128] = dsm[dk] * A.sgla[so + dk * 128] + acc[mb][r]; }
                asm volatile("" ::: "memory"); } }
    }
    LDS_WAIT(); asm volatile("" ::: "memory");
}
constexpr int NSCAN = 64, NSAMPWG = 8;
#ifdef DS_OLD
__device__ __forceinline__ void gla_scan(const Args& A, int l, int sblock, int tid) {
    const int gth = sblock * 512 + tid;
    const int seq = gth >> 12, e0 = (gth & 4095) * 2;
    const int b = seq >> 2, hd = seq & 3, dk = e0 >> 7;
    float* DS = (float*)(A.ws + WS_DS); const float* DEC = (const float*)(A.ws + WS_DECAY);
    float s0 = 0.f, s1 = 0.f;
    for (int c0 = 0; c0 < 256; c0 += 8) {
        float2 ds[8]; float dc[8];
#pragma unroll
        for (int j = 0; j < 8; ++j) { const size_t it = (size_t)((b * 256 + c0 + j) * 4 + hd); ds[j] = *(const float2*)(DS + it * 8192 + e0); dc[j] = DEC[it * 64 + dk]; }
#pragma unroll
        for (int j = 0; j < 8; ++j) { const size_t it = (size_t)((b * 256 + c0 + j) * 4 + hd); *(float2*)(DS + it * 8192 + e0) = make_float2(s0, s1);
            s0 = dc[j] * s0 + ds[j].x; s1 = dc[j] * s1 + ds[j].y; }
    }
    *(float2*)(A.out + O_GLAP + (((size_t)l * NBATCH + b) * 4 + hd) * 8192 + e0) = make_float2(s0, s1);
}
#else
__device__ __forceinline__ void gla_scan(const Args& A, int l, int sblock, int tid) {
    const int gth = sblock * 512 + tid;
    const int seq = gth >> 12, e0 = (gth & 4095) * 2;
    const int b = seq >> 2, hd = seq & 3, dv = e0 >> 6, dk = e0 & 63;
    float* DS = (float*)(A.ws + WS_DS); const float* DEC = (const float*)(A.ws + WS_DECAY);
    float s0 = 0.f, s1 = 0.f;
#pragma unroll 1
    for (int c0 = 0; c0 < 256; c0 += 16) {
        float2 ds[16], dc[16];
#pragma unroll
        for (int j = 0; j < 16; ++j) { const size_t it = (size_t)((b * 256 + c0 + j) * 4 + hd); ds[j] = *(const float2*)(DS + it * 8192 + e0); dc[j] = *(const float2*)(DEC + it * 64 + dk); }
#pragma unroll
        for (int j = 0; j < 16; ++j) { const size_t it = (size_t)((b * 256 + c0 + j) * 4 + hd); *(float2*)(DS + it * 8192 + e0) = make_float2(s0, s1);
            s0 = dc[j].x * s0 + ds[j].x; s1 = dc[j].y * s1 + ds[j].y; }
    }
    float* o = A.out + O_GLAP + (((size_t)l * NBATCH + b) * 4 + hd) * 8192;
    o[dk * 128 + dv] = s0; o[(dk + 1) * 128 + dv] = s1;
}
#endif
constexpr int BS_PITCH = 65;
template <bool SAMPLE> __device__ __forceinline__ void gla_g3(const Args& A, int l, int it, LAS unsigned char* wl, int lane) {
    const GlaItem g = gla_decode(it); unsigned char* ws = A.ws; constexpr int L = SAMPLE ? 32 : 64, NIB = L / 32;
    const int col = g.hd * 64 + lane, r32 = lane & 31, hi = lane >> 5;
    const float* GA = (const float*)(ws + WS_GA); const bf16* GQ = (const bf16*)(ws + WS_Z + 3 * T256); const bf16* GK = (const bf16*)(ws + WS_Z + 4 * T256);
    const bf16* GG = (const bf16*)(ws + WS_Z + 5 * T256); const bf16* GVT = (const bf16*)(ws + WS_GVT); bf16* CAT = (bf16*)(ws + WS_H);
    LAS float* bsm = (LAS float*)wl;
    {   float w[16], ga[16];
#pragma unroll
        for (int r = 0; r < 16; ++r) w[r] = A.w_a2[(size_t)l * 16 * 256 + r * 256 + col];
        const float bias = A.b_a2[l * 256 + col];
        { const int pl = lane < L ? lane : L - 1;
#pragma unroll
          for (int q = 0; q < 4; ++q) { const f32x4 v = *(const f32x4*)(GA + (size_t)(g.tok0 + pl) * 16 + 4 * q); ga[4 * q] = v.x; ga[4 * q + 1] = v.y; ga[4 * q + 2] = v.z; ga[4 * q + 3] = v.w; } }
        float bc = 0.f;
#pragma unroll 4
        for (int p = 0; p < L; ++p) { bc += gate_lg(ga, w, bias, p, GA + (size_t)g.tok0 * 16); bsm[p * BS_PITCH + lane] = bc; }
    }
    LDS_WAIT(); asm volatile("" ::: "memory");
    bf16x8 qf[NIB][4], kf[NIB][4];
#pragma unroll
    for (int ib = 0; ib < NIB; ++ib)
#pragma unroll
        for (int s = 0; s < 4; ++s) {
            const int i = 32 * ib + r32, dk0 = 16 * s + 8 * hi;
            const u32x4 rq = *(const u32x4*)(GQ + (size_t)(g.tok0 + i) * 256 + g.hd * 64 + dk0);
            const u32x4 rk = *(const u32x4*)(GK + (size_t)(g.tok0 + i) * 256 + g.hd * 64 + dk0);
            u32x4 oq, ok;
#pragma unroll
            for (int jj = 0; jj < 4; ++jj) { const float b0 = bsm[i * BS_PITCH + dk0 + 2 * jj], b1 = bsm[i * BS_PITCH + dk0 + 2 * jj + 1];
                const float e0 = __expf(b0), e1 = __expf(b1);
                oq[jj] = cvtpk(bflo(rq[jj]) * 0.125f * e0, bfhi(rq[jj]) * 0.125f * e1);
                ok[jj] = cvtpk(bflo(rk[jj]) * __builtin_amdgcn_rcpf(e0), bfhi(rk[jj]) * __builtin_amdgcn_rcpf(e1)); }
            qf[ib][s] = __builtin_bit_cast(bf16x8, oq); kf[ib][s] = __builtin_bit_cast(bf16x8, ok);
        }
    bf16x8 xp[NIB][NIB][2];
#pragma unroll
    for (int jb = 0; jb < NIB; ++jb)
#pragma unroll
        for (int ib = 0; ib < NIB; ++ib) {
            if (jb > ib) { xp[jb][ib][0] = (bf16x8){}; xp[jb][ib][1] = (bf16x8){}; continue; }
            f32x16 X = (f32x16){};
#pragma unroll
            for (int s = 0; s < 4; ++s) X = MFMA32(kf[jb][s], qf[ib][s], X);
            if (jb == ib) {
#pragma unroll
                for (int r = 0; r < 16; ++r) if (crow(r, hi) > r32) X[r] = 0.f; }
#pragma unroll
            for (int s2 = 0; s2 < 2; ++s2) { u32x4 pw;
#pragma unroll
                for (int jj = 0; jj < 4; ++jj) pw[jj] = cvtpk(X[8 * s2 + 2 * jj], X[8 * s2 + 2 * jj + 1]);
                xp[jb][ib][s2] = __builtin_bit_cast(bf16x8, pw); }
        }
    const float* Sp = SAMPLE ? A.sgla + (((size_t)l * DEC_B + g.sb) * 4 + g.hd) * 8192 : (const float*)(ws + WS_DS) + (size_t)it * 8192;
#pragma unroll
    for (int ib = 0; ib < NIB; ++ib) {
        f32x16 o[4];
#pragma unroll
        for (int nb = 0; nb < 4; ++nb) {
            const int dv = 32 * nb + r32;
            o[nb] = (f32x16){};
#pragma unroll
            for (int s = 0; s < 4; ++s) { u32x4 pw;
#ifdef DS_OLD
                if (true) {
#else
                if (SAMPLE) {
#endif
#pragma unroll
                    for (int jj = 0; jj < 4; ++jj) pw[jj] = cvtpk(Sp[(16 * s + 8 * hi + 2 * jj) * 128 + dv], Sp[(16 * s + 8 * hi + 2 * jj + 1) * 128 + dv]); }
                else { const f32x4 sa = *(const f32x4*)(Sp + dv * 64 + 16 * s + 8 * hi), sb = *(const f32x4*)(Sp + dv * 64 + 16 * s + 8 * hi + 4);
                    pw = (u32x4){cvtpk(sa.x, sa.y), cvtpk(sa.z, sa.w), cvtpk(sb.x, sb.y), cvtpk(sb.z, sb.w)}; }
                o[nb] = MFMA32(__builtin_bit_cast(bf16x8, pw), qf[ib][s], o[nb]); }
#pragma unroll
            for (int jb = 0; jb <= ib; ++jb)
#pragma unroll
                for (int s2 = 0; s2 < 2; ++s2) { const bf16* vp = GVT + (size_t)(g.hd * 128 + dv) * NTOK + g.tok0 + 32 * jb + 16 * s2 + 4 * hi;
                    const u32x2 lo = *(const u32x2*)vp, hi8 = *(const u32x2*)(vp + 8);
                    o[nb] = MFMA32(__builtin_bit_cast(bf16x8, (u32x4){lo.x, lo.y, hi8.x, hi8.y}), xp[jb][ib][s2], o[nb]); }
        }
        float ss = 0.f;
#pragma unroll
        for (int nb = 0; nb < 4; ++nb)
#pragma unroll
            for (int r = 0; r < 16; ++r) ss += o[nb][r] * o[nb][r];
        ss += __shfl_xor(ss, 32);
        const float rstd = 1.0f / sqrtf(ss * (1.f / 128) + EPS);
        const int tok = g.tok0 + 32 * ib + r32;
#pragma unroll
        for (int nb = 0; nb < 4; ++nb)
#pragma unroll
            for (int q = 0; q < 4; ++q) { const int dv0 = 32 * nb + 8 * q + 4 * hi; const int gc = g.hd * 128 + dv0;
                const u32x2 gw = *(const u32x2*)(GG + (size_t)(gc >> 8) * ((size_t)NTOK * 256) + (size_t)tok * 256 + (gc & 255));
                const f32x4 gon = *(const f32x4*)(A.g_on + l * 128 + dv0);
                const float g0 = bflo(gw.x), g1 = bfhi(gw.x), g2 = bflo(gw.y), g3 = bfhi(gw.y);
                const float v0 = o[nb][4 * q + 0] * rstd * gon.x * g0 * __builtin_amdgcn_rcpf(1.0f + __expf(-g0));
                const float v1 = o[nb][4 * q + 1] * rstd * gon.y * g1 * __builtin_amdgcn_rcpf(1.0f + __expf(-g1));
                const float v2 = o[nb][4 * q + 2] * rstd * gon.z * g2 * __builtin_amdgcn_rcpf(1.0f + __expf(-g2));
                const float v3 = o[nb][4 * q + 3] * rstd * gon.w * g3 * __builtin_amdgcn_rcpf(1.0f + __expf(-g3));
                u32x2 ow; ow.x = cvtpk(v0, v1); ow.y = cvtpk(v2, v3);
                *(u32x2*)(CAT + (size_t)tok * 1024 + 512 + g.hd * 128 + dv0) = ow; }
        asm volatile("" ::: "memory");
    }
    LDS_WAIT(); asm volatile("" ::: "memory");
}

__device__ __forceinline__ float max3f(float a, float b, float c) { return fmaxf(fmaxf(a, b), c); }
constexpr float ATT_THR = 8.0f;
template <class LD> __device__ __forceinline__ void attn_tile(const LD& ld, const bf16x8 (&qr)[6], f32x16 (&o)[2], float& m, float& l, bool half_only, bool first) {
    f32x16 negm;
#pragma unroll
    for (int r = 0; r < 16; ++r) negm[r] = -m;
    f32x16 p0 = negm, p1 = negm;
#pragma unroll
    for (int s = 0; s < 6; ++s) p0 = MFMA32(ld.k(0, s), qr[s], p0);
    if (!half_only) {
#pragma unroll
        for (int s = 0; s < 6; ++s) p1 = MFMA32(ld.k(1, s), qr[s], p1); }
    float mx = max3f(p0[0], p0[1], p0[2]);
#pragma unroll
    for (int r = 3; r < 15; r += 2) mx = max3f(mx, p0[r], p0[r + 1]);
    mx = fmaxf(mx, p0[15]);
    if (!half_only) {
#pragma unroll
        for (int r = 0; r < 16; r += 2) mx = max3f(mx, p1[r], p1[r + 1]); }
    mx = fmaxf(mx, __shfl_xor(mx, 32));
    if (first || __any(mx > ATT_THR)) {
        const float d = first ? mx : fmaxf(mx, 0.f);
        m += d;
        const float f = first ? 0.f : __builtin_amdgcn_exp2f(-d);
        l *= f;
#pragma unroll
        for (int r = 0; r < 16; ++r) { p0[r] -= d; p1[r] -= d; o[0][r] *= f; o[1][r] *= f; }
    }
    float rs = 0.f, rs1 = 0.f;
#pragma unroll
    for (int r = 0; r < 16; ++r) { p0[r] = __builtin_amdgcn_exp2f(p0[r]); rs += p0[r]; }
    if (!half_only) {
#pragma unroll
        for (int r = 0; r < 16; ++r) { p1[r] = __builtin_amdgcn_exp2f(p1[r]); rs1 += p1[r]; } }
    l += rs + rs1;
    bf16x8 pa[4];
#pragma unroll
    for (int s = 0; s < 2; ++s) { u32x4 w0, w1;
#pragma unroll
        for (int jj = 0; jj < 4; ++jj) { w0[jj] = cvtpk(p0[8 * s + 2 * jj], p0[8 * s + 2 * jj + 1]); w1[jj] = cvtpk(p1[8 * s + 2 * jj], p1[8 * s + 2 * jj + 1]); }
        pa[s] = __builtin_bit_cast(bf16x8, w0); pa[2 + s] = __builtin_bit_cast(bf16x8, w1); }
#pragma unroll
    for (int db = 0; db < 2; ++db) {
#pragma unroll
        for (int s = 0; s < 2; ++s) o[db] = MFMA32(ld.v(db, s), pa[s], o[db]);
        if (!half_only) {
#pragma unroll
            for (int s = 2; s < 4; ++s) o[db] = MFMA32(ld.v(db, s), pa[s], o[db]); }
    }
}
constexpr int K_PITCH = 208, V_PITCH = 136, KBUF = 64 * K_PITCH, VBUF = 64 * V_PITCH, ABUF = KBUF + VBUF;
struct LdsLoader {
    LAS const unsigned char* kb; LAS const unsigned char* vb; int r32, hi;
    __device__ __forceinline__ bf16x8 k(int half, int s) const { return *(LAS const bf16x8*)(kb + (r32 + 32 * half) * K_PITCH + s * 32 + hi * 16); }
    __device__ __forceinline__ bf16x8 v(int db, int s) const { LAS const unsigned char* p = vb + (r32 + 32 * db) * V_PITCH + s * 32 + hi * 8;
        const u32x2 lo = *(LAS const u32x2*)p, h8 = *(LAS const u32x2*)(p + 16); return __builtin_bit_cast(bf16x8, (u32x4){lo.x, lo.y, h8.x, h8.y}); }
};
struct GlbLoader {
    const bf16* kn; const bf16* kr; const bf16* vt; int r32, hi;
    __device__ __forceinline__ bf16x8 k(int half, int s) const { const int kv = r32 + 32 * half;
        return (s < 4) ? *(const bf16x8*)(kn + (size_t)kv * 512 + 16 * s + 8 * hi) : *(const bf16x8*)(kr + (size_t)kv * 32 + 16 * (s - 4) + 8 * hi); }
    __device__ __forceinline__ bf16x8 v(int db, int s) const { const bf16* p = vt + (size_t)(r32 + 32 * db) * NKVS + 16 * s + 4 * hi;
        const u32x2 lo = *(const u32x2*)p, h8 = *(const u32x2*)(p + 8); return __builtin_bit_cast(bf16x8, (u32x4){lo.x, lo.y, h8.x, h8.y}); }
};
__device__ __forceinline__ void load_q(bf16x8 (&qr)[6], const bf16* qp, const float* rope_row, int hi) {
#pragma unroll
    for (int s = 0; s < 6; ++s) qr[s] = *(const bf16x8*)(qp + 16 * s + 8 * hi);
    const u32x4 a = __builtin_bit_cast(u32x4, qr[4]), b = __builtin_bit_cast(u32x4, qr[5]); u32x4 oa, ob;
    const f32x4 c0 = *(const f32x4*)(rope_row + 8 * hi), c1 = *(const f32x4*)(rope_row + 8 * hi + 4), s0 = *(const f32x4*)(rope_row + 16 + 8 * hi), s1 = *(const f32x4*)(rope_row + 16 + 8 * hi + 4);
#pragma unroll
    for (int jj = 0; jj < 4; ++jj) {
        const float x1l = bflo(a[jj]), x1h = bfhi(a[jj]), x2l = bflo(b[jj]), x2h = bfhi(b[jj]);
        const float cl = (jj < 2) ? c0[2 * jj] : c1[2 * jj - 4], ch = (jj < 2) ? c0[2 * jj + 1] : c1[2 * jj - 3];
        const float sl = (jj < 2) ? s0[2 * jj] : s1[2 * jj - 4], sh = (jj < 2) ? s0[2 * jj + 1] : s1[2 * jj - 3];
        oa[jj] = pk2(x1l * cl - x2l * sl, x1h * ch - x2h * sh); ob[jj] = pk2(x1l * sl + x2l * cl, x1h * sh + x2h * ch); }
    qr[4] = __builtin_bit_cast(bf16x8, oa); qr[5] = __builtin_bit_cast(bf16x8, ob);
}
__device__ __forceinline__ void attn_prompt_unit(const Args& A, const Ctx& C, int b, int hd, int qb) {
    unsigned char* ws = A.ws; const int tid = C.tid, lane = C.lane, wid = C.wave, r32 = lane & 31, hi = lane >> 5;
    const bf16* Q = (const bf16*)(ws + WS_Z); const bf16* KN = (const bf16*)(ws + WS_KN); const bf16* KR = (const bf16*)(ws + WS_KR); const bf16* VT = (const bf16*)(ws + WS_VT);
    bf16* CAT = (bf16*)(ws + WS_H); const float* ROPE = (const float*)(ws + WS_ROPE);
    const int pos = qb * 256 + wid * 32 + r32; const size_t qrow = (size_t)b * SEQ + pos;
    bf16x8 qr[6]; load_q(qr, Q + qrow * 768 + hd * 96, ROPE + (size_t)pos * 32, hi);
    const int ntiles = 4 * qb + 4, my_last = 4 * qb + (wid >> 1);
    const int krow = tid >> 3, kch = tid & 7, rrow = (tid & 255) >> 2, rch = tid & 3;
    const bf16* kn_src = KN + ((size_t)b * SEQ + krow) * 512 + hd * 64 + kch * 8;
    const bf16* kr_src = KR + ((size_t)b * SEQ + rrow) * 32 + rch * 8;
    const bf16* vt_src = VT + (size_t)(hd * 64 + krow) * NP + (size_t)b * SEQ + kch * 8;
    const int kn_dst = krow * K_PITCH + kch * 16, kr_dst = rrow * K_PITCH + 128 + rch * 16, vt_dst = KBUF + krow * V_PITCH + kch * 16;
    u32x4 sk, sr, sv;
    sk = *(const u32x4*)kn_src; sv = *(const u32x4*)vt_src; if (tid < 256) sr = *(const u32x4*)kr_src;
    { LAS unsigned char* bufp = C.lds; *(LAS u32x4*)(bufp + kn_dst) = sk; if (tid < 256) *(LAS u32x4*)(bufp + kr_dst) = sr;
      *(LAS u32x2*)(bufp + vt_dst) = (u32x2){sv.x, sv.y}; *(LAS u32x2*)(bufp + vt_dst + 8) = (u32x2){sv.z, sv.w}; }
    __syncthreads();
    f32x16 o[2]; o[0] = (f32x16){}; o[1] = (f32x16){}; float m = 0.f, l = 0.f;
    for (int t = 0; t < ntiles; ++t) {
        const bool more = (t + 1 < ntiles);
        if (more) { sk = *(const u32x4*)(kn_src + (size_t)(t + 1) * 64 * 512); sv = *(const u32x4*)(vt_src + (size_t)(t + 1) * 64); if (tid < 256) sr = *(const u32x4*)(kr_src + (size_t)(t + 1) * 64 * 32); }
        if (t <= my_last) { LdsLoader ld{C.lds + (t & 1) * ABUF, C.lds + (t & 1) * ABUF + KBUF, r32, hi}; attn_tile(ld, qr, o, m, l, false, t == 0); }
        if (more) { LAS unsigned char* bufp = C.lds + ((t + 1) & 1) * ABUF; *(LAS u32x4*)(bufp + kn_dst) = sk; if (tid < 256) *(LAS u32x4*)(bufp + kr_dst) = sr;
            *(LAS u32x2*)(bufp + vt_dst) = (u32x2){sv.x, sv.y}; *(LAS u32x2*)(bufp + vt_dst + 8) = (u32x2){sv.z, sv.w}; }
        __syncthreads();
    }
    const float lt = l + __shfl_xor(l, 32); const float inv = 1.0f / lt;
    bf16* orow = CAT + qrow * 1024 + hd * 64;
#pragma unroll
    for (int db = 0; db < 2; ++db)
#pragma unroll
        for (int q = 0; q < 4; ++q) { u32x2 w; w.x = pk2(o[db][4 * q] * inv, o[db][4 * q + 1] * inv); w.y = pk2(o[db][4 * q + 2] * inv, o[db][4 * q + 3] * inv);
            *(u32x2*)(orow + 32 * db + 8 * q + 4 * hi) = w; }
}
__device__ __forceinline__ void attn_sample_unit(const Args& A, const Ctx& C, int b, int hd) {
    unsigned char* ws = A.ws; const int tid = C.tid, lane = C.lane, wid = C.wave, r32 = lane & 31, hi = lane >> 5;
    const bf16* Q = (const bf16*)(ws + WS_Z); const bf16* KNS = (const bf16*)(ws + WS_KNS); const bf16* KRS = (const bf16*)(ws + WS_KRS); const bf16* VTS = (const bf16*)(ws + WS_VTS);
    bf16* CAT = (bf16*)(ws + WS_H); const float* ROPE = (const float*)(ws + WS_ROPE);
    const size_t qrow = (size_t)NP + b * 32 + r32;
    bf16x8 qr[6]; load_q(qr, Q + qrow * 768 + hd * 96, ROPE + (size_t)(PAST + r32) * 32, hi);
    f32x16 o[2]; o[0] = (f32x16){}; o[1] = (f32x16){}; float m = 0.f, l = 0.f;
    for (int t = wid; t < 33; t += 8) {
        const size_t key0 = (size_t)b * SKV + 64 * t;
        GlbLoader ld{KNS + key0 * 512 + hd * 64, KRS + key0 * 32, VTS + (size_t)(hd * 64) * NKVS + key0, r32, hi};
        attn_tile(ld, qr, o, m, l, t == 32, t == wid);
    }
    const float lt = l + __shfl_xor(l, 32);
    LAS float* cm = (LAS float*)C.lds; LAS float* cl = cm + 256; LAS float* co = cm + 512;
    if (hi == 0) { cm[wid * 32 + r32] = m; cl[wid * 32 + r32] = lt; }
#pragma unroll
    for (int db = 0; db < 2; ++db)
#pragma unroll
        for (int r = 0; r < 16; ++r) co[(wid * 64 + 32 * db + crow(r, hi)) * 32 + r32] = o[db][r];
    __syncthreads();
    { const int q = tid & 31, d0 = (tid >> 5) * 4;
      float M = cm[q];
#pragma unroll
      for (int w = 1; w < 8; ++w) M = fmaxf(M, cm[w * 32 + q]);
      float L = 0.f, acc[4] = {0.f, 0.f, 0.f, 0.f};
#pragma unroll
      for (int w = 0; w < 8; ++w) { const float f = __builtin_amdgcn_exp2f(cm[w * 32 + q] - M); L += cl[w * 32 + q] * f;
#pragma unroll
          for (int i = 0; i < 4; ++i) acc[i] += co[(w * 64 + d0 + i) * 32 + q] * f; }
      const float inv = 1.0f / L;
      u32x2 wv; wv.x = pk2(acc[0] * inv, acc[1] * inv); wv.y = pk2(acc[2] * inv, acc[3] * inv);
      *(u32x2*)(CAT + ((size_t)NP + b * 32 + q) * 1024 + hd * 64 + d0) = wv; }
    __syncthreads();
}

#define XB_TMO      128
#define XB_XCNT(j)  (256  + 64 * (j))
#define XB_XSUB(j)  (1280 + 64 * (j))
#define XB_XGEN(j)  (2304 + 64 * (j))
#define XB_TOP      3328
#define XB_TOPGEN   3392
#define XCD_BAR_WORDS 3456
#define XB_SPIN_CAP (1u << 23)

__device__ __forceinline__ unsigned xb_ld(unsigned* p)              { return __hip_atomic_load(p, __ATOMIC_RELAXED, __HIP_MEMORY_SCOPE_AGENT); }
__device__ __forceinline__ unsigned xb_add(unsigned* p, unsigned v) { return __hip_atomic_fetch_add(p, v, __ATOMIC_RELAXED, __HIP_MEMORY_SCOPE_AGENT); }
__device__ __forceinline__ unsigned xb_xcc_id() { return (unsigned)__builtin_amdgcn_s_getreg((3 << 11) | 20) & 0xFu; }
#define XB_SPIN(cond, bar) do { unsigned _sp = 0; while (cond) { __builtin_amdgcn_s_sleep(1); \
    if ((++_sp & 255u) == 0u) { if (xb_ld(&(bar)[XB_TMO])) break; if (_sp > XB_SPIN_CAP) { atomicAdd(&(bar)[XB_TMO], 1u); break; } } } } while (0)

struct XcdBarrier {
    unsigned* bar; unsigned x;
    volatile LAS unsigned* st;
};

__device__ __forceinline__ XcdBarrier xcd_barrier_post(unsigned* bar, volatile LAS unsigned* st) {
    XcdBarrier b; b.bar = bar; b.x = xb_xcc_id(); b.st = st;
    if (threadIdx.x == 0) (void)xb_add(&bar[XB_XCNT(b.x)], 1u);
    return b;
}
__device__ __forceinline__ void xcd_barrier_complete(unsigned* bar, unsigned x, unsigned& nloc, unsigned& nx) {
    const unsigned G = gridDim.x * gridDim.y * gridDim.z;
    unsigned sum, cnt, mine, sp = 0u;
    for (;;) {
        sum = 0u; cnt = 0u; mine = 0u;
#pragma unroll
        for (unsigned j = 0; j < 16; ++j) { const unsigned c = xb_ld(&bar[XB_XCNT(j)]); sum += c; cnt += (c > 0u) ? 1u : 0u; mine = (j == x) ? c : mine; }
        if (sum == G) break;
        __builtin_amdgcn_s_sleep(1);
        if ((++sp & 255u) == 0u) { if (xb_ld(&bar[XB_TMO])) break; if (sp > XB_SPIN_CAP) { atomicAdd(&bar[XB_TMO], 1u); break; } }
    }
    nloc = mine > 0u ? mine : 1u; nx = cnt > 0u ? cnt : 1u;
}

__device__ __forceinline__ void xcd_barrier(const XcdBarrier& b) {
    asm volatile("s_waitcnt vmcnt(0)" ::: "memory");
    __syncthreads();
    if (threadIdx.x == 0) {
        unsigned* bar = b.bar;
        __builtin_amdgcn_s_waitcnt(0);
        unsigned nloc = b.st[0], nx = b.st[1];
        if (nloc == 0u) { xcd_barrier_complete(bar, b.x, nloc, nx); b.st[0] = nloc; b.st[1] = nx; }
        const unsigned old = xb_add(&bar[XB_XSUB(b.x)], 1u);
        const unsigned gen = old / nloc;
        if (old + 1u == (gen + 1u) * nloc) {
            __builtin_amdgcn_fence(__ATOMIC_RELEASE, "agent");
            asm volatile("s_waitcnt vmcnt(0)" ::: "memory");
            const unsigned og = xb_add(&bar[XB_TOP], 1u);
            const unsigned tg = og / nx;
            if (og + 1u == (tg + 1u) * nx) xb_add(&bar[XB_TOPGEN], 1u);
            else XB_SPIN(xb_ld(&bar[XB_TOPGEN]) == tg, bar);
            __builtin_amdgcn_fence(__ATOMIC_ACQUIRE, "agent");
            xb_add(&bar[XB_XGEN(b.x)], 1u);
            asm volatile("s_waitcnt vmcnt(0)" ::: "memory");
        } else {
            XB_SPIN(xb_ld(&bar[XB_XGEN(b.x)]) == gen, bar);
            __builtin_amdgcn_fence(__ATOMIC_ACQUIRE, "agent");
            asm volatile("s_waitcnt vmcnt(0)" ::: "memory");
        }
    }
    __syncthreads();
}

__global__ void __launch_bounds__(512, 2) fwd_mega(Args A) {
    extern __shared__ __attribute__((aligned(16))) unsigned char lds_raw[];
    cg::grid_group grid = cg::this_grid();
    volatile LAS unsigned* bst = (volatile LAS unsigned*)((LAS unsigned char*)lds_raw + LDS_BYTES - 64);
    if (threadIdx.x < 16) bst[threadIdx.x] = 0u;
    __syncthreads();
    XcdBarrier xbar = xcd_barrier_post((unsigned*)(A.ws + WS_CTL), bst);
#ifdef PROBE_SYNC2
#define GSYNC() do { xcd_barrier(xbar); xcd_barrier(xbar); } while (0)
#else
#define GSYNC() xcd_barrier(xbar)
#endif
    Ctx C; C.lds = (LAS unsigned char*)lds_raw; C.tid = threadIdx.x; C.lane = C.tid & 63; C.wave = __builtin_amdgcn_readfirstlane(C.tid >> 6);
    C.G = gridDim.x; { const int bx = blockIdx.x; C.vcu = (C.G % 8 == 0) ? (bx % 8) * (C.G / 8) + bx / 8 : bx; }
    C.gw = blockIdx.x * 8 + C.wave; C.NGW = C.G * 8;
    unsigned char* ws = A.ws;
    float* X = A.out + O_Y;
    { float* ROPE = (float*)(ws + WS_ROPE);
      for (int e = blockIdx.x * 512 + C.tid; e < SEQ * 16; e += C.G * 512) { const int p = e >> 4, i = e & 15;
          const double base = (i & 3) == 0 ? 1.0 : (i & 3) == 1 ? 0.5623413251903491 : (i & 3) == 2 ? 0.31622776601683794 : 0.1778279410038923;
          const double sc = (i >> 2) == 0 ? 1.0 : (i >> 2) == 1 ? 0.1 : (i >> 2) == 2 ? 0.01 : 0.001;
          const float inv = (float)(base * sc); const float ang = (float)p * inv;
          const double rev = (double)ang * 0.15915494309189535; const float fr = (float)(rev - __builtin_rint(rev));
          ROPE[p * 32 + i] = __builtin_amdgcn_cosf(fr); ROPE[p * 32 + 16 + i] = __builtin_amdgcn_sinf(fr); } }
#define REFRESH() do { int t_ = threadIdx.x; asm volatile("" : "+v"(t_)); C.tid = t_; C.lane = t_ & 63; C.wave = __builtin_amdgcn_readfirstlane(t_ >> 6); C.gw = blockIdx.x * 8 + C.wave; } while (0)
#pragma unroll 1
    for (int l = 0; l < DEPTH; ++l) {
        REFRESH();
#ifdef PROBE_P1
        for (int rep = 0; rep < 2; ++rep) {
#endif
        convert_weights(C, A, l);
        for (int mrow = C.gw; mrow < NTOK; mrow += C.NGW) {
            const float* xr = (l == 0) ? (mrow < NP ? A.xp + (size_t)mrow * DM : A.xs + (size_t)(mrow - NP) * DM) : X + (size_t)mrow * DM;
            norm_row(xr, A.g_attn + l * DM, (bf16*)(ws + WS_H) + (size_t)mrow * DM, (l == 0) ? X + (size_t)mrow * DM : nullptr, C.lane); }
        for (int r = C.gw; r < DEC_B * PAST; r += C.NGW) cache_row(A, l, r, C.lane);
#ifdef PROBE_P1
        }
#endif
        if (l == 0) grid.sync(); else GSYNC();
#ifndef NO_P2
#ifdef PROBE_P2
        for (int rep = 0; rep < 2; ++rep) {
#endif
        { pg8::EpiBf16 E{(pg8::bf16_t*)(ws + WS_Z), 256, 256, (size_t)NTOK * 256};
          pg8::Gemm g{(const pg8::bf16_t*)(ws + WS_H), (const pg8::bf16_t*)(ws + WS_WIN), NTOK, 1792, DM}; pg8::StaticOrder S; S.init(NTOK, 1792, C.G, (int)blockIdx.x);
          pg8::gemm_phase<pg8::EpiBf16, pg8::StaticOrder, true, true>(C.lds, g, S, E); }
        { pg8::EpiBf16 E{(pg8::bf16_t*)(ws + WS_GVT), NTOK, 0, 0};
          pg8::Gemm g{(const pg8::bf16_t*)(ws + WS_WGV), (const pg8::bf16_t*)(ws + WS_H), 512, NTOK, DM}; pg8::StaticOrder S; S.init(512, NTOK, C.G, (int)((blockIdx.x + 146) % C.G));
          pg8::gemm_phase<pg8::EpiBf16, pg8::StaticOrder, true, true>(C.lds, g, S, E); }
#ifdef PROBE_P2
        }
#endif
        GSYNC();
#endif
        REFRESH();
#ifdef PROBE_THIN
        for (int rep = 0; rep < 2; ++rep)
#endif
        for (int mrow = C.gw; mrow < NTOK; mrow += C.NGW) p3_token(A, l, mrow, C.lane);
        GSYNC();
        for (int it = C.gw; it < NITEM_P; it += C.NGW) gla_g1<false>(A, l, it, C.lds + C.wave * 16384, C.lane);
#ifdef SAMP_OLDPLACE
        if (C.gw < 64) gla_g1<true>(A, l, NITEM_P + C.gw, C.lds + C.wave * 16384, C.lane);
#endif
        GSYNC();
#ifndef NO_P4
        if ((int)blockIdx.x < NSCAN) gla_scan(A, l, blockIdx.x, C.tid);
#ifndef SAMP_OLDPLACE
        else if ((int)blockIdx.x < NSCAN + NSAMPWG) { const int it = NITEM_P + ((int)blockIdx.x - NSCAN) * 8 + C.wave;
            gla_g1<true>(A, l, it, C.lds + C.wave * 17408, C.lane); gla_g3<true>(A, l, it, C.lds + C.wave * 17408, C.lane); }
#else
        else if ((int)blockIdx.x < NSCAN + NSAMPWG) { }
#endif
        else {
            const int G2 = C.G - NSCAN - NSAMPWG, c2 = blockIdx.x - NSCAN - NSAMPWG;
#ifdef PROBE_P4G
            for (int rep = 0; rep < 2; ++rep)
#endif
#pragma unroll 1
            for (int gi = 0; gi < 5; ++gi) {
                pg8::Gemm g; pg8::EpiBf16 E; int M_, N_;
                if (gi == 0) { g = pg8::Gemm{(const pg8::bf16_t*)(ws + WS_CQN), (const pg8::bf16_t*)(ws + WS_WUQ), NTOK, 768, 256}; E = pg8::EpiBf16{(pg8::bf16_t*)(ws + WS_Z), 768, 0, 0}; M_ = NTOK; N_ = 768; }
                else if (gi == 1) { g = pg8::Gemm{(const pg8::bf16_t*)(ws + WS_CKVN), (const pg8::bf16_t*)(ws + WS_WUK), NP, 512, 256}; E = pg8::EpiBf16{(pg8::bf16_t*)(ws + WS_KN), 512, 0, 0}; M_ = NP; N_ = 512; }
                else if (gi == 2) { g = pg8::Gemm{(const pg8::bf16_t*)(ws + WS_WUV), (const pg8::bf16_t*)(ws + WS_CKVN), 512, NP, 256}; E = pg8::EpiBf16{(pg8::bf16_t*)(ws + WS_VT), NP, 0, 0}; M_ = 512; N_ = NP; }
                else if (gi == 3) { g = pg8::Gemm{(const pg8::bf16_t*)(ws + WS_CKVS), (const pg8::bf16_t*)(ws + WS_WUK), NKVS, 512, 256}; E = pg8::EpiBf16{(pg8::bf16_t*)(ws + WS_KNS), 512, 0, 0}; M_ = NKVS; N_ = 512; }
                else { g = pg8::Gemm{(const pg8::bf16_t*)(ws + WS_WUV), (const pg8::bf16_t*)(ws + WS_CKVS), 512, NKVS, 256}; E = pg8::EpiBf16{(pg8::bf16_t*)(ws + WS_VTS), NKVS, 0, 0}; M_ = 512; N_ = NKVS; }
                pg8::StaticOrder S; S.init(M_, N_, G2, (c2 + gi * 37) % G2);
                pg8::gemm_phase<pg8::EpiBf16, pg8::StaticOrder, true, true>(C.lds, g, S, E);
            }
        }
        GSYNC();
#endif
        REFRESH();
        for (int it = C.gw; it < NITEM_P; it += C.NGW) gla_g3<false>(A, l, it, C.lds + C.wave * 17408, C.lane);
#ifdef SAMP_OLDPLACE
        if (C.gw < 64) gla_g3<true>(A, l, NITEM_P + C.gw, C.lds + C.wave * 17408, C.lane);
#endif
        __syncthreads();
#ifdef PROBE_SAMP
#pragma unroll 1
        for (int rep = 0; rep < 2; ++rep)
#endif
#ifndef NO_SAMP
        if (C.vcu >= C.G - 128 && C.vcu < C.G) { const int u = C.vcu - (C.G - 128); attn_sample_unit(A, C, u >> 3, u & 7); }
#endif
#ifndef NO_ATTN
#ifdef PROBE_ATTN2
        for (int rep = 0; rep < 2; ++rep)
#endif
        for (int u = C.vcu; u < 1024; u += C.G) {
            const int bh = (u % 256) >> 4, s = u & 15, i = u >> 8; const int qb = (i == 0) ? 63 - s : (i == 1) ? 32 + s : (i == 2) ? 31 - s : s;
            attn_prompt_unit(A, C, bh >> 3, bh & 7, qb); }
#endif
        GSYNC();
#ifndef NO_P6
        { pg8::EpiRes E{X, DM};
          pg8::Gemm g{(const pg8::bf16_t*)(ws + WS_H), (const pg8::bf16_t*)(ws + WS_WO), NTOK, DM, DM}; pg8::StaticOrder S; S.init(NTOK, DM, C.G, (int)blockIdx.x);
          pg8::gemm_phase<pg8::EpiRes, pg8::StaticOrder, true, true>(C.lds, g, S, E); }
        GSYNC();
#endif
        REFRESH();
#ifdef PROBE_THIN
        for (int rep = 0; rep < 2; ++rep)
#endif
        for (int mrow = C.gw; mrow < NTOK; mrow += C.NGW) norm_row(X + (size_t)mrow * DM, A.g_ffn + l * DM, (bf16*)(ws + WS_H) + (size_t)mrow * DM, nullptr, C.lane);
        GSYNC();
#ifndef NO_P8
#ifdef PROBE_P8
        for (int rep = 0; rep < 2; ++rep)
#endif
        { pg8::EpiSwiglu E{(pg8::bf16_t*)(ws + WS_ACT), DFF};
          pg8::Gemm g{(const pg8::bf16_t*)(ws + WS_H), (const pg8::bf16_t*)(ws + WS_WGU), NTOK, 2 * DFF, DM}; pg8::StaticOrder S; S.init(NTOK, 2 * DFF, C.G, (int)blockIdx.x);
          pg8::gemm_phase<pg8::EpiSwiglu, pg8::StaticOrder, true, true>(C.lds, g, S, E); }
        GSYNC();
#endif
#ifndef NO_P9
        { pg8::EpiRes E{X, DM};
          pg8::Gemm g{(const pg8::bf16_t*)(ws + WS_ACT), (const pg8::bf16_t*)(ws + WS_WD), NTOK, DM, DFF}; pg8::StaticOrder S; S.init(NTOK, DM, C.G, (int)blockIdx.x);
          pg8::gemm_phase<pg8::EpiRes, pg8::StaticOrder, true, true>(C.lds, g, S, E); }
        GSYNC();
#endif
    }
    REFRESH();
    for (int mrow = C.gw; mrow < NTOK; mrow += C.NGW) final_norm_row(X + (size_t)mrow * DM, A.g_final, C.lane);
}

extern "C" void kernel_launch(void* const* d_in, const int* in_sizes, int n_in, void* d_out, int out_size, void* d_ws, size_t ws_size, hipStream_t stream) {
    static int grid = 0;
    if (grid == 0) {
        if (n_in != 19 || (size_t)out_size != O_END || ws_size < WS_END) { fprintf(stderr, "kernel_launch: unexpected shapes: n_in %d out %d ws %zu (need %zu)\n", n_in, out_size, ws_size, (size_t)WS_END); grid = -1; return; }
        int dev = 0, cus = 0, per_cu = 0;
        hipGetDevice(&dev); hipDeviceGetAttribute(&cus, hipDeviceAttributeMultiprocessorCount, dev);
        if (hipFuncSetAttribute((const void*)fwd_mega, hipFuncAttributeMaxDynamicSharedMemorySize, LDS_BYTES) != hipSuccess) { fprintf(stderr, "kernel_launch: hipFuncSetAttribute failed\n"); grid = -1; return; }
        if (hipOccupancyMaxActiveBlocksPerMultiprocessor(&per_cu, (const void*)fwd_mega, 512, LDS_BYTES) != hipSuccess || per_cu < 1) { fprintf(stderr, "kernel_launch: occupancy query says %d\n", per_cu); per_cu = 1; }
        (void)hipGetLastError();
        grid = cus;
    }
    if (grid < 0) return;
    Args a{};
    a.xp = (const float*)d_in[0]; a.xs = (const float*)d_in[1]; a.cckv = (const float*)d_in[2]; a.ckr = (const float*)d_in[3]; a.sgla = (const float*)d_in[4];
    a.g_attn = (const float*)d_in[5]; a.w_in = (const float*)d_in[6]; a.g_qn = (const float*)d_in[7]; a.w_uq = (const float*)d_in[8]; a.g_kvn = (const float*)d_in[9];
    a.w_ukv = (const float*)d_in[10]; a.w_a2 = (const float*)d_in[11]; a.b_a2 = (const float*)d_in[12]; a.g_on = (const float*)d_in[13]; a.w_o = (const float*)d_in[14];
    a.g_ffn = (const float*)d_in[15]; a.w_gu = (const float*)d_in[16]; a.w_down = (const float*)d_in[17]; a.g_final = (const float*)d_in[18];
    a.out = (float*)d_out; a.ws = (unsigned char*)d_ws;
    if (hipMemsetAsync((char*)d_ws + WS_CTL, 0, CTL_BYTES, stream) != hipSuccess) { fprintf(stderr, "kernel_launch: memset failed\n"); return; }
    void* args[] = {&a};
    hipError_t e = hipLaunchCooperativeKernel((const void*)fwd_mega, dim3(grid), dim3(512), args, LDS_BYTES, stream);
    if (e != hipSuccess) fprintf(stderr, "kernel_launch: cooperative launch failed: %s (grid %d)\n", hipGetErrorString(e), grid);
}
```

```cpp
#include <hip/hip_runtime.h>
#include <hip/hip_cooperative_groups.h>
#include <cstdio>
#include <cstdint>
namespace cg = cooperative_groups;
namespace pg8 {
#define PG8_LAS __attribute__((address_space(3)))
typedef unsigned short bf16_t;
typedef short bf16x8 __attribute__((ext_vector_type(8)));
typedef float f32x4 __attribute__((ext_vector_type(4)));
typedef unsigned u32x4 __attribute__((ext_vector_type(4)));
constexpr int BM = 256, BK = 64, HALF = 128, HTB = HALF * BK * 2  , STAGE_BYTES = 8 * HTB, NXCD = 8, WGM = 8;

__host__ __device__ __forceinline__ int lds_byte(int r, int c) { const int st = (r >> 4) * 2 + (c >> 5), rr = r & 15, cc = c & 31, ob = rr * 64 + cc * 2; return st * 1024 + (ob ^ (((ob >> 9) & 1) << 5)); }
__host__ __device__ __forceinline__ void stage_rc(int b, int& R, int& C) { const int st = b / 1024, sb = b % 1024, swz = sb ^ (((sb >> 9) & 1) << 5); R = (st >> 1) * 16 + swz / 64; C = (st & 1) * 32 + (swz % 64) / 2; }
__host__ __device__ __forceinline__ int perm32(int rho) { const int n = rho >> 4, i = rho & 15; return 8 * (i >> 2) + 4 * n + (i & 3); }

struct Unit { int pm, pn; };
struct Gemm { const bf16_t* A; const bf16_t* Bt; int M, N, K; };

struct StaticOrder {
    int nM, nN, nwg, G, c;
    __host__ __device__ void init(int M, int N, int G_, int c_) { nM = M / BM; nN = N / BM; nwg = nM * nN; G = G_; c = c_; }
    __host__ __device__ bool next(int i, Unit& u) const {
        const long L = (long)i * G + c; if (L >= nwg) return false;
        int wgid = (int)L; { const int q = nwg / NXCD, r = nwg % NXCD, xcd = wgid % NXCD, off = wgid / NXCD; wgid = (xcd < r ? xcd * (q + 1) : r * (q + 1) + (xcd - r) * q) + off; }
        const int nig = WGM * nN, gid = wgid / nig, fm = gid * WGM, gsz = (nM - fm) < WGM ? (nM - fm) : WGM;
        u.pm = fm + ((wgid % nig) % gsz); u.pn = (wgid % nig) / gsz; return true;
    }
    __device__ __forceinline__ void a_ready(const Unit&) const {}
    __device__ __forceinline__ void done(const Unit&) const {}
};

__device__ __forceinline__ unsigned cvt_pk_bf16(float lo, float hi) { unsigned r; asm volatile("v_cvt_pk_bf16_f32 %0, %1, %2" : "=v"(r) : "v"(lo), "v"(hi)); return r; }
typedef float f32x2 __attribute__((ext_vector_type(2)));
typedef float f32x2m_t __attribute__((ext_vector_type(2))); typedef __bf16 bf16x2m_t __attribute__((ext_vector_type(2)));
__device__ __forceinline__ unsigned cvt_pk_m(float lo, float hi) { f32x2m_t v = {lo, hi}; bf16x2m_t b = __builtin_convertvector(v, bf16x2m_t); return __builtin_bit_cast(unsigned, b); }
struct EpiBf16 {
    static constexpr bool PERM = true, AFTER_DRAIN = false;
    bf16_t* O; int ldc; int split_cols; size_t split_stride;
    __device__ __forceinline__ void operator()(const f32x4 (&acc)[2][2][4][2], const Unit& u, int wr, int wc, int fr, int fq) const {
        const int row0 = u.pm * BM + wr * 64 + fr; int colt = u.pn * BM; bf16_t* base = O;
        if (split_cols) { const int t = colt / split_cols; base += (size_t)t * split_stride; colt -= t * split_cols; }
        const int col0 = colt + wc * 32 + 8 * fq;
#pragma unroll
        for (int ai = 0; ai < 2; ++ai)
#pragma unroll
            for (int m = 0; m < 4; ++m) { bf16_t* rowp = base + (size_t)(row0 + ai * HALF + m * 16) * ldc + col0;
#pragma unroll
                for (int bj = 0; bj < 2; ++bj) { const f32x4 v0 = acc[ai][bj][m][0], v1 = acc[ai][bj][m][1];
                    u32x4 w; w.x = cvt_pk_m(v0[0], v0[1]); w.y = cvt_pk_m(v0[2], v0[3]); w.z = cvt_pk_m(v1[0], v1[1]); w.w = cvt_pk_m(v1[2], v1[3]);
                    *(u32x4*)(rowp + bj * HALF) = w; } }
    }
};
struct EpiSwiglu {
    static constexpr bool PERM = true, AFTER_DRAIN = false;
    bf16_t* O; int ldc;
    __device__ __forceinline__ void operator()(const f32x4 (&acc)[2][2][4][2], const Unit& u, int wr, int wc, int fr, int fq) const {
        const int row0 = u.pm * BM + wr * 64 + fr; const int col0 = u.pn * HALF + wc * 32 + 8 * fq;
#pragma unroll
        for (int ai = 0; ai < 2; ++ai)
#pragma unroll
            for (int m = 0; m < 4; ++m) { bf16_t* rowp = O + (size_t)(row0 + ai * HALF + m * 16) * ldc + col0;
                float r[8];
#pragma unroll
                for (int n = 0; n < 2; ++n)
#pragma unroll
                    for (int i = 0; i < 4; ++i) { const float a = acc[ai][0][m][n][i], uu = acc[ai][1][m][n][i];
                        r[n * 4 + i] = a * __builtin_amdgcn_rcpf(1.0f + __expf(-a)) * uu; }
                u32x4 w; w.x = cvt_pk_m(r[0], r[1]); w.y = cvt_pk_m(r[2], r[3]); w.z = cvt_pk_m(r[4], r[5]); w.w = cvt_pk_m(r[6], r[7]);
                *(u32x4*)rowp = w; }
    }
};
struct EpiRes {
    static constexpr bool PERM = false, AFTER_DRAIN = false;
    float* X; int ldc;
    __device__ __forceinline__ void operator()(const f32x4 (&acc)[2][2][4][2], const Unit& u, int wr, int wc, int fr, int fq) const {
        const int col0 = u.pn * BM + wc * 32 + 4 * fq;
#pragma unroll
        for (int ai = 0; ai < 2; ++ai)
#pragma unroll
            for (int m = 0; m < 4; ++m) { float* rowp = X + (size_t)(u.pm * BM + ai * HALF + wr * 64 + m * 16 + fr) * ldc + col0;
#pragma unroll
                for (int bj = 0; bj < 2; ++bj)
#pragma unroll
                    for (int n = 0; n < 2; ++n) { f32x4* p = (f32x4*)(rowp + bj * HALF + n * 16); *p = *p + acc[ai][bj][m][n]; }
                asm volatile("" ::: "memory"); }
    }
};
struct EpiNone {
    static constexpr bool PERM = false, AFTER_DRAIN = false;
    float* sink;
    __device__ __forceinline__ void operator()(const f32x4 (&acc)[2][2][4][2], const Unit& u, int wr, int wc, int fr, int fq) const {
        float t = 0.f;
#pragma unroll
        for (int ai = 0; ai < 2; ++ai)
#pragma unroll
            for (int bj = 0; bj < 2; ++bj)
#pragma unroll
                for (int m = 0; m < 4; ++m)
#pragma unroll
                    for (int n = 0; n < 2; ++n) t += acc[ai][bj][m][n][0] + acc[ai][bj][m][n][1] + acc[ai][bj][m][n][2] + acc[ai][bj][m][n][3];
        if (t == 123456.789f) sink[0] = t;
    }
};
template <class Epi, class Sched, bool ALIGN_EPI = false, bool SP2 = false>
__device__ __forceinline__ void gemm_phase(PG8_LAS unsigned char* lds, const Gemm g, const Sched& S, const Epi& E) {
    int tid_ = threadIdx.x; asm volatile("" : "+v"(tid_));
    const int tid = tid_, wid = __builtin_amdgcn_readfirstlane(tid >> 6), lane = tid & 63, wr = wid >> 2, wc = wid & 3, fr = lane & 15, fq = lane >> 4;
    const int K = g.K, nt = K / BK;
    unsigned voffA[2], voffB[2];
#pragma unroll
    for (int i = 0; i < 2; ++i) { int R, C; stage_rc(tid * 16 + i * 8192, R, C); const int Rb = Epi::PERM ? ((R & ~31) + perm32(R & 31)) : R;
        voffA[i] = (unsigned)(R * K + C) * 2u; voffB[i] = (unsigned)(Rb * K + C) * 2u; }
    const size_t kstep = (size_t)(BK * 2);
    const size_t hstep = (size_t)HALF * K * 2;
    const size_t tstep = 2 * hstep;
    const unsigned ldsw = (unsigned)wid * 1024u;
    const int aoff = lds_byte(wr * 64 + fr, fq * 8), boff = lds_byte(wc * 32 + fr, fq * 8);
#define PG8_SA(b, h) (((b) * 2 + (h)) * HTB)
#define PG8_SB(b, h) ((4 + (b) * 2 + (h)) * HTB)
#define PG8_STAGE(bufoff, gbase, voff) do { _Pragma("unroll") for (int _i = 0; _i < 2; ++_i) \
        __builtin_amdgcn_global_load_lds((const unsigned*)((const char*)(gbase) + (voff)[_i]), (PG8_LAS unsigned*)(lds + (bufoff) + ldsw + _i * 8192), 16, 0, 0); } while (0)
#define PG8_LDA(dst, b, h) do { _Pragma("unroll") for (int m = 0; m < 4; ++m) _Pragma("unroll") for (int k = 0; k < 2; ++k) dst[m][k] = *(const PG8_LAS bf16x8*)(lds + PG8_SA(b, h) + aoff + m * 2048 + k * 1024); } while (0)
#define PG8_LDB(dst, b, h) do { _Pragma("unroll") for (int n = 0; n < 2; ++n) _Pragma("unroll") for (int k = 0; k < 2; ++k) dst[n][k] = *(const PG8_LAS bf16x8*)(lds + PG8_SB(b, h) + boff + n * 2048 + k * 1024); } while (0)
#define PG8_MMA(ai, bj, At, Bt) do { __builtin_amdgcn_s_setprio(1); _Pragma("unroll") for (int m = 0; m < 4; ++m) _Pragma("unroll") for (int n = 0; n < 2; ++n) _Pragma("unroll") for (int k = 0; k < 2; ++k) \
        acc[ai][bj][m][n] = __builtin_amdgcn_mfma_f32_16x16x32_bf16(Bt[n][k], At[m][k], acc[ai][bj][m][n], 0, 0, 0); __builtin_amdgcn_s_setprio(0); } while (0)
#define PG8_WAIT_V(n) asm volatile("s_waitcnt vmcnt(" #n ")" ::: "memory")
#define PG8_WAIT_L(n) asm volatile("s_waitcnt lgkmcnt(" #n ")" ::: "memory")
#define PG8_BAR __builtin_amdgcn_s_barrier()
#define PG8_SCHED __builtin_amdgcn_sched_barrier(0)
    Unit cur, nxt; int ui = 0;
    if (!S.next(0, cur)) return;
    f32x4 acc[2][2][4][2];
#pragma unroll
    for (int a = 0; a < 2; ++a)
#pragma unroll
        for (int b = 0; b < 2; ++b)
#pragma unroll
            for (int m = 0; m < 4; ++m)
#pragma unroll
                for (int n = 0; n < 2; ++n) acc[a][b][m][n] = (f32x4){0.f, 0.f, 0.f, 0.f};
    bf16x8 At[4][2], B0[2][2], B1[2][2];
    const char* cA = (const char*)g.A + (size_t)cur.pm * tstep; const char* cB = (const char*)g.Bt + (size_t)cur.pn * tstep;
    S.a_ready(cur);
    if constexpr (SP2) {
        PG8_STAGE(PG8_SB(0, 0), cB, voffB); PG8_STAGE(PG8_SB(0, 1), cB + hstep, voffB); PG8_STAGE(PG8_SA(0, 0), cA, voffA); PG8_STAGE(PG8_SA(0, 1), cA + hstep, voffA);
        if (wr == 1) PG8_BAR;
        PG8_WAIT_V(2); PG8_BAR;
        PG8_STAGE(PG8_SB(1, 0), cB + kstep, voffB); PG8_STAGE(PG8_SA(1, 0), cA + kstep, voffA); PG8_STAGE(PG8_SB(1, 1), cB + hstep + kstep, voffB);
        PG8_WAIT_V(6); PG8_BAR;
    } else {
        PG8_STAGE(PG8_SB(0, 0), cB, voffB); PG8_STAGE(PG8_SA(0, 0), cA, voffA); PG8_STAGE(PG8_SB(0, 1), cB + hstep, voffB); PG8_STAGE(PG8_SA(0, 1), cA + hstep, voffA);
        if (wr == 1) PG8_BAR;
        PG8_WAIT_V(4); PG8_BAR;
        PG8_STAGE(PG8_SB(1, 0), cB + kstep, voffB); PG8_STAGE(PG8_SA(1, 0), cA + kstep, voffA); PG8_STAGE(PG8_SB(1, 1), cB + hstep + kstep, voffB);
        PG8_WAIT_V(6); PG8_BAR;
    }
    for (;;) {
        const bool has_next = S.next(ui + 1, nxt);
        const char* nA = has_next ? (const char*)g.A + (size_t)nxt.pm * tstep : cA; const char* nB = has_next ? (const char*)g.Bt + (size_t)nxt.pn * tstep : cB;
        for (int t = 0; t < nt; t += 2) {
            const bool last = (t == nt - 2);
            const char* a1 = cA + (size_t)(t + 1) * kstep;
            const char* a2 = last ? nA : cA + (size_t)(t + 2) * kstep; const char* b2 = last ? nB : cB + (size_t)(t + 2) * kstep;
            const char* a3 = a2 + kstep; const char* b3 = b2 + kstep;
            if (last && has_next) S.a_ready(nxt);
            if constexpr (SP2) {
            PG8_LDB(B0, 0, 0); PG8_LDB(B1, 0, 1); PG8_SCHED; PG8_LDA(At, 0, 0); PG8_STAGE(PG8_SA(1, 1), a1 + hstep, voffA);
            PG8_WAIT_V(8); PG8_WAIT_L(0); PG8_BAR; PG8_MMA(0, 0, At, B0); PG8_MMA(0, 1, At, B1); PG8_BAR; PG8_SCHED;
            PG8_LDA(At, 0, 1); PG8_STAGE(PG8_SB(0, 0), b2, voffB); PG8_STAGE(PG8_SB(0, 1), b2 + hstep, voffB); PG8_STAGE(PG8_SA(0, 0), a2, voffA);
            PG8_WAIT_V(8); PG8_WAIT_L(0); PG8_BAR; PG8_MMA(1, 0, At, B0); PG8_MMA(1, 1, At, B1); PG8_BAR; PG8_SCHED;
            PG8_LDB(B0, 1, 0); PG8_LDB(B1, 1, 1); PG8_SCHED; PG8_LDA(At, 1, 0); PG8_STAGE(PG8_SA(0, 1), a2 + hstep, voffA);
            PG8_WAIT_V(8); PG8_WAIT_L(0); PG8_BAR; PG8_MMA(0, 0, At, B0); PG8_MMA(0, 1, At, B1); PG8_BAR; PG8_SCHED;
            PG8_LDA(At, 1, 1); PG8_STAGE(PG8_SB(1, 0), b3, voffB); PG8_STAGE(PG8_SB(1, 1), b3 + hstep, voffB); PG8_STAGE(PG8_SA(1, 0), a3, voffA);
            PG8_WAIT_V(8); PG8_WAIT_L(0); PG8_BAR; PG8_MMA(1, 0, At, B0); PG8_MMA(1, 1, At, B1); PG8_BAR; PG8_SCHED;
            } else {
            PG8_LDB(B0, 0, 0); PG8_SCHED; PG8_LDA(At, 0, 0); PG8_STAGE(PG8_SA(1, 1), a1 + hstep, voffA);
            PG8_WAIT_L(8); PG8_BAR; PG8_WAIT_L(0); PG8_MMA(0, 0, At, B0); PG8_BAR; PG8_SCHED;
            PG8_LDB(B1, 0, 1); PG8_STAGE(PG8_SB(0, 0), b2, voffB);
            PG8_BAR; PG8_WAIT_L(0); PG8_MMA(0, 1, At, B1); PG8_BAR;
            PG8_LDA(At, 0, 1); PG8_STAGE(PG8_SA(0, 0), a2, voffA);
            PG8_BAR; PG8_WAIT_L(0); PG8_MMA(1, 0, At, B0); PG8_BAR; PG8_SCHED;
            PG8_STAGE(PG8_SB(0, 1), b2 + hstep, voffB);
            PG8_WAIT_V(6); PG8_BAR; PG8_MMA(1, 1, At, B1); PG8_BAR;
            PG8_LDB(B0, 1, 0); PG8_SCHED; PG8_LDA(At, 1, 0); PG8_STAGE(PG8_SA(0, 1), a2 + hstep, voffA);
            PG8_WAIT_L(8); PG8_BAR; PG8_WAIT_L(0); PG8_MMA(0, 0, At, B0); PG8_BAR; PG8_SCHED;
            PG8_LDB(B1, 1, 1); PG8_STAGE(PG8_SB(1, 0), b3, voffB);
            PG8_BAR; PG8_WAIT_L(0); PG8_MMA(0, 1, At, B1); PG8_BAR;
            PG8_LDA(At, 1, 1); PG8_STAGE(PG8_SA(1, 0), a3, voffA);
            PG8_BAR; PG8_WAIT_L(0); PG8_MMA(1, 0, At, B0); PG8_BAR; PG8_SCHED;
            PG8_STAGE(PG8_SB(1, 1), b3 + hstep, voffB);
            PG8_WAIT_V(6); PG8_BAR; PG8_MMA(1, 1, At, B1); PG8_BAR;
            }
        }
        if constexpr (ALIGN_EPI) { if (wr == 0) PG8_BAR; }
        if constexpr (!Epi::AFTER_DRAIN) { E(acc, cur, wr, wc, fr, fq); S.done(cur); }
        if (!has_next) break;
#pragma unroll
        for (int a = 0; a < 2; ++a)
#pragma unroll
            for (int b = 0; b < 2; ++b)
#pragma unroll
                for (int m = 0; m < 4; ++m)
#pragma unroll
                    for (int n = 0; n < 2; ++n) acc[a][b][m][n] = (f32x4){0.f, 0.f, 0.f, 0.f};
        cur = nxt; cA = nA; cB = nB; ++ui;
        if constexpr (ALIGN_EPI) { if (wr == 1) PG8_BAR; }
    }
    PG8_WAIT_V(0);
    if constexpr (!ALIGN_EPI) { if (wr == 0) PG8_BAR; }
    PG8_BAR;
    if constexpr (Epi::AFTER_DRAIN) { E.fused(acc, cur, wr, wc, fr, fq, lds, wid, lane); S.done(cur); }
#undef PG8_SA
#undef PG8_SB
#undef PG8_STAGE
#undef PG8_LDA
#undef PG8_LDB
#undef PG8_MMA
#undef PG8_WAIT_V
#undef PG8_WAIT_L
#undef PG8_BAR
#undef PG8_SCHED
}
}
constexpr int DM = 1024, SEQ = 16384, NBATCH = 2, NP = NBATCH * SEQ, DEC_B = 16, DEC_T = 32, PAST = 2048, SKV = PAST + DEC_T;
constexpr int NSQ = DEC_B * DEC_T, NTOK = NP + NSQ, NKVS = DEC_B * SKV;
constexpr int DFF = 2816, INW = 2096, DEPTH = 2;
constexpr float EPS = 1e-6f;
constexpr float QSCALE = 0.10206207261596575f * 1.4426950408889634f;
constexpr int NITEM_P = NBATCH * 256 * 4, NITEM = NITEM_P + DEC_B * 4;

typedef unsigned short bf16;
typedef short bf16x8 __attribute__((ext_vector_type(8)));
typedef float f32x4 __attribute__((ext_vector_type(4)));
typedef float f32x16 __attribute__((ext_vector_type(16)));
typedef unsigned u32x4 __attribute__((ext_vector_type(4)));
typedef unsigned u32x2 __attribute__((ext_vector_type(2)));
#define LAS __attribute__((address_space(3)))

constexpr size_t T256 = (size_t)NTOK * 256 * 2;
constexpr size_t al(size_t x) { return (x + 4095) & ~(size_t)4095; }
constexpr size_t WS_CTL = 0, CTL_BYTES = 65536;
constexpr size_t WS_ROPE = 65536;
constexpr size_t WS_GA = al(WS_ROPE + (size_t)SEQ * 32 * 4);
constexpr size_t WS_DECAY = al(WS_GA + (size_t)NTOK * 16 * 4);
constexpr size_t WS_WIN = al(WS_DECAY + (size_t)NITEM * 64 * 4);
constexpr size_t WS_WGV = al(WS_WIN + (size_t)1792 * 1024 * 2);
constexpr size_t WS_WUQ = al(WS_WGV + (size_t)512 * 1024 * 2);
constexpr size_t WS_WUK = al(WS_WUQ + (size_t)768 * 256 * 2);
constexpr size_t WS_WUV = al(WS_WUK + (size_t)512 * 256 * 2);
constexpr size_t WS_WO = al(WS_WUV + (size_t)512 * 256 * 2);
constexpr size_t WS_WGU = al(WS_WO + (size_t)1024 * 1024 * 2);
constexpr size_t WS_WD = al(WS_WGU + (size_t)5632 * 1024 * 2);
constexpr size_t WS_H = al(WS_WD + (size_t)1024 * 2816 * 2);
constexpr size_t WS_Z = al(WS_H + (size_t)NTOK * 1024 * 2);
constexpr size_t WS_GVT = al(WS_Z + 7 * T256);
constexpr size_t WS_CQN = al(WS_GVT + (size_t)512 * NTOK * 2);
constexpr size_t WS_CKVN = al(WS_CQN + T256);
constexpr size_t WS_CKVS = al(WS_CKVN + (size_t)NP * 256 * 2);
constexpr size_t WS_KR = al(WS_CKVS + (size_t)NKVS * 256 * 2);
constexpr size_t WS_KRS = al(WS_KR + (size_t)NP * 32 * 2);
constexpr size_t WS_KN = al(WS_KRS + (size_t)NKVS * 32 * 2);
constexpr size_t WS_VT = al(WS_KN + (size_t)NP * 512 * 2);
constexpr size_t WS_KNS = al(WS_VT + (size_t)512 * NP * 2);
constexpr size_t WS_VTS = al(WS_KNS + (size_t)NKVS * 512 * 2);
constexpr size_t WS_DS = al(WS_VTS + (size_t)512 * NKVS * 2);
constexpr size_t WS_END = al(WS_DS + (size_t)NITEM_P * 8192 * 4);
constexpr size_t WS_ACT = WS_Z;
static_assert(WS_ACT + (size_t)NTOK * DFF * 2 <= WS_END, "ACT overlay");
static_assert(WS_END <= (size_t)536870912, "ws budget");

constexpr size_t O_Y = 0, O_CKVP = (size_t)NTOK * DM, O_KRP = O_CKVP + (size_t)DEPTH * NP * 256, O_GLAP = O_KRP + (size_t)DEPTH * NP * 32,
                 O_CKVS = O_GLAP + (size_t)DEPTH * NBATCH * 4 * 8192, O_KRS = O_CKVS + (size_t)DEPTH * NSQ * 256, O_GLAS = O_KRS + (size_t)DEPTH * NSQ * 32,
                 O_END = O_GLAS + (size_t)DEPTH * DEC_B * 4 * 8192;

constexpr int LDS_BYTES = 147456;

struct Args {
    const float *xp, *xs, *cckv, *ckr, *sgla, *g_attn, *w_in, *g_qn, *w_uq, *g_kvn, *w_ukv, *w_a2, *b_a2, *g_on, *w_o, *g_ffn, *w_gu, *w_down, *g_final;
    float* out; unsigned char* ws;
};

__device__ __forceinline__ unsigned f2bf(float f) { unsigned u = __builtin_bit_cast(unsigned, f); return (u + 0x7fffu + ((u >> 16) & 1u)) >> 16; }
__device__ __forceinline__ unsigned pk2(float lo, float hi) { return f2bf(lo) | (f2bf(hi) << 16); }
__device__ __forceinline__ float bf2f(unsigned short b) { return __builtin_bit_cast(float, (unsigned)b << 16); }
__device__ __forceinline__ float bflo(unsigned w) { return __builtin_bit_cast(float, w << 16); }
__device__ __forceinline__ float bfhi(unsigned w) { return __builtin_bit_cast(float, w & 0xffff0000u); }
__device__ __forceinline__ float wave_sum(float v) {
#pragma unroll
    for (int o = 1; o < 64; o <<= 1) v += __shfl_xor(v, o);
    return v;
}
__device__ __forceinline__ int crow(int r, int hi) { return (r & 3) + 8 * (r >> 2) + 4 * hi; }
__device__ __forceinline__ float logsig(float x) { return fminf(x, 0.f) - __logf(1.0f + __expf(-fabsf(x))); }
#define LDS_WAIT() asm volatile("s_waitcnt lgkmcnt(0)" ::: "memory")
#define MFMA32(a, b, c) __builtin_amdgcn_mfma_f32_32x32x16_bf16((a), (b), (c), 0, 0, 0)
__device__ __forceinline__ f32x16 zero16() { float z = 0.f; asm volatile("" : "+v"(z)); f32x16 v;
#pragma unroll
    for (int r = 0; r < 16; ++r) v[r] = z;
    return v; }

struct Ctx {
    int tid, lane, wave, G, vcu, gw, NGW;
    LAS unsigned char* lds;
};

__device__ __forceinline__ void tr_item(const float* W, int K, int N, int k0, int src0, int nvalid, bf16* WT, int dst_row0, float scale, LAS float* scr, int lane) {
#pragma unroll 8
    for (int i = 0; i < 32; ++i) { const int kk = 2 * i + (lane >> 5), c = lane & 31;
        float v = 0.f; if (c < nvalid) v = W[(size_t)(k0 + kk) * N + src0 + c] * scale;
        scr[kk * 33 + c] = v; }
    LDS_WAIT(); asm volatile("" ::: "memory");
    const int c8 = lane & 7;
#pragma unroll
    for (int j = 0; j < 4; ++j) { const int n = (lane >> 3) + 8 * j; const LAS float* s = scr + (8 * c8) * 33 + n;
        u32x4 o; o.x = pk2(s[0 * 33], s[1 * 33]); o.y = pk2(s[2 * 33], s[3 * 33]); o.z = pk2(s[4 * 33], s[5 * 33]); o.w = pk2(s[6 * 33], s[7 * 33]);
        *(u32x4*)(WT + (size_t)(dst_row0 + n) * K + k0 + 8 * c8) = o; }
    LDS_WAIT(); asm volatile("" ::: "memory");
}
__device__ __forceinline__ void convert_weights(const Ctx& C, const Args& A, int l) {
    LAS float* scr = (LAS float*)(C.lds + C.wave * 16384);
    unsigned char* ws = A.ws;
    const float* w_in = A.w_in + (size_t)l * DM * INW; const float* w_uq = A.w_uq + (size_t)l * 256 * 768; const float* w_ukv = A.w_ukv + (size_t)l * 256 * 1024;
    const float* w_o = A.w_o + (size_t)l * DM * DM; const float* w_gu = A.w_gu + (size_t)l * DM * 2 * DFF; const float* w_d = A.w_down + (size_t)l * DFF * DM;
    constexpr int I0 = 56 * 16, I1 = 16 * 16, I2 = 24 * 4, I3 = 16 * 4, I4 = 16 * 4, I5 = 32 * 16, I6 = 176 * 16, I7 = 32 * 44;
    constexpr int NIT = I0 + I1 + I2 + I3 + I4 + I5 + I6 + I7;
    for (int it = C.gw; it < NIT; it += C.NGW) {
        int r = it;
        if (r < I0) { const int db = r >> 4, kb = r & 15; int src = 0, nv = 32;
            if (db < 16) src = 32 * db; else if (db == 16) src = 512; else if (db == 17) { src = 2080; nv = 16; } else if (db < 24) { src = 0; nv = 0; }
            else if (db < 32) src = 544 + 32 * (db - 24); else if (db < 40) src = 800 + 32 * (db - 32); else src = 1568 + 32 * (db - 40);
            tr_item(w_in, DM, INW, 64 * kb, src, nv, (bf16*)(ws + WS_WIN), 32 * db, 1.f, scr, C.lane); continue; } r -= I0;
        if (r < I1) { const int db = r >> 4, kb = r & 15; tr_item(w_in, DM, INW, 64 * kb, 1056 + 32 * db, 32, (bf16*)(ws + WS_WGV), 32 * db, 1.f, scr, C.lane); continue; } r -= I1;
        if (r < I2) { const int db = r >> 2, kb = r & 3; tr_item(w_uq, 256, 768, 64 * kb, 32 * db, 32, (bf16*)(ws + WS_WUQ), 32 * db, QSCALE, scr, C.lane); continue; } r -= I2;
        if (r < I3) { const int db = r >> 2, kb = r & 3; tr_item(w_ukv, 256, 1024, 64 * kb, (db >> 1) * 128 + (db & 1) * 32, 32, (bf16*)(ws + WS_WUK), 32 * db, 1.f, scr, C.lane); continue; } r -= I3;
        if (r < I4) { const int db = r >> 2, kb = r & 3; tr_item(w_ukv, 256, 1024, 64 * kb, (db >> 1) * 128 + 64 + (db & 1) * 32, 32, (bf16*)(ws + WS_WUV), 32 * db, 1.f, scr, C.lane); continue; } r -= I4;
        if (r < I5) { const int db = r >> 4, kb = r & 15; tr_item(w_o, DM, DM, 64 * kb, 32 * db, 32, (bf16*)(ws + WS_WO), 32 * db, 1.f, scr, C.lane); continue; } r -= I5;
        if (r < I6) { const int db = r >> 4, kb = r & 15; const int pn = db >> 3, t = db & 7; const int src = (t < 4) ? 128 * pn + 32 * t : DFF + 128 * pn + 32 * (t - 4);
            tr_item(w_gu, DM, 2 * DFF, 64 * kb, src, 32, (bf16*)(ws + WS_WGU), 32 * db, 1.f, scr, C.lane); continue; } r -= I6;
        { const int db = r / 44, kb = r % 44; tr_item(w_d, DFF, DM, 64 * kb, 32 * db, 32, (bf16*)(ws + WS_WD), 32 * db, 1.f, scr, C.lane); }
    }
}

__device__ __forceinline__ void norm_row(const float* xrow, const float* g, bf16* orow, float* copy, int lane) {
    const f32x4* xr = (const f32x4*)xrow + lane; const f32x4* gr = (const f32x4*)g + lane;
    f32x4 v[4]; float s = 0.f;
#pragma unroll
    for (int j = 0; j < 4; ++j) { v[j] = xr[64 * j]; s += (v[j].x * v[j].x + v[j].y * v[j].y) + (v[j].z * v[j].z + v[j].w * v[j].w); }
    const float rstd = 1.0f / sqrtf(wave_sum(s) * (1.f / DM) + EPS);
    if (copy) {
#pragma unroll
        for (int j = 0; j < 4; ++j) ((f32x4*)copy + lane)[64 * j] = v[j]; }
    u32x2* o8 = (u32x2*)orow + lane;
#pragma unroll
    for (int j = 0; j < 4; ++j) { const f32x4 gg = gr[64 * j]; u32x2 w; w.x = pk2(v[j].x * rstd * gg.x, v[j].y * rstd * gg.y); w.y = pk2(v[j].z * rstd * gg.z, v[j].w * rstd * gg.w); o8[64 * j] = w; }
}
__device__ __forceinline__ void final_norm_row(float* xrow, const float* g, int lane) {
    f32x4* xr = (f32x4*)xrow + lane; const f32x4* gr = (const f32x4*)g + lane;
    f32x4 v[4]; float s = 0.f;
#pragma unroll
    for (int j = 0; j < 4; ++j) { v[j] = xr[64 * j]; s += (v[j].x * v[j].x + v[j].y * v[j].y) + (v[j].z * v[j].z + v[j].w * v[j].w); }
    const float rstd = 1.0f / sqrtf(wave_sum(s) * (1.f / DM) + EPS);
#pragma unroll
    for (int j = 0; j < 4; ++j) { const f32x4 gg = gr[64 * j]; xr[64 * j] = v[j] * rstd * gg; }
}

__device__ __forceinline__ void p3_token(const Args& A, int l, int m, int lane) {
    unsigned char* ws = A.ws;
    const bf16* CQ = (const bf16*)(ws + WS_Z); const bf16* CKV = (const bf16*)(ws + WS_Z + T256); const bf16* MISC = (const bf16*)(ws + WS_Z + 2 * T256);
    const float* ROPE = (const float*)(ws + WS_ROPE);
    { const u32x2 w = *((const u32x2*)(CQ + (size_t)m * 256) + lane); const float a = bflo(w.x), b = bfhi(w.x), c = bflo(w.y), d = bfhi(w.y);
      const float rstd = 1.0f / sqrtf(wave_sum((a * a + b * b) + (c * c + d * d)) * (1.f / 256) + EPS);
      const f32x4 g = *((const f32x4*)(A.g_qn + l * 256) + lane);
      u32x2 o; o.x = pk2(a * rstd * g.x, b * rstd * g.y); o.y = pk2(c * rstd * g.z, d * rstd * g.w);
      *((u32x2*)((bf16*)(ws + WS_CQN) + (size_t)m * 256) + lane) = o; }
    int pos; float* ockv; float* okr; bf16* bckv; bf16* bkr;
    if (m < NP) { pos = m & (SEQ - 1); ockv = A.out + O_CKVP + ((size_t)l * NP + m) * 256; okr = A.out + O_KRP + ((size_t)l * NP + m) * 32;
        bckv = (bf16*)(ws + WS_CKVN) + (size_t)m * 256; bkr = (bf16*)(ws + WS_KR) + (size_t)m * 32; }
    else { const int s = m - NP, b = s >> 5, t = s & 31; pos = PAST + t; ockv = A.out + O_CKVS + ((size_t)l * NSQ + s) * 256; okr = A.out + O_KRS + ((size_t)l * NSQ + s) * 32;
        const size_t r = (size_t)b * SKV + PAST + t; bckv = (bf16*)(ws + WS_CKVS) + r * 256; bkr = (bf16*)(ws + WS_KRS) + r * 32; }
    { const u32x2 w = *((const u32x2*)(CKV + (size_t)m * 256) + lane); const float a = bflo(w.x), b = bfhi(w.x), c = bflo(w.y), d = bfhi(w.y);
      const float rstd = 1.0f / sqrtf(wave_sum((a * a + b * b) + (c * c + d * d)) * (1.f / 256) + EPS);
      const f32x4 g = *((const f32x4*)(A.g_kvn + l * 256) + lane);
      const f32x4 o = (f32x4){a * rstd * g.x, b * rstd * g.y, c * rstd * g.z, d * rstd * g.w};
      *((f32x4*)ockv + lane) = o;
      u32x2 ob; ob.x = pk2(o.x, o.y); ob.y = pk2(o.z, o.w); *((u32x2*)bckv + lane) = ob; }
    if (lane < 16) { const float x1 = bf2f(MISC[(size_t)m * 256 + lane]), x2 = bf2f(MISC[(size_t)m * 256 + 16 + lane]);
        const float c = ROPE[pos * 32 + lane], s = ROPE[pos * 32 + 16 + lane];
        const float o1 = x1 * c - x2 * s, o2 = x1 * s + x2 * c;
        okr[lane] = o1; okr[16 + lane] = o2; bkr[lane] = (bf16)f2bf(o1); bkr[16 + lane] = (bf16)f2bf(o2); }
    else if (lane < 32) { ((float*)(ws + WS_GA))[(size_t)m * 16 + (lane - 16)] = bf2f(MISC[(size_t)m * 256 + 32 + (lane - 16)]); }
}
__device__ __forceinline__ void cache_row(const Args& A, int l, int r, int lane) {
    const int b = r >> 11, p = r & (PAST - 1); const size_t dr = (size_t)b * SKV + p;
    const f32x4 v = *((const f32x4*)(A.cckv + ((size_t)l * DEC_B * PAST + r) * 256) + lane);
    u32x2 o; o.x = pk2(v.x, v.y); o.y = pk2(v.z, v.w); *((u32x2*)((bf16*)(A.ws + WS_CKVS) + dr * 256) + lane) = o;
    if (lane < 32) ((bf16*)(A.ws + WS_KRS))[dr * 32 + lane] = (bf16)f2bf(A.ckr[((size_t)l * DEC_B * PAST + r) * 32 + lane]);
}

struct GlaItem { int tok0, L, hd, sb; bool sample; };
__device__ __forceinline__ GlaItem gla_decode(int it) {
    GlaItem g;
    if (it < NITEM_P) { g.hd = it & 3; const int bc = it >> 2; g.tok0 = bc * 64; g.L = 64; g.sample = false; g.sb = 0; }
    else { const int j = it - NITEM_P; g.hd = j & 3; g.sb = j >> 2; g.tok0 = NP + g.sb * 32; g.L = 32; g.sample = true; }
    return g;
}
typedef float f32x2_t __attribute__((ext_vector_type(2))); typedef __bf16 bf16x2_t __attribute__((ext_vector_type(2)));
__device__ __forceinline__ unsigned cvtpk(float lo, float hi) { f32x2_t v = {lo, hi}; bf16x2_t b = __builtin_convertvector(v, bf16x2_t); return __builtin_bit_cast(unsigned, b); }
__device__ __forceinline__ float gate_lg(const float (&ga)[16], const float (&w)[16], float bias, int p, const float* g_GA_base) {
    float x = bias;
#ifdef GA_OLD
    const float* gp = g_GA_base + (size_t)p * 16;
#pragma unroll
    for (int r = 0; r < 16; ++r) x += gp[r] * w[r];
#else
#pragma unroll
    for (int r = 0; r < 16; ++r) x += __builtin_bit_cast(float, __builtin_amdgcn_readlane(__builtin_bit_cast(int, ga[r]), p)) * w[r];
#endif
    return logsig(x) * (1.f / 16.f);
}
constexpr int KT_PITCH = 72;
template <bool SAMPLE> __device__ __forceinline__ void gla_g1(const Args& A, int l, int it, LAS unsigned char* wl, int lane) {
    const GlaItem g = gla_decode(it); unsigned char* ws = A.ws; constexpr int L = SAMPLE ? 32 : 64;
    const int col = g.hd * 64 + lane, r32 = lane & 31, hi = lane >> 5;
    const float* GA = (const float*)(ws + WS_GA); const bf16* GK = (const bf16*)(ws + WS_Z + 4 * T256); const bf16* GVT = (const bf16*)(ws + WS_GVT);
    LAS bf16* kT = (LAS bf16*)wl; LAS float* dsm = (LAS float*)(wl + 64 * KT_PITCH * 2);
    float w[16], ga[16];
#pragma unroll
    for (int r = 0; r < 16; ++r) w[r] = A.w_a2[(size_t)l * 16 * 256 + r * 256 + col];
    const float bias = A.b_a2[l * 256 + col];
    { const int pl = lane < L ? lane : L - 1;
#pragma unroll
      for (int q = 0; q < 4; ++q) { const f32x4 v = *(const f32x4*)(GA + (size_t)(g.tok0 + pl) * 16 + 4 * q); ga[4 * q] = v.x; ga[4 * q + 1] = v.y; ga[4 * q + 2] = v.z; ga[4 * q + 3] = v.w; } }
    float blast = 0.f;
#pragma unroll 4
    for (int p = 0; p < L; ++p) blast += gate_lg(ga, w, bias, p, GA + (size_t)g.tok0 * 16);
    float bc = 0.f;
#pragma unroll 16
    for (int p = 0; p < L; ++p) { bc += gate_lg(ga, w, bias, p, GA + (size_t)g.tok0 * 16);
        const float kk = bf2f(GK[(size_t)(g.tok0 + p) * 256 + col]) * __expf(blast - bc);
        kT[lane * KT_PITCH + p] = (bf16)(cvtpk(kk, kk) & 0xffffu); }
    const float decay = __expf(blast);
    if (!SAMPLE) ((float*)(ws + WS_DECAY))[(size_t)it * 64 + lane] = decay;
    dsm[lane] = decay;
    LDS_WAIT(); asm volatile("" ::: "memory");
#pragma unroll 1
    for (int nb = 0; nb < 4; ++nb) {
        f32x16 acc[2]; acc[0] = (f32x16){}; acc[1] = (f32x16){};
#pragma unroll
        for (int s = 0; s < L / 16; ++s) {
            const bf16x8 bfr = *(const bf16x8*)(GVT + (size_t)(g.hd * 128 + 32 * nb + r32) * NTOK + g.tok0 + 16 * s + 8 * hi);
#pragma unroll
            for (int mb = 0; mb < 2; ++mb) { const bf16x8 af = *(const LAS bf16x8*)(kT + (32 * mb + r32) * KT_PITCH + 16 * s + 8 * hi); acc[mb] = MFMA32(af, bfr, acc[mb]); }
        }
        const int dv = 32 * nb + r32;
#ifdef DS_OLD
        if (!SAMPLE) { float* dsp = (float*)(ws + WS_DS) + (size_t)it * 8192 + dv;
#pragma unroll
            for (int mb = 0; mb < 2; ++mb)
#pragma unroll
                for (int r = 0; r < 16; ++r) dsp[(32 * mb + crow(r, hi)) * 128] = acc[mb][r]; }
#else
        if (!SAMPLE) { float* dsp = (float*)(ws + WS_DS) + (size_t)it * 8192 + dv * 64 + 4 * hi;
#pragma unroll
            for (int mb = 0; mb < 2; ++mb)
#pragma unroll
                for (int q = 0; q < 4; ++q) *(f32x4*)(dsp + 32 * mb + 8 * q) = (f32x4){acc[mb][4 * q], acc[mb][4 * q + 1], acc[mb][4 * q + 2], acc[mb][4 * q + 3]}; }
#endif
        else { const size_t so = (((size_t)l * DEC_B + g.sb) * 4 + g.hd) * 8192 + dv;
#pragma unroll
            for (int mb = 0; mb < 2; ++mb) {
#pragma unroll
                for (int r = 0; r < 16; ++r) { const int dk = 32 * mb + crow(r, hi); A.out[O_GLAS + so + dk * 128] = dsm[dk] * A.sgla[so + dk * 128] + acc[mb][r]; }
                asm volatile("" ::: "memory"); } }
    }
    LDS_WAIT(); asm volatile("" ::: "memory");
}
constexpr int NSCAN = 64, NSAMPWG = 8;
#ifdef DS_OLD
__device__ __forceinline__ void gla_scan(const Args& A, int l, int sblock, int tid) {
    const int gth = sblock * 512 + tid;
    const int seq = gth >> 12, e0 = (gth & 4095) * 2;
    const int b = seq >> 2, hd = seq & 3, dk = e0 >> 7;
    float* DS = (float*)(A.ws + WS_DS); const float* DEC = (const float*)(A.ws + WS_DECAY);
    float s0 = 0.f, s1 = 0.f;
    for (int c0 = 0; c0 < 256; c0 += 8) {
        float2 ds[8]; float dc[8];
#pragma unroll
        for (int j = 0; j < 8; ++j) { const size_t it = (size_t)((b * 256 + c0 + j) * 4 + hd); ds[j] = *(const float2*)(DS + it * 8192 + e0); dc[j] = DEC[it * 64 + dk]; }
#pragma unroll
        for (int j = 0; j < 8; ++j) { const size_t it = (size_t)((b * 256 + c0 + j) * 4 + hd); *(float2*)(DS + it * 8192 + e0) = make_float2(s0, s1);
            s0 = dc[j] * s0 + ds[j].x; s1 = dc[j] * s1 + ds[j].y; }
    }
    *(float2*)(A.out + O_GLAP + (((size_t)l * NBATCH + b) * 4 + hd) * 8192 + e0) = make_float2(s0, s1);
}
#else
__device__ __forceinline__ void gla_scan(const Args& A, int l, int sblock, int tid) {
    const int gth = sblock * 512 + tid;
    const int seq = gth >> 12, e0 = (gth & 4095) * 2;
    const int b = seq >> 2, hd = seq & 3, dv = e0 >> 6, dk = e0 & 63;
    float* DS = (float*)(A.ws + WS_DS); const float* DEC = (const float*)(A.ws + WS_DECAY);
    float s0 = 0.f, s1 = 0.f;
#pragma unroll 1
    for (int c0 = 0; c0 < 256; c0 += 16) {
        float2 ds[16], dc[16];
#pragma unroll
        for (int j = 0; j < 16; ++j) { const size_t it = (size_t)((b * 256 + c0 + j) * 4 + hd); ds[j] = *(const float2*)(DS + it * 8192 + e0); dc[j] = *(const float2*)(DEC + it * 64 + dk); }
#pragma unroll
        for (int j = 0; j < 16; ++j) { const size_t it = (size_t)((b * 256 + c0 + j) * 4 + hd); *(float2*)(DS + it * 8192 + e0) = make_float2(s0, s1);
            s0 = dc[j].x * s0 + ds[j].x; s1 = dc[j].y * s1 + ds[j].y; }
    }
    float* o = A.out + O_GLAP + (((size_t)l * NBATCH + b) * 4 + hd) * 8192;
    o[dk * 128 + dv] = s0; o[(dk + 1) * 128 + dv] = s1;
}
#endif
constexpr int BS_PITCH = 65;
template <bool SAMPLE> __device__ __forceinline__ void gla_g3(const Args& A, int l, int it, LAS unsigned char* wl, int lane) {
    const GlaItem g = gla_decode(it); unsigned char* ws = A.ws; constexpr int L = SAMPLE ? 32 : 64, NIB = L / 32;
    const int col = g.hd * 64 + lane, r32 = lane & 31, hi = lane >> 5;
    const float* GA = (const float*)(ws + WS_GA); const bf16* GQ = (const bf16*)(ws + WS_Z + 3 * T256); const bf16* GK = (const bf16*)(ws + WS_Z + 4 * T256);
    const bf16* GG = (const bf16*)(ws + WS_Z + 5 * T256); const bf16* GVT = (const bf16*)(ws + WS_GVT); bf16* CAT = (bf16*)(ws + WS_H);
    LAS float* bsm = (LAS float*)wl;
    {   float w[16], ga[16];
#pragma unroll
        for (int r = 0; r < 16; ++r) w[r] = A.w_a2[(size_t)l * 16 * 256 + r * 256 + col];
        const float bias = A.b_a2[l * 256 + col];
        { const int pl = lane < L ? lane : L - 1;
#pragma unroll
          for (int q = 0; q < 4; ++q) { const f32x4 v = *(const f32x4*)(GA + (size_t)(g.tok0 + pl) * 16 + 4 * q); ga[4 * q] = v.x; ga[4 * q + 1] = v.y; ga[4 * q + 2] = v.z; ga[4 * q + 3] = v.w; } }
        float bc = 0.f;
#pragma unroll 4
        for (int p = 0; p < L; ++p) { bc += gate_lg(ga, w, bias, p, GA + (size_t)g.tok0 * 16); bsm[p * BS_PITCH + lane] = bc; }
    }
    LDS_WAIT(); asm volatile("" ::: "memory");
    bf16x8 qf[NIB][4], kf[NIB][4];
#pragma unroll
    for (int ib = 0; ib < NIB; ++ib)
#pragma unroll
        for (int s = 0; s < 4; ++s) {
            const int i = 32 * ib + r32, dk0 = 16 * s + 8 * hi;
            const u32x4 rq = *(const u32x4*)(GQ + (size_t)(g.tok0 + i) * 256 + g.hd * 64 + dk0);
            const u32x4 rk = *(const u32x4*)(GK + (size_t)(g.tok0 + i) * 256 + g.hd * 64 + dk0);
            u32x4 oq, ok;
#pragma unroll
            for (int jj = 0; jj < 4; ++jj) { const float b0 = bsm[i * BS_PITCH + dk0 + 2 * jj], b1 = bsm[i * BS_PITCH + dk0 + 2 * jj + 1];
                const float e0 = __expf(b0), e1 = __expf(b1);
                oq[jj] = cvtpk(bflo(rq[jj]) * 0.125f * e0, bfhi(rq[jj]) * 0.125f * e1);
                ok[jj] = cvtpk(bflo(rk[jj]) * __builtin_amdgcn_rcpf(e0), bfhi(rk[jj]) * __builtin_amdgcn_rcpf(e1)); }
            qf[ib][s] = __builtin_bit_cast(bf16x8, oq); kf[ib][s] = __builtin_bit_cast(bf16x8, ok);
        }
    bf16x8 xp[NIB][NIB][2];
#pragma unroll
    for (int jb = 0; jb < NIB; ++jb)
#pragma unroll
        for (int ib = 0; ib < NIB; ++ib) {
            if (jb > ib) { xp[jb][ib][0] = (bf16x8){}; xp[jb][ib][1] = (bf16x8){}; continue; }
            f32x16 X = (f32x16){};
#pragma unroll
            for (int s = 0; s < 4; ++s) X = MFMA32(kf[jb][s], qf[ib][s], X);
            if (jb == ib) {
#pragma unroll
                for (int r = 0; r < 16; ++r) if (crow(r, hi) > r32) X[r] = 0.f; }
#pragma unroll
            for (int s2 = 0; s2 < 2; ++s2) { u32x4 pw;
#pragma unroll
                for (int jj = 0; jj < 4; ++jj) pw[jj] = cvtpk(X[8 * s2 + 2 * jj], X[8 * s2 + 2 * jj + 1]);
                xp[jb][ib][s2] = __builtin_bit_cast(bf16x8, pw); }
        }
    const float* Sp = SAMPLE ? A.sgla + (((size_t)l * DEC_B + g.sb) * 4 + g.hd) * 8192 : (const float*)(ws + WS_DS) + (size_t)it * 8192;
#pragma unroll
    for (int ib = 0; ib < NIB; ++ib) {
        f32x16 o[4];
#pragma unroll
        for (int nb = 0; nb < 4; ++nb) {
            const int dv = 32 * nb + r32;
            o[nb] = (f32x16){};
#pragma unroll
            for (int s = 0; s < 4; ++s) { u32x4 pw;
#ifdef DS_OLD
                if (true) {
#else
                if (SAMPLE) {
#endif
#pragma unroll
                    for (int jj = 0; jj < 4; ++jj) pw[jj] = cvtpk(Sp[(16 * s + 8 * hi + 2 * jj) * 128 + dv], Sp[(16 * s + 8 * hi + 2 * jj + 1) * 128 + dv]); }
                else { const f32x4 sa = *(const f32x4*)(Sp + dv * 64 + 16 * s + 8 * hi), sb = *(const f32x4*)(Sp + dv * 64 + 16 * s + 8 * hi + 4);
                    pw = (u32x4){cvtpk(sa.x, sa.y), cvtpk(sa.z, sa.w), cvtpk(sb.x, sb.y), cvtpk(sb.z, sb.w)}; }
                o[nb] = MFMA32(__builtin_bit_cast(bf16x8, pw), qf[ib][s], o[nb]); }
#pragma unroll
            for (int jb = 0; jb <= ib; ++jb)
#pragma unroll
                for (int s2 = 0; s2 < 2; ++s2) { const bf16* vp = GVT + (size_t)(g.hd * 128 + dv) * NTOK + g.tok0 + 32 * jb + 16 * s2 + 4 * hi;
                    const u32x2 lo = *(const u32x2*)vp, hi8 = *(const u32x2*)(vp + 8);
                    o[nb] = MFMA32(__builtin_bit_cast(bf16x8, (u32x4){lo.x, lo.y, hi8.x, hi8.y}), xp[jb][ib][s2], o[nb]); }
        }
        float ss = 0.f;
#pragma unroll
        for (int nb = 0; nb < 4; ++nb)
#pragma unroll
            for (int r = 0; r < 16; ++r) ss += o[nb][r] * o[nb][r];
        ss += __shfl_xor(ss, 32);
        const float rstd = 1.0f / sqrtf(ss * (1.f / 128) + EPS);
        const int tok = g.tok0 + 32 * ib + r32;
#pragma unroll
        for (int nb = 0; nb < 4; ++nb)
#pragma unroll
            for (int q = 0; q < 4; ++q) { const int dv0 = 32 * nb + 8 * q + 4 * hi; const int gc = g.hd * 128 + dv0;
                const u32x2 gw = *(const u32x2*)(GG + (size_t)(gc >> 8) * ((size_t)NTOK * 256) + (size_t)tok * 256 + (gc & 255));
                const f32x4 gon = *(const f32x4*)(A.g_on + l * 128 + dv0);
                const float g0 = bflo(gw.x), g1 = bfhi(gw.x), g2 = bflo(gw.y), g3 = bfhi(gw.y);
                const float v0 = o[nb][4 * q + 0] * rstd * gon.x * g0 * __builtin_amdgcn_rcpf(1.0f + __expf(-g0));
                const float v1 = o[nb][4 * q + 1] * rstd * gon.y * g1 * __builtin_amdgcn_rcpf(1.0f + __expf(-g1));
                const float v2 = o[nb][4 * q + 2] * rstd * gon.z * g2 * __builtin_amdgcn_rcpf(1.0f + __expf(-g2));
                const float v3 = o[nb][4 * q + 3] * rstd * gon.w * g3 * __builtin_amdgcn_rcpf(1.0f + __expf(-g3));
                u32x2 ow; ow.x = cvtpk(v0, v1); ow.y = cvtpk(v2, v3);
                *(u32x2*)(CAT + (size_t)tok * 1024 + 512 + g.hd * 128 + dv0) = ow; }
        asm volatile("" ::: "memory");
    }
    LDS_WAIT(); asm volatile("" ::: "memory");
}

__device__ __forceinline__ float max3f(float a, float b, float c) { return fmaxf(fmaxf(a, b), c); }
constexpr float ATT_THR = 8.0f;
template <class LD> __device__ __forceinline__ void attn_tile(const LD& ld, const bf16x8 (&qr)[6], f32x16 (&o)[2], float& m, float& l, bool half_only, bool first) {
    f32x16 negm;
#pragma unroll
    for (int r = 0; r < 16; ++r) negm[r] = -m;
    f32x16 p0 = negm, p1 = negm;
#pragma unroll
    for (int s = 0; s < 6; ++s) p0 = MFMA32(ld.k(0, s), qr[s], p0);
    if (!half_only) {
#pragma unroll
        for (int s = 0; s < 6; ++s) p1 = MFMA32(ld.k(1, s), qr[s], p1); }
    float mx = max3f(p0[0], p0[1], p0[2]);
#pragma unroll
    for (int r = 3; r < 15; r += 2) mx = max3f(mx, p0[r], p0[r + 1]);
    mx = fmaxf(mx, p0[15]);
    if (!half_only) {
#pragma unroll
        for (int r = 0; r < 16; r += 2) mx = max3f(mx, p1[r], p1[r + 1]); }
    mx = fmaxf(mx, __shfl_xor(mx, 32));
    if (first || __any(mx > ATT_THR)) {
        const float d = first ? mx : fmaxf(mx, 0.f);
        m += d;
        const float f = first ? 0.f : __builtin_amdgcn_exp2f(-d);
        l *= f;
#pragma unroll
        for (int r = 0; r < 16; ++r) { p0[r] -= d; p1[r] -= d; o[0][r] *= f; o[1][r] *= f; }
    }
    float rs = 0.f, rs1 = 0.f;
#pragma unroll
    for (int r = 0; r < 16; ++r) { p0[r] = __builtin_amdgcn_exp2f(p0[r]); rs += p0[r]; }
    if (!half_only) {
#pragma unroll
        for (int r = 0; r < 16; ++r) { p1[r] = __builtin_amdgcn_exp2f(p1[r]); rs1 += p1[r]; } }
    l += rs + rs1;
    bf16x8 pa[4];
#pragma unroll
    for (int s = 0; s < 2; ++s) { u32x4 w0, w1;
#pragma unroll
        for (int jj = 0; jj < 4; ++jj) { w0[jj] = cvtpk(p0[8 * s + 2 * jj], p0[8 * s + 2 * jj + 1]); w1[jj] = cvtpk(p1[8 * s + 2 * jj], p1[8 * s + 2 * jj + 1]); }
        pa[s] = __builtin_bit_cast(bf16x8, w0); pa[2 + s] = __builtin_bit_cast(bf16x8, w1); }
#pragma unroll
    for (int db = 0; db < 2; ++db) {
#pragma unroll
        for (int s = 0; s < 2; ++s) o[db] = MFMA32(ld.v(db, s), pa[s], o[db]);
        if (!half_only) {
#pragma unroll
            for (int s = 2; s < 4; ++s) o[db] = MFMA32(ld.v(db, s), pa[s], o[db]); }
    }
}
constexpr int K_PITCH = 208, V_PITCH = 136, KBUF = 64 * K_PITCH, VBUF = 64 * V_PITCH, ABUF = KBUF + VBUF;
struct LdsLoader {
    LAS const unsigned char* kb; LAS const unsigned char* vb; int r32, hi;
    __device__ __forceinline__ bf16x8 k(int half, int s) const { return *(LAS const bf16x8*)(kb + (r32 + 32 * half) * K_PITCH + s * 32 + hi * 16); }
    __device__ __forceinline__ bf16x8 v(int db, int s) const { LAS const unsigned char* p = vb + (r32 + 32 * db) * V_PITCH + s * 32 + hi * 8;
        const u32x2 lo = *(LAS const u32x2*)p, h8 = *(LAS const u32x2*)(p + 16); return __builtin_bit_cast(bf16x8, (u32x4){lo.x, lo.y, h8.x, h8.y}); }
};
struct GlbLoader {
    const bf16* kn; const bf16* kr; const bf16* vt; int r32, hi;
    __device__ __forceinline__ bf16x8 k(int half, int s) const { const int kv = r32 + 32 * half;
        return (s < 4) ? *(const bf16x8*)(kn + (size_t)kv * 512 + 16 * s + 8 * hi) : *(const bf16x8*)(kr + (size_t)kv * 32 + 16 * (s - 4) + 8 * hi); }
    __device__ __forceinline__ bf16x8 v(int db, int s) const { const bf16* p = vt + (size_t)(r32 + 32 * db) * NKVS + 16 * s + 4 * hi;
        const u32x2 lo = *(const u32x2*)p, h8 = *(const u32x2*)(p + 8); return __builtin_bit_cast(bf16x8, (u32x4){lo.x, lo.y, h8.x, h8.y}); }
};
__device__ __forceinline__ void load_q(bf16x8 (&qr)[6], const bf16* qp, const float* rope_row, int hi) {
#pragma unroll
    for (int s = 0; s < 6; ++s) qr[s] = *(const bf16x8*)(qp + 16 * s + 8 * hi);
    const u32x4 a = __builtin_bit_cast(u32x4, qr[4]), b = __builtin_bit_cast(u32x4, qr[5]); u32x4 oa, ob;
    const f32x4 c0 = *(const f32x4*)(rope_row + 8 * hi), c1 = *(const f32x4*)(rope_row + 8 * hi + 4), s0 = *(const f32x4*)(rope_row + 16 + 8 * hi), s1 = *(const f32x4*)(rope_row + 16 + 8 * hi + 4);
#pragma unroll
    for (int jj = 0; jj < 4; ++jj) {
        const float x1l = bflo(a[jj]), x1h = bfhi(a[jj]), x2l = bflo(b[jj]), x2h = bfhi(b[jj]);
        const float cl = (jj < 2) ? c0[2 * jj] : c1[2 * jj - 4], ch = (jj < 2) ? c0[2 * jj + 1] : c1[2 * jj - 3];
        const float sl = (jj < 2) ? s0[2 * jj] : s1[2 * jj - 4], sh = (jj < 2) ? s0[2 * jj + 1] : s1[2 * jj - 3];
        oa[jj] = pk2(x1l * cl - x2l * sl, x1h * ch - x2h * sh); ob[jj] = pk2(x1l * sl + x2l * cl, x1h * sh + x2h * ch); }
    qr[4] = __builtin_bit_cast(bf16x8, oa); qr[5] = __builtin_bit_cast(bf16x8, ob);
}
__device__ __forceinline__ float halfmax(float x) { auto rr = __builtin_amdgcn_permlane32_swap(__float_as_uint(x), __float_as_uint(x), false, false); return fmaxf(__uint_as_float(rr[0]), __uint_as_float(rr[1])); }
__device__ __forceinline__ float halfsum(float x) { auto rr = __builtin_amdgcn_permlane32_swap(__float_as_uint(x), __float_as_uint(x), false, false); return __uint_as_float(rr[0]) + __uint_as_float(rr[1]); }
__device__ __forceinline__ void attn_qk(const LdsLoader& ld, const bf16x8 (&qr)[6], float m, f32x16& c0, f32x16& c1) {
    f32x16 negm;
#pragma unroll
    for (int r = 0; r < 16; ++r) negm[r] = -m;
    c0 = negm; c1 = negm;
#pragma unroll
    for (int s = 0; s < 6; ++s) { c0 = MFMA32(ld.k(0, s), qr[s], c0); c1 = MFMA32(ld.k(1, s), qr[s], c1); }
}
__device__ __forceinline__ void attn_prompt_unit(const Args& A, const Ctx& C, int b, int hd, int qb) {
    int tid_ = threadIdx.x; asm volatile("" : "+v"(tid_));
    unsigned char* ws = A.ws; const int tid = tid_, lane = tid & 63, wid = C.wave, r32 = lane & 31, hi = lane >> 5;
    const bf16* Q = (const bf16*)(ws + WS_Z); const bf16* KN = (const bf16*)(ws + WS_KN); const bf16* KR = (const bf16*)(ws + WS_KR); const bf16* VT = (const bf16*)(ws + WS_VT);
    bf16* CAT = (bf16*)(ws + WS_H); const float* ROPE = (const float*)(ws + WS_ROPE);
    const int pos = qb * 256 + wid * 32 + r32; const size_t qrow = (size_t)b * SEQ + pos;
    bf16x8 qr[6]; load_q(qr, Q + qrow * 768 + hd * 96, ROPE + (size_t)pos * 32, hi);
    const int ntiles = 4 * qb + 4, my_last = 4 * qb + (wid >> 1);
    const int krow = tid >> 3, kch = tid & 7, rrow = (tid & 255) >> 2, rch = tid & 3;
    const char* kn_base = (const char*)(KN + (size_t)b * SEQ * 512 + hd * 64); const char* kr_base = (const char*)(KR + (size_t)b * SEQ * 32);
    const char* vt_base = (const char*)(VT + (size_t)(hd * 64) * NP + (size_t)b * SEQ);
    const unsigned kn_off = (unsigned)(krow * 512 + kch * 8) * 2u, kr_off = (unsigned)(rrow * 32 + rch * 8) * 2u, vt_off = (unsigned)(krow * NP + kch * 8) * 2u;
    const int kn_dst = krow * K_PITCH + kch * 16, kr_dst = rrow * K_PITCH + 128 + rch * 16, vt_dst = KBUF + krow * V_PITCH + kch * 16;
    u32x4 sk, sr, sv;
#define ATT_GLOAD(tt) do { sk = *(const u32x4*)(kn_base + (size_t)(tt) * (64 * 512 * 2) + kn_off); sv = *(const u32x4*)(vt_base + (size_t)(tt) * 128 + vt_off); if (tid < 256) sr = *(const u32x4*)(kr_base + (size_t)(tt) * (64 * 32 * 2) + kr_off); } while (0)
#define ATT_LSTORE(slot_) do { LAS unsigned char* bufp = C.lds + (slot_) * ABUF; *(LAS u32x4*)(bufp + kn_dst) = sk; if (tid < 256) *(LAS u32x4*)(bufp + kr_dst) = sr; \
        *(LAS u32x2*)(bufp + vt_dst) = (u32x2){sv.x, sv.y}; *(LAS u32x2*)(bufp + vt_dst + 8) = (u32x2){sv.z, sv.w}; } while (0)
    ATT_GLOAD(0); ATT_LSTORE(0); ATT_GLOAD(1); ATT_LSTORE(1);
    __syncthreads();
    f32x16 o[2]; o[0] = zero16(); o[1] = zero16(); float m = o[0][0], l = m;
    f32x16 c0, c1;
    { const LdsLoader ld0{C.lds, C.lds + KBUF, r32, hi}; attn_qk(ld0, qr, m, c0, c1); }
    int slot = 0;
    for (int t = 0; t < ntiles; ++t) {
        const int s1 = (slot == 2) ? 0 : slot + 1, s2 = (s1 == 2) ? 0 : s1 + 1;
        const bool more = (t + 2 < ntiles);
        if (more) ATT_GLOAD(t + 2);
        if (t <= my_last) {
            float mx = max3f(c0[0], c0[1], c0[2]);
#pragma unroll
            for (int r = 3; r < 15; r += 2) mx = max3f(mx, c0[r], c0[r + 1]);
            mx = fmaxf(mx, c0[15]);
#pragma unroll
            for (int r = 0; r < 16; r += 2) mx = max3f(mx, c1[r], c1[r + 1]);
            mx = halfmax(mx);
            const bool first = (t == 0);
            if (first || __any(mx > ATT_THR)) {
                const float d = first ? mx : fmaxf(mx, 0.f);
                m += d; const float f = first ? 0.f : __builtin_amdgcn_exp2f(-d); l *= f;
#pragma unroll
                for (int r = 0; r < 16; ++r) { c0[r] -= d; c1[r] -= d; o[0][r] *= f; o[1][r] *= f; }
            }
            f32x16 n0, n1;
            { const LdsLoader ldn{C.lds + s1 * ABUF, C.lds + s1 * ABUF + KBUF, r32, hi}; attn_qk(ldn, qr, m, n0, n1); }
            float rs0 = 0.f, rs1 = 0.f;
#pragma unroll
            for (int r = 0; r < 16; ++r) { c0[r] = __builtin_amdgcn_exp2f(c0[r]); rs0 += c0[r]; c1[r] = __builtin_amdgcn_exp2f(c1[r]); rs1 += c1[r]; }
            l += rs0 + rs1;
            bf16x8 pa[4];
#pragma unroll
            for (int s = 0; s < 2; ++s) { u32x4 w0, w1;
#pragma unroll
                for (int jj = 0; jj < 4; ++jj) { w0[jj] = cvtpk(c0[8 * s + 2 * jj], c0[8 * s + 2 * jj + 1]); w1[jj] = cvtpk(c1[8 * s + 2 * jj], c1[8 * s + 2 * jj + 1]); }
                pa[s] = __builtin_bit_cast(bf16x8, w0); pa[2 + s] = __builtin_bit_cast(bf16x8, w1); }
            { const LdsLoader ldv{C.lds + slot * ABUF, C.lds + slot * ABUF + KBUF, r32, hi};
#pragma unroll
              for (int s = 0; s < 4; ++s) { o[0] = MFMA32(ldv.v(0, s), pa[s], o[0]); o[1] = MFMA32(ldv.v(1, s), pa[s], o[1]); } }
            c0 = n0; c1 = n1;
        }
        if (more) ATT_LSTORE(s2);
        slot = s1;
        __syncthreads();
    }
#undef ATT_GLOAD
#undef ATT_LSTORE
    const float lt = halfsum(l); const float inv = 1.0f / lt;
    bf16* orow = CAT + qrow * 1024 + hd * 64;
#pragma unroll
    for (int db = 0; db < 2; ++db)
#pragma unroll
        for (int q = 0; q < 4; ++q) { u32x2 w; w.x = cvtpk(o[db][4 * q] * inv, o[db][4 * q + 1] * inv); w.y = cvtpk(o[db][4 * q + 2] * inv, o[db][4 * q + 3] * inv);
            *(u32x2*)(orow + 32 * db + 8 * q + 4 * hi) = w; }
}
__device__ __forceinline__ void attn_sample_unit(const Args& A, const Ctx& C, int b, int hd) {
    unsigned char* ws = A.ws; const int tid = C.tid, lane = C.lane, wid = C.wave, r32 = lane & 31, hi = lane >> 5;
    const bf16* Q = (const bf16*)(ws + WS_Z); const bf16* KNS = (const bf16*)(ws + WS_KNS); const bf16* KRS = (const bf16*)(ws + WS_KRS); const bf16* VTS = (const bf16*)(ws + WS_VTS);
    bf16* CAT = (bf16*)(ws + WS_H); const float* ROPE = (const float*)(ws + WS_ROPE);
    const size_t qrow = (size_t)NP + b * 32 + r32;
    bf16x8 qr[6]; load_q(qr, Q + qrow * 768 + hd * 96, ROPE + (size_t)(PAST + r32) * 32, hi);
    f32x16 o[2]; o[0] = (f32x16){}; o[1] = (f32x16){}; float m = 0.f, l = 0.f;
    for (int t = wid; t < 33; t += 8) {
        const size_t key0 = (size_t)b * SKV + 64 * t;
        GlbLoader ld{KNS + key0 * 512 + hd * 64, KRS + key0 * 32, VTS + (size_t)(hd * 64) * NKVS + key0, r32, hi};
        attn_tile(ld, qr, o, m, l, t == 32, t == wid);
    }
    const float lt = l + __shfl_xor(l, 32);
    LAS float* cm = (LAS float*)C.lds; LAS float* cl = cm + 256; LAS float* co = cm + 512;
    if (hi == 0) { cm[wid * 32 + r32] = m; cl[wid * 32 + r32] = lt; }
#pragma unroll
    for (int db = 0; db < 2; ++db)
#pragma unroll
        for (int r = 0; r < 16; ++r) co[(wid * 64 + 32 * db + crow(r, hi)) * 32 + r32] = o[db][r];
    __syncthreads();
    { const int q = tid & 31, d0 = (tid >> 5) * 4;
      float M = cm[q];
#pragma unroll
      for (int w = 1; w < 8; ++w) M = fmaxf(M, cm[w * 32 + q]);
      float L = 0.f, acc[4] = {0.f, 0.f, 0.f, 0.f};
#pragma unroll
      for (int w = 0; w < 8; ++w) { const float f = __builtin_amdgcn_exp2f(cm[w * 32 + q] - M); L += cl[w * 32 + q] * f;
#pragma unroll
          for (int i = 0; i < 4; ++i) acc[i] += co[(w * 64 + d0 + i) * 32 + q] * f; }
      const float inv = 1.0f / L;
      u32x2 wv; wv.x = pk2(acc[0] * inv, acc[1] * inv); wv.y = pk2(acc[2] * inv, acc[3] * inv);
      *(u32x2*)(CAT + ((size_t)NP + b * 32 + q) * 1024 + hd * 64 + d0) = wv; }
    __syncthreads();
}

#define XB_TMO      128
#define XB_XCNT(j)  (256  + 64 * (j))
#define XB_XSUB(j)  (1280 + 64 * (j))
#define XB_XGEN(j)  (2304 + 64 * (j))
#define XB_TOP      3328
#define XB_TOPGEN   3392
#define XCD_BAR_WORDS 3456
#define XB_SPIN_CAP (1u << 23)

__device__ __forceinline__ unsigned xb_ld(unsigned* p)              { return __hip_atomic_load(p, __ATOMIC_RELAXED, __HIP_MEMORY_SCOPE_AGENT); }
__device__ __forceinline__ unsigned xb_add(unsigned* p, unsigned v) { return __hip_atomic_fetch_add(p, v, __ATOMIC_RELAXED, __HIP_MEMORY_SCOPE_AGENT); }
__device__ __forceinline__ unsigned xb_xcc_id() { return (unsigned)__builtin_amdgcn_s_getreg((3 << 11) | 20) & 0xFu; }
#define XB_SPIN(cond, bar) do { unsigned _sp = 0; while (cond) { __builtin_amdgcn_s_sleep(1); \
    if ((++_sp & 255u) == 0u) { if (xb_ld(&(bar)[XB_TMO])) break; if (_sp > XB_SPIN_CAP) { atomicAdd(&(bar)[XB_TMO], 1u); break; } } } } while (0)

struct XcdBarrier {
    unsigned* bar; unsigned x;
    volatile LAS unsigned* st;
};

__device__ __forceinline__ XcdBarrier xcd_barrier_post(unsigned* bar, volatile LAS unsigned* st) {
    XcdBarrier b; b.bar = bar; b.x = xb_xcc_id(); b.st = st;
    if (threadIdx.x == 0) (void)xb_add(&bar[XB_XCNT(b.x)], 1u);
    return b;
}
__device__ __forceinline__ void xcd_barrier_complete(unsigned* bar, unsigned x, unsigned& nloc, unsigned& nx) {
    const unsigned G = gridDim.x * gridDim.y * gridDim.z;
    unsigned sum, cnt, mine, sp = 0u;
    for (;;) {
        sum = 0u; cnt = 0u; mine = 0u;
#pragma unroll
        for (unsigned j = 0; j < 16; ++j) { const unsigned c = xb_ld(&bar[XB_XCNT(j)]); sum += c; cnt += (c > 0u) ? 1u : 0u; mine = (j == x) ? c : mine; }
        if (sum == G) break;
        __builtin_amdgcn_s_sleep(1);
        if ((++sp & 255u) == 0u) { if (xb_ld(&bar[XB_TMO])) break; if (sp > XB_SPIN_CAP) { atomicAdd(&bar[XB_TMO], 1u); break; } }
    }
    nloc = mine > 0u ? mine : 1u; nx = cnt > 0u ? cnt : 1u;
}

__device__ __forceinline__ void xcd_barrier(const XcdBarrier& b) {
    asm volatile("s_waitcnt vmcnt(0)" ::: "memory");
    __syncthreads();
    if (threadIdx.x == 0) {
        unsigned* bar = b.bar;
        __builtin_amdgcn_s_waitcnt(0);
        unsigned nloc = b.st[0], nx = b.st[1];
        if (nloc == 0u) { xcd_barrier_complete(bar, b.x, nloc, nx); b.st[0] = nloc; b.st[1] = nx; }
        const unsigned old = xb_add(&bar[XB_XSUB(b.x)], 1u);
        const unsigned gen = old / nloc;
        if (old + 1u == (gen + 1u) * nloc) {
            __builtin_amdgcn_fence(__ATOMIC_RELEASE, "agent");
            asm volatile("s_waitcnt vmcnt(0)" ::: "memory");
            const unsigned og = xb_add(&bar[XB_TOP], 1u);
            const unsigned tg = og / nx;
            if (og + 1u == (tg + 1u) * nx) xb_add(&bar[XB_TOPGEN], 1u);
            else XB_SPIN(xb_ld(&bar[XB_TOPGEN]) == tg, bar);
            __builtin_amdgcn_fence(__ATOMIC_ACQUIRE, "agent");
            xb_add(&bar[XB_XGEN(b.x)], 1u);
            asm volatile("s_waitcnt vmcnt(0)" ::: "memory");
        } else {
            XB_SPIN(xb_ld(&bar[XB_XGEN(b.x)]) == gen, bar);
            __builtin_amdgcn_fence(__ATOMIC_ACQUIRE, "agent");
            asm volatile("s_waitcnt vmcnt(0)" ::: "memory");
        }
    }
    __syncthreads();
}

__global__ void __launch_bounds__(512, 2) fwd_mega(Args A) {
    extern __shared__ __attribute__((aligned(16))) unsigned char lds_raw[];
    cg::grid_group grid = cg::this_grid();
    volatile LAS unsigned* bst = (volatile LAS unsigned*)((LAS unsigned char*)lds_raw + LDS_BYTES - 64);
    if (threadIdx.x < 16) bst[threadIdx.x] = 0u;
    __syncthreads();
    XcdBarrier xbar = xcd_barrier_post((unsigned*)(A.ws + WS_CTL), bst);
#ifdef PROBE_SYNC2
#define GSYNC() do { xcd_barrier(xbar); xcd_barrier(xbar); } while (0)
#else
#define GSYNC() xcd_barrier(xbar)
#endif
    Ctx C; C.lds = (LAS unsigned char*)lds_raw; C.tid = threadIdx.x; C.lane = C.tid & 63; C.wave = __builtin_amdgcn_readfirstlane(C.tid >> 6);
    C.G = gridDim.x; { const int bx = blockIdx.x; C.vcu = (C.G % 8 == 0) ? (bx % 8) * (C.G / 8) + bx / 8 : bx; }
    C.gw = blockIdx.x * 8 + C.wave; C.NGW = C.G * 8;
    unsigned char* ws = A.ws;
    float* X = A.out + O_Y;
    { float* ROPE = (float*)(ws + WS_ROPE);
      for (int e = blockIdx.x * 512 + C.tid; e < SEQ * 16; e += C.G * 512) { const int p = e >> 4, i = e & 15;
          const double base = (i & 3) == 0 ? 1.0 : (i & 3) == 1 ? 0.5623413251903491 : (i & 3) == 2 ? 0.31622776601683794 : 0.1778279410038923;
          const double sc = (i >> 2) == 0 ? 1.0 : (i >> 2) == 1 ? 0.1 : (i >> 2) == 2 ? 0.01 : 0.001;
          const float inv = (float)(base * sc); const float ang = (float)p * inv;
          const double rev = (double)ang * 0.15915494309189535; const float fr = (float)(rev - __builtin_rint(rev));
          ROPE[p * 32 + i] = __builtin_amdgcn_cosf(fr); ROPE[p * 32 + 16 + i] = __builtin_amdgcn_sinf(fr); } }
#define REFRESH() do { int t_ = threadIdx.x; asm volatile("" : "+v"(t_)); C.tid = t_; C.lane = t_ & 63; C.wave = __builtin_amdgcn_readfirstlane(t_ >> 6); C.gw = blockIdx.x * 8 + C.wave; } while (0)
#pragma unroll 1
    for (int l = 0; l < DEPTH; ++l) {
        REFRESH();
#ifdef PROBE_P1
        for (int rep = 0; rep < 2; ++rep) {
#endif
        convert_weights(C, A, l);
        for (int mrow = C.gw; mrow < NTOK; mrow += C.NGW) {
            const float* xr = (l == 0) ? (mrow < NP ? A.xp + (size_t)mrow * DM : A.xs + (size_t)(mrow - NP) * DM) : X + (size_t)mrow * DM;
            norm_row(xr, A.g_attn + l * DM, (bf16*)(ws + WS_H) + (size_t)mrow * DM, (l == 0) ? X + (size_t)mrow * DM : nullptr, C.lane); }
        for (int r = C.gw; r < DEC_B * PAST; r += C.NGW) cache_row(A, l, r, C.lane);
#ifdef PROBE_P1
        }
#endif
        if (l == 0) grid.sync(); else GSYNC();
#ifndef NO_P2
#ifdef PROBE_P2
        for (int rep = 0; rep < 2; ++rep) {
#endif
        { pg8::EpiBf16 E{(pg8::bf16_t*)(ws + WS_Z), 256, 256, (size_t)NTOK * 256};
          pg8::Gemm g{(const pg8::bf16_t*)(ws + WS_H), (const pg8::bf16_t*)(ws + WS_WIN), NTOK, 1792, DM}; pg8::StaticOrder S; S.init(NTOK, 1792, C.G, (int)blockIdx.x);
          pg8::gemm_phase<pg8::EpiBf16, pg8::StaticOrder, true, true>(C.lds, g, S, E); }
        { pg8::EpiBf16 E{(pg8::bf16_t*)(ws + WS_GVT), NTOK, 0, 0};
          pg8::Gemm g{(const pg8::bf16_t*)(ws + WS_WGV), (const pg8::bf16_t*)(ws + WS_H), 512, NTOK, DM}; pg8::StaticOrder S; S.init(512, NTOK, C.G, (int)((blockIdx.x + 146) % C.G));
          pg8::gemm_phase<pg8::EpiBf16, pg8::StaticOrder, true, true>(C.lds, g, S, E); }
#ifdef PROBE_P2
        }
#endif
        GSYNC();
#endif
        REFRESH();
#ifdef PROBE_THIN
        for (int rep = 0; rep < 2; ++rep)
#endif
        for (int mrow = C.gw; mrow < NTOK; mrow += C.NGW) p3_token(A, l, mrow, C.lane);
        GSYNC();
        for (int it = C.gw; it < NITEM_P; it += C.NGW) gla_g1<false>(A, l, it, C.lds + C.wave * 16384, C.lane);
#ifdef SAMP_OLDPLACE
        if (C.gw < 64) gla_g1<true>(A, l, NITEM_P + C.gw, C.lds + C.wave * 16384, C.lane);
#endif
        GSYNC();
#ifndef NO_P4
        if ((int)blockIdx.x < NSCAN) gla_scan(A, l, blockIdx.x, C.tid);
#ifndef SAMP_OLDPLACE
        else if ((int)blockIdx.x < NSCAN + NSAMPWG) { const int it = NITEM_P + ((int)blockIdx.x - NSCAN) * 8 + C.wave;
            gla_g1<true>(A, l, it, C.lds + C.wave * 17408, C.lane); gla_g3<true>(A, l, it, C.lds + C.wave * 17408, C.lane); }
#else
        else if ((int)blockIdx.x < NSCAN + NSAMPWG) { }
#endif
        else {
            const int G2 = C.G - NSCAN - NSAMPWG, c2 = blockIdx.x - NSCAN - NSAMPWG;
#ifdef PROBE_P4G
            for (int rep = 0; rep < 2; ++rep)
#endif
#pragma unroll 1
            for (int gi = 0; gi < 5; ++gi) {
                pg8::Gemm g; pg8::EpiBf16 E; int M_, N_;
                if (gi == 0) { g = pg8::Gemm{(const pg8::bf16_t*)(ws + WS_CQN), (const pg8::bf16_t*)(ws + WS_WUQ), NTOK, 768, 256}; E = pg8::EpiBf16{(pg8::bf16_t*)(ws + WS_Z), 768, 0, 0}; M_ = NTOK; N_ = 768; }
                else if (gi == 1) { g = pg8::Gemm{(const pg8::bf16_t*)(ws + WS_CKVN), (const pg8::bf16_t*)(ws + WS_WUK), NP, 512, 256}; E = pg8::EpiBf16{(pg8::bf16_t*)(ws + WS_KN), 512, 0, 0}; M_ = NP; N_ = 512; }
                else if (gi == 2) { g = pg8::Gemm{(const pg8::bf16_t*)(ws + WS_WUV), (const pg8::bf16_t*)(ws + WS_CKVN), 512, NP, 256}; E = pg8::EpiBf16{(pg8::bf16_t*)(ws + WS_VT), NP, 0, 0}; M_ = 512; N_ = NP; }
                else if (gi == 3) { g = pg8::Gemm{(const pg8::bf16_t*)(ws + WS_CKVS), (const pg8::bf16_t*)(ws + WS_WUK), NKVS, 512, 256}; E = pg8::EpiBf16{(pg8::bf16_t*)(ws + WS_KNS), 512, 0, 0}; M_ = NKVS; N_ = 512; }
                else { g = pg8::Gemm{(const pg8::bf16_t*)(ws + WS_WUV), (const pg8::bf16_t*)(ws + WS_CKVS), 512, NKVS, 256}; E = pg8::EpiBf16{(pg8::bf16_t*)(ws + WS_VTS), NKVS, 0, 0}; M_ = 512; N_ = NKVS; }
                pg8::StaticOrder S; S.init(M_, N_, G2, (c2 + gi * 37) % G2);
                pg8::gemm_phase<pg8::EpiBf16, pg8::StaticOrder, true, true>(C.lds, g, S, E);
            }
        }
        GSYNC();
#endif
        REFRESH();
        for (int it = C.gw; it < NITEM_P; it += C.NGW) gla_g3<false>(A, l, it, C.lds + C.wave * 17408, C.lane);
#ifdef SAMP_OLDPLACE
        if (C.gw < 64) gla_g3<true>(A, l, NITEM_P + C.gw, C.lds + C.wave * 17408, C.lane);
#endif
        __syncthreads();
#ifdef PROBE_SAMP
#pragma unroll 1
        for (int rep = 0; rep < 2; ++rep)
#endif
#ifndef NO_SAMP
        if (C.vcu >= C.G - 128 && C.vcu < C.G) { const int u = C.vcu - (C.G - 128); attn_sample_unit(A, C, u >> 3, u & 7); }
#endif
#ifndef NO_ATTN
#ifdef PROBE_ATTN2
        for (int rep = 0; rep < 2; ++rep)
#endif
        for (int u = C.vcu; u < 1024; u += C.G) {
            const int bh = (u % 256) >> 4, s = u & 15, i = u >> 8; const int qb = (i == 0) ? 63 - s : (i == 1) ? 32 + s : (i == 2) ? 31 - s : s;
            attn_prompt_unit(A, C, bh >> 3, bh & 7, qb); }
#endif
        GSYNC();
#ifndef NO_P6
        { pg8::EpiRes E{X, DM};
          pg8::Gemm g{(const pg8::bf16_t*)(ws + WS_H), (const pg8::bf16_t*)(ws + WS_WO), NTOK, DM, DM}; pg8::StaticOrder S; S.init(NTOK, DM, C.G, (int)blockIdx.x);
          pg8::gemm_phase<pg8::EpiRes, pg8::StaticOrder, true, true>(C.lds, g, S, E); }
        GSYNC();
#endif
        REFRESH();
#ifdef PROBE_THIN
        for (int rep = 0; rep < 2; ++rep)
#endif
        for (int mrow = C.gw; mrow < NTOK; mrow += C.NGW) norm_row(X + (size_t)mrow * DM, A.g_ffn + l * DM, (bf16*)(ws + WS_H) + (size_t)mrow * DM, nullptr, C.lane);
        GSYNC();
#ifndef NO_P8
#ifdef PROBE_P8
        for (int rep = 0; rep < 2; ++rep)
#endif
        { pg8::EpiSwiglu E{(pg8::bf16_t*)(ws + WS_ACT), DFF};
          pg8::Gemm g{(const pg8::bf16_t*)(ws + WS_H), (const pg8::bf16_t*)(ws + WS_WGU), NTOK, 2 * DFF, DM}; pg8::StaticOrder S; S.init(NTOK, 2 * DFF, C.G, (int)blockIdx.x);
          pg8::gemm_phase<pg8::EpiSwiglu, pg8::StaticOrder, true, true>(C.lds, g, S, E); }
        GSYNC();
#endif
#ifndef NO_P9
        { pg8::EpiRes E{X, DM};
          pg8::Gemm g{(const pg8::bf16_t*)(ws + WS_ACT), (const pg8::bf16_t*)(ws + WS_WD), NTOK, DM, DFF}; pg8::StaticOrder S; S.init(NTOK, DM, C.G, (int)blockIdx.x);
          pg8::gemm_phase<pg8::EpiRes, pg8::StaticOrder, true, true>(C.lds, g, S, E); }
        GSYNC();
#endif
    }
    REFRESH();
    for (int mrow = C.gw; mrow < NTOK; mrow += C.NGW) final_norm_row(X + (size_t)mrow * DM, A.g_final, C.lane);
}

extern "C" void kernel_launch(void* const* d_in, const int* in_sizes, int n_in, void* d_out, int out_size, void* d_ws, size_t ws_size, hipStream_t stream) {
    static int grid = 0;
    if (grid == 0) {
        if (n_in != 19 || (size_t)out_size != O_END || ws_size < WS_END) { fprintf(stderr, "kernel_launch: unexpected shapes: n_in %d out %d ws %zu (need %zu)\n", n_in, out_size, ws_size, (size_t)WS_END); grid = -1; return; }
        int dev = 0, cus = 0, per_cu = 0;
        hipGetDevice(&dev); hipDeviceGetAttribute(&cus, hipDeviceAttributeMultiprocessorCount, dev);
        if (hipFuncSetAttribute((const void*)fwd_mega, hipFuncAttributeMaxDynamicSharedMemorySize, LDS_BYTES) != hipSuccess) { fprintf(stderr, "kernel_launch: hipFuncSetAttribute failed\n"); grid = -1; return; }
        if (hipOccupancyMaxActiveBlocksPerMultiprocessor(&per_cu, (const void*)fwd_mega, 512, LDS_BYTES) != hipSuccess || per_cu < 1) { fprintf(stderr, "kernel_launch: occupancy query says %d\n", per_cu); per_cu = 1; }
        (void)hipGetLastError();
        grid = cus;
    }
    if (grid < 0) return;
    Args a{};
    a.xp = (const float*)d_in[0]; a.xs = (const float*)d_in[1]; a.cckv = (const float*)d_in[2]; a.ckr = (const float*)d_in[3]; a.sgla = (const float*)d_in[4];
    a.g_attn = (const float*)d_in[5]; a.w_in = (const float*)d_in[6]; a.g_qn = (const float*)d_in[7]; a.w_uq = (const float*)d_in[8]; a.g_kvn = (const float*)d_in[9];
    a.w_ukv = (const float*)d_in[10]; a.w_a2 = (const float*)d_in[11]; a.b_a2 = (const float*)d_in[12]; a.g_on = (const float*)d_in[13]; a.w_o = (const float*)d_in[14];
    a.g_ffn = (const float*)d_in[15]; a.w_gu = (const float*)d_in[16]; a.w_down = (const float*)d_in[17]; a.g_final = (const float*)d_in[18];
    a.out = (float*)d_out; a.ws = (unsigned char*)d_ws;
    if (hipMemsetAsync((char*)d_ws + WS_CTL, 0, CTL_BYTES, stream) != hipSuccess) { fprintf(stderr, "kernel_launch: memset failed\n"); return; }
    void* args[] = {&a};
    hipError_t e = hipLaunchCooperativeKernel((const void*)fwd_mega, dim3(grid), dim3(512), args, LDS_BYTES, stream);
    if (e != hipSuccess) fprintf(stderr, "kernel_launch: cooperative launch failed: %s (grid %d)\n", hipGetErrorString(e), grid);
}
```

```cpp
#include <hip/hip_runtime.h>
#include <hip/hip_cooperative_groups.h>
#include <cstdio>
#include <cstdint>
namespace cg = cooperative_groups;
namespace pg8 {
#define PG8_LAS __attribute__((address_space(3)))
typedef unsigned short bf16_t;
typedef short bf16x8 __attribute__((ext_vector_type(8)));
typedef float f32x4 __attribute__((ext_vector_type(4)));
typedef unsigned u32x4 __attribute__((ext_vector_type(4)));
constexpr int BM = 256, BK = 64, HALF = 128, HTB = HALF * BK * 2  , STAGE_BYTES = 8 * HTB, NXCD = 8, WGM = 8;

__host__ __device__ __forceinline__ int lds_byte(int r, int c) { const int st = (r >> 4) * 2 + (c >> 5), rr = r & 15, cc = c & 31, ob = rr * 64 + cc * 2; return st * 1024 + (ob ^ (((ob >> 9) & 1) << 5)); }
__host__ __device__ __forceinline__ void stage_rc(int b, int& R, int& C) { const int st = b / 1024, sb = b % 1024, swz = sb ^ (((sb >> 9) & 1) << 5); R = (st >> 1) * 16 + swz / 64; C = (st & 1) * 32 + (swz % 64) / 2; }
__host__ __device__ __forceinline__ int perm32(int rho) { const int n = rho >> 4, i = rho & 15; return 8 * (i >> 2) + 4 * n + (i & 3); }

struct Unit { int pm, pn; };
struct Gemm { const bf16_t* A; const bf16_t* Bt; int M, N, K; };

struct StaticOrder {
    int nM, nN, nwg, G, c;
    __host__ __device__ void init(int M, int N, int G_, int c_) { nM = M / BM; nN = N / BM; nwg = nM * nN; G = G_; c = c_; }
    __host__ __device__ bool next(int i, Unit& u) const {
        const long L = (long)i * G + c; if (L >= nwg) return false;
        int wgid = (int)L; { const int q = nwg / NXCD, r = nwg % NXCD, xcd = wgid % NXCD, off = wgid / NXCD; wgid = (xcd < r ? xcd * (q + 1) : r * (q + 1) + (xcd - r) * q) + off; }
        const int nig = WGM * nN, gid = wgid / nig, fm = gid * WGM, gsz = (nM - fm) < WGM ? (nM - fm) : WGM;
        u.pm = fm + ((wgid % nig) % gsz); u.pn = (wgid % nig) / gsz; return true;
    }
    __device__ __forceinline__ void a_ready(const Unit&) const {}
    __device__ __forceinline__ void done(const Unit&) const {}
};

__device__ __forceinline__ unsigned cvt_pk_bf16(float lo, float hi) { unsigned r; asm volatile("v_cvt_pk_bf16_f32 %0, %1, %2" : "=v"(r) : "v"(lo), "v"(hi)); return r; }
typedef float f32x2 __attribute__((ext_vector_type(2)));
typedef float f32x2m_t __attribute__((ext_vector_type(2))); typedef __bf16 bf16x2m_t __attribute__((ext_vector_type(2)));
__device__ __forceinline__ unsigned cvt_pk_m(float lo, float hi) { f32x2m_t v = {lo, hi}; bf16x2m_t b = __builtin_convertvector(v, bf16x2m_t); return __builtin_bit_cast(unsigned, b); }
struct EpiBf16 {
    static constexpr bool PERM = true, AFTER_DRAIN = false;
    bf16_t* O; int ldc; int split_cols; size_t split_stride;
    __device__ __forceinline__ void operator()(const f32x4 (&acc)[2][2][4][2], const Unit& u, int wr, int wc, int fr, int fq) const {
        const int row0 = u.pm * BM + wr * 64 + fr; int colt = u.pn * BM; bf16_t* base = O;
        if (split_cols) { const int t = colt / split_cols; base += (size_t)t * split_stride; colt -= t * split_cols; }
        const int col0 = colt + wc * 32 + 8 * fq;
#pragma unroll
        for (int ai = 0; ai < 2; ++ai)
#pragma unroll
            for (int m = 0; m < 4; ++m) { bf16_t* rowp = base + (size_t)(row0 + ai * HALF + m * 16) * ldc + col0;
#pragma unroll
                for (int bj = 0; bj < 2; ++bj) { const f32x4 v0 = acc[ai][bj][m][0], v1 = acc[ai][bj][m][1];
                    u32x4 w; w.x = cvt_pk_m(v0[0], v0[1]); w.y = cvt_pk_m(v0[2], v0[3]); w.z = cvt_pk_m(v1[0], v1[1]); w.w = cvt_pk_m(v1[2], v1[3]);
                    *(u32x4*)(rowp + bj * HALF) = w; } }
    }
};
struct EpiSwiglu {
    static constexpr bool PERM = true, AFTER_DRAIN = false;
    bf16_t* O; int ldc;
    __device__ __forceinline__ void operator()(const f32x4 (&acc)[2][2][4][2], const Unit& u, int wr, int wc, int fr, int fq) const {
        const int row0 = u.pm * BM + wr * 64 + fr; const int col0 = u.pn * HALF + wc * 32 + 8 * fq;
#pragma unroll
        for (int ai = 0; ai < 2; ++ai)
#pragma unroll
            for (int m = 0; m < 4; ++m) { bf16_t* rowp = O + (size_t)(row0 + ai * HALF + m * 16) * ldc + col0;
                float r[8];
#pragma unroll
                for (int n = 0; n < 2; ++n)
#pragma unroll
                    for (int i = 0; i < 4; ++i) { const float a = acc[ai][0][m][n][i], uu = acc[ai][1][m][n][i];
                        r[n * 4 + i] = a * __builtin_amdgcn_rcpf(1.0f + __expf(-a)) * uu; }
                u32x4 w; w.x = cvt_pk_m(r[0], r[1]); w.y = cvt_pk_m(r[2], r[3]); w.z = cvt_pk_m(r[4], r[5]); w.w = cvt_pk_m(r[6], r[7]);
                *(u32x4*)rowp = w; }
    }
};
struct EpiRes {
    static constexpr bool PERM = false, AFTER_DRAIN = false;
    float* X; int ldc;
    __device__ __forceinline__ void operator()(const f32x4 (&acc)[2][2][4][2], const Unit& u, int wr, int wc, int fr, int fq) const {
        const int col0 = u.pn * BM + wc * 32 + 4 * fq;
#pragma unroll
        for (int ai = 0; ai < 2; ++ai)
#pragma unroll
            for (int m = 0; m < 4; ++m) { float* rowp = X + (size_t)(u.pm * BM + ai * HALF + wr * 64 + m * 16 + fr) * ldc + col0;
#pragma unroll
                for (int bj = 0; bj < 2; ++bj)
#pragma unroll
                    for (int n = 0; n < 2; ++n) { f32x4* p = (f32x4*)(rowp + bj * HALF + n * 16); *p = *p + acc[ai][bj][m][n]; }
                asm volatile("" ::: "memory"); }
    }
};
struct EpiNone {
    static constexpr bool PERM = false, AFTER_DRAIN = false;
    float* sink;
    __device__ __forceinline__ void operator()(const f32x4 (&acc)[2][2][4][2], const Unit& u, int wr, int wc, int fr, int fq) const {
        float t = 0.f;
#pragma unroll
        for (int ai = 0; ai < 2; ++ai)
#pragma unroll
            for (int bj = 0; bj < 2; ++bj)
#pragma unroll
                for (int m = 0; m < 4; ++m)
#pragma unroll
                    for (int n = 0; n < 2; ++n) t += acc[ai][bj][m][n][0] + acc[ai][bj][m][n][1] + acc[ai][bj][m][n][2] + acc[ai][bj][m][n][3];
        if (t == 123456.789f) sink[0] = t;
    }
};
template <class Epi, class Sched, bool ALIGN_EPI = false, bool SP2 = false>
__device__ __forceinline__ void gemm_phase(PG8_LAS unsigned char* lds, const Gemm g, const Sched& S, const Epi& E) {
    int tid_ = threadIdx.x; asm volatile("" : "+v"(tid_));
    const int tid = tid_, wid = __builtin_amdgcn_readfirstlane(tid >> 6), lane = tid & 63, wr = wid >> 2, wc = wid & 3, fr = lane & 15, fq = lane >> 4;
    const int K = g.K, nt = K / BK;
    unsigned voffA[2], voffB[2];
#pragma unroll
    for (int i = 0; i < 2; ++i) { int R, C; stage_rc(tid * 16 + i * 8192, R, C); const int Rb = Epi::PERM ? ((R & ~31) + perm32(R & 31)) : R;
        voffA[i] = (unsigned)(R * K + C) * 2u; voffB[i] = (unsigned)(Rb * K + C) * 2u; }
    const size_t kstep = (size_t)(BK * 2);
    const size_t hstep = (size_t)HALF * K * 2;
    const size_t tstep = 2 * hstep;
    const unsigned ldsw = (unsigned)wid * 1024u;
    const int aoff = lds_byte(wr * 64 + fr, fq * 8), boff = lds_byte(wc * 32 + fr, fq * 8);
#define PG8_SA(b, h) (((b) * 2 + (h)) * HTB)
#define PG8_SB(b, h) ((4 + (b) * 2 + (h)) * HTB)
#define PG8_STAGE(bufoff, gbase, voff) do { _Pragma("unroll") for (int _i = 0; _i < 2; ++_i) \
        __builtin_amdgcn_global_load_lds((const unsigned*)((const char*)(gbase) + (voff)[_i]), (PG8_LAS unsigned*)(lds + (bufoff) + ldsw + _i * 8192), 16, 0, 0); } while (0)
#define PG8_LDA(dst, b, h) do { _Pragma("unroll") for (int m = 0; m < 4; ++m) _Pragma("unroll") for (int k = 0; k < 2; ++k) dst[m][k] = *(const PG8_LAS bf16x8*)(lds + PG8_SA(b, h) + aoff + m * 2048 + k * 1024); } while (0)
#define PG8_LDB(dst, b, h) do { _Pragma("unroll") for (int n = 0; n < 2; ++n) _Pragma("unroll") for (int k = 0; k < 2; ++k) dst[n][k] = *(const PG8_LAS bf16x8*)(lds + PG8_SB(b, h) + boff + n * 2048 + k * 1024); } while (0)
#define PG8_MMA(ai, bj, At, Bt) do { __builtin_amdgcn_s_setprio(1); _Pragma("unroll") for (int m = 0; m < 4; ++m) _Pragma("unroll") for (int n = 0; n < 2; ++n) _Pragma("unroll") for (int k = 0; k < 2; ++k) \
        acc[ai][bj][m][n] = __builtin_amdgcn_mfma_f32_16x16x32_bf16(Bt[n][k], At[m][k], acc[ai][bj][m][n], 0, 0, 0); __builtin_amdgcn_s_setprio(0); } while (0)
#define PG8_WAIT_V(n) asm volatile("s_waitcnt vmcnt(" #n ")" ::: "memory")
#define PG8_WAIT_L(n) asm volatile("s_waitcnt lgkmcnt(" #n ")" ::: "memory")
#define PG8_BAR __builtin_amdgcn_s_barrier()
#define PG8_SCHED __builtin_amdgcn_sched_barrier(0)
    Unit cur, nxt; int ui = 0;
    if (!S.next(0, cur)) return;
    f32x4 acc[2][2][4][2];
#pragma unroll
    for (int a = 0; a < 2; ++a)
#pragma unroll
        for (int b = 0; b < 2; ++b)
#pragma unroll
            for (int m = 0; m < 4; ++m)
#pragma unroll
                for (int n = 0; n < 2; ++n) acc[a][b][m][n] = (f32x4){0.f, 0.f, 0.f, 0.f};
    bf16x8 At[4][2], B0[2][2], B1[2][2];
    const char* cA = (const char*)g.A + (size_t)cur.pm * tstep; const char* cB = (const char*)g.Bt + (size_t)cur.pn * tstep;
    S.a_ready(cur);
    if constexpr (SP2) {
        PG8_STAGE(PG8_SB(0, 0), cB, voffB); PG8_STAGE(PG8_SB(0, 1), cB + hstep, voffB); PG8_STAGE(PG8_SA(0, 0), cA, voffA); PG8_STAGE(PG8_SA(0, 1), cA + hstep, voffA);
        if (wr == 1) PG8_BAR;
        PG8_WAIT_V(2); PG8_BAR;
        PG8_STAGE(PG8_SB(1, 0), cB + kstep, voffB); PG8_STAGE(PG8_SA(1, 0), cA + kstep, voffA); PG8_STAGE(PG8_SB(1, 1), cB + hstep + kstep, voffB);
        PG8_WAIT_V(6); PG8_BAR;
    } else {
        PG8_STAGE(PG8_SB(0, 0), cB, voffB); PG8_STAGE(PG8_SA(0, 0), cA, voffA); PG8_STAGE(PG8_SB(0, 1), cB + hstep, voffB); PG8_STAGE(PG8_SA(0, 1), cA + hstep, voffA);
        if (wr == 1) PG8_BAR;
        PG8_WAIT_V(4); PG8_BAR;
        PG8_STAGE(PG8_SB(1, 0), cB + kstep, voffB); PG8_STAGE(PG8_SA(1, 0), cA + kstep, voffA); PG8_STAGE(PG8_SB(1, 1), cB + hstep + kstep, voffB);
        PG8_WAIT_V(6); PG8_BAR;
    }
    for (;;) {
        const bool has_next = S.next(ui + 1, nxt);
        const char* nA = has_next ? (const char*)g.A + (size_t)nxt.pm * tstep : cA; const char* nB = has_next ? (const char*)g.Bt + (size_t)nxt.pn * tstep : cB;
        for (int t = 0; t < nt; t += 2) {
            const bool last = (t == nt - 2);
            const char* a1 = cA + (size_t)(t + 1) * kstep;
            const char* a2 = last ? nA : cA + (size_t)(t + 2) * kstep; const char* b2 = last ? nB : cB + (size_t)(t + 2) * kstep;
            const char* a3 = a2 + kstep; const char* b3 = b2 + kstep;
            if (last && has_next) S.a_ready(nxt);
            if constexpr (SP2) {
            PG8_LDB(B0, 0, 0); PG8_LDB(B1, 0, 1); PG8_SCHED; PG8_LDA(At, 0, 0); PG8_STAGE(PG8_SA(1, 1), a1 + hstep, voffA);
            PG8_WAIT_V(8); PG8_WAIT_L(0); PG8_BAR; PG8_MMA(0, 0, At, B0); PG8_MMA(0, 1, At, B1); PG8_BAR; PG8_SCHED;
            PG8_LDA(At, 0, 1); PG8_STAGE(PG8_SB(0, 0), b2, voffB); PG8_STAGE(PG8_SB(0, 1), b2 + hstep, voffB); PG8_STAGE(PG8_SA(0, 0), a2, voffA);
            PG8_WAIT_V(8); PG8_WAIT_L(0); PG8_BAR; PG8_MMA(1, 0, At, B0); PG8_MMA(1, 1, At, B1); PG8_BAR; PG8_SCHED;
            PG8_LDB(B0, 1, 0); PG8_LDB(B1, 1, 1); PG8_SCHED; PG8_LDA(At, 1, 0); PG8_STAGE(PG8_SA(0, 1), a2 + hstep, voffA);
            PG8_WAIT_V(8); PG8_WAIT_L(0); PG8_BAR; PG8_MMA(0, 0, At, B0); PG8_MMA(0, 1, At, B1); PG8_BAR; PG8_SCHED;
            PG8_LDA(At, 1, 1); PG8_STAGE(PG8_SB(1, 0), b3, voffB); PG8_STAGE(PG8_SB(1, 1), b3 + hstep, voffB); PG8_STAGE(PG8_SA(1, 0), a3, voffA);
            PG8_WAIT_V(8); PG8_WAIT_L(0); PG8_BAR; PG8_MMA(1, 0, At, B0); PG8_MMA(1, 1, At, B1); PG8_BAR; PG8_SCHED;
            } else {
            PG8_LDB(B0, 0, 0); PG8_SCHED; PG8_LDA(At, 0, 0); PG8_STAGE(PG8_SA(1, 1), a1 + hstep, voffA);
            PG8_WAIT_L(8); PG8_BAR; PG8_WAIT_L(0); PG8_MMA(0, 0, At, B0); PG8_BAR; PG8_SCHED;
            PG8_LDB(B1, 0, 1); PG8_STAGE(PG8_SB(0, 0), b2, voffB);
            PG8_BAR; PG8_WAIT_L(0); PG8_MMA(0, 1, At, B1); PG8_BAR;
            PG8_LDA(At, 0, 1); PG8_STAGE(PG8_SA(0, 0), a2, voffA);
            PG8_BAR; PG8_WAIT_L(0); PG8_MMA(1, 0, At, B0); PG8_BAR; PG8_SCHED;
            PG8_STAGE(PG8_SB(0, 1), b2 + hstep, voffB);
            PG8_WAIT_V(6); PG8_BAR; PG8_MMA(1, 1, At, B1); PG8_BAR;
            PG8_LDB(B0, 1, 0); PG8_SCHED; PG8_LDA(At, 1, 0); PG8_STAGE(PG8_SA(0, 1), a2 + hstep, voffA);
            PG8_WAIT_L(8); PG8_BAR; PG8_WAIT_L(0); PG8_MMA(0, 0, At, B0); PG8_BAR; PG8_SCHED;
            PG8_LDB(B1, 1, 1); PG8_STAGE(PG8_SB(1, 0), b3, voffB);
            PG8_BAR; PG8_WAIT_L(0); PG8_MMA(0, 1, At, B1); PG8_BAR;
            PG8_LDA(At, 1, 1); PG8_STAGE(PG8_SA(1, 0), a3, voffA);
            PG8_BAR; PG8_WAIT_L(0); PG8_MMA(1, 0, At, B0); PG8_BAR; PG8_SCHED;
            PG8_STAGE(PG8_SB(1, 1), b3 + hstep, voffB);
            PG8_WAIT_V(6); PG8_BAR; PG8_MMA(1, 1, At, B1); PG8_BAR;
            }
        }
        if constexpr (ALIGN_EPI) { if (wr == 0) PG8_BAR; }
        if constexpr (!Epi::AFTER_DRAIN) { E(acc, cur, wr, wc, fr, fq); S.done(cur); }
        if (!has_next) break;
#pragma unroll
        for (int a = 0; a < 2; ++a)
#pragma unroll
            for (int b = 0; b < 2; ++b)
#pragma unroll
                for (int m = 0; m < 4; ++m)
#pragma unroll
                    for (int n = 0; n < 2; ++n) acc[a][b][m][n] = (f32x4){0.f, 0.f, 0.f, 0.f};
        cur = nxt; cA = nA; cB = nB; ++ui;
        if constexpr (ALIGN_EPI) { if (wr == 1) PG8_BAR; }
    }
    PG8_WAIT_V(0);
    if constexpr (!ALIGN_EPI) { if (wr == 0) PG8_BAR; }
    PG8_BAR;
    if constexpr (Epi::AFTER_DRAIN) { E.fused(acc, cur, wr, wc, fr, fq, lds, wid, lane); S.done(cur); }
#undef PG8_SA
#undef PG8_SB
#undef PG8_STAGE
#undef PG8_LDA
#undef PG8_LDB
#undef PG8_MMA
#undef PG8_WAIT_V
#undef PG8_WAIT_L
#undef PG8_BAR
#undef PG8_SCHED
}
}
constexpr int DM = 1024, SEQ = 16384, NBATCH = 2, NP = NBATCH * SEQ, DEC_B = 16, DEC_T = 32, PAST = 2048, SKV = PAST + DEC_T;
constexpr int NSQ = DEC_B * DEC_T, NTOK = NP + NSQ, NKVS = DEC_B * SKV;
constexpr int DFF = 2816, INW = 2096, DEPTH = 2;
constexpr float EPS = 1e-6f;
constexpr float QSCALE = 0.10206207261596575f * 1.4426950408889634f;
constexpr int NITEM_P = NBATCH * 256 * 4, NITEM = NITEM_P + DEC_B * 4;

typedef unsigned short bf16;
typedef short bf16x8 __attribute__((ext_vector_type(8)));
typedef float f32x4 __attribute__((ext_vector_type(4)));
typedef float f32x16 __attribute__((ext_vector_type(16)));
typedef unsigned u32x4 __attribute__((ext_vector_type(4)));
typedef unsigned u32x2 __attribute__((ext_vector_type(2)));
#define LAS __attribute__((address_space(3)))

constexpr size_t T256 = (size_t)NTOK * 256 * 2;
constexpr size_t al(size_t x) { return (x + 4095) & ~(size_t)4095; }
constexpr size_t WS_CTL = 0, CTL_BYTES = 65536;
constexpr size_t WS_ROPE = 65536;
constexpr size_t WS_GA = al(WS_ROPE + (size_t)SEQ * 32 * 4);
constexpr size_t WS_DECAY = al(WS_GA + (size_t)NTOK * 16 * 4);
constexpr size_t WS_WIN = al(WS_DECAY + (size_t)NITEM * 64 * 4);
constexpr size_t WS_WGV = al(WS_WIN + (size_t)1792 * 1024 * 2);
constexpr size_t WS_WUQ = al(WS_WGV + (size_t)512 * 1024 * 2);
constexpr size_t WS_WUK = al(WS_WUQ + (size_t)768 * 256 * 2);
constexpr size_t WS_WUV = al(WS_WUK + (size_t)512 * 256 * 2);
constexpr size_t WS_WO = al(WS_WUV + (size_t)512 * 256 * 2);
constexpr size_t WS_WGU = al(WS_WO + (size_t)1024 * 1024 * 2);
constexpr size_t WS_WD = al(WS_WGU + (size_t)5632 * 1024 * 2);
constexpr size_t WS_H = al(WS_WD + (size_t)1024 * 2816 * 2);
constexpr size_t WS_Z = al(WS_H + (size_t)NTOK * 1024 * 2);
constexpr size_t WS_GVT = al(WS_Z + 7 * T256);
constexpr size_t WS_CQN = al(WS_GVT + (size_t)512 * NTOK * 2);
constexpr size_t WS_CKVN = al(WS_CQN + T256);
constexpr size_t WS_CKVS = al(WS_CKVN + (size_t)NP * 256 * 2);
constexpr size_t WS_KR = al(WS_CKVS + (size_t)NKVS * 256 * 2);
constexpr size_t WS_KRS = al(WS_KR + (size_t)NP * 32 * 2);
constexpr size_t WS_KN = al(WS_KRS + (size_t)NKVS * 32 * 2);
constexpr size_t WS_VT = al(WS_KN + (size_t)NP * 512 * 2);
constexpr size_t WS_KNS = al(WS_VT + (size_t)512 * NP * 2);
constexpr size_t WS_VTS = al(WS_KNS + (size_t)NKVS * 512 * 2);
constexpr size_t WS_DS = al(WS_VTS + (size_t)512 * NKVS * 2);
constexpr size_t WS_END = al(WS_DS + (size_t)NITEM_P * 8192 * 4);
constexpr size_t WS_ACT = WS_Z;
static_assert(WS_ACT + (size_t)NTOK * DFF * 2 <= WS_END, "ACT overlay");
static_assert(WS_END <= (size_t)536870912, "ws budget");

constexpr size_t O_Y = 0, O_CKVP = (size_t)NTOK * DM, O_KRP = O_CKVP + (size_t)DEPTH * NP * 256, O_GLAP = O_KRP + (size_t)DEPTH * NP * 32,
                 O_CKVS = O_GLAP + (size_t)DEPTH * NBATCH * 4 * 8192, O_KRS = O_CKVS + (size_t)DEPTH * NSQ * 256, O_GLAS = O_KRS + (size_t)DEPTH * NSQ * 32,
                 O_END = O_GLAS + (size_t)DEPTH * DEC_B * 4 * 8192;

constexpr int LDS_BYTES = 147456;

struct Args {
    const float *xp, *xs, *cckv, *ckr, *sgla, *g_attn, *w_in, *g_qn, *w_uq, *g_kvn, *w_ukv, *w_a2, *b_a2, *g_on, *w_o, *g_ffn, *w_gu, *w_down, *g_final;
    float* out; unsigned char* ws;
};

__device__ __forceinline__ unsigned f2bf(float f) { unsigned u = __builtin_bit_cast(unsigned, f); return (u + 0x7fffu + ((u >> 16) & 1u)) >> 16; }
__device__ __forceinline__ unsigned pk2(float lo, float hi) { return f2bf(lo) | (f2bf(hi) << 16); }
__device__ __forceinline__ float bf2f(unsigned short b) { return __builtin_bit_cast(float, (unsigned)b << 16); }
__device__ __forceinline__ float bflo(unsigned w) { return __builtin_bit_cast(float, w << 16); }
__device__ __forceinline__ float bfhi(unsigned w) { return __builtin_bit_cast(float, w & 0xffff0000u); }
__device__ __forceinline__ float wave_sum(float v) {
#pragma unroll
    for (int o = 1; o < 64; o <<= 1) v += __shfl_xor(v, o);
    return v;
}
__device__ __forceinline__ int crow(int r, int hi) { return (r & 3) + 8 * (r >> 2) + 4 * hi; }
__device__ __forceinline__ float logsig(float x) { return fminf(x, 0.f) - __logf(1.0f + __expf(-fabsf(x))); }
#define LDS_WAIT() asm volatile("s_waitcnt lgkmcnt(0)" ::: "memory")
#define MFMA32(a, b, c) __builtin_amdgcn_mfma_f32_32x32x16_bf16((a), (b), (c), 0, 0, 0)
__device__ __forceinline__ f32x16 zero16() { float z = 0.f; asm volatile("" : "+v"(z)); f32x16 v;
#pragma unroll
    for (int r = 0; r < 16; ++r) v[r] = z;
    return v; }

struct Ctx {
    int tid, lane, wave, G, vcu, gw, NGW;
    LAS unsigned char* lds;
};

__device__ __forceinline__ void tr_item(const float* W, int K, int N, int k0, int src0, int nvalid, bf16* WT, int dst_row0, float scale, LAS float* scr, int lane) {
#pragma unroll 8
    for (int i = 0; i < 32; ++i) { const int kk = 2 * i + (lane >> 5), c = lane & 31;
        float v = 0.f; if (c < nvalid) v = W[(size_t)(k0 + kk) * N + src0 + c] * scale;
        scr[kk * 33 + c] = v; }
    LDS_WAIT(); asm volatile("" ::: "memory");
    const int c8 = lane & 7;
#pragma unroll
    for (int j = 0; j < 4; ++j) { const int n = (lane >> 3) + 8 * j; const LAS float* s = scr + (8 * c8) * 33 + n;
        u32x4 o; o.x = pk2(s[0 * 33], s[1 * 33]); o.y = pk2(s[2 * 33], s[3 * 33]); o.z = pk2(s[4 * 33], s[5 * 33]); o.w = pk2(s[6 * 33], s[7 * 33]);
        *(u32x4*)(WT + (size_t)(dst_row0 + n) * K + k0 + 8 * c8) = o; }
    LDS_WAIT(); asm volatile("" ::: "memory");
}
__device__ __forceinline__ void convert_weights(const Ctx& C, const Args& A, int l) {
    LAS float* scr = (LAS float*)(C.lds + C.wave * 16384);
    unsigned char* ws = A.ws;
    const float* w_in = A.w_in + (size_t)l * DM * INW; const float* w_uq = A.w_uq + (size_t)l * 256 * 768; const float* w_ukv = A.w_ukv + (size_t)l * 256 * 1024;
    const float* w_o = A.w_o + (size_t)l * DM * DM; const float* w_gu = A.w_gu + (size_t)l * DM * 2 * DFF; const float* w_d = A.w_down + (size_t)l * DFF * DM;
    constexpr int I0 = 56 * 16, I1 = 16 * 16, I2 = 24 * 4, I3 = 16 * 4, I4 = 16 * 4, I5 = 32 * 16, I6 = 176 * 16, I7 = 32 * 44;
    constexpr int NIT = I0 + I1 + I2 + I3 + I4 + I5 + I6 + I7;
    for (int it = C.gw; it < NIT; it += C.NGW) {
        int r = it;
        if (r < I0) { const int db = r >> 4, kb = r & 15; int src = 0, nv = 32;
            if (db < 16) src = 32 * db; else if (db == 16) src = 512; else if (db == 17) { src = 2080; nv = 16; } else if (db < 24) { src = 0; nv = 0; }
            else if (db < 32) src = 544 + 32 * (db - 24); else if (db < 40) src = 800 + 32 * (db - 32); else src = 1568 + 32 * (db - 40);
            tr_item(w_in, DM, INW, 64 * kb, src, nv, (bf16*)(ws + WS_WIN), 32 * db, 1.f, scr, C.lane); continue; } r -= I0;
        if (r < I1) { const int db = r >> 4, kb = r & 15; tr_item(w_in, DM, INW, 64 * kb, 1056 + 32 * db, 32, (bf16*)(ws + WS_WGV), 32 * db, 1.f, scr, C.lane); continue; } r -= I1;
        if (r < I2) { const int db = r >> 2, kb = r & 3; tr_item(w_uq, 256, 768, 64 * kb, 32 * db, 32, (bf16*)(ws + WS_WUQ), 32 * db, QSCALE, scr, C.lane); continue; } r -= I2;
        if (r < I3) { const int db = r >> 2, kb = r & 3; tr_item(w_ukv, 256, 1024, 64 * kb, (db >> 1) * 128 + (db & 1) * 32, 32, (bf16*)(ws + WS_WUK), 32 * db, 1.f, scr, C.lane); continue; } r -= I3;
        if (r < I4) { const int db = r >> 2, kb = r & 3; tr_item(w_ukv, 256, 1024, 64 * kb, (db >> 1) * 128 + 64 + (db & 1) * 32, 32, (bf16*)(ws + WS_WUV), 32 * db, 1.f, scr, C.lane); continue; } r -= I4;
        if (r < I5) { const int db = r >> 4, kb = r & 15; tr_item(w_o, DM, DM, 64 * kb, 32 * db, 32, (bf16*)(ws + WS_WO), 32 * db, 1.f, scr, C.lane); continue; } r -= I5;
        if (r < I6) { const int db = r >> 4, kb = r & 15; const int pn = db >> 3, t = db & 7; const int src = (t < 4) ? 128 * pn + 32 * t : DFF + 128 * pn + 32 * (t - 4);
            tr_item(w_gu, DM, 2 * DFF, 64 * kb, src, 32, (bf16*)(ws + WS_WGU), 32 * db, 1.f, scr, C.lane); continue; } r -= I6;
        { const int db = r / 44, kb = r % 44; tr_item(w_d, DFF, DM, 64 * kb, 32 * db, 32, (bf16*)(ws + WS_WD), 32 * db, 1.f, scr, C.lane); }
    }
}

__device__ __forceinline__ void norm_row(const float* xrow, const float* g, bf16* orow, float* copy, int lane) {
    const f32x4* xr = (const f32x4*)xrow + lane; const f32x4* gr = (const f32x4*)g + lane;
    f32x4 v[4]; float s = 0.f;
#pragma unroll
    for (int j = 0; j < 4; ++j) { v[j] = xr[64 * j]; s += (v[j].x * v[j].x + v[j].y * v[j].y) + (v[j].z * v[j].z + v[j].w * v[j].w); }
    const float rstd = 1.0f / sqrtf(wave_sum(s) * (1.f / DM) + EPS);
    if (copy) {
#pragma unroll
        for (int j = 0; j < 4; ++j) ((f32x4*)copy + lane)[64 * j] = v[j]; }
    u32x2* o8 = (u32x2*)orow + lane;
#pragma unroll
    for (int j = 0; j < 4; ++j) { const f32x4 gg = gr[64 * j]; u32x2 w; w.x = pk2(v[j].x * rstd * gg.x, v[j].y * rstd * gg.y); w.y = pk2(v[j].z * rstd * gg.z, v[j].w * rstd * gg.w); o8[64 * j] = w; }
}
__device__ __forceinline__ void final_norm_row(float* xrow, const float* g, int lane) {
    f32x4* xr = (f32x4*)xrow + lane; const f32x4* gr = (const f32x4*)g + lane;
    f32x4 v[4]; float s = 0.f;
#pragma unroll
    for (int j = 0; j < 4; ++j) { v[j] = xr[64 * j]; s += (v[j].x * v[j].x + v[j].y * v[j].y) + (v[j].z * v[j].z + v[j].w * v[j].w); }
    const float rstd = 1.0f / sqrtf(wave_sum(s) * (1.f / DM) + EPS);
#pragma unroll
    for (int j = 0; j < 4; ++j) { const f32x4 gg = gr[64 * j]; xr[64 * j] = v[j] * rstd * gg; }
}

__device__ __forceinline__ void p3_token(const Args& A, int l, int m, int lane) {
    unsigned char* ws = A.ws;
    const bf16* CQ = (const bf16*)(ws + WS_Z); const bf16* CKV = (const bf16*)(ws + WS_Z + T256); const bf16* MISC = (const bf16*)(ws + WS_Z + 2 * T256);
    const float* ROPE = (const float*)(ws + WS_ROPE);
    { const u32x2 w = *((const u32x2*)(CQ + (size_t)m * 256) + lane); const float a = bflo(w.x), b = bfhi(w.x), c = bflo(w.y), d = bfhi(w.y);
      const float rstd = 1.0f / sqrtf(wave_sum((a * a + b * b) + (c * c + d * d)) * (1.f / 256) + EPS);
      const f32x4 g = *((const f32x4*)(A.g_qn + l * 256) + lane);
      u32x2 o; o.x = pk2(a * rstd * g.x, b * rstd * g.y); o.y = pk2(c * rstd * g.z, d * rstd * g.w);
      *((u32x2*)((bf16*)(ws + WS_CQN) + (size_t)m * 256) + lane) = o; }
    int pos; float* ockv; float* okr; bf16* bckv; bf16* bkr;
    if (m < NP) { pos = m & (SEQ - 1); ockv = A.out + O_CKVP + ((size_t)l * NP + m) * 256; okr = A.out + O_KRP + ((size_t)l * NP + m) * 32;
        bckv = (bf16*)(ws + WS_CKVN) + (size_t)m * 256; bkr = (bf16*)(ws + WS_KR) + (size_t)m * 32; }
    else { const int s = m - NP, b = s >> 5, t = s & 31; pos = PAST + t; ockv = A.out + O_CKVS + ((size_t)l * NSQ + s) * 256; okr = A.out + O_KRS + ((size_t)l * NSQ + s) * 32;
        const size_t r = (size_t)b * SKV + PAST + t; bckv = (bf16*)(ws + WS_CKVS) + r * 256; bkr = (bf16*)(ws + WS_KRS) + r * 32; }
    { const u32x2 w = *((const u32x2*)(CKV + (size_t)m * 256) + lane); const float a = bflo(w.x), b = bfhi(w.x), c = bflo(w.y), d = bfhi(w.y);
      const float rstd = 1.0f / sqrtf(wave_sum((a * a + b * b) + (c * c + d * d)) * (1.f / 256) + EPS);
      const f32x4 g = *((const f32x4*)(A.g_kvn + l * 256) + lane);
      const f32x4 o = (f32x4){a * rstd * g.x, b * rstd * g.y, c * rstd * g.z, d * rstd * g.w};
      *((f32x4*)ockv + lane) = o;
      u32x2 ob; ob.x = pk2(o.x, o.y); ob.y = pk2(o.z, o.w); *((u32x2*)bckv + lane) = ob; }
    if (lane < 16) { const float x1 = bf2f(MISC[(size_t)m * 256 + lane]), x2 = bf2f(MISC[(size_t)m * 256 + 16 + lane]);
        const float c = ROPE[pos * 32 + lane], s = ROPE[pos * 32 + 16 + lane];
        const float o1 = x1 * c - x2 * s, o2 = x1 * s + x2 * c;
        okr[lane] = o1; okr[16 + lane] = o2; bkr[lane] = (bf16)f2bf(o1); bkr[16 + lane] = (bf16)f2bf(o2); }
    else if (lane < 32) { ((float*)(ws + WS_GA))[(size_t)m * 16 + (lane - 16)] = bf2f(MISC[(size_t)m * 256 + 32 + (lane - 16)]); }
}
__device__ __forceinline__ void cache_row(const Args& A, int l, int r, int lane) {
    const int b = r >> 11, p = r & (PAST - 1); const size_t dr = (size_t)b * SKV + p;
    const f32x4 v = *((const f32x4*)(A.cckv + ((size_t)l * DEC_B * PAST + r) * 256) + lane);
    u32x2 o; o.x = pk2(v.x, v.y); o.y = pk2(v.z, v.w); *((u32x2*)((bf16*)(A.ws + WS_CKVS) + dr * 256) + lane) = o;
    if (lane < 32) ((bf16*)(A.ws + WS_KRS))[dr * 32 + lane] = (bf16)f2bf(A.ckr[((size_t)l * DEC_B * PAST + r) * 32 + lane]);
}

struct GlaItem { int tok0, L, hd, sb; bool sample; };
__device__ __forceinline__ GlaItem gla_decode(int it) {
    GlaItem g;
    if (it < NITEM_P) { g.hd = it & 3; const int bc = it >> 2; g.tok0 = bc * 64; g.L = 64; g.sample = false; g.sb = 0; }
    else { const int j = it - NITEM_P; g.hd = j & 3; g.sb = j >> 2; g.tok0 = NP + g.sb * 32; g.L = 32; g.sample = true; }
    return g;
}
typedef float f32x2_t __attribute__((ext_vector_type(2))); typedef __bf16 bf16x2_t __attribute__((ext_vector_type(2)));
__device__ __forceinline__ unsigned cvtpk(float lo, float hi) { f32x2_t v = {lo, hi}; bf16x2_t b = __builtin_convertvector(v, bf16x2_t); return __builtin_bit_cast(unsigned, b); }
__device__ __forceinline__ float gate_lg(const float (&ga)[16], const float (&w)[16], float bias, int p, const float* g_GA_base) {
    float x = bias;
#ifdef GA_OLD
    const float* gp = g_GA_base + (size_t)p * 16;
#pragma unroll
    for (int r = 0; r < 16; ++r) x += gp[r] * w[r];
#else
#pragma unroll
    for (int r = 0; r < 16; ++r) x += __builtin_bit_cast(float, __builtin_amdgcn_readlane(__builtin_bit_cast(int, ga[r]), p)) * w[r];
#endif
    return logsig(x) * (1.f / 16.f);
}
constexpr int KT_PITCH = 72;
template <bool SAMPLE> __device__ __forceinline__ void gla_g1(const Args& A, int l, int it, LAS unsigned char* wl, int lane) {
    const GlaItem g = gla_decode(it); unsigned char* ws = A.ws; constexpr int L = SAMPLE ? 32 : 64;
    const int col = g.hd * 64 + lane, r32 = lane & 31, hi = lane >> 5;
    const float* GA = (const float*)(ws + WS_GA); const bf16* GK = (const bf16*)(ws + WS_Z + 4 * T256); const bf16* GVT = (const bf16*)(ws + WS_GVT);
    LAS bf16* kT = (LAS bf16*)wl; LAS float* dsm = (LAS float*)(wl + 64 * KT_PITCH * 2);
    float w[16], ga[16];
#pragma unroll
    for (int r = 0; r < 16; ++r) w[r] = A.w_a2[(size_t)l * 16 * 256 + r * 256 + col];
    const float bias = A.b_a2[l * 256 + col];
    { const int pl = lane < L ? lane : L - 1;
#pragma unroll
      for (int q = 0; q < 4; ++q) { const f32x4 v = *(const f32x4*)(GA + (size_t)(g.tok0 + pl) * 16 + 4 * q); ga[4 * q] = v.x; ga[4 * q + 1] = v.y; ga[4 * q + 2] = v.z; ga[4 * q + 3] = v.w; } }
    float blast = 0.f;
#pragma unroll 4
    for (int p = 0; p < L; ++p) blast += gate_lg(ga, w, bias, p, GA + (size_t)g.tok0 * 16);
    float bc = 0.f;
#pragma unroll 16
    for (int p = 0; p < L; ++p) { bc += gate_lg(ga, w, bias, p, GA + (size_t)g.tok0 * 16);
        const float kk = bf2f(GK[(size_t)(g.tok0 + p) * 256 + col]) * __expf(blast - bc);
        kT[lane * KT_PITCH + p] = (bf16)(cvtpk(kk, kk) & 0xffffu); }
    const float decay = __expf(blast);
    if (!SAMPLE) ((float*)(ws + WS_DECAY))[(size_t)it * 64 + lane] = decay;
    dsm[lane] = decay;
    LDS_WAIT(); asm volatile("" ::: "memory");
#pragma unroll 1
    for (int nb = 0; nb < 4; ++nb) {
        f32x16 acc[2]; acc[0] = (f32x16){}; acc[1] = (f32x16){};
#pragma unroll
        for (int s = 0; s < L / 16; ++s) {
            const bf16x8 bfr = *(const bf16x8*)(GVT + (size_t)(g.hd * 128 + 32 * nb + r32) * NTOK + g.tok0 + 16 * s + 8 * hi);
#pragma unroll
            for (int mb = 0; mb < 2; ++mb) { const bf16x8 af = *(const LAS bf16x8*)(kT + (32 * mb + r32) * KT_PITCH + 16 * s + 8 * hi); acc[mb] = MFMA32(af, bfr, acc[mb]); }
        }
        const int dv = 32 * nb + r32;
#ifdef DS_OLD
        if (!SAMPLE) { float* dsp = (float*)(ws + WS_DS) + (size_t)it * 8192 + dv;
#pragma unroll
            for (int mb = 0; mb < 2; ++mb)
#pragma unroll
                for (int r = 0; r < 16; ++r) dsp[(32 * mb + crow(r, hi)) * 128] = acc[mb][r]; }
#else
        if (!SAMPLE) { float* dsp = (float*)(ws + WS_DS) + (size_t)it * 8192 + dv * 64 + 4 * hi;
#pragma unroll
            for (int mb = 0; mb < 2; ++mb)
#pragma unroll
                for (int q = 0; q < 4; ++q) *(f32x4*)(dsp + 32 * mb + 8 * q) = (f32x4){acc[mb][4 * q], acc[mb][4 * q + 1], acc[mb][4 * q + 2], acc[mb][4 * q + 3]}; }
#endif
        else { const size_t so = (((size_t)l * DEC_B + g.sb) * 4 + g.hd) * 8192 + dv;
#pragma unroll
            for (int mb = 0; mb < 2; ++mb) {
#pragma unroll
                for (int r = 0; r < 16; ++r) { const int dk = 32 * mb + crow(r, hi); A.out[O_GLAS + so + dk * 128] = dsm[dk] * A.sgla[so + dk * 128] + acc[mb][r]; }
                asm volatile("" ::: "memory"); } }
    }
    LDS_WAIT(); asm volatile("" ::: "memory");
}
constexpr int NSCAN = 64, NSAMPWG = 8;
#ifdef DS_OLD
__device__ __forceinline__ void gla_scan(const Args& A, int l, int sblock, int tid) {
    const int gth = sblock * 512 + tid;
    const int seq = gth >> 12, e0 = (gth & 4095) * 2;
    const int b = seq >> 2, hd = seq & 3, dk = e0 >> 7;
    float* DS = (float*)(A.ws + WS_DS); const float* DEC = (const float*)(A.ws + WS_DECAY);
    float s0 = 0.f, s1 = 0.f;
    for (int c0 = 0; c0 < 256; c0 += 8) {
        float2 ds[8]; float dc[8];
#pragma unroll
        for (int j = 0; j < 8; ++j) { const size_t it = (size_t)((b * 256 + c0 + j) * 4 + hd); ds[j] = *(const float2*)(DS + it * 8192 + e0); dc[j] = DEC[it * 64 + dk]; }
#pragma unroll
        for (int j = 0; j < 8; ++j) { const size_t it = (size_t)((b * 256 + c0 + j) * 4 + hd); *(float2*)(DS + it * 8192 + e0) = make_float2(s0, s1);
            s0 = dc[j] * s0 + ds[j].x; s1 = dc[j] * s1 + ds[j].y; }
    }
    *(float2*)(A.out + O_GLAP + (((size_t)l * NBATCH + b) * 4 + hd) * 8192 + e0) = make_float2(s0, s1);
}
#else
__device__ __forceinline__ void gla_scan(const Args& A, int l, int sblock, int tid) {
    const int gth = sblock * 512 + tid;
    const int seq = gth >> 12, e0 = (gth & 4095) * 2;
    const int b = seq >> 2, hd = seq & 3, dv = e0 >> 6, dk = e0 & 63;
    float* DS = (float*)(A.ws + WS_DS); const float* DEC = (const float*)(A.ws + WS_DECAY);
    float s0 = 0.f, s1 = 0.f;
#pragma unroll 1
    for (int c0 = 0; c0 < 256; c0 += 16) {
        float2 ds[16], dc[16];
#pragma unroll
        for (int j = 0; j < 16; ++j) { const size_t it = (size_t)((b * 256 + c0 + j) * 4 + hd); ds[j] = *(const float2*)(DS + it * 8192 + e0); dc[j] = *(const float2*)(DEC + it * 64 + dk); }
#pragma unroll
        for (int j = 0; j < 16; ++j) { const size_t it = (size_t)((b * 256 + c0 + j) * 4 + hd); *(float2*)(DS + it * 8192 + e0) = make_float2(s0, s1);
            s0 = dc[j].x * s0 + ds[j].x; s1 = dc[j].y * s1 + ds[j].y; }
    }
    float* o = A.out + O_GLAP + (((size_t)l * NBATCH + b) * 4 + hd) * 8192;
    o[dk * 128 + dv] = s0; o[(dk + 1) * 128 + dv] = s1;
}
#endif
constexpr int BS_PITCH = 65;
template <bool SAMPLE> __device__ __forceinline__ void gla_g3(const Args& A, int l, int it, LAS unsigned char* wl, int lane) {
    const GlaItem g = gla_decode(it); unsigned char* ws = A.ws; constexpr int L = SAMPLE ? 32 : 64, NIB = L / 32;
    const int col = g.hd * 64 + lane, r32 = lane & 31, hi = lane >> 5;
    const float* GA = (const float*)(ws + WS_GA); const bf16* GQ = (const bf16*)(ws + WS_Z + 3 * T256); const bf16* GK = (const bf16*)(ws + WS_Z + 4 * T256);
    const bf16* GG = (const bf16*)(ws + WS_Z + 5 * T256); const bf16* GVT = (const bf16*)(ws + WS_GVT); bf16* CAT = (bf16*)(ws + WS_H);
    LAS float* bsm = (LAS float*)wl;
    {   float w[16], ga[16];
#pragma unroll
        for (int r = 0; r < 16; ++r) w[r] = A.w_a2[(size_t)l * 16 * 256 + r * 256 + col];
        const float bias = A.b_a2[l * 256 + col];
        { const int pl = lane < L ? lane : L - 1;
#pragma unroll
          for (int q = 0; q < 4; ++q) { const f32x4 v = *(const f32x4*)(GA + (size_t)(g.tok0 + pl) * 16 + 4 * q); ga[4 * q] = v.x; ga[4 * q + 1] = v.y; ga[4 * q + 2] = v.z; ga[4 * q + 3] = v.w; } }
        float bc = 0.f;
#pragma unroll 4
        for (int p = 0; p < L; ++p) { bc += gate_lg(ga, w, bias, p, GA + (size_t)g.tok0 * 16); bsm[p * BS_PITCH + lane] = bc; }
    }
    LDS_WAIT(); asm volatile("" ::: "memory");
    bf16x8 qf[NIB][4], kf[NIB][4];
#pragma unroll
    for (int ib = 0; ib < NIB; ++ib)
#pragma unroll
        for (int s = 0; s < 4; ++s) {
            const int i = 32 * ib + r32, dk0 = 16 * s + 8 * hi;
            const u32x4 rq = *(const u32x4*)(GQ + (size_t)(g.tok0 + i) * 256 + g.hd * 64 + dk0);
            const u32x4 rk = *(const u32x4*)(GK + (size_t)(g.tok0 + i) * 256 + g.hd * 64 + dk0);
            u32x4 oq, ok;
#pragma unroll
            for (int jj = 0; jj < 4; ++jj) { const float b0 = bsm[i * BS_PITCH + dk0 + 2 * jj], b1 = bsm[i * BS_PITCH + dk0 + 2 * jj + 1];
                const float e0 = __expf(b0), e1 = __expf(b1);
                oq[jj] = cvtpk(bflo(rq[jj]) * 0.125f * e0, bfhi(rq[jj]) * 0.125f * e1);
                ok[jj] = cvtpk(bflo(rk[jj]) * __builtin_amdgcn_rcpf(e0), bfhi(rk[jj]) * __builtin_amdgcn_rcpf(e1)); }
            qf[ib][s] = __builtin_bit_cast(bf16x8, oq); kf[ib][s] = __builtin_bit_cast(bf16x8, ok);
        }
    bf16x8 xp[NIB][NIB][2];
#pragma unroll
    for (int jb = 0; jb < NIB; ++jb)
#pragma unroll
        for (int ib = 0; ib < NIB; ++ib) {
            if (jb > ib) { xp[jb][ib][0] = (bf16x8){}; xp[jb][ib][1] = (bf16x8){}; continue; }
            f32x16 X = (f32x16){};
#pragma unroll
            for (int s = 0; s < 4; ++s) X = MFMA32(kf[jb][s], qf[ib][s], X);
            if (jb == ib) {
#pragma unroll
                for (int r = 0; r < 16; ++r) if (crow(r, hi) > r32) X[r] = 0.f; }
#pragma unroll
            for (int s2 = 0; s2 < 2; ++s2) { u32x4 pw;
#pragma unroll
                for (int jj = 0; jj < 4; ++jj) pw[jj] = cvtpk(X[8 * s2 + 2 * jj], X[8 * s2 + 2 * jj + 1]);
                xp[jb][ib][s2] = __builtin_bit_cast(bf16x8, pw); }
        }
    const float* Sp = SAMPLE ? A.sgla + (((size_t)l * DEC_B + g.sb) * 4 + g.hd) * 8192 : (const float*)(ws + WS_DS) + (size_t)it * 8192;
#pragma unroll
    for (int ib = 0; ib < NIB; ++ib) {
        f32x16 o[4];
#pragma unroll
        for (int nb = 0; nb < 4; ++nb) {
            const int dv = 32 * nb + r32;
            o[nb] = (f32x16){};
#pragma unroll
            for (int s = 0; s < 4; ++s) { u32x4 pw;
#ifdef DS_OLD
                if (true) {
#else
                if (SAMPLE) {
#endif
#pragma unroll
                    for (int jj = 0; jj < 4; ++jj) pw[jj] = cvtpk(Sp[(16 * s + 8 * hi + 2 * jj) * 128 + dv], Sp[(16 * s + 8 * hi + 2 * jj + 1) * 128 + dv]); }
                else { const f32x4 sa = *(const f32x4*)(Sp + dv * 64 + 16 * s + 8 * hi), sb = *(const f32x4*)(Sp + dv * 64 + 16 * s + 8 * hi + 4);
                    pw = (u32x4){cvtpk(sa.x, sa.y), cvtpk(sa.z, sa.w), cvtpk(sb.x, sb.y), cvtpk(sb.z, sb.w)}; }
                o[nb] = MFMA32(__builtin_bit_cast(bf16x8, pw), qf[ib][s], o[nb]); }
#pragma unroll
            for (int jb = 0; jb <= ib; ++jb)
#pragma unroll
                for (int s2 = 0; s2 < 2; ++s2) { const bf16* vp = GVT + (size_t)(g.hd * 128 + dv) * NTOK + g.tok0 + 32 * jb + 16 * s2 + 4 * hi;
                    const u32x2 lo = *(const u32x2*)vp, hi8 = *(const u32x2*)(vp + 8);
                    o[nb] = MFMA32(__builtin_bit_cast(bf16x8, (u32x4){lo.x, lo.y, hi8.x, hi8.y}), xp[jb][ib][s2], o[nb]); }
        }
        float ss = 0.f;
#pragma unroll
        for (int nb = 0; nb < 4; ++nb)
#pragma unroll
            for (int r = 0; r < 16; ++r) ss += o[nb][r] * o[nb][r];
        ss += __shfl_xor(ss, 32);
        const float rstd = 1.0f / sqrtf(ss * (1.f / 128) + EPS);
        const int tok = g.tok0 + 32 * ib + r32;
#pragma unroll
        for (int nb = 0; nb < 4; ++nb)
#pragma unroll
            for (int q = 0; q < 4; ++q) { const int dv0 = 32 * nb + 8 * q + 4 * hi; const int gc = g.hd * 128 + dv0;
                const u32x2 gw = *(const u32x2*)(GG + (size_t)(gc >> 8) * ((size_t)NTOK * 256) + (size_t)tok * 256 + (gc & 255));
                const f32x4 gon = *(const f32x4*)(A.g_on + l * 128 + dv0);
                const float g0 = bflo(gw.x), g1 = bfhi(gw.x), g2 = bflo(gw.y), g3 = bfhi(gw.y);
                const float v0 = o[nb][4 * q + 0] * rstd * gon.x * g0 * __builtin_amdgcn_rcpf(1.0f + __expf(-g0));
                const float v1 = o[nb][4 * q + 1] * rstd * gon.y * g1 * __builtin_amdgcn_rcpf(1.0f + __expf(-g1));
                const float v2 = o[nb][4 * q + 2] * rstd * gon.z * g2 * __builtin_amdgcn_rcpf(1.0f + __expf(-g2));
                const float v3 = o[nb][4 * q + 3] * rstd * gon.w * g3 * __builtin_amdgcn_rcpf(1.0f + __expf(-g3));
                u32x2 ow; ow.x = cvtpk(v0, v1); ow.y = cvtpk(v2, v3);
                *(u32x2*)(CAT + (size_t)tok * 1024 + 512 + g.hd * 128 + dv0) = ow; }
        asm volatile("" ::: "memory");
    }
    LDS_WAIT(); asm volatile("" ::: "memory");
}

__device__ __forceinline__ float max3f(float a, float b, float c) { return fmaxf(fmaxf(a, b), c); }
constexpr float ATT_THR = 8.0f;
template <class LD> __device__ __forceinline__ void attn_tile(const LD& ld, const bf16x8 (&qr)[6], f32x16 (&o)[2], float& m, float& l, bool half_only, bool first) {
    f32x16 negm;
#pragma unroll
    for (int r = 0; r < 16; ++r) negm[r] = -m;
    f32x16 p0 = negm, p1 = negm;
#pragma unroll
    for (int s = 0; s < 6; ++s) p0 = MFMA32(ld.k(0, s), qr[s], p0);
    if (!half_only) {
#pragma unroll
        for (int s = 0; s < 6; ++s) p1 = MFMA32(ld.k(1, s), qr[s], p1); }
    float mx = max3f(p0[0], p0[1], p0[2]);
#pragma unroll
    for (int r = 3; r < 15; r += 2) mx = max3f(mx, p0[r], p0[r + 1]);
    mx = fmaxf(mx, p0[15]);
    if (!half_only) {
#pragma unroll
        for (int r = 0; r < 16; r += 2) mx = max3f(mx, p1[r], p1[r + 1]); }
    mx = fmaxf(mx, __shfl_xor(mx, 32));
    if (first || __any(mx > ATT_THR)) {
        const float d = first ? mx : fmaxf(mx, 0.f);
        m += d;
        const float f = first ? 0.f : __builtin_amdgcn_exp2f(-d);
        l *= f;
#pragma unroll
        for (int r = 0; r < 16; ++r) { p0[r] -= d; p1[r] -= d; o[0][r] *= f; o[1][r] *= f; }
    }
    float rs = 0.f, rs1 = 0.f;
#pragma unroll
    for (int r = 0; r < 16; ++r) { p0[r] = __builtin_amdgcn_exp2f(p0[r]); rs += p0[r]; }
    if (!half_only) {
#pragma unroll
        for (int r = 0; r < 16; ++r) { p1[r] = __builtin_amdgcn_exp2f(p1[r]); rs1 += p1[r]; } }
    l += rs + rs1;
    bf16x8 pa[4];
#pragma unroll
    for (int s = 0; s < 2; ++s) { u32x4 w0, w1;
#pragma unroll
        for (int jj = 0; jj < 4; ++jj) { w0[jj] = cvtpk(p0[8 * s + 2 * jj], p0[8 * s + 2 * jj + 1]); w1[jj] = cvtpk(p1[8 * s + 2 * jj], p1[8 * s + 2 * jj + 1]); }
        pa[s] = __builtin_bit_cast(bf16x8, w0); pa[2 + s] = __builtin_bit_cast(bf16x8, w1); }
#pragma unroll
    for (int db = 0; db < 2; ++db) {
#pragma unroll
        for (int s = 0; s < 2; ++s) o[db] = MFMA32(ld.v(db, s), pa[s], o[db]);
        if (!half_only) {
#pragma unroll
            for (int s = 2; s < 4; ++s) o[db] = MFMA32(ld.v(db, s), pa[s], o[db]); }
    }
}
constexpr int K_PITCH = 208, V_PITCH = 136, KBUF = 64 * K_PITCH, VBUF = 64 * V_PITCH, ABUF = KBUF + VBUF;
struct LdsLoader {
    LAS const unsigned char* kb; LAS const unsigned char* vb; int r32, hi;
    __device__ __forceinline__ bf16x8 k(int half, int s) const { return *(LAS const bf16x8*)(kb + (r32 + 32 * half) * K_PITCH + s * 32 + hi * 16); }
    __device__ __forceinline__ bf16x8 v(int db, int s) const { LAS const unsigned char* p = vb + (r32 + 32 * db) * V_PITCH + s * 32 + hi * 8;
        const u32x2 lo = *(LAS const u32x2*)p, h8 = *(LAS const u32x2*)(p + 16); return __builtin_bit_cast(bf16x8, (u32x4){lo.x, lo.y, h8.x, h8.y}); }
};
struct GlbLoader {
    const bf16* kn; const bf16* kr; const bf16* vt; int r32, hi;
    __device__ __forceinline__ bf16x8 k(int half, int s) const { const int kv = r32 + 32 * half;
        return (s < 4) ? *(const bf16x8*)(kn + (size_t)kv * 512 + 16 * s + 8 * hi) : *(const bf16x8*)(kr + (size_t)kv * 32 + 16 * (s - 4) + 8 * hi); }
    __device__ __forceinline__ bf16x8 v(int db, int s) const { const bf16* p = vt + (size_t)(r32 + 32 * db) * NKVS + 16 * s + 4 * hi;
        const u32x2 lo = *(const u32x2*)p, h8 = *(const u32x2*)(p + 8); return __builtin_bit_cast(bf16x8, (u32x4){lo.x, lo.y, h8.x, h8.y}); }
};
__device__ __forceinline__ void load_q(bf16x8 (&qr)[6], const bf16* qp, const float* rope_row, int hi) {
#pragma unroll
    for (int s = 0; s < 6; ++s) qr[s] = *(const bf16x8*)(qp + 16 * s + 8 * hi);
    const u32x4 a = __builtin_bit_cast(u32x4, qr[4]), b = __builtin_bit_cast(u32x4, qr[5]); u32x4 oa, ob;
    const f32x4 c0 = *(const f32x4*)(rope_row + 8 * hi), c1 = *(const f32x4*)(rope_row + 8 * hi + 4), s0 = *(const f32x4*)(rope_row + 16 + 8 * hi), s1 = *(const f32x4*)(rope_row + 16 + 8 * hi + 4);
#pragma unroll
    for (int jj = 0; jj < 4; ++jj) {
        const float x1l = bflo(a[jj]), x1h = bfhi(a[jj]), x2l = bflo(b[jj]), x2h = bfhi(b[jj]);
        const float cl = (jj < 2) ? c0[2 * jj] : c1[2 * jj - 4], ch = (jj < 2) ? c0[2 * jj + 1] : c1[2 * jj - 3];
        const float sl = (jj < 2) ? s0[2 * jj] : s1[2 * jj - 4], sh = (jj < 2) ? s0[2 * jj + 1] : s1[2 * jj - 3];
        oa[jj] = pk2(x1l * cl - x2l * sl, x1h * ch - x2h * sh); ob[jj] = pk2(x1l * sl + x2l * cl, x1h * sh + x2h * ch); }
    qr[4] = __builtin_bit_cast(bf16x8, oa); qr[5] = __builtin_bit_cast(bf16x8, ob);
}
__device__ __forceinline__ float halfmax(float x) { auto rr = __builtin_amdgcn_permlane32_swap(__float_as_uint(x), __float_as_uint(x), false, false); return fmaxf(__uint_as_float(rr[0]), __uint_as_float(rr[1])); }
__device__ __forceinline__ float halfsum(float x) { auto rr = __builtin_amdgcn_permlane32_swap(__float_as_uint(x), __float_as_uint(x), false, false); return __uint_as_float(rr[0]) + __uint_as_float(rr[1]); }
__device__ __forceinline__ float rowmax32(const f32x16& c0, const f32x16& c1) {
    float mx = max3f(c0[0], c0[1], c0[2]);
#pragma unroll
    for (int r = 3; r < 15; r += 2) mx = max3f(mx, c0[r], c0[r + 1]);
    mx = fmaxf(mx, c0[15]);
#pragma unroll
    for (int r = 0; r < 16; r += 2) mx = max3f(mx, c1[r], c1[r + 1]);
    return halfmax(mx);
}
__device__ __forceinline__ void attn_qk(const LdsLoader& ld, const bf16x8 (&qr)[6], float m, f32x16& c0, f32x16& c1) {
    f32x16 negm;
#pragma unroll
    for (int r = 0; r < 16; ++r) negm[r] = -m;
    c0 = negm; c1 = negm;
#pragma unroll
    for (int s = 0; s < 6; ++s) { c0 = MFMA32(ld.k(0, s), qr[s], c0); c1 = MFMA32(ld.k(1, s), qr[s], c1); }
}
__device__ __forceinline__ void attn_prompt_unit(const Args& A, const Ctx& C, int b, int hd, int qb) {
    int tid_ = threadIdx.x; asm volatile("" : "+v"(tid_));
    unsigned char* ws = A.ws; const int tid = tid_, lane = tid & 63, wid = C.wave, r32 = lane & 31, hi = lane >> 5;
    const bf16* Q = (const bf16*)(ws + WS_Z); const bf16* KN = (const bf16*)(ws + WS_KN); const bf16* KR = (const bf16*)(ws + WS_KR); const bf16* VT = (const bf16*)(ws + WS_VT);
    bf16* CAT = (bf16*)(ws + WS_H); const float* ROPE = (const float*)(ws + WS_ROPE);
    const int pos = qb * 256 + wid * 32 + r32; const size_t qrow = (size_t)b * SEQ + pos;
    bf16x8 qr[6]; load_q(qr, Q + qrow * 768 + hd * 96, ROPE + (size_t)pos * 32, hi);
    const int ntiles = 4 * qb + 4, my_last = 4 * qb + (wid >> 1);
    const int krow = tid >> 3, kch = tid & 7, rrow = (tid & 255) >> 2, rch = tid & 3;
    const char* kn_base = (const char*)(KN + (size_t)b * SEQ * 512 + hd * 64); const char* kr_base = (const char*)(KR + (size_t)b * SEQ * 32);
    const char* vt_base = (const char*)(VT + (size_t)(hd * 64) * NP + (size_t)b * SEQ);
    const unsigned kn_off = (unsigned)(krow * 512 + kch * 8) * 2u, kr_off = (unsigned)(rrow * 32 + rch * 8) * 2u, vt_off = (unsigned)(krow * NP + kch * 8) * 2u;
    const int kn_dst = krow * K_PITCH + kch * 16, kr_dst = rrow * K_PITCH + 128 + rch * 16, vt_dst = KBUF + krow * V_PITCH + kch * 16;
    u32x4 sk, sr, sv;
#define ATT_GLOAD(tt) do { sk = *(const u32x4*)(kn_base + (size_t)(tt) * (64 * 512 * 2) + kn_off); sv = *(const u32x4*)(vt_base + (size_t)(tt) * 128 + vt_off); if (tid < 256) sr = *(const u32x4*)(kr_base + (size_t)(tt) * (64 * 32 * 2) + kr_off); } while (0)
#define ATT_LSTORE(slot_) do { LAS unsigned char* bufp = C.lds + (slot_) * ABUF; *(LAS u32x4*)(bufp + kn_dst) = sk; if (tid < 256) *(LAS u32x4*)(bufp + kr_dst) = sr; \
        *(LAS u32x2*)(bufp + vt_dst) = (u32x2){sv.x, sv.y}; *(LAS u32x2*)(bufp + vt_dst + 8) = (u32x2){sv.z, sv.w}; } while (0)
    ATT_GLOAD(0); ATT_LSTORE(0); ATT_GLOAD(1); ATT_LSTORE(1);
    __syncthreads();
    f32x16 o[2]; o[0] = zero16(); o[1] = zero16(); float m = o[0][0], l = m;
    f32x16 c0, c1;
    { const LdsLoader ld0{C.lds, C.lds + KBUF, r32, hi}; attn_qk(ld0, qr, m, c0, c1); }
    int slot = 0;
    for (int t = 0; t < ntiles; ++t) {
        const int s1 = (slot == 2) ? 0 : slot + 1, s2 = (s1 == 2) ? 0 : s1 + 1;
        const bool more = (t + 2 < ntiles);
        if (more) ATT_GLOAD(t + 2);
        if (t <= my_last) {
            bf16x8 kf[12];
            { const LdsLoader ldn{C.lds + s1 * ABUF, C.lds + s1 * ABUF + KBUF, r32, hi};
#pragma unroll
              for (int s = 0; s < 6; ++s) { kf[2 * s] = ldn.k(0, s); kf[2 * s + 1] = ldn.k(1, s); } }
            const float mx = rowmax32(c0, c1);
            const bool first = (t == 0);
            if (first || __any(mx > ATT_THR)) {
                const float d = first ? mx : fmaxf(mx, 0.f);
                m += d; const float f = first ? 0.f : __builtin_amdgcn_exp2f(-d); l *= f;
#pragma unroll
                for (int r = 0; r < 16; ++r) { c0[r] -= d; c1[r] -= d; o[0][r] *= f; o[1][r] *= f; }
            }
            f32x16 n0, n1;
            { f32x16 negm;
#pragma unroll
              for (int r = 0; r < 16; ++r) negm[r] = -m;
              n0 = negm; n1 = negm;
#pragma unroll
              for (int s = 0; s < 6; ++s) { n0 = MFMA32(kf[2 * s], qr[s], n0); n1 = MFMA32(kf[2 * s + 1], qr[s], n1); } }
            float rs0 = 0.f, rs1 = 0.f;
#pragma unroll
            for (int r = 0; r < 16; ++r) { c0[r] = __builtin_amdgcn_exp2f(c0[r]); rs0 += c0[r]; c1[r] = __builtin_amdgcn_exp2f(c1[r]); rs1 += c1[r]; }
            l += rs0 + rs1;
            bf16x8 pa[4];
#pragma unroll
            for (int s = 0; s < 2; ++s) { u32x4 w0, w1;
#pragma unroll
                for (int jj = 0; jj < 4; ++jj) { w0[jj] = cvtpk(c0[8 * s + 2 * jj], c0[8 * s + 2 * jj + 1]); w1[jj] = cvtpk(c1[8 * s + 2 * jj], c1[8 * s + 2 * jj + 1]); }
                pa[s] = __builtin_bit_cast(bf16x8, w0); pa[2 + s] = __builtin_bit_cast(bf16x8, w1); }
            { const LdsLoader ldv{C.lds + slot * ABUF, C.lds + slot * ABUF + KBUF, r32, hi};
#pragma unroll
              for (int s = 0; s < 4; ++s) { o[0] = MFMA32(ldv.v(0, s), pa[s], o[0]); o[1] = MFMA32(ldv.v(1, s), pa[s], o[1]); } }
            c0 = n0; c1 = n1;
#ifdef ATT_SGB
#pragma unroll
            for (int i = 0; i < 20; ++i) { __builtin_amdgcn_sched_group_barrier(0x008, 1, 0); __builtin_amdgcn_sched_group_barrier(0x100, 2, 0); __builtin_amdgcn_sched_group_barrier(0x002, 4, 0); }
#endif
        }
        if (more) ATT_LSTORE(s2);
        slot = s1;
        __syncthreads();
    }
#undef ATT_GLOAD
#undef ATT_LSTORE
    const float lt = halfsum(l); const float inv = 1.0f / lt;
    bf16* orow = CAT + qrow * 1024 + hd * 64;
#pragma unroll
    for (int db = 0; db < 2; ++db)
#pragma unroll
        for (int q = 0; q < 4; ++q) { u32x2 w; w.x = cvtpk(o[db][4 * q] * inv, o[db][4 * q + 1] * inv); w.y = cvtpk(o[db][4 * q + 2] * inv, o[db][4 * q + 3] * inv);
            *(u32x2*)(orow + 32 * db + 8 * q + 4 * hi) = w; }
}
__device__ __forceinline__ void attn_sample_unit(const Args& A, const Ctx& C, int b, int hd) {
    unsigned char* ws = A.ws; const int tid = C.tid, lane = C.lane, wid = C.wave, r32 = lane & 31, hi = lane >> 5;
    const bf16* Q = (const bf16*)(ws + WS_Z); const bf16* KNS = (const bf16*)(ws + WS_KNS); const bf16* KRS = (const bf16*)(ws + WS_KRS); const bf16* VTS = (const bf16*)(ws + WS_VTS);
    bf16* CAT = (bf16*)(ws + WS_H); const float* ROPE = (const float*)(ws + WS_ROPE);
    const size_t qrow = (size_t)NP + b * 32 + r32;
    bf16x8 qr[6]; load_q(qr, Q + qrow * 768 + hd * 96, ROPE + (size_t)(PAST + r32) * 32, hi);
    f32x16 o[2]; o[0] = (f32x16){}; o[1] = (f32x16){}; float m = 0.f, l = 0.f;
    for (int t = wid; t < 33; t += 8) {
        const size_t key0 = (size_t)b * SKV + 64 * t;
        GlbLoader ld{KNS + key0 * 512 + hd * 64, KRS + key0 * 32, VTS + (size_t)(hd * 64) * NKVS + key0, r32, hi};
        attn_tile(ld, qr, o, m, l, t == 32, t == wid);
    }
    const float lt = l + __shfl_xor(l, 32);
    LAS float* cm = (LAS float*)C.lds; LAS float* cl = cm + 256; LAS float* co = cm + 512;
    if (hi == 0) { cm[wid * 32 + r32] = m; cl[wid * 32 + r32] = lt; }
#pragma unroll
    for (int db = 0; db < 2; ++db)
#pragma unroll
        for (int r = 0; r < 16; ++r) co[(wid * 64 + 32 * db + crow(r, hi)) * 32 + r32] = o[db][r];
    __syncthreads();
    { const int q = tid & 31, d0 = (tid >> 5) * 4;
      float M = cm[q];
#pragma unroll
      for (int w = 1; w < 8; ++w) M = fmaxf(M, cm[w * 32 + q]);
      float L = 0.f, acc[4] = {0.f, 0.f, 0.f, 0.f};
#pragma unroll
      for (int w = 0; w < 8; ++w) { const float f = __builtin_amdgcn_exp2f(cm[w * 32 + q] - M); L += cl[w * 32 + q] * f;
#pragma unroll
          for (int i = 0; i < 4; ++i) acc[i] += co[(w * 64 + d0 + i) * 32 + q] * f; }
      const float inv = 1.0f / L;
      u32x2 wv; wv.x = pk2(acc[0] * inv, acc[1] * inv); wv.y = pk2(acc[2] * inv, acc[3] * inv);
      *(u32x2*)(CAT + ((size_t)NP + b * 32 + q) * 1024 + hd * 64 + d0) = wv; }
    __syncthreads();
}

#define XB_TMO      128
#define XB_XCNT(j)  (256  + 64 * (j))
#define XB_XSUB(j)  (1280 + 64 * (j))
#define XB_XGEN(j)  (2304 + 64 * (j))
#define XB_TOP      3328
#define XB_TOPGEN   3392
#define XCD_BAR_WORDS 3456
#define XB_SPIN_CAP (1u << 23)

__device__ __forceinline__ unsigned xb_ld(unsigned* p)              { return __hip_atomic_load(p, __ATOMIC_RELAXED, __HIP_MEMORY_SCOPE_AGENT); }
__device__ __forceinline__ unsigned xb_add(unsigned* p, unsigned v) { return __hip_atomic_fetch_add(p, v, __ATOMIC_RELAXED, __HIP_MEMORY_SCOPE_AGENT); }
__device__ __forceinline__ unsigned xb_xcc_id() { return (unsigned)__builtin_amdgcn_s_getreg((3 << 11) | 20) & 0xFu; }
#define XB_SPIN(cond, bar) do { unsigned _sp = 0; while (cond) { __builtin_amdgcn_s_sleep(1); \
    if ((++_sp & 255u) == 0u) { if (xb_ld(&(bar)[XB_TMO])) break; if (_sp > XB_SPIN_CAP) { atomicAdd(&(bar)[XB_TMO], 1u); break; } } } } while (0)

struct XcdBarrier {
    unsigned* bar; unsigned x;
    volatile LAS unsigned* st;
};

__device__ __forceinline__ XcdBarrier xcd_barrier_post(unsigned* bar, volatile LAS unsigned* st) {
    XcdBarrier b; b.bar = bar; b.x = xb_xcc_id(); b.st = st;
    if (threadIdx.x == 0) (void)xb_add(&bar[XB_XCNT(b.x)], 1u);
    return b;
}
__device__ __forceinline__ void xcd_barrier_complete(unsigned* bar, unsigned x, unsigned& nloc, unsigned& nx) {
    const unsigned G = gridDim.x * gridDim.y * gridDim.z;
    unsigned sum, cnt, mine, sp = 0u;
    for (;;) {
        sum = 0u; cnt = 0u; mine = 0u;
#pragma unroll
        for (unsigned j = 0; j < 16; ++j) { const unsigned c = xb_ld(&bar[XB_XCNT(j)]); sum += c; cnt += (c > 0u) ? 1u : 0u; mine = (j == x) ? c : mine; }
        if (sum == G) break;
        __builtin_amdgcn_s_sleep(1);
        if ((++sp & 255u) == 0u) { if (xb_ld(&bar[XB_TMO])) break; if (sp > XB_SPIN_CAP) { atomicAdd(&bar[XB_TMO], 1u); break; } }
    }
    nloc = mine > 0u ? mine : 1u; nx = cnt > 0u ? cnt : 1u;
}

__device__ __forceinline__ void xcd_barrier(const XcdBarrier& b) {
    asm volatile("s_waitcnt vmcnt(0)" ::: "memory");
    __syncthreads();
    if (threadIdx.x == 0) {
        unsigned* bar = b.bar;
        __builtin_amdgcn_s_waitcnt(0);
        unsigned nloc = b.st[0], nx = b.st[1];
        if (nloc == 0u) { xcd_barrier_complete(bar, b.x, nloc, nx); b.st[0] = nloc; b.st[1] = nx; }
        const unsigned old = xb_add(&bar[XB_XSUB(b.x)], 1u);
        const unsigned gen = old / nloc;
        if (old + 1u == (gen + 1u) * nloc) {
            __builtin_amdgcn_fence(__ATOMIC_RELEASE, "agent");
            asm volatile("s_waitcnt vmcnt(0)" ::: "memory");
            const unsigned og = xb_add(&bar[XB_TOP], 1u);
            const unsigned tg = og / nx;
            if (og + 1u == (tg + 1u) * nx) xb_add(&bar[XB_TOPGEN], 1u);
            else XB_SPIN(xb_ld(&bar[XB_TOPGEN]) == tg, bar);
            __builtin_amdgcn_fence(__ATOMIC_ACQUIRE, "agent");
            xb_add(&bar[XB_XGEN(b.x)], 1u);
            asm volatile("s_waitcnt vmcnt(0)" ::: "memory");
        } else {
            XB_SPIN(xb_ld(&bar[XB_XGEN(b.x)]) == gen, bar);
            __builtin_amdgcn_fence(__ATOMIC_ACQUIRE, "agent");
            asm volatile("s_waitcnt vmcnt(0)" ::: "memory");
        }
    }
    __syncthreads();
}

__global__ void __launch_bounds__(512, 2) fwd_mega(Args A) {
    extern __shared__ __attribute__((aligned(16))) unsigned char lds_raw[];
    cg::grid_group grid = cg::this_grid();
    volatile LAS unsigned* bst = (volatile LAS unsigned*)((LAS unsigned char*)lds_raw + LDS_BYTES - 64);
    if (threadIdx.x < 16) bst[threadIdx.x] = 0u;
    __syncthreads();
    XcdBarrier xbar = xcd_barrier_post((unsigned*)(A.ws + WS_CTL), bst);
#ifdef PROBE_SYNC2
#define GSYNC() do { xcd_barrier(xbar); xcd_barrier(xbar); } while (0)
#else
#define GSYNC() xcd_barrier(xbar)
#endif
    Ctx C; C.lds = (LAS unsigned char*)lds_raw; C.tid = threadIdx.x; C.lane = C.tid & 63; C.wave = __builtin_amdgcn_readfirstlane(C.tid >> 6);
    C.G = gridDim.x; { const int bx = blockIdx.x; C.vcu = (C.G % 8 == 0) ? (bx % 8) * (C.G / 8) + bx / 8 : bx; }
    C.gw = blockIdx.x * 8 + C.wave; C.NGW = C.G * 8;
    unsigned char* ws = A.ws;
    float* X = A.out + O_Y;
    { float* ROPE = (float*)(ws + WS_ROPE);
      for (int e = blockIdx.x * 512 + C.tid; e < SEQ * 16; e += C.G * 512) { const int p = e >> 4, i = e & 15;
          const double base = (i & 3) == 0 ? 1.0 : (i & 3) == 1 ? 0.5623413251903491 : (i & 3) == 2 ? 0.31622776601683794 : 0.1778279410038923;
          const double sc = (i >> 2) == 0 ? 1.0 : (i >> 2) == 1 ? 0.1 : (i >> 2) == 2 ? 0.01 : 0.001;
          const float inv = (float)(base * sc); const float ang = (float)p * inv;
          const double rev = (double)ang * 0.15915494309189535; const float fr = (float)(rev - __builtin_rint(rev));
          ROPE[p * 32 + i] = __builtin_amdgcn_cosf(fr); ROPE[p * 32 + 16 + i] = __builtin_amdgcn_sinf(fr); } }
#define REFRESH() do { int t_ = threadIdx.x; asm volatile("" : "+v"(t_)); C.tid = t_; C.lane = t_ & 63; C.wave = __builtin_amdgcn_readfirstlane(t_ >> 6); C.gw = blockIdx.x * 8 + C.wave; } while (0)
#pragma unroll 1
    for (int l = 0; l < DEPTH; ++l) {
        REFRESH();
#ifdef PROBE_P1
        for (int rep = 0; rep < 2; ++rep) {
#endif
        convert_weights(C, A, l);
        for (int mrow = C.gw; mrow < NTOK; mrow += C.NGW) {
            const float* xr = (l == 0) ? (mrow < NP ? A.xp + (size_t)mrow * DM : A.xs + (size_t)(mrow - NP) * DM) : X + (size_t)mrow * DM;
            norm_row(xr, A.g_attn + l * DM, (bf16*)(ws + WS_H) + (size_t)mrow * DM, (l == 0) ? X + (size_t)mrow * DM : nullptr, C.lane); }
        for (int r = C.gw; r < DEC_B * PAST; r += C.NGW) cache_row(A, l, r, C.lane);
#ifdef PROBE_P1
        }
#endif
        if (l == 0) grid.sync(); else GSYNC();
#ifndef NO_P2
#ifdef PROBE_P2
        for (int rep = 0; rep < 2; ++rep) {
#endif
        { pg8::EpiBf16 E{(pg8::bf16_t*)(ws + WS_Z), 256, 256, (size_t)NTOK * 256};
          pg8::Gemm g{(const pg8::bf16_t*)(ws + WS_H), (const pg8::bf16_t*)(ws + WS_WIN), NTOK, 1792, DM}; pg8::StaticOrder S; S.init(NTOK, 1792, C.G, (int)blockIdx.x);
          pg8::gemm_phase<pg8::EpiBf16, pg8::StaticOrder, true, true>(C.lds, g, S, E); }
        { pg8::EpiBf16 E{(pg8::bf16_t*)(ws + WS_GVT), NTOK, 0, 0};
          pg8::Gemm g{(const pg8::bf16_t*)(ws + WS_WGV), (const pg8::bf16_t*)(ws + WS_H), 512, NTOK, DM}; pg8::StaticOrder S; S.init(512, NTOK, C.G, (int)((blockIdx.x + 146) % C.G));
          pg8::gemm_phase<pg8::EpiBf16, pg8::StaticOrder, true, true>(C.lds, g, S, E); }
#ifdef PROBE_P2
        }
#endif
        GSYNC();
#endif
        REFRESH();
#ifdef PROBE_THIN
        for (int rep = 0; rep < 2; ++rep)
#endif
        for (int mrow = C.gw; mrow < NTOK; mrow += C.NGW) p3_token(A, l, mrow, C.lane);
        GSYNC();
        for (int it = C.gw; it < NITEM_P; it += C.NGW) gla_g1<false>(A, l, it, C.lds + C.wave * 16384, C.lane);
#ifdef SAMP_OLDPLACE
        if (C.gw < 64) gla_g1<true>(A, l, NITEM_P + C.gw, C.lds + C.wave * 16384, C.lane);
#endif
        GSYNC();
#ifndef NO_P4
        if ((int)blockIdx.x < NSCAN) gla_scan(A, l, blockIdx.x, C.tid);
#ifndef SAMP_OLDPLACE
        else if ((int)blockIdx.x < NSCAN + NSAMPWG) { const int it = NITEM_P + ((int)blockIdx.x - NSCAN) * 8 + C.wave;
            gla_g1<true>(A, l, it, C.lds + C.wave * 17408, C.lane); gla_g3<true>(A, l, it, C.lds + C.wave * 17408, C.lane); }
#else
        else if ((int)blockIdx.x < NSCAN + NSAMPWG) { }
#endif
        else {
            const int G2 = C.G - NSCAN - NSAMPWG, c2 = blockIdx.x - NSCAN - NSAMPWG;
#ifdef PROBE_P4G
            for (int rep = 0; rep < 2; ++rep)
#endif
#pragma unroll 1
            for (int gi = 0; gi < 5; ++gi) {
                pg8::Gemm g; pg8::EpiBf16 E; int M_, N_;
                if (gi == 0) { g = pg8::Gemm{(const pg8::bf16_t*)(ws + WS_CQN), (const pg8::bf16_t*)(ws + WS_WUQ), NTOK, 768, 256}; E = pg8::EpiBf16{(pg8::bf16_t*)(ws + WS_Z), 768, 0, 0}; M_ = NTOK; N_ = 768; }
                else if (gi == 1) { g = pg8::Gemm{(const pg8::bf16_t*)(ws + WS_CKVN), (const pg8::bf16_t*)(ws + WS_WUK), NP, 512, 256}; E = pg8::EpiBf16{(pg8::bf16_t*)(ws + WS_KN), 512, 0, 0}; M_ = NP; N_ = 512; }
                else if (gi == 2) { g = pg8::Gemm{(const pg8::bf16_t*)(ws + WS_WUV), (const pg8::bf16_t*)(ws + WS_CKVN), 512, NP, 256}; E = pg8::EpiBf16{(pg8::bf16_t*)(ws + WS_VT), NP, 0, 0}; M_ = 512; N_ = NP; }
                else if (gi == 3) { g = pg8::Gemm{(const pg8::bf16_t*)(ws + WS_CKVS), (const pg8::bf16_t*)(ws + WS_WUK), NKVS, 512, 256}; E = pg8::EpiBf16{(pg8::bf16_t*)(ws + WS_KNS), 512, 0, 0}; M_ = NKVS; N_ = 512; }
                else { g = pg8::Gemm{(const pg8::bf16_t*)(ws + WS_WUV), (const pg8::bf16_t*)(ws + WS_CKVS), 512, NKVS, 256}; E = pg8::EpiBf16{(pg8::bf16_t*)(ws + WS_VTS), NKVS, 0, 0}; M_ = 512; N_ = NKVS; }
                pg8::StaticOrder S; S.init(M_, N_, G2, (c2 + gi * 37) % G2);
                pg8::gemm_phase<pg8::EpiBf16, pg8::StaticOrder, true, true>(C.lds, g, S, E);
            }
        }
        GSYNC();
#endif
        REFRESH();
        for (int it = C.gw; it < NITEM_P; it += C.NGW) gla_g3<false>(A, l, it, C.lds + C.wave * 17408, C.lane);
#ifdef SAMP_OLDPLACE
        if (C.gw < 64) gla_g3<true>(A, l, NITEM_P + C.gw, C.lds + C.wave * 17408, C.lane);
#endif
        __syncthreads();
#ifdef PROBE_SAMP
#pragma unroll 1
        for (int rep = 0; rep < 2; ++rep)
#endif
#ifndef NO_SAMP
        if (C.vcu >= C.G - 128 && C.vcu < C.G) { const int u = C.vcu - (C.G - 128); attn_sample_unit(A, C, u >> 3, u & 7); }
#endif
#ifndef NO_ATTN
#ifdef PROBE_ATTN2
        for (int rep = 0; rep < 2; ++rep)
#endif
        for (int u = C.vcu; u < 1024; u += C.G) {
            const int bh = (u % 256) >> 4, s = u & 15, i = u >> 8; const int qb = (i == 0) ? 63 - s : (i == 1) ? 32 + s : (i == 2) ? 31 - s : s;
            attn_prompt_unit(A, C, bh >> 3, bh & 7, qb); }
#endif
        GSYNC();
#ifndef NO_P6
        { pg8::EpiRes E{X, DM};
          pg8::Gemm g{(const pg8::bf16_t*)(ws + WS_H), (const pg8::bf16_t*)(ws + WS_WO), NTOK, DM, DM}; pg8::StaticOrder S; S.init(NTOK, DM, C.G, (int)blockIdx.x);
          pg8::gemm_phase<pg8::EpiRes, pg8::StaticOrder, true, true>(C.lds, g, S, E); }
        GSYNC();
#endif
        REFRESH();
#ifdef PROBE_THIN
        for (int rep = 0; rep < 2; ++rep)
#endif
        for (int mrow = C.gw; mrow < NTOK; mrow += C.NGW) norm_row(X + (size_t)mrow * DM, A.g_ffn + l * DM, (bf16*)(ws + WS_H) + (size_t)mrow * DM, nullptr, C.lane);
        GSYNC();
#ifndef NO_P8
#ifdef PROBE_P8
        for (int rep = 0; rep < 2; ++rep)
#endif
        { pg8::EpiSwiglu E{(pg8::bf16_t*)(ws + WS_ACT), DFF};
          pg8::Gemm g{(const pg8::bf16_t*)(ws + WS_H), (const pg8::bf16_t*)(ws + WS_WGU), NTOK, 2 * DFF, DM}; pg8::StaticOrder S; S.init(NTOK, 2 * DFF, C.G, (int)blockIdx.x);
          pg8::gemm_phase<pg8::EpiSwiglu, pg8::StaticOrder, true, true>(C.lds, g, S, E); }
        GSYNC();
#endif
#ifndef NO_P9
        { pg8::EpiRes E{X, DM};
          pg8::Gemm g{(const pg8::bf16_t*)(ws + WS_ACT), (const pg8::bf16_t*)(ws + WS_WD), NTOK, DM, DFF}; pg8::StaticOrder S; S.init(NTOK, DM, C.G, (int)blockIdx.x);
          pg8::gemm_phase<pg8::EpiRes, pg8::StaticOrder, true, true>(C.lds, g, S, E); }
        GSYNC();
#endif
    }
    REFRESH();
    for (int mrow = C.gw; mrow < NTOK; mrow += C.NGW) final_norm_row(X + (size_t)mrow * DM, A.g_final, C.lane);
}

extern "C" void kernel_launch(void* const* d_in, const int* in_sizes, int n_in, void* d_out, int out_size, void* d_ws, size_t ws_size, hipStream_t stream) {
    static int grid = 0;
    if (grid == 0) {
        if (n_in != 19 || (size_t)out_size != O_END || ws_size < WS_END) { fprintf(stderr, "kernel_launch: unexpected shapes: n_in %d out %d ws %zu (need %zu)\n", n_in, out_size, ws_size, (size_t)WS_END); grid = -1; return; }
        int dev = 0, cus = 0, per_cu = 0;
        hipGetDevice(&dev); hipDeviceGetAttribute(&cus, hipDeviceAttributeMultiprocessorCount, dev);
        if (hipFuncSetAttribute((const void*)fwd_mega, hipFuncAttributeMaxDynamicSharedMemorySize, LDS_BYTES) != hipSuccess) { fprintf(stderr, "kernel_launch: hipFuncSetAttribute failed\n"); grid = -1; return; }
        if (hipOccupancyMaxActiveBlocksPerMultiprocessor(&per_cu, (const void*)fwd_mega, 512, LDS_BYTES) != hipSuccess || per_cu < 1) { fprintf(stderr, "kernel_launch: occupancy query says %d\n", per_cu); per_cu = 1; }
        (void)hipGetLastError();
        grid = cus;
    }
    if (grid < 0) return;
    Args a{};
    a.xp = (const float*)d_in[0]; a.xs = (const float*)d_in[1]; a.cckv = (const float*)d_in[2]; a.ckr = (const float*)d_in[3]; a.sgla = (const float*)d_in[4];
    a.g_attn = (const float*)d_in[5]; a.w_in = (const float*)d_in[6]; a.g_qn = (const float*)d_in[7]; a.w_uq = (const float*)d_in[8]; a.g_kvn = (const float*)d_in[9];
    a.w_ukv = (const float*)d_in[10]; a.w_a2 = (const float*)d_in[11]; a.b_a2 = (const float*)d_in[12]; a.g_on = (const float*)d_in[13]; a.w_o = (const float*)d_in[14];
    a.g_ffn = (const float*)d_in[15]; a.w_gu = (const float*)d_in[16]; a.w_down = (const float*)d_in[17]; a.g_final = (const float*)d_in[18];
    a.out = (float*)d_out; a.ws = (unsigned char*)d_ws;
    if (hipMemsetAsync((char*)d_ws + WS_CTL, 0, CTL_BYTES, stream) != hipSuccess) { fprintf(stderr, "kernel_launch: memset failed\n"); return; }
    void* args[] = {&a};
    hipError_t e = hipLaunchCooperativeKernel((const void*)fwd_mega, dim3(grid), dim3(512), args, LDS_BYTES, stream);
    if (e != hipSuccess) fprintf(stderr, "kernel_launch: cooperative launch failed: %s (grid %d)\n", hipGetErrorString(e), grid);
}
```

```cpp
#include <hip/hip_runtime.h>
#include <hip/hip_cooperative_groups.h>
#include <cstdio>
#include <cstdint>
namespace cg = cooperative_groups;
namespace pg8 {
#define PG8_LAS __attribute__((address_space(3)))
typedef unsigned short bf16_t;
typedef short bf16x8 __attribute__((ext_vector_type(8)));
typedef float f32x4 __attribute__((ext_vector_type(4)));
typedef unsigned u32x4 __attribute__((ext_vector_type(4)));
constexpr int BM = 256, BK = 64, HALF = 128, HTB = HALF * BK * 2  , STAGE_BYTES = 8 * HTB, NXCD = 8, WGM = 8;

__host__ __device__ __forceinline__ int lds_byte(int r, int c) { const int st = (r >> 4) * 2 + (c >> 5), rr = r & 15, cc = c & 31, ob = rr * 64 + cc * 2; return st * 1024 + (ob ^ (((ob >> 9) & 1) << 5)); }
__host__ __device__ __forceinline__ void stage_rc(int b, int& R, int& C) { const int st = b / 1024, sb = b % 1024, swz = sb ^ (((sb >> 9) & 1) << 5); R = (st >> 1) * 16 + swz / 64; C = (st & 1) * 32 + (swz % 64) / 2; }
__host__ __device__ __forceinline__ int perm32(int rho) { const int n = rho >> 4, i = rho & 15; return 8 * (i >> 2) + 4 * n + (i & 3); }

struct Unit { int pm, pn; };
struct Gemm { const bf16_t* A; const bf16_t* Bt; int M, N, K; };

struct StaticOrder {
    int nM, nN, nwg, G, c;
    __host__ __device__ void init(int M, int N, int G_, int c_) { nM = M / BM; nN = N / BM; nwg = nM * nN; G = G_; c = c_; }
    __host__ __device__ bool next(int i, Unit& u) const {
        const long L = (long)i * G + c; if (L >= nwg) return false;
        int wgid = (int)L; { const int q = nwg / NXCD, r = nwg % NXCD, xcd = wgid % NXCD, off = wgid / NXCD; wgid = (xcd < r ? xcd * (q + 1) : r * (q + 1) + (xcd - r) * q) + off; }
        const int nig = WGM * nN, gid = wgid / nig, fm = gid * WGM, gsz = (nM - fm) < WGM ? (nM - fm) : WGM;
        u.pm = fm + ((wgid % nig) % gsz); u.pn = (wgid % nig) / gsz; return true;
    }
    __device__ __forceinline__ void a_ready(const Unit&) const {}
    __device__ __forceinline__ void done(const Unit&) const {}
};

__device__ __forceinline__ unsigned cvt_pk_bf16(float lo, float hi) { unsigned r; asm volatile("v_cvt_pk_bf16_f32 %0, %1, %2" : "=v"(r) : "v"(lo), "v"(hi)); return r; }
typedef float f32x2 __attribute__((ext_vector_type(2)));
typedef float f32x2m_t __attribute__((ext_vector_type(2))); typedef __bf16 bf16x2m_t __attribute__((ext_vector_type(2)));
__device__ __forceinline__ unsigned cvt_pk_m(float lo, float hi) { f32x2m_t v = {lo, hi}; bf16x2m_t b = __builtin_convertvector(v, bf16x2m_t); return __builtin_bit_cast(unsigned, b); }
struct EpiBf16 {
    static constexpr bool PERM = true, AFTER_DRAIN = false;
    bf16_t* O; int ldc; int split_cols; size_t split_stride;
    __device__ __forceinline__ void operator()(const f32x4 (&acc)[2][2][4][2], const Unit& u, int wr, int wc, int fr, int fq) const {
        const int row0 = u.pm * BM + wr * 64 + fr; int colt = u.pn * BM; bf16_t* base = O;
        if (split_cols) { const int t = colt / split_cols; base += (size_t)t * split_stride; colt -= t * split_cols; }
        const int col0 = colt + wc * 32 + 8 * fq;
#pragma unroll
        for (int ai = 0; ai < 2; ++ai)
#pragma unroll
            for (int m = 0; m < 4; ++m) { bf16_t* rowp = base + (size_t)(row0 + ai * HALF + m * 16) * ldc + col0;
#pragma unroll
                for (int bj = 0; bj < 2; ++bj) { const f32x4 v0 = acc[ai][bj][m][0], v1 = acc[ai][bj][m][1];
                    u32x4 w; w.x = cvt_pk_m(v0[0], v0[1]); w.y = cvt_pk_m(v0[2], v0[3]); w.z = cvt_pk_m(v1[0], v1[1]); w.w = cvt_pk_m(v1[2], v1[3]);
                    *(u32x4*)(rowp + bj * HALF) = w; } }
    }
};
struct EpiSwiglu {
    static constexpr bool PERM = true, AFTER_DRAIN = false;
    bf16_t* O; int ldc;
    __device__ __forceinline__ void operator()(const f32x4 (&acc)[2][2][4][2], const Unit& u, int wr, int wc, int fr, int fq) const {
        const int row0 = u.pm * BM + wr * 64 + fr; const int col0 = u.pn * HALF + wc * 32 + 8 * fq;
#pragma unroll
        for (int ai = 0; ai < 2; ++ai)
#pragma unroll
            for (int m = 0; m < 4; ++m) { bf16_t* rowp = O + (size_t)(row0 + ai * HALF + m * 16) * ldc + col0;
                float r[8];
#pragma unroll
                for (int n = 0; n < 2; ++n)
#pragma unroll
                    for (int i = 0; i < 4; ++i) { const float a = acc[ai][0][m][n][i], uu = acc[ai][1][m][n][i];
                        r[n * 4 + i] = a * __builtin_amdgcn_rcpf(1.0f + __expf(-a)) * uu; }
                u32x4 w; w.x = cvt_pk_m(r[0], r[1]); w.y = cvt_pk_m(r[2], r[3]); w.z = cvt_pk_m(r[4], r[5]); w.w = cvt_pk_m(r[6], r[7]);
                *(u32x4*)rowp = w; }
    }
};
struct EpiRes {
    static constexpr bool PERM = false, AFTER_DRAIN = false;
    float* X; int ldc;
    __device__ __forceinline__ void operator()(const f32x4 (&acc)[2][2][4][2], const Unit& u, int wr, int wc, int fr, int fq) const {
        const int col0 = u.pn * BM + wc * 32 + 4 * fq;
#pragma unroll
        for (int ai = 0; ai < 2; ++ai)
#pragma unroll
            for (int m = 0; m < 4; ++m) { float* rowp = X + (size_t)(u.pm * BM + ai * HALF + wr * 64 + m * 16 + fr) * ldc + col0;
#pragma unroll
                for (int bj = 0; bj < 2; ++bj)
#pragma unroll
                    for (int n = 0; n < 2; ++n) { f32x4* p = (f32x4*)(rowp + bj * HALF + n * 16); *p = *p + acc[ai][bj][m][n]; }
                asm volatile("" ::: "memory"); }
    }
};
struct EpiNone {
    static constexpr bool PERM = false, AFTER_DRAIN = false;
    float* sink;
    __device__ __forceinline__ void operator()(const f32x4 (&acc)[2][2][4][2], const Unit& u, int wr, int wc, int fr, int fq) const {
        float t = 0.f;
#pragma unroll
        for (int ai = 0; ai < 2; ++ai)
#pragma unroll
            for (int bj = 0; bj < 2; ++bj)
#pragma unroll
                for (int m = 0; m < 4; ++m)
#pragma unroll
                    for (int n = 0; n < 2; ++n) t += acc[ai][bj][m][n][0] + acc[ai][bj][m][n][1] + acc[ai][bj][m][n][2] + acc[ai][bj][m][n][3];
        if (t == 123456.789f) sink[0] = t;
    }
};
struct EpiResB {
    static constexpr bool PERM = false, AFTER_DRAIN = false;
    float* X; const float* xp; const float* xs; int np; int ldc;
    __device__ __forceinline__ void operator()(const f32x4 (&acc)[2][2][4][2], const Unit& u, int wr, int wc, int fr, int fq) const {
        const int col0 = u.pn * BM + wc * 32 + 4 * fq;
        const float* bbase = (u.pm * BM < np) ? xp : xs - (size_t)np * ldc;
#pragma unroll
        for (int ai = 0; ai < 2; ++ai)
#pragma unroll
            for (int m = 0; m < 4; ++m) { const size_t off = (size_t)(u.pm * BM + ai * HALF + wr * 64 + m * 16 + fr) * ldc + col0;
#pragma unroll
                for (int bj = 0; bj < 2; ++bj)
#pragma unroll
                    for (int n = 0; n < 2; ++n) *(f32x4*)(X + off + bj * HALF + n * 16) = *(const f32x4*)(bbase + off + bj * HALF + n * 16) + acc[ai][bj][m][n];
                asm volatile("" ::: "memory"); }
    }
};
template <class Epi, class Sched, bool ALIGN_EPI = false, bool SP2 = false>
__device__ __forceinline__ void gemm_phase(PG8_LAS unsigned char* lds, const Gemm g, const Sched& S, const Epi& E) {
    int tid_ = threadIdx.x; asm volatile("" : "+v"(tid_));
    const int tid = tid_, wid = __builtin_amdgcn_readfirstlane(tid >> 6), lane = tid & 63, wr = wid >> 2, wc = wid & 3, fr = lane & 15, fq = lane >> 4;
    const int K = g.K, nt = K / BK;
    unsigned voffA[2], voffB[2];
#pragma unroll
    for (int i = 0; i < 2; ++i) { int R, C; stage_rc(tid * 16 + i * 8192, R, C); const int Rb = Epi::PERM ? ((R & ~31) + perm32(R & 31)) : R;
        voffA[i] = (unsigned)(R * K + C) * 2u; voffB[i] = (unsigned)(Rb * K + C) * 2u; }
    const size_t kstep = (size_t)(BK * 2);
    const size_t hstep = (size_t)HALF * K * 2;
    const size_t tstep = 2 * hstep;
    const unsigned ldsw = (unsigned)wid * 1024u;
    const int aoff = lds_byte(wr * 64 + fr, fq * 8), boff = lds_byte(wc * 32 + fr, fq * 8);
#define PG8_SA(b, h) (((b) * 2 + (h)) * HTB)
#define PG8_SB(b, h) ((4 + (b) * 2 + (h)) * HTB)
#define PG8_STAGE(bufoff, gbase, voff) do { _Pragma("unroll") for (int _i = 0; _i < 2; ++_i) \
        __builtin_amdgcn_global_load_lds((const unsigned*)((const char*)(gbase) + (voff)[_i]), (PG8_LAS unsigned*)(lds + (bufoff) + ldsw + _i * 8192), 16, 0, 0); } while (0)
#define PG8_LDA(dst, b, h) do { _Pragma("unroll") for (int m = 0; m < 4; ++m) _Pragma("unroll") for (int k = 0; k < 2; ++k) dst[m][k] = *(const PG8_LAS bf16x8*)(lds + PG8_SA(b, h) + aoff + m * 2048 + k * 1024); } while (0)
#define PG8_LDB(dst, b, h) do { _Pragma("unroll") for (int n = 0; n < 2; ++n) _Pragma("unroll") for (int k = 0; k < 2; ++k) dst[n][k] = *(const PG8_LAS bf16x8*)(lds + PG8_SB(b, h) + boff + n * 2048 + k * 1024); } while (0)
#define PG8_MMA(ai, bj, At, Bt) do { __builtin_amdgcn_s_setprio(1); _Pragma("unroll") for (int m = 0; m < 4; ++m) _Pragma("unroll") for (int n = 0; n < 2; ++n) _Pragma("unroll") for (int k = 0; k < 2; ++k) \
        acc[ai][bj][m][n] = __builtin_amdgcn_mfma_f32_16x16x32_bf16(Bt[n][k], At[m][k], acc[ai][bj][m][n], 0, 0, 0); __builtin_amdgcn_s_setprio(0); } while (0)
#define PG8_WAIT_V(n) asm volatile("s_waitcnt vmcnt(" #n ")" ::: "memory")
#define PG8_WAIT_L(n) asm volatile("s_waitcnt lgkmcnt(" #n ")" ::: "memory")
#define PG8_BAR __builtin_amdgcn_s_barrier()
#define PG8_SCHED __builtin_amdgcn_sched_barrier(0)
    Unit cur, nxt; int ui = 0;
    if (!S.next(0, cur)) return;
    f32x4 acc[2][2][4][2];
#pragma unroll
    for (int a = 0; a < 2; ++a)
#pragma unroll
        for (int b = 0; b < 2; ++b)
#pragma unroll
            for (int m = 0; m < 4; ++m)
#pragma unroll
                for (int n = 0; n < 2; ++n) acc[a][b][m][n] = (f32x4){0.f, 0.f, 0.f, 0.f};
    bf16x8 At[4][2], B0[2][2], B1[2][2];
    const char* cA = (const char*)g.A + (size_t)cur.pm * tstep; const char* cB = (const char*)g.Bt + (size_t)cur.pn * tstep;
    S.a_ready(cur);
    if constexpr (SP2) {
        PG8_STAGE(PG8_SB(0, 0), cB, voffB); PG8_STAGE(PG8_SB(0, 1), cB + hstep, voffB); PG8_STAGE(PG8_SA(0, 0), cA, voffA); PG8_STAGE(PG8_SA(0, 1), cA + hstep, voffA);
        if (wr == 1) PG8_BAR;
        PG8_WAIT_V(2); PG8_BAR;
        PG8_STAGE(PG8_SB(1, 0), cB + kstep, voffB); PG8_STAGE(PG8_SA(1, 0), cA + kstep, voffA); PG8_STAGE(PG8_SB(1, 1), cB + hstep + kstep, voffB);
        PG8_WAIT_V(6); PG8_BAR;
    } else {
        PG8_STAGE(PG8_SB(0, 0), cB, voffB); PG8_STAGE(PG8_SA(0, 0), cA, voffA); PG8_STAGE(PG8_SB(0, 1), cB + hstep, voffB); PG8_STAGE(PG8_SA(0, 1), cA + hstep, voffA);
        if (wr == 1) PG8_BAR;
        PG8_WAIT_V(4); PG8_BAR;
        PG8_STAGE(PG8_SB(1, 0), cB + kstep, voffB); PG8_STAGE(PG8_SA(1, 0), cA + kstep, voffA); PG8_STAGE(PG8_SB(1, 1), cB + hstep + kstep, voffB);
        PG8_WAIT_V(6); PG8_BAR;
    }
    for (;;) {
        const bool has_next = S.next(ui + 1, nxt);
        const char* nA = has_next ? (const char*)g.A + (size_t)nxt.pm * tstep : cA; const char* nB = has_next ? (const char*)g.Bt + (size_t)nxt.pn * tstep : cB;
        for (int t = 0; t < nt; t += 2) {
            const bool last = (t == nt - 2);
            const char* a1 = cA + (size_t)(t + 1) * kstep;
            const char* a2 = last ? nA : cA + (size_t)(t + 2) * kstep; const char* b2 = last ? nB : cB + (size_t)(t + 2) * kstep;
            const char* a3 = a2 + kstep; const char* b3 = b2 + kstep;
            if (last && has_next) S.a_ready(nxt);
            if constexpr (SP2) {
            PG8_LDB(B0, 0, 0); PG8_LDB(B1, 0, 1); PG8_SCHED; PG8_LDA(At, 0, 0); PG8_STAGE(PG8_SA(1, 1), a1 + hstep, voffA);
            PG8_WAIT_V(8); PG8_WAIT_L(0); PG8_BAR; PG8_MMA(0, 0, At, B0); PG8_MMA(0, 1, At, B1); PG8_BAR; PG8_SCHED;
            PG8_LDA(At, 0, 1); PG8_STAGE(PG8_SB(0, 0), b2, voffB); PG8_STAGE(PG8_SB(0, 1), b2 + hstep, voffB); PG8_STAGE(PG8_SA(0, 0), a2, voffA);
            PG8_WAIT_V(8); PG8_WAIT_L(0); PG8_BAR; PG8_MMA(1, 0, At, B0); PG8_MMA(1, 1, At, B1); PG8_BAR; PG8_SCHED;
            PG8_LDB(B0, 1, 0); PG8_LDB(B1, 1, 1); PG8_SCHED; PG8_LDA(At, 1, 0); PG8_STAGE(PG8_SA(0, 1), a2 + hstep, voffA);
            PG8_WAIT_V(8); PG8_WAIT_L(0); PG8_BAR; PG8_MMA(0, 0, At, B0); PG8_MMA(0, 1, At, B1); PG8_BAR; PG8_SCHED;
            PG8_LDA(At, 1, 1); PG8_STAGE(PG8_SB(1, 0), b3, voffB); PG8_STAGE(PG8_SB(1, 1), b3 + hstep, voffB); PG8_STAGE(PG8_SA(1, 0), a3, voffA);
            PG8_WAIT_V(8); PG8_WAIT_L(0); PG8_BAR; PG8_MMA(1, 0, At, B0); PG8_MMA(1, 1, At, B1); PG8_BAR; PG8_SCHED;
            } else {
            PG8_LDB(B0, 0, 0); PG8_SCHED; PG8_LDA(At, 0, 0); PG8_STAGE(PG8_SA(1, 1), a1 + hstep, voffA);
            PG8_WAIT_L(8); PG8_BAR; PG8_WAIT_L(0); PG8_MMA(0, 0, At, B0); PG8_BAR; PG8_SCHED;
            PG8_LDB(B1, 0, 1); PG8_STAGE(PG8_SB(0, 0), b2, voffB);
            PG8_BAR; PG8_WAIT_L(0); PG8_MMA(0, 1, At, B1); PG8_BAR;
            PG8_LDA(At, 0, 1); PG8_STAGE(PG8_SA(0, 0), a2, voffA);
            PG8_BAR; PG8_WAIT_L(0); PG8_MMA(1, 0, At, B0); PG8_BAR; PG8_SCHED;
            PG8_STAGE(PG8_SB(0, 1), b2 + hstep, voffB);
            PG8_WAIT_V(6); PG8_BAR; PG8_MMA(1, 1, At, B1); PG8_BAR;
            PG8_LDB(B0, 1, 0); PG8_SCHED; PG8_LDA(At, 1, 0); PG8_STAGE(PG8_SA(0, 1), a2 + hstep, voffA);
            PG8_WAIT_L(8); PG8_BAR; PG8_WAIT_L(0); PG8_MMA(0, 0, At, B0); PG8_BAR; PG8_SCHED;
            PG8_LDB(B1, 1, 1); PG8_STAGE(PG8_SB(1, 0), b3, voffB);
            PG8_BAR; PG8_WAIT_L(0); PG8_MMA(0, 1, At, B1); PG8_BAR;
            PG8_LDA(At, 1, 1); PG8_STAGE(PG8_SA(1, 0), a3, voffA);
            PG8_BAR; PG8_WAIT_L(0); PG8_MMA(1, 0, At, B0); PG8_BAR; PG8_SCHED;
            PG8_STAGE(PG8_SB(1, 1), b3 + hstep, voffB);
            PG8_WAIT_V(6); PG8_BAR; PG8_MMA(1, 1, At, B1); PG8_BAR;
            }
        }
        if constexpr (ALIGN_EPI) { if (wr == 0) PG8_BAR; }
        if constexpr (!Epi::AFTER_DRAIN) { E(acc, cur, wr, wc, fr, fq); S.done(cur); }
        if (!has_next) break;
#pragma unroll
        for (int a = 0; a < 2; ++a)
#pragma unroll
            for (int b = 0; b < 2; ++b)
#pragma unroll
                for (int m = 0; m < 4; ++m)
#pragma unroll
                    for (int n = 0; n < 2; ++n) acc[a][b][m][n] = (f32x4){0.f, 0.f, 0.f, 0.f};
        cur = nxt; cA = nA; cB = nB; ++ui;
        if constexpr (ALIGN_EPI) { if (wr == 1) PG8_BAR; }
    }
    PG8_WAIT_V(0);
    if constexpr (!ALIGN_EPI) { if (wr == 0) PG8_BAR; }
    PG8_BAR;
    if constexpr (Epi::AFTER_DRAIN) { E.fused(acc, cur, wr, wc, fr, fq, lds, wid, lane); S.done(cur); }
#undef PG8_SA
#undef PG8_SB
#undef PG8_STAGE
#undef PG8_LDA
#undef PG8_LDB
#undef PG8_MMA
#undef PG8_WAIT_V
#undef PG8_WAIT_L
#undef PG8_BAR
#undef PG8_SCHED
}
}
constexpr int DM = 1024, SEQ = 16384, NBATCH = 2, NP = NBATCH * SEQ, DEC_B = 16, DEC_T = 32, PAST = 2048, SKV = PAST + DEC_T;
constexpr int NSQ = DEC_B * DEC_T, NTOK = NP + NSQ, NKVS = DEC_B * SKV;
constexpr int DFF = 2816, INW = 2096, DEPTH = 2;
constexpr float EPS = 1e-6f;
constexpr float QSCALE = 0.10206207261596575f * 1.4426950408889634f;
constexpr int NITEM_P = NBATCH * 256 * 4, NITEM = NITEM_P + DEC_B * 4;

typedef unsigned short bf16;
typedef short bf16x8 __attribute__((ext_vector_type(8)));
typedef float f32x4 __attribute__((ext_vector_type(4)));
typedef float f32x16 __attribute__((ext_vector_type(16)));
typedef unsigned u32x4 __attribute__((ext_vector_type(4)));
typedef unsigned u32x2 __attribute__((ext_vector_type(2)));
#define LAS __attribute__((address_space(3)))

constexpr size_t T256 = (size_t)NTOK * 256 * 2;
constexpr size_t al(size_t x) { return (x + 4095) & ~(size_t)4095; }
constexpr size_t WS_CTL = 0, CTL_BYTES = 65536;
constexpr size_t WS_ROPE = 65536;
constexpr size_t WS_GA = al(WS_ROPE + (size_t)SEQ * 32 * 4);
constexpr size_t WS_DECAY = al(WS_GA + (size_t)NTOK * 16 * 4);
constexpr size_t WS_WIN = al(WS_DECAY + (size_t)NITEM * 64 * 4);
constexpr size_t WS_WGV = al(WS_WIN + (size_t)1792 * 1024 * 2);
constexpr size_t WS_WUQ = al(WS_WGV + (size_t)512 * 1024 * 2);
constexpr size_t WS_WUK = al(WS_WUQ + (size_t)768 * 256 * 2);
constexpr size_t WS_WUV = al(WS_WUK + (size_t)512 * 256 * 2);
constexpr size_t WS_WO = al(WS_WUV + (size_t)512 * 256 * 2);
constexpr size_t WS_WGU = al(WS_WO + (size_t)1024 * 1024 * 2);
constexpr size_t WS_WD = al(WS_WGU + (size_t)5632 * 1024 * 2);
constexpr size_t WS_H = al(WS_WD + (size_t)1024 * 2816 * 2);
constexpr size_t WS_Z = al(WS_H + (size_t)NTOK * 1024 * 2);
constexpr size_t WS_GVT = al(WS_Z + 7 * T256);
constexpr size_t WS_CQN = al(WS_GVT + (size_t)512 * NTOK * 2);
constexpr size_t WS_CKVN = al(WS_CQN + T256);
constexpr size_t WS_CKVS = al(WS_CKVN + (size_t)NP * 256 * 2);
constexpr size_t WS_KR = al(WS_CKVS + (size_t)NKVS * 256 * 2);
constexpr size_t WS_KRS = al(WS_KR + (size_t)NP * 32 * 2);
constexpr size_t WS_KN = al(WS_KRS + (size_t)NKVS * 32 * 2);
constexpr size_t WS_VT = al(WS_KN + (size_t)NP * 512 * 2);
constexpr size_t WS_KNS = al(WS_VT + (size_t)512 * NP * 2);
constexpr size_t WS_VTS = al(WS_KNS + (size_t)NKVS * 512 * 2);
constexpr size_t WS_DS = al(WS_VTS + (size_t)512 * NKVS * 2);
constexpr size_t WS_END = al(WS_DS + (size_t)NITEM_P * 8192 * 4);
constexpr size_t WS_ACT = WS_Z;
static_assert(WS_ACT + (size_t)NTOK * DFF * 2 <= WS_END, "ACT overlay");
static_assert(WS_END <= (size_t)536870912, "ws budget");

constexpr size_t O_Y = 0, O_CKVP = (size_t)NTOK * DM, O_KRP = O_CKVP + (size_t)DEPTH * NP * 256, O_GLAP = O_KRP + (size_t)DEPTH * NP * 32,
                 O_CKVS = O_GLAP + (size_t)DEPTH * NBATCH * 4 * 8192, O_KRS = O_CKVS + (size_t)DEPTH * NSQ * 256, O_GLAS = O_KRS + (size_t)DEPTH * NSQ * 32,
                 O_END = O_GLAS + (size_t)DEPTH * DEC_B * 4 * 8192;

constexpr int LDS_BYTES = 147456;

struct Args {
    const float *xp, *xs, *cckv, *ckr, *sgla, *g_attn, *w_in, *g_qn, *w_uq, *g_kvn, *w_ukv, *w_a2, *b_a2, *g_on, *w_o, *g_ffn, *w_gu, *w_down, *g_final;
    float* out; unsigned char* ws;
};

__device__ __forceinline__ unsigned f2bf(float f) { unsigned u = __builtin_bit_cast(unsigned, f); return (u + 0x7fffu + ((u >> 16) & 1u)) >> 16; }
__device__ __forceinline__ unsigned pk2(float lo, float hi) { return f2bf(lo) | (f2bf(hi) << 16); }
__device__ __forceinline__ float bf2f(unsigned short b) { return __builtin_bit_cast(float, (unsigned)b << 16); }
__device__ __forceinline__ float bflo(unsigned w) { return __builtin_bit_cast(float, w << 16); }
__device__ __forceinline__ float bfhi(unsigned w) { return __builtin_bit_cast(float, w & 0xffff0000u); }
__device__ __forceinline__ float wave_sum(float v) {
#pragma unroll
    for (int o = 1; o < 64; o <<= 1) v += __shfl_xor(v, o);
    return v;
}
__device__ __forceinline__ int crow(int r, int hi) { return (r & 3) + 8 * (r >> 2) + 4 * hi; }
__device__ __forceinline__ float logsig(float x) { return fminf(x, 0.f) - __logf(1.0f + __expf(-fabsf(x))); }
#define LDS_WAIT() asm volatile("s_waitcnt lgkmcnt(0)" ::: "memory")
#define MFMA32(a, b, c) __builtin_amdgcn_mfma_f32_32x32x16_bf16((a), (b), (c), 0, 0, 0)
__device__ __forceinline__ f32x16 zero16() { float z = 0.f; asm volatile("" : "+v"(z)); f32x16 v;
#pragma unroll
    for (int r = 0; r < 16; ++r) v[r] = z;
    return v; }

struct Ctx {
    int tid, lane, wave, G, vcu, gw, NGW;
    LAS unsigned char* lds;
};

__device__ __forceinline__ void tr_item(const float* W, int K, int N, int k0, int src0, int nvalid, bf16* WT, int dst_row0, float scale, LAS float* scr, int lane) {
#pragma unroll 8
    for (int i = 0; i < 32; ++i) { const int kk = 2 * i + (lane >> 5), c = lane & 31;
        float v = 0.f; if (c < nvalid) v = W[(size_t)(k0 + kk) * N + src0 + c] * scale;
        scr[kk * 33 + c] = v; }
    LDS_WAIT(); asm volatile("" ::: "memory");
    const int c8 = lane & 7;
#pragma unroll
    for (int j = 0; j < 4; ++j) { const int n = (lane >> 3) + 8 * j; const LAS float* s = scr + (8 * c8) * 33 + n;
        u32x4 o; o.x = pk2(s[0 * 33], s[1 * 33]); o.y = pk2(s[2 * 33], s[3 * 33]); o.z = pk2(s[4 * 33], s[5 * 33]); o.w = pk2(s[6 * 33], s[7 * 33]);
        *(u32x4*)(WT + (size_t)(dst_row0 + n) * K + k0 + 8 * c8) = o; }
    LDS_WAIT(); asm volatile("" ::: "memory");
}
__device__ __forceinline__ void convert_weights(const Ctx& C, const Args& A, int l) {
    LAS float* scr = (LAS float*)(C.lds + C.wave * 16384);
    unsigned char* ws = A.ws;
    const float* w_in = A.w_in + (size_t)l * DM * INW; const float* w_uq = A.w_uq + (size_t)l * 256 * 768; const float* w_ukv = A.w_ukv + (size_t)l * 256 * 1024;
    const float* w_o = A.w_o + (size_t)l * DM * DM; const float* w_gu = A.w_gu + (size_t)l * DM * 2 * DFF; const float* w_d = A.w_down + (size_t)l * DFF * DM;
    constexpr int I0 = 56 * 16, I1 = 16 * 16, I2 = 24 * 4, I3 = 16 * 4, I4 = 16 * 4, I5 = 32 * 16, I6 = 176 * 16, I7 = 32 * 44;
    constexpr int NIT = I0 + I1 + I2 + I3 + I4 + I5 + I6 + I7;
    for (int it = C.gw; it < NIT; it += C.NGW) {
        int r = it;
        if (r < I0) { const int db = r >> 4, kb = r & 15; int src = 0, nv = 32;
            if (db < 16) src = 32 * db; else if (db == 16) src = 512; else if (db == 17) { src = 2080; nv = 16; } else if (db < 24) { src = 0; nv = 0; }
            else if (db < 32) src = 544 + 32 * (db - 24); else if (db < 40) src = 800 + 32 * (db - 32); else src = 1568 + 32 * (db - 40);
            tr_item(w_in, DM, INW, 64 * kb, src, nv, (bf16*)(ws + WS_WIN), 32 * db, 1.f, scr, C.lane); continue; } r -= I0;
        if (r < I1) { const int db = r >> 4, kb = r & 15; tr_item(w_in, DM, INW, 64 * kb, 1056 + 32 * db, 32, (bf16*)(ws + WS_WGV), 32 * db, 1.f, scr, C.lane); continue; } r -= I1;
        if (r < I2) { const int db = r >> 2, kb = r & 3; tr_item(w_uq, 256, 768, 64 * kb, 32 * db, 32, (bf16*)(ws + WS_WUQ), 32 * db, QSCALE, scr, C.lane); continue; } r -= I2;
        if (r < I3) { const int db = r >> 2, kb = r & 3; tr_item(w_ukv, 256, 1024, 64 * kb, (db >> 1) * 128 + (db & 1) * 32, 32, (bf16*)(ws + WS_WUK), 32 * db, 1.f, scr, C.lane); continue; } r -= I3;
        if (r < I4) { const int db = r >> 2, kb = r & 3; tr_item(w_ukv, 256, 1024, 64 * kb, (db >> 1) * 128 + 64 + (db & 1) * 32, 32, (bf16*)(ws + WS_WUV), 32 * db, 1.f, scr, C.lane); continue; } r -= I4;
        if (r < I5) { const int db = r >> 4, kb = r & 15; tr_item(w_o, DM, DM, 64 * kb, 32 * db, 32, (bf16*)(ws + WS_WO), 32 * db, 1.f, scr, C.lane); continue; } r -= I5;
        if (r < I6) { const int db = r >> 4, kb = r & 15; const int pn = db >> 3, t = db & 7; const int src = (t < 4) ? 128 * pn + 32 * t : DFF + 128 * pn + 32 * (t - 4);
            tr_item(w_gu, DM, 2 * DFF, 64 * kb, src, 32, (bf16*)(ws + WS_WGU), 32 * db, 1.f, scr, C.lane); continue; } r -= I6;
        { const int db = r / 44, kb = r % 44; tr_item(w_d, DFF, DM, 64 * kb, 32 * db, 32, (bf16*)(ws + WS_WD), 32 * db, 1.f, scr, C.lane); }
    }
}

__device__ __forceinline__ void norm_row(const float* xrow, const float* g, bf16* orow, float* copy, int lane) {
    const f32x4* xr = (const f32x4*)xrow + lane; const f32x4* gr = (const f32x4*)g + lane;
    f32x4 v[4]; float s = 0.f;
#pragma unroll
    for (int j = 0; j < 4; ++j) { v[j] = xr[64 * j]; s += (v[j].x * v[j].x + v[j].y * v[j].y) + (v[j].z * v[j].z + v[j].w * v[j].w); }
    const float rstd = 1.0f / sqrtf(wave_sum(s) * (1.f / DM) + EPS);
    if (copy) {
#pragma unroll
        for (int j = 0; j < 4; ++j) ((f32x4*)copy + lane)[64 * j] = v[j]; }
    u32x2* o8 = (u32x2*)orow + lane;
#pragma unroll
    for (int j = 0; j < 4; ++j) { const f32x4 gg = gr[64 * j]; u32x2 w; w.x = pk2(v[j].x * rstd * gg.x, v[j].y * rstd * gg.y); w.y = pk2(v[j].z * rstd * gg.z, v[j].w * rstd * gg.w); o8[64 * j] = w; }
}
__device__ __forceinline__ void final_norm_row(float* xrow, const float* g, int lane) {
    f32x4* xr = (f32x4*)xrow + lane; const f32x4* gr = (const f32x4*)g + lane;
    f32x4 v[4]; float s = 0.f;
#pragma unroll
    for (int j = 0; j < 4; ++j) { v[j] = xr[64 * j]; s += (v[j].x * v[j].x + v[j].y * v[j].y) + (v[j].z * v[j].z + v[j].w * v[j].w); }
    const float rstd = 1.0f / sqrtf(wave_sum(s) * (1.f / DM) + EPS);
#pragma unroll
    for (int j = 0; j < 4; ++j) { const f32x4 gg = gr[64 * j]; xr[64 * j] = v[j] * rstd * gg; }
}

__device__ __forceinline__ void p3_token(const Args& A, int l, int m, int lane) {
    unsigned char* ws = A.ws;
    const bf16* CQ = (const bf16*)(ws + WS_Z); const bf16* CKV = (const bf16*)(ws + WS_Z + T256); const bf16* MISC = (const bf16*)(ws + WS_Z + 2 * T256);
    const float* ROPE = (const float*)(ws + WS_ROPE);
    { const u32x2 w = *((const u32x2*)(CQ + (size_t)m * 256) + lane); const float a = bflo(w.x), b = bfhi(w.x), c = bflo(w.y), d = bfhi(w.y);
      const float rstd = 1.0f / sqrtf(wave_sum((a * a + b * b) + (c * c + d * d)) * (1.f / 256) + EPS);
      const f32x4 g = *((const f32x4*)(A.g_qn + l * 256) + lane);
      u32x2 o; o.x = pk2(a * rstd * g.x, b * rstd * g.y); o.y = pk2(c * rstd * g.z, d * rstd * g.w);
      *((u32x2*)((bf16*)(ws + WS_CQN) + (size_t)m * 256) + lane) = o; }
    int pos; float* ockv; float* okr; bf16* bckv; bf16* bkr;
    if (m < NP) { pos = m & (SEQ - 1); ockv = A.out + O_CKVP + ((size_t)l * NP + m) * 256; okr = A.out + O_KRP + ((size_t)l * NP + m) * 32;
        bckv = (bf16*)(ws + WS_CKVN) + (size_t)m * 256; bkr = (bf16*)(ws + WS_KR) + (size_t)m * 32; }
    else { const int s = m - NP, b = s >> 5, t = s & 31; pos = PAST + t; ockv = A.out + O_CKVS + ((size_t)l * NSQ + s) * 256; okr = A.out + O_KRS + ((size_t)l * NSQ + s) * 32;
        const size_t r = (size_t)b * SKV + PAST + t; bckv = (bf16*)(ws + WS_CKVS) + r * 256; bkr = (bf16*)(ws + WS_KRS) + r * 32; }
    { const u32x2 w = *((const u32x2*)(CKV + (size_t)m * 256) + lane); const float a = bflo(w.x), b = bfhi(w.x), c = bflo(w.y), d = bfhi(w.y);
      const float rstd = 1.0f / sqrtf(wave_sum((a * a + b * b) + (c * c + d * d)) * (1.f / 256) + EPS);
      const f32x4 g = *((const f32x4*)(A.g_kvn + l * 256) + lane);
      const f32x4 o = (f32x4){a * rstd * g.x, b * rstd * g.y, c * rstd * g.z, d * rstd * g.w};
      *((f32x4*)ockv + lane) = o;
      u32x2 ob; ob.x = pk2(o.x, o.y); ob.y = pk2(o.z, o.w); *((u32x2*)bckv + lane) = ob; }
    if (lane < 16) { const float x1 = bf2f(MISC[(size_t)m * 256 + lane]), x2 = bf2f(MISC[(size_t)m * 256 + 16 + lane]);
        const float c = ROPE[pos * 32 + lane], s = ROPE[pos * 32 + 16 + lane];
        const float o1 = x1 * c - x2 * s, o2 = x1 * s + x2 * c;
        okr[lane] = o1; okr[16 + lane] = o2; bkr[lane] = (bf16)f2bf(o1); bkr[16 + lane] = (bf16)f2bf(o2); }
    else if (lane < 32) { ((float*)(ws + WS_GA))[(size_t)m * 16 + (lane - 16)] = bf2f(MISC[(size_t)m * 256 + 32 + (lane - 16)]); }
}
__device__ __forceinline__ void cache_row(const Args& A, int l, int r, int lane) {
    const int b = r >> 11, p = r & (PAST - 1); const size_t dr = (size_t)b * SKV + p;
    const f32x4 v = *((const f32x4*)(A.cckv + ((size_t)l * DEC_B * PAST + r) * 256) + lane);
    u32x2 o; o.x = pk2(v.x, v.y); o.y = pk2(v.z, v.w); *((u32x2*)((bf16*)(A.ws + WS_CKVS) + dr * 256) + lane) = o;
    if (lane < 32) ((bf16*)(A.ws + WS_KRS))[dr * 32 + lane] = (bf16)f2bf(A.ckr[((size_t)l * DEC_B * PAST + r) * 32 + lane]);
}

struct GlaItem { int tok0, L, hd, sb; bool sample; };
__device__ __forceinline__ GlaItem gla_decode(int it) {
    GlaItem g;
    if (it < NITEM_P) { g.hd = it & 3; const int bc = it >> 2; g.tok0 = bc * 64; g.L = 64; g.sample = false; g.sb = 0; }
    else { const int j = it - NITEM_P; g.hd = j & 3; g.sb = j >> 2; g.tok0 = NP + g.sb * 32; g.L = 32; g.sample = true; }
    return g;
}
typedef float f32x2_t __attribute__((ext_vector_type(2))); typedef __bf16 bf16x2_t __attribute__((ext_vector_type(2)));
__device__ __forceinline__ unsigned cvtpk(float lo, float hi) { f32x2_t v = {lo, hi}; bf16x2_t b = __builtin_convertvector(v, bf16x2_t); return __builtin_bit_cast(unsigned, b); }
__device__ __forceinline__ float gate_lg(const float (&ga)[16], const float (&w)[16], float bias, int p, const float* g_GA_base) {
    float x = bias;
#ifdef GA_OLD
    const float* gp = g_GA_base + (size_t)p * 16;
#pragma unroll
    for (int r = 0; r < 16; ++r) x += gp[r] * w[r];
#else
#pragma unroll
    for (int r = 0; r < 16; ++r) x += __builtin_bit_cast(float, __builtin_amdgcn_readlane(__builtin_bit_cast(int, ga[r]), p)) * w[r];
#endif
    return logsig(x) * (1.f / 16.f);
}
constexpr int KT_PITCH = 72;
template <bool SAMPLE> __device__ __forceinline__ void gla_g1(const Args& A, int l, int it, LAS unsigned char* wl, int lane) {
    const GlaItem g = gla_decode(it); unsigned char* ws = A.ws; constexpr int L = SAMPLE ? 32 : 64;
    const int col = g.hd * 64 + lane, r32 = lane & 31, hi = lane >> 5;
    const float* GA = (const float*)(ws + WS_GA); const bf16* GK = (const bf16*)(ws + WS_Z + 4 * T256); const bf16* GVT = (const bf16*)(ws + WS_GVT);
    LAS bf16* kT = (LAS bf16*)wl; LAS float* dsm = (LAS float*)(wl + 64 * KT_PITCH * 2);
    float w[16], ga[16];
#pragma unroll
    for (int r = 0; r < 16; ++r) w[r] = A.w_a2[(size_t)l * 16 * 256 + r * 256 + col];
    const float bias = A.b_a2[l * 256 + col];
    { const int pl = lane < L ? lane : L - 1;
#pragma unroll
      for (int q = 0; q < 4; ++q) { const f32x4 v = *(const f32x4*)(GA + (size_t)(g.tok0 + pl) * 16 + 4 * q); ga[4 * q] = v.x; ga[4 * q + 1] = v.y; ga[4 * q + 2] = v.z; ga[4 * q + 3] = v.w; } }
    float blast = 0.f;
#pragma unroll 4
    for (int p = 0; p < L; ++p) blast += gate_lg(ga, w, bias, p, GA + (size_t)g.tok0 * 16);
    float bc = 0.f;
#pragma unroll 16
    for (int p = 0; p < L; ++p) { bc += gate_lg(ga, w, bias, p, GA + (size_t)g.tok0 * 16);
        const float kk = bf2f(GK[(size_t)(g.tok0 + p) * 256 + col]) * __expf(blast - bc);
        kT[lane * KT_PITCH + p] = (bf16)(cvtpk(kk, kk) & 0xffffu); }
    const float decay = __expf(blast);
    if (!SAMPLE) ((float*)(ws + WS_DECAY))[(size_t)it * 64 + lane] = decay;
    dsm[lane] = decay;
    LDS_WAIT(); asm volatile("" ::: "memory");
#pragma unroll 1
    for (int nb = 0; nb < 4; ++nb) {
        f32x16 acc[2]; acc[0] = (f32x16){}; acc[1] = (f32x16){};
#pragma unroll
        for (int s = 0; s < L / 16; ++s) {
            const bf16x8 bfr = *(const bf16x8*)(GVT + (size_t)(g.hd * 128 + 32 * nb + r32) * NTOK + g.tok0 + 16 * s + 8 * hi);
#pragma unroll
            for (int mb = 0; mb < 2; ++mb) { const bf16x8 af = *(const LAS bf16x8*)(kT + (32 * mb + r32) * KT_PITCH + 16 * s + 8 * hi); acc[mb] = MFMA32(af, bfr, acc[mb]); }
        }
        const int dv = 32 * nb + r32;
#ifdef DS_OLD
        if (!SAMPLE) { float* dsp = (float*)(ws + WS_DS) + (size_t)it * 8192 + dv;
#pragma unroll
            for (int mb = 0; mb < 2; ++mb)
#pragma unroll
                for (int r = 0; r < 16; ++r) dsp[(32 * mb + crow(r, hi)) * 128] = acc[mb][r]; }
#else
        if (!SAMPLE) { float* dsp = (float*)(ws + WS_DS) + (size_t)it * 8192 + dv * 64 + 4 * hi;
#pragma unroll
            for (int mb = 0; mb < 2; ++mb)
#pragma unroll
                for (int q = 0; q < 4; ++q) *(f32x4*)(dsp + 32 * mb + 8 * q) = (f32x4){acc[mb][4 * q], acc[mb][4 * q + 1], acc[mb][4 * q + 2], acc[mb][4 * q + 3]}; }
#endif
        else { const size_t so = (((size_t)l * DEC_B + g.sb) * 4 + g.hd) * 8192 + dv;
#pragma unroll
            for (int mb = 0; mb < 2; ++mb) {
#pragma unroll
                for (int r = 0; r < 16; ++r) { const int dk = 32 * mb + crow(r, hi); A.out[O_GLAS + so + dk * 128] = dsm[dk] * A.sgla[so + dk * 128] + acc[mb][r]; }
                asm volatile("" ::: "memory"); } }
    }
    LDS_WAIT(); asm volatile("" ::: "memory");
}
constexpr int NSCAN = 64, NSAMPWG = 8;
#ifdef DS_OLD
__device__ __forceinline__ void gla_scan(const Args& A, int l, int sblock, int tid) {
    const int gth = sblock * 512 + tid;
    const int seq = gth >> 12, e0 = (gth & 4095) * 2;
    const int b = seq >> 2, hd = seq & 3, dk = e0 >> 7;
    float* DS = (float*)(A.ws + WS_DS); const float* DEC = (const float*)(A.ws + WS_DECAY);
    float s0 = 0.f, s1 = 0.f;
    for (int c0 = 0; c0 < 256; c0 += 8) {
        float2 ds[8]; float dc[8];
#pragma unroll
        for (int j = 0; j < 8; ++j) { const size_t it = (size_t)((b * 256 + c0 + j) * 4 + hd); ds[j] = *(const float2*)(DS + it * 8192 + e0); dc[j] = DEC[it * 64 + dk]; }
#pragma unroll
        for (int j = 0; j < 8; ++j) { const size_t it = (size_t)((b * 256 + c0 + j) * 4 + hd); *(float2*)(DS + it * 8192 + e0) = make_float2(s0, s1);
            s0 = dc[j] * s0 + ds[j].x; s1 = dc[j] * s1 + ds[j].y; }
    }
    *(float2*)(A.out + O_GLAP + (((size_t)l * NBATCH + b) * 4 + hd) * 8192 + e0) = make_float2(s0, s1);
}
#else
__device__ __forceinline__ void gla_scan(const Args& A, int l, int sblock, int tid) {
    const int gth = sblock * 512 + tid;
    const int seq = gth >> 12, e0 = (gth & 4095) * 2;
    const int b = seq >> 2, hd = seq & 3, dv = e0 >> 6, dk = e0 & 63;
    float* DS = (float*)(A.ws + WS_DS); const float* DEC = (const float*)(A.ws + WS_DECAY);
    float s0 = 0.f, s1 = 0.f;
#pragma unroll 1
    for (int c0 = 0; c0 < 256; c0 += 16) {
        float2 ds[16], dc[16];
#pragma unroll
        for (int j = 0; j < 16; ++j) { const size_t it = (size_t)((b * 256 + c0 + j) * 4 + hd); ds[j] = *(const float2*)(DS + it * 8192 + e0); dc[j] = *(const float2*)(DEC + it * 64 + dk); }
#pragma unroll
        for (int j = 0; j < 16; ++j) { const size_t it = (size_t)((b * 256 + c0 + j) * 4 + hd); *(float2*)(DS + it * 8192 + e0) = make_float2(s0, s1);
            s0 = dc[j].x * s0 + ds[j].x; s1 = dc[j].y * s1 + ds[j].y; }
    }
    float* o = A.out + O_GLAP + (((size_t)l * NBATCH + b) * 4 + hd) * 8192;
    o[dk * 128 + dv] = s0; o[(dk + 1) * 128 + dv] = s1;
}
#endif
constexpr int BS_PITCH = 65;
template <bool SAMPLE> __device__ __forceinline__ void gla_g3(const Args& A, int l, int it, LAS unsigned char* wl, int lane) {
    const GlaItem g = gla_decode(it); unsigned char* ws = A.ws; constexpr int L = SAMPLE ? 32 : 64, NIB = L / 32;
    const int col = g.hd * 64 + lane, r32 = lane & 31, hi = lane >> 5;
    const float* GA = (const float*)(ws + WS_GA); const bf16* GQ = (const bf16*)(ws + WS_Z + 3 * T256); const bf16* GK = (const bf16*)(ws + WS_Z + 4 * T256);
    const bf16* GG = (const bf16*)(ws + WS_Z + 5 * T256); const bf16* GVT = (const bf16*)(ws + WS_GVT); bf16* CAT = (bf16*)(ws + WS_H);
    LAS float* bsm = (LAS float*)wl;
    {   float w[16], ga[16];
#pragma unroll
        for (int r = 0; r < 16; ++r) w[r] = A.w_a2[(size_t)l * 16 * 256 + r * 256 + col];
        const float bias = A.b_a2[l * 256 + col];
        { const int pl = lane < L ? lane : L - 1;
#pragma unroll
          for (int q = 0; q < 4; ++q) { const f32x4 v = *(const f32x4*)(GA + (size_t)(g.tok0 + pl) * 16 + 4 * q); ga[4 * q] = v.x; ga[4 * q + 1] = v.y; ga[4 * q + 2] = v.z; ga[4 * q + 3] = v.w; } }
        float bc = 0.f;
#pragma unroll 4
        for (int p = 0; p < L; ++p) { bc += gate_lg(ga, w, bias, p, GA + (size_t)g.tok0 * 16); bsm[p * BS_PITCH + lane] = bc; }
    }
    LDS_WAIT(); asm volatile("" ::: "memory");
    bf16x8 qf[NIB][4], kf[NIB][4];
#pragma unroll
    for (int ib = 0; ib < NIB; ++ib)
#pragma unroll
        for (int s = 0; s < 4; ++s) {
            const int i = 32 * ib + r32, dk0 = 16 * s + 8 * hi;
            const u32x4 rq = *(const u32x4*)(GQ + (size_t)(g.tok0 + i) * 256 + g.hd * 64 + dk0);
            const u32x4 rk = *(const u32x4*)(GK + (size_t)(g.tok0 + i) * 256 + g.hd * 64 + dk0);
            u32x4 oq, ok;
#pragma unroll
            for (int jj = 0; jj < 4; ++jj) { const float b0 = bsm[i * BS_PITCH + dk0 + 2 * jj], b1 = bsm[i * BS_PITCH + dk0 + 2 * jj + 1];
                const float e0 = __expf(b0), e1 = __expf(b1);
                oq[jj] = cvtpk(bflo(rq[jj]) * 0.125f * e0, bfhi(rq[jj]) * 0.125f * e1);
                ok[jj] = cvtpk(bflo(rk[jj]) * __expf(-b0), bfhi(rk[jj]) * __expf(-b1)); }
            qf[ib][s] = __builtin_bit_cast(bf16x8, oq); kf[ib][s] = __builtin_bit_cast(bf16x8, ok);
        }
    bf16x8 xp[NIB][NIB][2];
#pragma unroll
    for (int jb = 0; jb < NIB; ++jb)
#pragma unroll
        for (int ib = 0; ib < NIB; ++ib) {
            if (jb > ib) { xp[jb][ib][0] = (bf16x8){}; xp[jb][ib][1] = (bf16x8){}; continue; }
            f32x16 X = (f32x16){};
#pragma unroll
            for (int s = 0; s < 4; ++s) X = MFMA32(kf[jb][s], qf[ib][s], X);
            if (jb == ib) {
#pragma unroll
                for (int r = 0; r < 16; ++r) if (crow(r, hi) > r32) X[r] = 0.f; }
#pragma unroll
            for (int s2 = 0; s2 < 2; ++s2) { u32x4 pw;
#pragma unroll
                for (int jj = 0; jj < 4; ++jj) pw[jj] = cvtpk(X[8 * s2 + 2 * jj], X[8 * s2 + 2 * jj + 1]);
                xp[jb][ib][s2] = __builtin_bit_cast(bf16x8, pw); }
        }
    const float* Sp = SAMPLE ? A.sgla + (((size_t)l * DEC_B + g.sb) * 4 + g.hd) * 8192 : (const float*)(ws + WS_DS) + (size_t)it * 8192;
#pragma unroll
    for (int ib = 0; ib < NIB; ++ib) {
        f32x16 o[4];
#pragma unroll
        for (int nb = 0; nb < 4; ++nb) {
            const int dv = 32 * nb + r32;
            o[nb] = (f32x16){};
#pragma unroll
            for (int s = 0; s < 4; ++s) { u32x4 pw;
#ifdef DS_OLD
                if (true) {
#else
                if (SAMPLE) {
#endif
#pragma unroll
                    for (int jj = 0; jj < 4; ++jj) pw[jj] = cvtpk(Sp[(16 * s + 8 * hi + 2 * jj) * 128 + dv], Sp[(16 * s + 8 * hi + 2 * jj + 1) * 128 + dv]); }
                else { const f32x4 sa = *(const f32x4*)(Sp + dv * 64 + 16 * s + 8 * hi), sb = *(const f32x4*)(Sp + dv * 64 + 16 * s + 8 * hi + 4);
                    pw = (u32x4){cvtpk(sa.x, sa.y), cvtpk(sa.z, sa.w), cvtpk(sb.x, sb.y), cvtpk(sb.z, sb.w)}; }
                o[nb] = MFMA32(__builtin_bit_cast(bf16x8, pw), qf[ib][s], o[nb]); }
#pragma unroll
            for (int jb = 0; jb <= ib; ++jb)
#pragma unroll
                for (int s2 = 0; s2 < 2; ++s2) { const bf16* vp = GVT + (size_t)(g.hd * 128 + dv) * NTOK + g.tok0 + 32 * jb + 16 * s2 + 4 * hi;
                    const u32x2 lo = *(const u32x2*)vp, hi8 = *(const u32x2*)(vp + 8);
                    o[nb] = MFMA32(__builtin_bit_cast(bf16x8, (u32x4){lo.x, lo.y, hi8.x, hi8.y}), xp[jb][ib][s2], o[nb]); }
        }
        float ss = 0.f;
#pragma unroll
        for (int nb = 0; nb < 4; ++nb)
#pragma unroll
            for (int r = 0; r < 16; ++r) ss += o[nb][r] * o[nb][r];
        ss += __shfl_xor(ss, 32);
        const float rstd = 1.0f / sqrtf(ss * (1.f / 128) + EPS);
        const int tok = g.tok0 + 32 * ib + r32;
#pragma unroll
        for (int nb = 0; nb < 4; ++nb)
#pragma unroll
            for (int q = 0; q < 4; ++q) { const int dv0 = 32 * nb + 8 * q + 4 * hi; const int gc = g.hd * 128 + dv0;
                const u32x2 gw = *(const u32x2*)(GG + (size_t)(gc >> 8) * ((size_t)NTOK * 256) + (size_t)tok * 256 + (gc & 255));
                const f32x4 gon = *(const f32x4*)(A.g_on + l * 128 + dv0);
                const float g0 = bflo(gw.x), g1 = bfhi(gw.x), g2 = bflo(gw.y), g3 = bfhi(gw.y);
                const float v0 = o[nb][4 * q + 0] * rstd * gon.x * g0 * __builtin_amdgcn_rcpf(1.0f + __expf(-g0));
                const float v1 = o[nb][4 * q + 1] * rstd * gon.y * g1 * __builtin_amdgcn_rcpf(1.0f + __expf(-g1));
                const float v2 = o[nb][4 * q + 2] * rstd * gon.z * g2 * __builtin_amdgcn_rcpf(1.0f + __expf(-g2));
                const float v3 = o[nb][4 * q + 3] * rstd * gon.w * g3 * __builtin_amdgcn_rcpf(1.0f + __expf(-g3));
                u32x2 ow; ow.x = cvtpk(v0, v1); ow.y = cvtpk(v2, v3);
                *(u32x2*)(CAT + (size_t)tok * 1024 + 512 + g.hd * 128 + dv0) = ow; }
        asm volatile("" ::: "memory");
    }
    LDS_WAIT(); asm volatile("" ::: "memory");
}

__device__ __forceinline__ float max3f(float a, float b, float c) { return fmaxf(fmaxf(a, b), c); }
constexpr float ATT_THR = 8.0f;
template <class LD> __device__ __forceinline__ void attn_tile(const LD& ld, const bf16x8 (&qr)[6], f32x16 (&o)[2], float& m, float& l, bool half_only, bool first) {
    f32x16 negm;
#pragma unroll
    for (int r = 0; r < 16; ++r) negm[r] = -m;
    f32x16 p0 = negm, p1 = negm;
#pragma unroll
    for (int s = 0; s < 6; ++s) p0 = MFMA32(ld.k(0, s), qr[s], p0);
    if (!half_only) {
#pragma unroll
        for (int s = 0; s < 6; ++s) p1 = MFMA32(ld.k(1, s), qr[s], p1); }
    float mx = max3f(p0[0], p0[1], p0[2]);
#pragma unroll
    for (int r = 3; r < 15; r += 2) mx = max3f(mx, p0[r], p0[r + 1]);
    mx = fmaxf(mx, p0[15]);
    if (!half_only) {
#pragma unroll
        for (int r = 0; r < 16; r += 2) mx = max3f(mx, p1[r], p1[r + 1]); }
    mx = fmaxf(mx, __shfl_xor(mx, 32));
    if (first || __any(mx > ATT_THR)) {
        const float d = first ? mx : fmaxf(mx, 0.f);
        m += d;
        const float f = first ? 0.f : __builtin_amdgcn_exp2f(-d);
        l *= f;
#pragma unroll
        for (int r = 0; r < 16; ++r) { p0[r] -= d; p1[r] -= d; o[0][r] *= f; o[1][r] *= f; }
    }
    float rs = 0.f, rs1 = 0.f;
#pragma unroll
    for (int r = 0; r < 16; ++r) { p0[r] = __builtin_amdgcn_exp2f(p0[r]); rs += p0[r]; }
    if (!half_only) {
#pragma unroll
        for (int r = 0; r < 16; ++r) { p1[r] = __builtin_amdgcn_exp2f(p1[r]); rs1 += p1[r]; } }
    l += rs + rs1;
    bf16x8 pa[4];
#pragma unroll
    for (int s = 0; s < 2; ++s) { u32x4 w0, w1;
#pragma unroll
        for (int jj = 0; jj < 4; ++jj) { w0[jj] = cvtpk(p0[8 * s + 2 * jj], p0[8 * s + 2 * jj + 1]); w1[jj] = cvtpk(p1[8 * s + 2 * jj], p1[8 * s + 2 * jj + 1]); }
        pa[s] = __builtin_bit_cast(bf16x8, w0); pa[2 + s] = __builtin_bit_cast(bf16x8, w1); }
#pragma unroll
    for (int db = 0; db < 2; ++db) {
#pragma unroll
        for (int s = 0; s < 2; ++s) o[db] = MFMA32(ld.v(db, s), pa[s], o[db]);
        if (!half_only) {
#pragma unroll
            for (int s = 2; s < 4; ++s) o[db] = MFMA32(ld.v(db, s), pa[s], o[db]); }
    }
}
constexpr int K_PITCH = 208, V_PITCH = 136, KBUF = 64 * K_PITCH, VBUF = 64 * V_PITCH, ABUF = KBUF + VBUF;
struct LdsLoader {
    LAS const unsigned char* kb; LAS const unsigned char* vb; int r32, hi;
    __device__ __forceinline__ bf16x8 k(int half, int s) const { return *(LAS const bf16x8*)(kb + (r32 + 32 * half) * K_PITCH + s * 32 + hi * 16); }
    __device__ __forceinline__ bf16x8 v(int db, int s) const { LAS const unsigned char* p = vb + (r32 + 32 * db) * V_PITCH + s * 32 + hi * 8;
        const u32x2 lo = *(LAS const u32x2*)p, h8 = *(LAS const u32x2*)(p + 16); return __builtin_bit_cast(bf16x8, (u32x4){lo.x, lo.y, h8.x, h8.y}); }
};
struct GlbLoader {
    const bf16* kn; const bf16* kr; const bf16* vt; int r32, hi;
    __device__ __forceinline__ bf16x8 k(int half, int s) const { const int kv = r32 + 32 * half;
        return (s < 4) ? *(const bf16x8*)(kn + (size_t)kv * 512 + 16 * s + 8 * hi) : *(const bf16x8*)(kr + (size_t)kv * 32 + 16 * (s - 4) + 8 * hi); }
    __device__ __forceinline__ bf16x8 v(int db, int s) const { const bf16* p = vt + (size_t)(r32 + 32 * db) * NKVS + 16 * s + 4 * hi;
        const u32x2 lo = *(const u32x2*)p, h8 = *(const u32x2*)(p + 8); return __builtin_bit_cast(bf16x8, (u32x4){lo.x, lo.y, h8.x, h8.y}); }
};
__device__ __forceinline__ void load_q(bf16x8 (&qr)[6], const bf16* qp, const float* rope_row, int hi) {
#pragma unroll
    for (int s = 0; s < 6; ++s) qr[s] = *(const bf16x8*)(qp + 16 * s + 8 * hi);
    const u32x4 a = __builtin_bit_cast(u32x4, qr[4]), b = __builtin_bit_cast(u32x4, qr[5]); u32x4 oa, ob;
    const f32x4 c0 = *(const f32x4*)(rope_row + 8 * hi), c1 = *(const f32x4*)(rope_row + 8 * hi + 4), s0 = *(const f32x4*)(rope_row + 16 + 8 * hi), s1 = *(const f32x4*)(rope_row + 16 + 8 * hi + 4);
#pragma unroll
    for (int jj = 0; jj < 4; ++jj) {
        const float x1l = bflo(a[jj]), x1h = bfhi(a[jj]), x2l = bflo(b[jj]), x2h = bfhi(b[jj]);
        const float cl = (jj < 2) ? c0[2 * jj] : c1[2 * jj - 4], ch = (jj < 2) ? c0[2 * jj + 1] : c1[2 * jj - 3];
        const float sl = (jj < 2) ? s0[2 * jj] : s1[2 * jj - 4], sh = (jj < 2) ? s0[2 * jj + 1] : s1[2 * jj - 3];
        oa[jj] = pk2(x1l * cl - x2l * sl, x1h * ch - x2h * sh); ob[jj] = pk2(x1l * sl + x2l * cl, x1h * sh + x2h * ch); }
    qr[4] = __builtin_bit_cast(bf16x8, oa); qr[5] = __builtin_bit_cast(bf16x8, ob);
}
__device__ __forceinline__ float halfmax(float x) { auto rr = __builtin_amdgcn_permlane32_swap(__float_as_uint(x), __float_as_uint(x), false, false); return fmaxf(__uint_as_float(rr[0]), __uint_as_float(rr[1])); }
__device__ __forceinline__ float halfsum(float x) { auto rr = __builtin_amdgcn_permlane32_swap(__float_as_uint(x), __float_as_uint(x), false, false); return __uint_as_float(rr[0]) + __uint_as_float(rr[1]); }
__device__ __forceinline__ float rowmax32(const f32x16& c0, const f32x16& c1) {
    float mx = max3f(c0[0], c0[1], c0[2]);
#pragma unroll
    for (int r = 3; r < 15; r += 2) mx = max3f(mx, c0[r], c0[r + 1]);
    mx = fmaxf(mx, c0[15]);
#pragma unroll
    for (int r = 0; r < 16; r += 2) mx = max3f(mx, c1[r], c1[r + 1]);
    return halfmax(mx);
}
__device__ __forceinline__ void attn_qk(const LdsLoader& ld, const bf16x8 (&qr)[6], float m, f32x16& c0, f32x16& c1) {
    f32x16 negm;
#pragma unroll
    for (int r = 0; r < 16; ++r) negm[r] = -m;
    c0 = negm; c1 = negm;
#pragma unroll
    for (int s = 0; s < 6; ++s) { c0 = MFMA32(ld.k(0, s), qr[s], c0); c1 = MFMA32(ld.k(1, s), qr[s], c1); }
}
__device__ __forceinline__ void attn_prompt_unit(const Args& A, const Ctx& C, int b, int hd, int qb) {
    int tid_ = threadIdx.x; asm volatile("" : "+v"(tid_));
    unsigned char* ws = A.ws; const int tid = tid_, lane = tid & 63, wid = C.wave, r32 = lane & 31, hi = lane >> 5;
    const bf16* Q = (const bf16*)(ws + WS_Z); const bf16* KN = (const bf16*)(ws + WS_KN); const bf16* KR = (const bf16*)(ws + WS_KR); const bf16* VT = (const bf16*)(ws + WS_VT);
    bf16* CAT = (bf16*)(ws + WS_H); const float* ROPE = (const float*)(ws + WS_ROPE);
    const int pos = qb * 256 + wid * 32 + r32; const size_t qrow = (size_t)b * SEQ + pos;
    bf16x8 qr[6]; load_q(qr, Q + qrow * 768 + hd * 96, ROPE + (size_t)pos * 32, hi);
    const int ntiles = 4 * qb + 4, my_last = 4 * qb + (wid >> 1);
    const int krow = tid >> 3, kch = tid & 7, rrow = (tid & 255) >> 2, rch = tid & 3;
    const char* kn_base = (const char*)(KN + (size_t)b * SEQ * 512 + hd * 64); const char* kr_base = (const char*)(KR + (size_t)b * SEQ * 32);
    const char* vt_base = (const char*)(VT + (size_t)(hd * 64) * NP + (size_t)b * SEQ);
    const unsigned kn_off = (unsigned)(krow * 512 + kch * 8) * 2u, kr_off = (unsigned)(rrow * 32 + rch * 8) * 2u, vt_off = (unsigned)(krow * NP + kch * 8) * 2u;
    const int kn_dst = krow * K_PITCH + kch * 16, kr_dst = rrow * K_PITCH + 128 + rch * 16, vt_dst = KBUF + krow * V_PITCH + kch * 16;
    u32x4 sk, sr, sv;
#define ATT_GLOAD(tt) do { sk = *(const u32x4*)(kn_base + (size_t)(tt) * (64 * 512 * 2) + kn_off); sv = *(const u32x4*)(vt_base + (size_t)(tt) * 128 + vt_off); if (tid < 256) sr = *(const u32x4*)(kr_base + (size_t)(tt) * (64 * 32 * 2) + kr_off); } while (0)
#define ATT_LSTORE(slot_) do { LAS unsigned char* bufp = C.lds + (slot_) * ABUF; *(LAS u32x4*)(bufp + kn_dst) = sk; if (tid < 256) *(LAS u32x4*)(bufp + kr_dst) = sr; \
        *(LAS u32x2*)(bufp + vt_dst) = (u32x2){sv.x, sv.y}; *(LAS u32x2*)(bufp + vt_dst + 8) = (u32x2){sv.z, sv.w}; } while (0)
    ATT_GLOAD(0); ATT_LSTORE(0); ATT_GLOAD(1); ATT_LSTORE(1);
    __syncthreads();
    f32x16 o[2]; o[0] = zero16(); o[1] = zero16(); float m = o[0][0], l = m;
    f32x16 c0, c1;
    { const LdsLoader ld0{C.lds, C.lds + KBUF, r32, hi}; attn_qk(ld0, qr, m, c0, c1); }
    int slot = 0;
    for (int t = 0; t < ntiles; ++t) {
        const int s1 = (slot == 2) ? 0 : slot + 1, s2 = (s1 == 2) ? 0 : s1 + 1;
        const bool more = (t + 2 < ntiles);
        if (more) ATT_GLOAD(t + 2);
        if (t <= my_last) {
            bf16x8 kf[12];
            { const LdsLoader ldn{C.lds + s1 * ABUF, C.lds + s1 * ABUF + KBUF, r32, hi};
#pragma unroll
              for (int s = 0; s < 6; ++s) { kf[2 * s] = ldn.k(0, s); kf[2 * s + 1] = ldn.k(1, s); } }
            const float mx = rowmax32(c0, c1);
            const bool first = (t == 0);
            if (first || __any(mx > ATT_THR)) {
                const float d = first ? mx : fmaxf(mx, 0.f);
                m += d; const float f = first ? 0.f : __builtin_amdgcn_exp2f(-d); l *= f;
#pragma unroll
                for (int r = 0; r < 16; ++r) { c0[r] -= d; c1[r] -= d; o[0][r] *= f; o[1][r] *= f; }
            }
            f32x16 n0, n1;
            { f32x16 negm;
#pragma unroll
              for (int r = 0; r < 16; ++r) negm[r] = -m;
              n0 = negm; n1 = negm;
#pragma unroll
              for (int s = 0; s < 6; ++s) { n0 = MFMA32(kf[2 * s], qr[s], n0); n1 = MFMA32(kf[2 * s + 1], qr[s], n1); } }
            float rs0 = 0.f, rs1 = 0.f;
#pragma unroll
            for (int r = 0; r < 16; ++r) { c0[r] = __builtin_amdgcn_exp2f(c0[r]); rs0 += c0[r]; c1[r] = __builtin_amdgcn_exp2f(c1[r]); rs1 += c1[r]; }
            l += rs0 + rs1;
            bf16x8 pa[4];
#pragma unroll
            for (int s = 0; s < 2; ++s) { u32x4 w0, w1;
#pragma unroll
                for (int jj = 0; jj < 4; ++jj) { w0[jj] = cvtpk(c0[8 * s + 2 * jj], c0[8 * s + 2 * jj + 1]); w1[jj] = cvtpk(c1[8 * s + 2 * jj], c1[8 * s + 2 * jj + 1]); }
                pa[s] = __builtin_bit_cast(bf16x8, w0); pa[2 + s] = __builtin_bit_cast(bf16x8, w1); }
            { const LdsLoader ldv{C.lds + slot * ABUF, C.lds + slot * ABUF + KBUF, r32, hi};
#pragma unroll
              for (int s = 0; s < 4; ++s) { o[0] = MFMA32(ldv.v(0, s), pa[s], o[0]); o[1] = MFMA32(ldv.v(1, s), pa[s], o[1]); } }
            c0 = n0; c1 = n1;
#ifdef ATT_SGB
#pragma unroll
            for (int i = 0; i < 20; ++i) { __builtin_amdgcn_sched_group_barrier(0x008, 1, 0); __builtin_amdgcn_sched_group_barrier(0x100, 2, 0); __builtin_amdgcn_sched_group_barrier(0x002, 4, 0); }
#endif
        }
        if (more) ATT_LSTORE(s2);
        slot = s1;
        __syncthreads();
    }
#undef ATT_GLOAD
#undef ATT_LSTORE
    const float lt = halfsum(l); const float inv = 1.0f / lt;
    bf16* orow = CAT + qrow * 1024 + hd * 64;
#pragma unroll
    for (int db = 0; db < 2; ++db)
#pragma unroll
        for (int q = 0; q < 4; ++q) { u32x2 w; w.x = cvtpk(o[db][4 * q] * inv, o[db][4 * q + 1] * inv); w.y = cvtpk(o[db][4 * q + 2] * inv, o[db][4 * q + 3] * inv);
            *(u32x2*)(orow + 32 * db + 8 * q + 4 * hi) = w; }
}
__device__ __forceinline__ void attn_sample_unit(const Args& A, const Ctx& C, int b, int hd) {
    unsigned char* ws = A.ws; const int tid = C.tid, lane = C.lane, wid = C.wave, r32 = lane & 31, hi = lane >> 5;
    const bf16* Q = (const bf16*)(ws + WS_Z); const bf16* KNS = (const bf16*)(ws + WS_KNS); const bf16* KRS = (const bf16*)(ws + WS_KRS); const bf16* VTS = (const bf16*)(ws + WS_VTS);
    bf16* CAT = (bf16*)(ws + WS_H); const float* ROPE = (const float*)(ws + WS_ROPE);
    const size_t qrow = (size_t)NP + b * 32 + r32;
    bf16x8 qr[6]; load_q(qr, Q + qrow * 768 + hd * 96, ROPE + (size_t)(PAST + r32) * 32, hi);
    f32x16 o[2]; o[0] = (f32x16){}; o[1] = (f32x16){}; float m = 0.f, l = 0.f;
    for (int t = wid; t < 33; t += 8) {
        const size_t key0 = (size_t)b * SKV + 64 * t;
        GlbLoader ld{KNS + key0 * 512 + hd * 64, KRS + key0 * 32, VTS + (size_t)(hd * 64) * NKVS + key0, r32, hi};
        attn_tile(ld, qr, o, m, l, t == 32, t == wid);
    }
    const float lt = l + __shfl_xor(l, 32);
    LAS float* cm = (LAS float*)C.lds; LAS float* cl = cm + 256; LAS float* co = cm + 512;
    if (hi == 0) { cm[wid * 32 + r32] = m; cl[wid * 32 + r32] = lt; }
#pragma unroll
    for (int db = 0; db < 2; ++db)
#pragma unroll
        for (int r = 0; r < 16; ++r) co[(wid * 64 + 32 * db + crow(r, hi)) * 32 + r32] = o[db][r];
    __syncthreads();
    { const int q = tid & 31, d0 = (tid >> 5) * 4;
      float M = cm[q];
#pragma unroll
      for (int w = 1; w < 8; ++w) M = fmaxf(M, cm[w * 32 + q]);
      float L = 0.f, acc[4] = {0.f, 0.f, 0.f, 0.f};
#pragma unroll
      for (int w = 0; w < 8; ++w) { const float f = __builtin_amdgcn_exp2f(cm[w * 32 + q] - M); L += cl[w * 32 + q] * f;
#pragma unroll
          for (int i = 0; i < 4; ++i) acc[i] += co[(w * 64 + d0 + i) * 32 + q] * f; }
      const float inv = 1.0f / L;
      u32x2 wv; wv.x = pk2(acc[0] * inv, acc[1] * inv); wv.y = pk2(acc[2] * inv, acc[3] * inv);
      *(u32x2*)(CAT + ((size_t)NP + b * 32 + q) * 1024 + hd * 64 + d0) = wv; }
    __syncthreads();
}

#define XB_TMO      128
#define XB_XCNT(j)  (256  + 64 * (j))
#define XB_XSUB(j)  (1280 + 64 * (j))
#define XB_XGEN(j)  (2304 + 64 * (j))
#define XB_TOP      3328
#define XB_TOPGEN   3392
#define XCD_BAR_WORDS 3456
#define XB_SPIN_CAP (1u << 23)

__device__ __forceinline__ unsigned xb_ld(unsigned* p)              { return __hip_atomic_load(p, __ATOMIC_RELAXED, __HIP_MEMORY_SCOPE_AGENT); }
__device__ __forceinline__ unsigned xb_add(unsigned* p, unsigned v) { return __hip_atomic_fetch_add(p, v, __ATOMIC_RELAXED, __HIP_MEMORY_SCOPE_AGENT); }
__device__ __forceinline__ unsigned xb_xcc_id() { return (unsigned)__builtin_amdgcn_s_getreg((3 << 11) | 20) & 0xFu; }
#define XB_SPIN(cond, bar) do { unsigned _sp = 0; while (cond) { __builtin_amdgcn_s_sleep(1); \
    if ((++_sp & 255u) == 0u) { if (xb_ld(&(bar)[XB_TMO])) break; if (_sp > XB_SPIN_CAP) { atomicAdd(&(bar)[XB_TMO], 1u); break; } } } } while (0)

struct XcdBarrier {
    unsigned* bar; unsigned x;
    volatile LAS unsigned* st;
};

__device__ __forceinline__ XcdBarrier xcd_barrier_post(unsigned* bar, volatile LAS unsigned* st) {
    XcdBarrier b; b.bar = bar; b.x = xb_xcc_id(); b.st = st;
    if (threadIdx.x == 0) (void)xb_add(&bar[XB_XCNT(b.x)], 1u);
    return b;
}
__device__ __forceinline__ void xcd_barrier_complete(unsigned* bar, unsigned x, unsigned& nloc, unsigned& nx) {
    const unsigned G = gridDim.x * gridDim.y * gridDim.z;
    unsigned sum, cnt, mine, sp = 0u;
    for (;;) {
        sum = 0u; cnt = 0u; mine = 0u;
#pragma unroll
        for (unsigned j = 0; j < 16; ++j) { const unsigned c = xb_ld(&bar[XB_XCNT(j)]); sum += c; cnt += (c > 0u) ? 1u : 0u; mine = (j == x) ? c : mine; }
        if (sum == G) break;
        __builtin_amdgcn_s_sleep(1);
        if ((++sp & 255u) == 0u) { if (xb_ld(&bar[XB_TMO])) break; if (sp > XB_SPIN_CAP) { atomicAdd(&bar[XB_TMO], 1u); break; } }
    }
    nloc = mine > 0u ? mine : 1u; nx = cnt > 0u ? cnt : 1u;
}

__device__ __forceinline__ void xcd_barrier(const XcdBarrier& b) {
    asm volatile("s_waitcnt vmcnt(0)" ::: "memory");
    __syncthreads();
    if (threadIdx.x == 0) {
        unsigned* bar = b.bar;
        __builtin_amdgcn_s_waitcnt(0);
        unsigned nloc = b.st[0], nx = b.st[1];
        if (nloc == 0u) { xcd_barrier_complete(bar, b.x, nloc, nx); b.st[0] = nloc; b.st[1] = nx; }
        const unsigned old = xb_add(&bar[XB_XSUB(b.x)], 1u);
        const unsigned gen = old / nloc;
        if (old + 1u == (gen + 1u) * nloc) {
            __builtin_amdgcn_fence(__ATOMIC_RELEASE, "agent");
            asm volatile("s_waitcnt vmcnt(0)" ::: "memory");
            const unsigned og = xb_add(&bar[XB_TOP], 1u);
            const unsigned tg = og / nx;
            if (og + 1u == (tg + 1u) * nx) xb_add(&bar[XB_TOPGEN], 1u);
            else XB_SPIN(xb_ld(&bar[XB_TOPGEN]) == tg, bar);
            __builtin_amdgcn_fence(__ATOMIC_ACQUIRE, "agent");
            xb_add(&bar[XB_XGEN(b.x)], 1u);
            asm volatile("s_waitcnt vmcnt(0)" ::: "memory");
        } else {
            XB_SPIN(xb_ld(&bar[XB_XGEN(b.x)]) == gen, bar);
            __builtin_amdgcn_fence(__ATOMIC_ACQUIRE, "agent");
            asm volatile("s_waitcnt vmcnt(0)" ::: "memory");
        }
    }
    __syncthreads();
}

__global__ void __launch_bounds__(512, 2) fwd_mega(Args A) {
    extern __shared__ __attribute__((aligned(16))) unsigned char lds_raw[];
    cg::grid_group grid = cg::this_grid();
    volatile LAS unsigned* bst = (volatile LAS unsigned*)((LAS unsigned char*)lds_raw + LDS_BYTES - 64);
    if (threadIdx.x < 16) bst[threadIdx.x] = 0u;
    __syncthreads();
    XcdBarrier xbar = xcd_barrier_post((unsigned*)(A.ws + WS_CTL), bst);
#ifdef PROBE_SYNC2
#define GSYNC() do { xcd_barrier(xbar); xcd_barrier(xbar); } while (0)
#else
#define GSYNC() xcd_barrier(xbar)
#endif
    Ctx C; C.lds = (LAS unsigned char*)lds_raw; C.tid = threadIdx.x; C.lane = C.tid & 63; C.wave = __builtin_amdgcn_readfirstlane(C.tid >> 6);
    C.G = gridDim.x; { const int bx = blockIdx.x; C.vcu = (C.G % 8 == 0) ? (bx % 8) * (C.G / 8) + bx / 8 : bx; }
    C.gw = blockIdx.x * 8 + C.wave; C.NGW = C.G * 8;
    unsigned char* ws = A.ws;
    float* X = A.out + O_Y;
    { float* ROPE = (float*)(ws + WS_ROPE);
      for (int e = blockIdx.x * 512 + C.tid; e < SEQ * 16; e += C.G * 512) { const int p = e >> 4, i = e & 15;
          const double base = (i & 3) == 0 ? 1.0 : (i & 3) == 1 ? 0.5623413251903491 : (i & 3) == 2 ? 0.31622776601683794 : 0.1778279410038923;
          const double sc = (i >> 2) == 0 ? 1.0 : (i >> 2) == 1 ? 0.1 : (i >> 2) == 2 ? 0.01 : 0.001;
          const float inv = (float)(base * sc); const float ang = (float)p * inv;
          const double rev = (double)ang * 0.15915494309189535; const float fr = (float)(rev - __builtin_rint(rev));
          ROPE[p * 32 + i] = __builtin_amdgcn_cosf(fr); ROPE[p * 32 + 16 + i] = __builtin_amdgcn_sinf(fr); } }
#define REFRESH() do { int t_ = threadIdx.x; asm volatile("" : "+v"(t_)); C.tid = t_; C.lane = t_ & 63; C.wave = __builtin_amdgcn_readfirstlane(t_ >> 6); C.gw = blockIdx.x * 8 + C.wave; } while (0)
#pragma unroll 1
    for (int l = 0; l < DEPTH; ++l) {
        REFRESH();
#ifdef PROBE_P1
        for (int rep = 0; rep < 2; ++rep) {
#endif
        convert_weights(C, A, l);
        for (int mrow = C.gw; mrow < NTOK; mrow += C.NGW) {
            const float* xr = (l == 0) ? (mrow < NP ? A.xp + (size_t)mrow * DM : A.xs + (size_t)(mrow - NP) * DM) : X + (size_t)mrow * DM;
            norm_row(xr, A.g_attn + l * DM, (bf16*)(ws + WS_H) + (size_t)mrow * DM, nullptr, C.lane); }
        for (int r = C.gw; r < DEC_B * PAST; r += C.NGW) cache_row(A, l, r, C.lane);
#ifdef PROBE_P1
        }
#endif
        if (A.ws == nullptr) grid.sync();
        GSYNC();
#ifndef NO_P2
#ifdef PROBE_P2
        for (int rep = 0; rep < 2; ++rep) {
#endif
        { pg8::EpiBf16 E{(pg8::bf16_t*)(ws + WS_Z), 256, 256, (size_t)NTOK * 256};
          pg8::Gemm g{(const pg8::bf16_t*)(ws + WS_H), (const pg8::bf16_t*)(ws + WS_WIN), NTOK, 1792, DM}; pg8::StaticOrder S; S.init(NTOK, 1792, C.G, (int)blockIdx.x);
          pg8::gemm_phase<pg8::EpiBf16, pg8::StaticOrder, true, true>(C.lds, g, S, E); }
        if (C.G == 256) {
            const bool hiq = (int)blockIdx.x >= 142; const int ct0 = hiq ? 0 : 114, nct = hiq ? 114 : 16, g2 = hiq ? 114 : 32, c2 = hiq ? (int)blockIdx.x - 142 : (int)blockIdx.x;
            if (hiq || (int)blockIdx.x < 32) {
                pg8::EpiBf16 E{(pg8::bf16_t*)(ws + WS_GVT) + (size_t)ct0 * 256, NTOK, 0, 0};
                pg8::Gemm g{(const pg8::bf16_t*)(ws + WS_WGV), (const pg8::bf16_t*)(ws + WS_H) + (size_t)ct0 * 256 * DM, 512, nct * 256, DM}; pg8::StaticOrder S; S.init(512, nct * 256, g2, c2);
                pg8::gemm_phase<pg8::EpiBf16, pg8::StaticOrder, true, true>(C.lds, g, S, E); }
        } else {
            pg8::EpiBf16 E{(pg8::bf16_t*)(ws + WS_GVT), NTOK, 0, 0};
            pg8::Gemm g{(const pg8::bf16_t*)(ws + WS_WGV), (const pg8::bf16_t*)(ws + WS_H), 512, NTOK, DM}; pg8::StaticOrder S; S.init(512, NTOK, C.G, (int)((blockIdx.x + 146) % C.G));
            pg8::gemm_phase<pg8::EpiBf16, pg8::StaticOrder, true, true>(C.lds, g, S, E); }
#ifdef PROBE_P2
        }
#endif
        GSYNC();
#endif
        REFRESH();
#ifdef PROBE_THIN
        for (int rep = 0; rep < 2; ++rep)
#endif
        for (int mrow = C.gw; mrow < NTOK; mrow += C.NGW) p3_token(A, l, mrow, C.lane);
        GSYNC();
        for (int it = C.gw; it < NITEM_P; it += C.NGW) gla_g1<false>(A, l, it, C.lds + C.wave * 16384, C.lane);
#ifdef SAMP_OLDPLACE
        if (C.gw < 64) gla_g1<true>(A, l, NITEM_P + C.gw, C.lds + C.wave * 16384, C.lane);
#endif
        GSYNC();
#ifndef NO_P4
        if ((int)blockIdx.x < NSCAN) gla_scan(A, l, blockIdx.x, C.tid);
#ifndef SAMP_OLDPLACE
        else if ((int)blockIdx.x < NSCAN + NSAMPWG) { const int it = NITEM_P + ((int)blockIdx.x - NSCAN) * 8 + C.wave;
            gla_g1<true>(A, l, it, C.lds + C.wave * 17408, C.lane); gla_g3<true>(A, l, it, C.lds + C.wave * 17408, C.lane); }
#else
        else if ((int)blockIdx.x < NSCAN + NSAMPWG) { }
#endif
        else {
            const int G2 = C.G - NSCAN - NSAMPWG, c2 = blockIdx.x - NSCAN - NSAMPWG;
#ifdef PROBE_P4G
            for (int rep = 0; rep < 2; ++rep)
#endif
#pragma unroll 1
            for (int gi = 0; gi < 5; ++gi) {
                pg8::Gemm g; pg8::EpiBf16 E; int M_, N_;
                if (gi == 0) { g = pg8::Gemm{(const pg8::bf16_t*)(ws + WS_CQN), (const pg8::bf16_t*)(ws + WS_WUQ), NTOK, 768, 256}; E = pg8::EpiBf16{(pg8::bf16_t*)(ws + WS_Z), 768, 0, 0}; M_ = NTOK; N_ = 768; }
                else if (gi == 1) { g = pg8::Gemm{(const pg8::bf16_t*)(ws + WS_CKVN), (const pg8::bf16_t*)(ws + WS_WUK), NP, 512, 256}; E = pg8::EpiBf16{(pg8::bf16_t*)(ws + WS_KN), 512, 0, 0}; M_ = NP; N_ = 512; }
                else if (gi == 2) { g = pg8::Gemm{(const pg8::bf16_t*)(ws + WS_WUV), (const pg8::bf16_t*)(ws + WS_CKVN), 512, NP, 256}; E = pg8::EpiBf16{(pg8::bf16_t*)(ws + WS_VT), NP, 0, 0}; M_ = 512; N_ = NP; }
                else if (gi == 3) { g = pg8::Gemm{(const pg8::bf16_t*)(ws + WS_CKVS), (const pg8::bf16_t*)(ws + WS_WUK), NKVS, 512, 256}; E = pg8::EpiBf16{(pg8::bf16_t*)(ws + WS_KNS), 512, 0, 0}; M_ = NKVS; N_ = 512; }
                else { g = pg8::Gemm{(const pg8::bf16_t*)(ws + WS_WUV), (const pg8::bf16_t*)(ws + WS_CKVS), 512, NKVS, 256}; E = pg8::EpiBf16{(pg8::bf16_t*)(ws + WS_VTS), NKVS, 0, 0}; M_ = 512; N_ = NKVS; }
                pg8::StaticOrder S; S.init(M_, N_, G2, (c2 + gi * 37) % G2);
                pg8::gemm_phase<pg8::EpiBf16, pg8::StaticOrder, true, true>(C.lds, g, S, E);
            }
        }
        GSYNC();
#endif
        REFRESH();
        for (int it = C.gw; it < NITEM_P; it += C.NGW) gla_g3<false>(A, l, it, C.lds + C.wave * 17408, C.lane);
#ifdef SAMP_OLDPLACE
        if (C.gw < 64) gla_g3<true>(A, l, NITEM_P + C.gw, C.lds + C.wave * 17408, C.lane);
#endif
        __syncthreads();
#ifdef PROBE_SAMP
#pragma unroll 1
        for (int rep = 0; rep < 2; ++rep)
#endif
#ifndef NO_SAMP
        if (C.vcu >= C.G - 128 && C.vcu < C.G) { const int u = C.vcu - (C.G - 128); attn_sample_unit(A, C, u >> 3, u & 7); }
#endif
#ifndef NO_ATTN
#ifdef PROBE_ATTN2
        for (int rep = 0; rep < 2; ++rep)
#endif
        for (int u = C.vcu; u < 1024; u += C.G) {
            const int bh = (u % 256) >> 4, s = u & 15, i = u >> 8; const int qb = (i == 0) ? 63 - s : (i == 1) ? 32 + s : (i == 2) ? 31 - s : s;
            attn_prompt_unit(A, C, bh >> 3, bh & 7, qb); }
#endif
        GSYNC();
#ifndef NO_P6
        if (l == 0) { pg8::EpiResB E{X, A.xp, A.xs, NP, DM};
          pg8::Gemm g{(const pg8::bf16_t*)(ws + WS_H), (const pg8::bf16_t*)(ws + WS_WO), NTOK, DM, DM}; pg8::StaticOrder S; S.init(NTOK, DM, C.G, (int)blockIdx.x);
          pg8::gemm_phase<pg8::EpiResB, pg8::StaticOrder, true, true>(C.lds, g, S, E); }
        else { pg8::EpiRes E{X, DM};
          pg8::Gemm g{(const pg8::bf16_t*)(ws + WS_H), (const pg8::bf16_t*)(ws + WS_WO), NTOK, DM, DM}; pg8::StaticOrder S; S.init(NTOK, DM, C.G, (int)blockIdx.x);
          pg8::gemm_phase<pg8::EpiRes, pg8::StaticOrder, true, true>(C.lds, g, S, E); }
        GSYNC();
#endif
        REFRESH();
#ifdef PROBE_THIN
        for (int rep = 0; rep < 2; ++rep)
#endif
        for (int mrow = C.gw; mrow < NTOK; mrow += C.NGW) norm_row(X + (size_t)mrow * DM, A.g_ffn + l * DM, (bf16*)(ws + WS_H) + (size_t)mrow * DM, nullptr, C.lane);
        GSYNC();
#ifndef NO_P8
#ifdef PROBE_P8
        for (int rep = 0; rep < 2; ++rep)
#endif
        { pg8::EpiSwiglu E{(pg8::bf16_t*)(ws + WS_ACT), DFF};
          pg8::Gemm g{(const pg8::bf16_t*)(ws + WS_H), (const pg8::bf16_t*)(ws + WS_WGU), NTOK, 2 * DFF, DM}; pg8::StaticOrder S; S.init(NTOK, 2 * DFF, C.G, (int)blockIdx.x);
          pg8::gemm_phase<pg8::EpiSwiglu, pg8::StaticOrder, true, true>(C.lds, g, S, E); }
        GSYNC();
#endif
#ifndef NO_P9
        { pg8::EpiRes E{X, DM};
          pg8::Gemm g{(const pg8::bf16_t*)(ws + WS_ACT), (const pg8::bf16_t*)(ws + WS_WD), NTOK, DM, DFF}; pg8::StaticOrder S; S.init(NTOK, DM, C.G, (int)blockIdx.x);
          pg8::gemm_phase<pg8::EpiRes, pg8::StaticOrder, true, true>(C.lds, g, S, E); }
        GSYNC();
#endif
    }
    REFRESH();
    for (int mrow = C.gw; mrow < NTOK; mrow += C.NGW) final_norm_row(X + (size_t)mrow * DM, A.g_final, C.lane);
}

extern "C" void kernel_launch(void* const* d_in, const int* in_sizes, int n_in, void* d_out, int out_size, void* d_ws, size_t ws_size, hipStream_t stream) {
    static int grid = 0;
    if (grid == 0) {
        if (n_in != 19 || (size_t)out_size != O_END || ws_size < WS_END) { fprintf(stderr, "kernel_launch: unexpected shapes: n_in %d out %d ws %zu (need %zu)\n", n_in, out_size, ws_size, (size_t)WS_END); grid = -1; return; }
        int dev = 0, cus = 0, per_cu = 0;
        hipGetDevice(&dev); hipDeviceGetAttribute(&cus, hipDeviceAttributeMultiprocessorCount, dev);
        if (hipFuncSetAttribute((const void*)fwd_mega, hipFuncAttributeMaxDynamicSharedMemorySize, LDS_BYTES) != hipSuccess) { fprintf(stderr, "kernel_launch: hipFuncSetAttribute failed\n"); grid = -1; return; }
        if (hipOccupancyMaxActiveBlocksPerMultiprocessor(&per_cu, (const void*)fwd_mega, 512, LDS_BYTES) != hipSuccess || per_cu < 1) { fprintf(stderr, "kernel_launch: occupancy query says %d\n", per_cu); per_cu = 1; }
        (void)hipGetLastError();
        grid = cus;
    }
    if (grid < 0) return;
    Args a{};
    a.xp = (const float*)d_in[0]; a.xs = (const float*)d_in[1]; a.cckv = (const float*)d_in[2]; a.ckr = (const float*)d_in[3]; a.sgla = (const float*)d_in[4];
    a.g_attn = (const float*)d_in[5]; a.w_in = (const float*)d_in[6]; a.g_qn = (const float*)d_in[7]; a.w_uq = (const float*)d_in[8]; a.g_kvn = (const float*)d_in[9];
    a.w_ukv = (const float*)d_in[10]; a.w_a2 = (const float*)d_in[11]; a.b_a2 = (const float*)d_in[12]; a.g_on = (const float*)d_in[13]; a.w_o = (const float*)d_in[14];
    a.g_ffn = (const float*)d_in[15]; a.w_gu = (const float*)d_in[16]; a.w_down = (const float*)d_in[17]; a.g_final = (const float*)d_in[18];
    a.out = (float*)d_out; a.ws = (unsigned char*)d_ws;
    if (hipMemsetAsync((char*)d_ws + WS_CTL, 0, CTL_BYTES, stream) != hipSuccess) { fprintf(stderr, "kernel_launch: memset failed\n"); return; }
    void* args[] = {&a};
    hipError_t e = hipLaunchCooperativeKernel((const void*)fwd_mega, dim3(grid), dim3(512), args, LDS_BYTES, stream);
    if (e != hipSuccess) fprintf(stderr, "kernel_launch: cooperative launch failed: %s (grid %d)\n", hipGetErrorString(e), grid);
}
```

```cpp
#include <hip/hip_runtime.h>
#include <hip/hip_cooperative_groups.h>
#include <cstdio>
#include <cstdint>
namespace cg = cooperative_groups;
namespace pg8 {
#define PG8_LAS __attribute__((address_space(3)))
typedef unsigned short bf16_t;
typedef short bf16x8 __attribute__((ext_vector_type(8)));
typedef float f32x4 __attribute__((ext_vector_type(4)));
typedef unsigned u32x4 __attribute__((ext_vector_type(4)));
constexpr int BM = 256, BK = 64, HALF = 128, HTB = HALF * BK * 2  , STAGE_BYTES = 8 * HTB, NXCD = 8, WGM = 8;

__host__ __device__ __forceinline__ int lds_byte(int r, int c) { const int st = (r >> 4) * 2 + (c >> 5), rr = r & 15, cc = c & 31, ob = rr * 64 + cc * 2; return st * 1024 + (ob ^ (((ob >> 9) & 1) << 5)); }
__host__ __device__ __forceinline__ void stage_rc(int b, int& R, int& C) { const int st = b / 1024, sb = b % 1024, swz = sb ^ (((sb >> 9) & 1) << 5); R = (st >> 1) * 16 + swz / 64; C = (st & 1) * 32 + (swz % 64) / 2; }
__host__ __device__ __forceinline__ int perm32(int rho) { const int n = rho >> 4, i = rho & 15; return 8 * (i >> 2) + 4 * n + (i & 3); }

struct Unit { int pm, pn; };
struct Gemm { const bf16_t* A; const bf16_t* Bt; int M, N, K; };

struct StaticOrder {
    int nM, nN, nwg, G, c;
    __host__ __device__ void init(int M, int N, int G_, int c_) { nM = M / BM; nN = N / BM; nwg = nM * nN; G = G_; c = c_; }
    __host__ __device__ bool next(int i, Unit& u) const {
        const long L = (long)i * G + c; if (L >= nwg) return false;
        int wgid = (int)L; { const int q = nwg / NXCD, r = nwg % NXCD, xcd = wgid % NXCD, off = wgid / NXCD; wgid = (xcd < r ? xcd * (q + 1) : r * (q + 1) + (xcd - r) * q) + off; }
        const int nig = WGM * nN, gid = wgid / nig, fm = gid * WGM, gsz = (nM - fm) < WGM ? (nM - fm) : WGM;
        u.pm = fm + ((wgid % nig) % gsz); u.pn = (wgid % nig) / gsz; return true;
    }
    __device__ __forceinline__ void a_ready(const Unit&) const {}
    __device__ __forceinline__ void done(const Unit&) const {}
};

__device__ __forceinline__ unsigned cvt_pk_bf16(float lo, float hi) { unsigned r; asm volatile("v_cvt_pk_bf16_f32 %0, %1, %2" : "=v"(r) : "v"(lo), "v"(hi)); return r; }
typedef float f32x2 __attribute__((ext_vector_type(2)));
typedef float f32x2m_t __attribute__((ext_vector_type(2))); typedef __bf16 bf16x2m_t __attribute__((ext_vector_type(2)));
__device__ __forceinline__ unsigned cvt_pk_m(float lo, float hi) { f32x2m_t v = {lo, hi}; bf16x2m_t b = __builtin_convertvector(v, bf16x2m_t); return __builtin_bit_cast(unsigned, b); }
struct EpiBf16 {
    static constexpr bool PERM = true, AFTER_DRAIN = false;
    bf16_t* O; int ldc; int split_cols; size_t split_stride;
    __device__ __forceinline__ void operator()(const f32x4 (&acc)[2][2][4][2], const Unit& u, int wr, int wc, int fr, int fq) const {
        const int row0 = u.pm * BM + wr * 64 + fr; int colt = u.pn * BM; bf16_t* base = O;
        if (split_cols) { const int t = colt / split_cols; base += (size_t)t * split_stride; colt -= t * split_cols; }
        const int col0 = colt + wc * 32 + 8 * fq;
#pragma unroll
        for (int ai = 0; ai < 2; ++ai)
#pragma unroll
            for (int m = 0; m < 4; ++m) { bf16_t* rowp = base + (size_t)(row0 + ai * HALF + m * 16) * ldc + col0;
#pragma unroll
                for (int bj = 0; bj < 2; ++bj) { const f32x4 v0 = acc[ai][bj][m][0], v1 = acc[ai][bj][m][1];
                    u32x4 w; w.x = cvt_pk_m(v0[0], v0[1]); w.y = cvt_pk_m(v0[2], v0[3]); w.z = cvt_pk_m(v1[0], v1[1]); w.w = cvt_pk_m(v1[2], v1[3]);
                    *(u32x4*)(rowp + bj * HALF) = w; } }
    }
};
struct EpiSwiglu {
    static constexpr bool PERM = true, AFTER_DRAIN = false;
    bf16_t* O; int ldc;
    __device__ __forceinline__ void operator()(const f32x4 (&acc)[2][2][4][2], const Unit& u, int wr, int wc, int fr, int fq) const {
        const int row0 = u.pm * BM + wr * 64 + fr; const int col0 = u.pn * HALF + wc * 32 + 8 * fq;
#pragma unroll
        for (int ai = 0; ai < 2; ++ai)
#pragma unroll
            for (int m = 0; m < 4; ++m) { bf16_t* rowp = O + (size_t)(row0 + ai * HALF + m * 16) * ldc + col0;
                float r[8];
#pragma unroll
                for (int n = 0; n < 2; ++n)
#pragma unroll
                    for (int i = 0; i < 4; ++i) { const float a = acc[ai][0][m][n][i], uu = acc[ai][1][m][n][i];
                        r[n * 4 + i] = a * __builtin_amdgcn_rcpf(1.0f + __expf(-a)) * uu; }
                u32x4 w; w.x = cvt_pk_m(r[0], r[1]); w.y = cvt_pk_m(r[2], r[3]); w.z = cvt_pk_m(r[4], r[5]); w.w = cvt_pk_m(r[6], r[7]);
                *(u32x4*)rowp = w; }
    }
};
struct EpiRes {
    static constexpr bool PERM = false, AFTER_DRAIN = false;
    float* X; int ldc;
    __device__ __forceinline__ void operator()(const f32x4 (&acc)[2][2][4][2], const Unit& u, int wr, int wc, int fr, int fq) const {
        const int col0 = u.pn * BM + wc * 32 + 4 * fq;
#pragma unroll
        for (int ai = 0; ai < 2; ++ai)
#pragma unroll
            for (int m = 0; m < 4; ++m) { float* rowp = X + (size_t)(u.pm * BM + ai * HALF + wr * 64 + m * 16 + fr) * ldc + col0;
#pragma unroll
                for (int bj = 0; bj < 2; ++bj)
#pragma unroll
                    for (int n = 0; n < 2; ++n) { f32x4* p = (f32x4*)(rowp + bj * HALF + n * 16); *p = *p + acc[ai][bj][m][n]; }
                asm volatile("" ::: "memory"); }
    }
};
struct EpiNone {
    static constexpr bool PERM = false, AFTER_DRAIN = false;
    float* sink;
    __device__ __forceinline__ void operator()(const f32x4 (&acc)[2][2][4][2], const Unit& u, int wr, int wc, int fr, int fq) const {
        float t = 0.f;
#pragma unroll
        for (int ai = 0; ai < 2; ++ai)
#pragma unroll
            for (int bj = 0; bj < 2; ++bj)
#pragma unroll
                for (int m = 0; m < 4; ++m)
#pragma unroll
                    for (int n = 0; n < 2; ++n) t += acc[ai][bj][m][n][0] + acc[ai][bj][m][n][1] + acc[ai][bj][m][n][2] + acc[ai][bj][m][n][3];
        if (t == 123456.789f) sink[0] = t;
    }
};
struct EpiResB {
    static constexpr bool PERM = false, AFTER_DRAIN = false;
    float* X; const float* xp; const float* xs; int np; int ldc;
    __device__ __forceinline__ void operator()(const f32x4 (&acc)[2][2][4][2], const Unit& u, int wr, int wc, int fr, int fq) const {
        const int col0 = u.pn * BM + wc * 32 + 4 * fq;
        const float* bbase = (u.pm * BM < np) ? xp : xs - (size_t)np * ldc;
#pragma unroll
        for (int ai = 0; ai < 2; ++ai)
#pragma unroll
            for (int m = 0; m < 4; ++m) { const size_t off = (size_t)(u.pm * BM + ai * HALF + wr * 64 + m * 16 + fr) * ldc + col0;
#pragma unroll
                for (int bj = 0; bj < 2; ++bj)
#pragma unroll
                    for (int n = 0; n < 2; ++n) *(f32x4*)(X + off + bj * HALF + n * 16) = *(const f32x4*)(bbase + off + bj * HALF + n * 16) + acc[ai][bj][m][n];
                asm volatile("" ::: "memory"); }
    }
};
template <class Epi, class Sched, bool ALIGN_EPI = false, bool SP2 = false>
__device__ __forceinline__ void gemm_phase(PG8_LAS unsigned char* lds, const Gemm g, const Sched& S, const Epi& E) {
    int tid_ = threadIdx.x; asm volatile("" : "+v"(tid_));
    const int tid = tid_, wid = __builtin_amdgcn_readfirstlane(tid >> 6), lane = tid & 63, wr = wid >> 2, wc = wid & 3, fr = lane & 15, fq = lane >> 4;
    const int K = g.K, nt = K / BK;
    unsigned voffA[2], voffB[2];
#pragma unroll
    for (int i = 0; i < 2; ++i) { int R, C; stage_rc(tid * 16 + i * 8192, R, C); const int Rb = Epi::PERM ? ((R & ~31) + perm32(R & 31)) : R;
        voffA[i] = (unsigned)(R * K + C) * 2u; voffB[i] = (unsigned)(Rb * K + C) * 2u; }
    const size_t kstep = (size_t)(BK * 2);
    const size_t hstep = (size_t)HALF * K * 2;
    const size_t tstep = 2 * hstep;
    const unsigned ldsw = (unsigned)wid * 1024u;
    const int aoff = lds_byte(wr * 64 + fr, fq * 8), boff = lds_byte(wc * 32 + fr, fq * 8);
#define PG8_SA(b, h) (((b) * 2 + (h)) * HTB)
#define PG8_SB(b, h) ((4 + (b) * 2 + (h)) * HTB)
#define PG8_STAGE(bufoff, gbase, voff) do { _Pragma("unroll") for (int _i = 0; _i < 2; ++_i) \
        __builtin_amdgcn_global_load_lds((const unsigned*)((const char*)(gbase) + (voff)[_i]), (PG8_LAS unsigned*)(lds + (bufoff) + ldsw + _i * 8192), 16, 0, 0); } while (0)
#define PG8_LDA(dst, b, h) do { _Pragma("unroll") for (int m = 0; m < 4; ++m) _Pragma("unroll") for (int k = 0; k < 2; ++k) dst[m][k] = *(const PG8_LAS bf16x8*)(lds + PG8_SA(b, h) + aoff + m * 2048 + k * 1024); } while (0)
#define PG8_LDB(dst, b, h) do { _Pragma("unroll") for (int n = 0; n < 2; ++n) _Pragma("unroll") for (int k = 0; k < 2; ++k) dst[n][k] = *(const PG8_LAS bf16x8*)(lds + PG8_SB(b, h) + boff + n * 2048 + k * 1024); } while (0)
#define PG8_MMA(ai, bj, At, Bt) do { __builtin_amdgcn_s_setprio(1); _Pragma("unroll") for (int m = 0; m < 4; ++m) _Pragma("unroll") for (int n = 0; n < 2; ++n) _Pragma("unroll") for (int k = 0; k < 2; ++k) \
        acc[ai][bj][m][n] = __builtin_amdgcn_mfma_f32_16x16x32_bf16(Bt[n][k], At[m][k], acc[ai][bj][m][n], 0, 0, 0); __builtin_amdgcn_s_setprio(0); } while (0)
#define PG8_WAIT_V(n) asm volatile("s_waitcnt vmcnt(" #n ")" ::: "memory")
#define PG8_WAIT_L(n) asm volatile("s_waitcnt lgkmcnt(" #n ")" ::: "memory")
#define PG8_BAR __builtin_amdgcn_s_barrier()
#define PG8_SCHED __builtin_amdgcn_sched_barrier(0)
    Unit cur, nxt; int ui = 0;
    if (!S.next(0, cur)) return;
    f32x4 acc[2][2][4][2];
#pragma unroll
    for (int a = 0; a < 2; ++a)
#pragma unroll
        for (int b = 0; b < 2; ++b)
#pragma unroll
            for (int m = 0; m < 4; ++m)
#pragma unroll
                for (int n = 0; n < 2; ++n) acc[a][b][m][n] = (f32x4){0.f, 0.f, 0.f, 0.f};
    bf16x8 At[4][2], B0[2][2], B1[2][2];
    const char* cA = (const char*)g.A + (size_t)cur.pm * tstep; const char* cB = (const char*)g.Bt + (size_t)cur.pn * tstep;
    S.a_ready(cur);
    if constexpr (SP2) {
        PG8_STAGE(PG8_SB(0, 0), cB, voffB); PG8_STAGE(PG8_SB(0, 1), cB + hstep, voffB); PG8_STAGE(PG8_SA(0, 0), cA, voffA); PG8_STAGE(PG8_SA(0, 1), cA + hstep, voffA);
        if (wr == 1) PG8_BAR;
        PG8_WAIT_V(2); PG8_BAR;
        PG8_STAGE(PG8_SB(1, 0), cB + kstep, voffB); PG8_STAGE(PG8_SA(1, 0), cA + kstep, voffA); PG8_STAGE(PG8_SB(1, 1), cB + hstep + kstep, voffB);
        PG8_WAIT_V(6); PG8_BAR;
    } else {
        PG8_STAGE(PG8_SB(0, 0), cB, voffB); PG8_STAGE(PG8_SA(0, 0), cA, voffA); PG8_STAGE(PG8_SB(0, 1), cB + hstep, voffB); PG8_STAGE(PG8_SA(0, 1), cA + hstep, voffA);
        if (wr == 1) PG8_BAR;
        PG8_WAIT_V(4); PG8_BAR;
        PG8_STAGE(PG8_SB(1, 0), cB + kstep, voffB); PG8_STAGE(PG8_SA(1, 0), cA + kstep, voffA); PG8_STAGE(PG8_SB(1, 1), cB + hstep + kstep, voffB);
        PG8_WAIT_V(6); PG8_BAR;
    }
    for (;;) {
        const bool has_next = S.next(ui + 1, nxt);
        const char* nA = has_next ? (const char*)g.A + (size_t)nxt.pm * tstep : cA; const char* nB = has_next ? (const char*)g.Bt + (size_t)nxt.pn * tstep : cB;
        for (int t = 0; t < nt; t += 2) {
            const bool last = (t == nt - 2);
            const char* a1 = cA + (size_t)(t + 1) * kstep;
            const char* a2 = last ? nA : cA + (size_t)(t + 2) * kstep; const char* b2 = last ? nB : cB + (size_t)(t + 2) * kstep;
            const char* a3 = a2 + kstep; const char* b3 = b2 + kstep;
            if (last && has_next) S.a_ready(nxt);
            if constexpr (SP2) {
            PG8_LDB(B0, 0, 0); PG8_LDB(B1, 0, 1); PG8_SCHED; PG8_LDA(At, 0, 0); PG8_STAGE(PG8_SA(1, 1), a1 + hstep, voffA);
            PG8_WAIT_V(8); PG8_WAIT_L(0); PG8_BAR; PG8_MMA(0, 0, At, B0); PG8_MMA(0, 1, At, B1); PG8_BAR; PG8_SCHED;
            PG8_LDA(At, 0, 1); PG8_STAGE(PG8_SB(0, 0), b2, voffB); PG8_STAGE(PG8_SB(0, 1), b2 + hstep, voffB); PG8_STAGE(PG8_SA(0, 0), a2, voffA);
            PG8_WAIT_V(8); PG8_WAIT_L(0); PG8_BAR; PG8_MMA(1, 0, At, B0); PG8_MMA(1, 1, At, B1); PG8_BAR; PG8_SCHED;
            PG8_LDB(B0, 1, 0); PG8_LDB(B1, 1, 1); PG8_SCHED; PG8_LDA(At, 1, 0); PG8_STAGE(PG8_SA(0, 1), a2 + hstep, voffA);
            PG8_WAIT_V(8); PG8_WAIT_L(0); PG8_BAR; PG8_MMA(0, 0, At, B0); PG8_MMA(0, 1, At, B1); PG8_BAR; PG8_SCHED;
            PG8_LDA(At, 1, 1); PG8_STAGE(PG8_SB(1, 0), b3, voffB); PG8_STAGE(PG8_SB(1, 1), b3 + hstep, voffB); PG8_STAGE(PG8_SA(1, 0), a3, voffA);
            PG8_WAIT_V(8); PG8_WAIT_L(0); PG8_BAR; PG8_MMA(1, 0, At, B0); PG8_MMA(1, 1, At, B1); PG8_BAR; PG8_SCHED;
            } else {
            PG8_LDB(B0, 0, 0); PG8_SCHED; PG8_LDA(At, 0, 0); PG8_STAGE(PG8_SA(1, 1), a1 + hstep, voffA);
            PG8_WAIT_L(8); PG8_BAR; PG8_WAIT_L(0); PG8_MMA(0, 0, At, B0); PG8_BAR; PG8_SCHED;
            PG8_LDB(B1, 0, 1); PG8_STAGE(PG8_SB(0, 0), b2, voffB);
            PG8_BAR; PG8_WAIT_L(0); PG8_MMA(0, 1, At, B1); PG8_BAR;
            PG8_LDA(At, 0, 1); PG8_STAGE(PG8_SA(0, 0), a2, voffA);
            PG8_BAR; PG8_WAIT_L(0); PG8_MMA(1, 0, At, B0); PG8_BAR; PG8_SCHED;
            PG8_STAGE(PG8_SB(0, 1), b2 + hstep, voffB);
            PG8_WAIT_V(6); PG8_BAR; PG8_MMA(1, 1, At, B1); PG8_BAR;
            PG8_LDB(B0, 1, 0); PG8_SCHED; PG8_LDA(At, 1, 0); PG8_STAGE(PG8_SA(0, 1), a2 + hstep, voffA);
            PG8_WAIT_L(8); PG8_BAR; PG8_WAIT_L(0); PG8_MMA(0, 0, At, B0); PG8_BAR; PG8_SCHED;
            PG8_LDB(B1, 1, 1); PG8_STAGE(PG8_SB(1, 0), b3, voffB);
            PG8_BAR; PG8_WAIT_L(0); PG8_MMA(0, 1, At, B1); PG8_BAR;
            PG8_LDA(At, 1, 1); PG8_STAGE(PG8_SA(1, 0), a3, voffA);
            PG8_BAR; PG8_WAIT_L(0); PG8_MMA(1, 0, At, B0); PG8_BAR; PG8_SCHED;
            PG8_STAGE(PG8_SB(1, 1), b3 + hstep, voffB);
            PG8_WAIT_V(6); PG8_BAR; PG8_MMA(1, 1, At, B1); PG8_BAR;
            }
        }
        if constexpr (ALIGN_EPI) { if (wr == 0) PG8_BAR; }
        if constexpr (!Epi::AFTER_DRAIN) { E(acc, cur, wr, wc, fr, fq); S.done(cur); }
        if (!has_next) break;
#pragma unroll
        for (int a = 0; a < 2; ++a)
#pragma unroll
            for (int b = 0; b < 2; ++b)
#pragma unroll
                for (int m = 0; m < 4; ++m)
#pragma unroll
                    for (int n = 0; n < 2; ++n) acc[a][b][m][n] = (f32x4){0.f, 0.f, 0.f, 0.f};
        cur = nxt; cA = nA; cB = nB; ++ui;
        if constexpr (ALIGN_EPI) { if (wr == 1) PG8_BAR; }
    }
    PG8_WAIT_V(0);
    if constexpr (!ALIGN_EPI) { if (wr == 0) PG8_BAR; }
    PG8_BAR;
    if constexpr (Epi::AFTER_DRAIN) { E.fused(acc, cur, wr, wc, fr, fq, lds, wid, lane); S.done(cur); }
#undef PG8_SA
#undef PG8_SB
#undef PG8_STAGE
#undef PG8_LDA
#undef PG8_LDB
#undef PG8_MMA
#undef PG8_WAIT_V
#undef PG8_WAIT_L
#undef PG8_BAR
#undef PG8_SCHED
}
}
constexpr int DM = 1024, SEQ = 16384, NBATCH = 2, NP = NBATCH * SEQ, DEC_B = 16, DEC_T = 32, PAST = 2048, SKV = PAST + DEC_T;
constexpr int NSQ = DEC_B * DEC_T, NTOK = NP + NSQ, NKVS = DEC_B * SKV;
constexpr int DFF = 2816, INW = 2096, DEPTH = 2;
constexpr float EPS = 1e-6f;
constexpr float QSCALE = 0.10206207261596575f * 1.4426950408889634f;
constexpr int NITEM_P = NBATCH * 256 * 4, NITEM = NITEM_P + DEC_B * 4;

typedef unsigned short bf16;
typedef short bf16x8 __attribute__((ext_vector_type(8)));
typedef float f32x4 __attribute__((ext_vector_type(4)));
typedef float f32x16 __attribute__((ext_vector_type(16)));
typedef unsigned u32x4 __attribute__((ext_vector_type(4)));
typedef unsigned u32x2 __attribute__((ext_vector_type(2)));
#define LAS __attribute__((address_space(3)))

constexpr size_t T256 = (size_t)NTOK * 256 * 2;
constexpr size_t al(size_t x) { return (x + 4095) & ~(size_t)4095; }
constexpr size_t WS_CTL = 0, CTL_BYTES = 65536;
constexpr size_t WS_ROPE = 65536;
constexpr size_t WS_GA = al(WS_ROPE + (size_t)SEQ * 32 * 4);
constexpr size_t WS_DECAY = al(WS_GA + (size_t)NTOK * 16 * 4);
constexpr size_t WS_WIN = al(WS_DECAY + (size_t)NITEM * 64 * 4);
constexpr size_t WS_WGV = al(WS_WIN + (size_t)1792 * 1024 * 2);
constexpr size_t WS_WUQ = al(WS_WGV + (size_t)512 * 1024 * 2);
constexpr size_t WS_WUK = al(WS_WUQ + (size_t)768 * 256 * 2);
constexpr size_t WS_WUV = al(WS_WUK + (size_t)512 * 256 * 2);
constexpr size_t WS_WO = al(WS_WUV + (size_t)512 * 256 * 2);
constexpr size_t WS_WGU = al(WS_WO + (size_t)1024 * 1024 * 2);
constexpr size_t WS_WD = al(WS_WGU + (size_t)5632 * 1024 * 2);
constexpr size_t WS_H = al(WS_WD + (size_t)1024 * 2816 * 2);
constexpr size_t WS_Z = al(WS_H + (size_t)NTOK * 1024 * 2);
constexpr size_t WS_GVT = al(WS_Z + 7 * T256);
constexpr size_t WS_CQN = al(WS_GVT + (size_t)512 * NTOK * 2);
constexpr size_t WS_CKVN = al(WS_CQN + T256);
constexpr size_t WS_CKVS = al(WS_CKVN + (size_t)NP * 256 * 2);
constexpr size_t WS_KR = al(WS_CKVS + (size_t)NKVS * 256 * 2);
constexpr size_t WS_KRS = al(WS_KR + (size_t)NP * 32 * 2);
constexpr size_t WS_KN = al(WS_KRS + (size_t)NKVS * 32 * 2);
constexpr size_t WS_VT = al(WS_KN + (size_t)NP * 512 * 2);
constexpr size_t WS_KNS = al(WS_VT + (size_t)512 * NP * 2);
constexpr size_t WS_VTS = al(WS_KNS + (size_t)NKVS * 512 * 2);
constexpr size_t WS_DS = al(WS_VTS + (size_t)512 * NKVS * 2);
constexpr size_t WS_LG = al(WS_DS + (size_t)NITEM_P * 8192 * 4);
constexpr size_t WS_END = al(WS_LG + (size_t)NTOK * 256 * 2);
constexpr size_t WS_ACT = WS_Z;
static_assert(WS_ACT + (size_t)NTOK * DFF * 2 <= WS_END, "ACT overlay");
static_assert(WS_END <= (size_t)536870912, "ws budget");

constexpr size_t O_Y = 0, O_CKVP = (size_t)NTOK * DM, O_KRP = O_CKVP + (size_t)DEPTH * NP * 256, O_GLAP = O_KRP + (size_t)DEPTH * NP * 32,
                 O_CKVS = O_GLAP + (size_t)DEPTH * NBATCH * 4 * 8192, O_KRS = O_CKVS + (size_t)DEPTH * NSQ * 256, O_GLAS = O_KRS + (size_t)DEPTH * NSQ * 32,
                 O_END = O_GLAS + (size_t)DEPTH * DEC_B * 4 * 8192;

constexpr int LDS_BYTES = 147456;

struct Args {
    const float *xp, *xs, *cckv, *ckr, *sgla, *g_attn, *w_in, *g_qn, *w_uq, *g_kvn, *w_ukv, *w_a2, *b_a2, *g_on, *w_o, *g_ffn, *w_gu, *w_down, *g_final;
    float* out; unsigned char* ws;
};

__device__ __forceinline__ unsigned f2bf(float f) { unsigned u = __builtin_bit_cast(unsigned, f); return (u + 0x7fffu + ((u >> 16) & 1u)) >> 16; }
__device__ __forceinline__ unsigned pk2(float lo, float hi) { return f2bf(lo) | (f2bf(hi) << 16); }
__device__ __forceinline__ float bf2f(unsigned short b) { return __builtin_bit_cast(float, (unsigned)b << 16); }
__device__ __forceinline__ float bflo(unsigned w) { return __builtin_bit_cast(float, w << 16); }
__device__ __forceinline__ float bfhi(unsigned w) { return __builtin_bit_cast(float, w & 0xffff0000u); }
__device__ __forceinline__ float wave_sum(float v) {
#pragma unroll
    for (int o = 1; o < 64; o <<= 1) v += __shfl_xor(v, o);
    return v;
}
__device__ __forceinline__ int crow(int r, int hi) { return (r & 3) + 8 * (r >> 2) + 4 * hi; }
__device__ __forceinline__ float logsig(float x) { return fminf(x, 0.f) - __logf(1.0f + __expf(-fabsf(x))); }
#define LDS_WAIT() asm volatile("s_waitcnt lgkmcnt(0)" ::: "memory")
#define MFMA32(a, b, c) __builtin_amdgcn_mfma_f32_32x32x16_bf16((a), (b), (c), 0, 0, 0)
__device__ __forceinline__ f32x16 zero16() { float z = 0.f; asm volatile("" : "+v"(z)); f32x16 v;
#pragma unroll
    for (int r = 0; r < 16; ++r) v[r] = z;
    return v; }

struct Ctx {
    int tid, lane, wave, G, vcu, gw, NGW;
    LAS unsigned char* lds;
};

__device__ __forceinline__ void tr_item(const float* W, int K, int N, int k0, int src0, int nvalid, bf16* WT, int dst_row0, float scale, LAS float* scr, int lane) {
#pragma unroll 32
    for (int i = 0; i < 32; ++i) { const int kk = 2 * i + (lane >> 5), c = lane & 31;
        float v = 0.f; if (c < nvalid) v = W[(size_t)(k0 + kk) * N + src0 + c] * scale;
        scr[kk * 33 + c] = v; }
    LDS_WAIT(); asm volatile("" ::: "memory");
    const int c8 = lane & 7;
#pragma unroll
    for (int j = 0; j < 4; ++j) { const int n = (lane >> 3) + 8 * j; const LAS float* s = scr + (8 * c8) * 33 + n;
        u32x4 o; o.x = pk2(s[0 * 33], s[1 * 33]); o.y = pk2(s[2 * 33], s[3 * 33]); o.z = pk2(s[4 * 33], s[5 * 33]); o.w = pk2(s[6 * 33], s[7 * 33]);
        *(u32x4*)(WT + (size_t)(dst_row0 + n) * K + k0 + 8 * c8) = o; }
    LDS_WAIT(); asm volatile("" ::: "memory");
}
__device__ __forceinline__ void convert_weights(const Ctx& C, const Args& A, int l) {
    LAS float* scr = (LAS float*)(C.lds + C.wave * 16384);
    unsigned char* ws = A.ws;
    const float* w_in = A.w_in + (size_t)l * DM * INW; const float* w_uq = A.w_uq + (size_t)l * 256 * 768; const float* w_ukv = A.w_ukv + (size_t)l * 256 * 1024;
    const float* w_o = A.w_o + (size_t)l * DM * DM; const float* w_gu = A.w_gu + (size_t)l * DM * 2 * DFF; const float* w_d = A.w_down + (size_t)l * DFF * DM;
    constexpr int I0 = 56 * 16, I1 = 16 * 16, I2 = 24 * 4, I3 = 16 * 4, I4 = 16 * 4, I5 = 32 * 16, I6 = 176 * 16, I7 = 32 * 44;
    constexpr int NIT = I0 + I1 + I2 + I3 + I4 + I5 + I6 + I7;
    for (int it = C.gw; it < NIT; it += C.NGW) {
        int r = it;
        if (r < I0) { const int db = r >> 4, kb = r & 15; int src = 0, nv = 32;
            if (db < 16) src = 32 * db; else if (db == 16) src = 512; else if (db == 17) { src = 2080; nv = 16; } else if (db < 24) { src = 0; nv = 0; }
            else if (db < 32) src = 544 + 32 * (db - 24); else if (db < 40) src = 800 + 32 * (db - 32); else src = 1568 + 32 * (db - 40);
            tr_item(w_in, DM, INW, 64 * kb, src, nv, (bf16*)(ws + WS_WIN), 32 * db, 1.f, scr, C.lane); continue; } r -= I0;
        if (r < I1) { const int db = r >> 4, kb = r & 15; tr_item(w_in, DM, INW, 64 * kb, 1056 + 32 * db, 32, (bf16*)(ws + WS_WGV), 32 * db, 1.f, scr, C.lane); continue; } r -= I1;
        if (r < I2) { const int db = r >> 2, kb = r & 3; tr_item(w_uq, 256, 768, 64 * kb, 32 * db, 32, (bf16*)(ws + WS_WUQ), 32 * db, QSCALE, scr, C.lane); continue; } r -= I2;
        if (r < I3) { const int db = r >> 2, kb = r & 3; tr_item(w_ukv, 256, 1024, 64 * kb, (db >> 1) * 128 + (db & 1) * 32, 32, (bf16*)(ws + WS_WUK), 32 * db, 1.f, scr, C.lane); continue; } r -= I3;
        if (r < I4) { const int db = r >> 2, kb = r & 3; tr_item(w_ukv, 256, 1024, 64 * kb, (db >> 1) * 128 + 64 + (db & 1) * 32, 32, (bf16*)(ws + WS_WUV), 32 * db, 1.f, scr, C.lane); continue; } r -= I4;
        if (r < I5) { const int db = r >> 4, kb = r & 15; tr_item(w_o, DM, DM, 64 * kb, 32 * db, 32, (bf16*)(ws + WS_WO), 32 * db, 1.f, scr, C.lane); continue; } r -= I5;
        if (r < I6) { const int db = r >> 4, kb = r & 15; const int pn = db >> 3, t = db & 7; const int src = (t < 4) ? 128 * pn + 32 * t : DFF + 128 * pn + 32 * (t - 4);
            tr_item(w_gu, DM, 2 * DFF, 64 * kb, src, 32, (bf16*)(ws + WS_WGU), 32 * db, 1.f, scr, C.lane); continue; } r -= I6;
        { const int db = r / 44, kb = r % 44; tr_item(w_d, DFF, DM, 64 * kb, 32 * db, 32, (bf16*)(ws + WS_WD), 32 * db, 1.f, scr, C.lane); }
    }
}

__device__ __forceinline__ void norm_row(const float* xrow, const float* g, bf16* orow, float* copy, int lane) {
    const f32x4* xr = (const f32x4*)xrow + lane; const f32x4* gr = (const f32x4*)g + lane;
    f32x4 v[4]; float s = 0.f;
#pragma unroll
    for (int j = 0; j < 4; ++j) { v[j] = xr[64 * j]; s += (v[j].x * v[j].x + v[j].y * v[j].y) + (v[j].z * v[j].z + v[j].w * v[j].w); }
    const float rstd = 1.0f / sqrtf(wave_sum(s) * (1.f / DM) + EPS);
    if (copy) {
#pragma unroll
        for (int j = 0; j < 4; ++j) ((f32x4*)copy + lane)[64 * j] = v[j]; }
    u32x2* o8 = (u32x2*)orow + lane;
#pragma unroll
    for (int j = 0; j < 4; ++j) { const f32x4 gg = gr[64 * j]; u32x2 w; w.x = pk2(v[j].x * rstd * gg.x, v[j].y * rstd * gg.y); w.y = pk2(v[j].z * rstd * gg.z, v[j].w * rstd * gg.w); o8[64 * j] = w; }
}
__device__ __forceinline__ void final_norm_row(float* xrow, const float* g, int lane) {
    f32x4* xr = (f32x4*)xrow + lane; const f32x4* gr = (const f32x4*)g + lane;
    f32x4 v[4]; float s = 0.f;
#pragma unroll
    for (int j = 0; j < 4; ++j) { v[j] = xr[64 * j]; s += (v[j].x * v[j].x + v[j].y * v[j].y) + (v[j].z * v[j].z + v[j].w * v[j].w); }
    const float rstd = 1.0f / sqrtf(wave_sum(s) * (1.f / DM) + EPS);
#pragma unroll
    for (int j = 0; j < 4; ++j) { const f32x4 gg = gr[64 * j]; xr[64 * j] = v[j] * rstd * gg; }
}

__device__ __forceinline__ void norm_row2(const float* x0, const float* x1, const f32x4 (&gv)[4], bf16* o0, bf16* o1, bool has1, int lane) {
    const f32x4* p0 = (const f32x4*)x0 + lane; const f32x4* p1 = (const f32x4*)x1 + lane;
    f32x4 v0[4], v1[4]; float s0 = 0.f, s1 = 0.f;
#pragma unroll
    for (int j = 0; j < 4; ++j) { v0[j] = p0[64 * j]; v1[j] = p1[64 * j]; }
#pragma unroll
    for (int j = 0; j < 4; ++j) { s0 += (v0[j].x * v0[j].x + v0[j].y * v0[j].y) + (v0[j].z * v0[j].z + v0[j].w * v0[j].w); s1 += (v1[j].x * v1[j].x + v1[j].y * v1[j].y) + (v1[j].z * v1[j].z + v1[j].w * v1[j].w); }
    const float r0 = 1.0f / sqrtf(wave_sum(s0) * (1.f / DM) + EPS), r1 = 1.0f / sqrtf(wave_sum(s1) * (1.f / DM) + EPS);
    u32x2* q0 = (u32x2*)o0 + lane; u32x2* q1 = (u32x2*)o1 + lane;
#pragma unroll
    for (int j = 0; j < 4; ++j) { u32x2 w; w.x = pk2(v0[j].x * r0 * gv[j].x, v0[j].y * r0 * gv[j].y); w.y = pk2(v0[j].z * r0 * gv[j].z, v0[j].w * r0 * gv[j].w); q0[64 * j] = w; }
    if (has1) {
#pragma unroll
        for (int j = 0; j < 4; ++j) { u32x2 w; w.x = pk2(v1[j].x * r1 * gv[j].x, v1[j].y * r1 * gv[j].y); w.y = pk2(v1[j].z * r1 * gv[j].z, v1[j].w * r1 * gv[j].w); q1[64 * j] = w; } }
}
__device__ __forceinline__ void final_norm_row2(float* x0, float* x1, const f32x4 (&gv)[4], bool has1, int lane) {
    f32x4* p0 = (f32x4*)x0 + lane; f32x4* p1 = (f32x4*)x1 + lane;
    f32x4 v0[4], v1[4]; float s0 = 0.f, s1 = 0.f;
#pragma unroll
    for (int j = 0; j < 4; ++j) { v0[j] = p0[64 * j]; v1[j] = p1[64 * j]; }
#pragma unroll
    for (int j = 0; j < 4; ++j) { s0 += (v0[j].x * v0[j].x + v0[j].y * v0[j].y) + (v0[j].z * v0[j].z + v0[j].w * v0[j].w); s1 += (v1[j].x * v1[j].x + v1[j].y * v1[j].y) + (v1[j].z * v1[j].z + v1[j].w * v1[j].w); }
    const float r0 = 1.0f / sqrtf(wave_sum(s0) * (1.f / DM) + EPS), r1 = 1.0f / sqrtf(wave_sum(s1) * (1.f / DM) + EPS);
#pragma unroll
    for (int j = 0; j < 4; ++j) p0[64 * j] = v0[j] * r0 * gv[j];
    if (has1) {
#pragma unroll
        for (int j = 0; j < 4; ++j) p1[64 * j] = v1[j] * r1 * gv[j]; }
}
struct P3Loads { u32x2 cq, ckv; u32x4 g0, g1; unsigned short x1r, x2r; float rc, rs; };
__device__ __forceinline__ int p3_pos(int m) { return (m < NP) ? (m & (SEQ - 1)) : PAST + ((m - NP) & 31); }
__device__ __forceinline__ P3Loads p3_load(const Args& A, int m, int lane) {
    unsigned char* ws = A.ws; P3Loads L;
    const bf16* CQ = (const bf16*)(ws + WS_Z); const bf16* CKV = (const bf16*)(ws + WS_Z + T256); const bf16* MISC = (const bf16*)(ws + WS_Z + 2 * T256);
    const float* ROPE = (const float*)(ws + WS_ROPE);
    L.cq = *((const u32x2*)(CQ + (size_t)m * 256) + lane); L.ckv = *((const u32x2*)(CKV + (size_t)m * 256) + lane);
    L.g0 = *(const u32x4*)(MISC + (size_t)m * 256 + 32); L.g1 = *(const u32x4*)(MISC + (size_t)m * 256 + 40);
    L.x1r = MISC[(size_t)m * 256 + lane]; L.x2r = MISC[(size_t)m * 256 + 16 + lane];
    const int pos = p3_pos(m); L.rc = ROPE[pos * 32 + (lane & 15)]; L.rs = ROPE[pos * 32 + 16 + (lane & 15)];
    return L;
}
__device__ __forceinline__ void p3_token(const Args& A, int l, int m, int lane, const f32x4 (&wv)[16], const f32x4& bv, const f32x4& gq, const f32x4& gkv, const P3Loads& L) {
    unsigned char* ws = A.ws;
    { const u32x2 w = L.cq; const float a = bflo(w.x), b = bfhi(w.x), c = bflo(w.y), d = bfhi(w.y);
      const float rstd = 1.0f / sqrtf(wave_sum((a * a + b * b) + (c * c + d * d)) * (1.f / 256) + EPS);
      u32x2 o; o.x = pk2(a * rstd * gq.x, b * rstd * gq.y); o.y = pk2(c * rstd * gq.z, d * rstd * gq.w);
      *((u32x2*)((bf16*)(ws + WS_CQN) + (size_t)m * 256) + lane) = o; }
    float* ockv; float* okr; bf16* bckv; bf16* bkr;
    if (m < NP) { ockv = A.out + O_CKVP + ((size_t)l * NP + m) * 256; okr = A.out + O_KRP + ((size_t)l * NP + m) * 32;
        bckv = (bf16*)(ws + WS_CKVN) + (size_t)m * 256; bkr = (bf16*)(ws + WS_KR) + (size_t)m * 32; }
    else { const int s = m - NP, b = s >> 5, t = s & 31; ockv = A.out + O_CKVS + ((size_t)l * NSQ + s) * 256; okr = A.out + O_KRS + ((size_t)l * NSQ + s) * 32;
        const size_t r = (size_t)b * SKV + PAST + t; bckv = (bf16*)(ws + WS_CKVS) + r * 256; bkr = (bf16*)(ws + WS_KRS) + r * 32; }
    { const u32x2 w = L.ckv; const float a = bflo(w.x), b = bfhi(w.x), c = bflo(w.y), d = bfhi(w.y);
      const float rstd = 1.0f / sqrtf(wave_sum((a * a + b * b) + (c * c + d * d)) * (1.f / 256) + EPS);
      const f32x4 o = (f32x4){a * rstd * gkv.x, b * rstd * gkv.y, c * rstd * gkv.z, d * rstd * gkv.w};
      *((f32x4*)ockv + lane) = o;
      u32x2 ob; ob.x = pk2(o.x, o.y); ob.y = pk2(o.z, o.w); *((u32x2*)bckv + lane) = ob; }
    if (lane < 16) { const float x1 = bf2f(L.x1r), x2 = bf2f(L.x2r); const float c = L.rc, s = L.rs;
        const float o1 = x1 * c - x2 * s, o2 = x1 * s + x2 * c;
        okr[lane] = o1; okr[16 + lane] = o2; bkr[lane] = (bf16)f2bf(o1); bkr[16 + lane] = (bf16)f2bf(o2); }
    else if (lane < 32) { ((float*)(ws + WS_GA))[(size_t)m * 16 + (lane - 16)] = bf2f(L.x2r); }
    { const u32x4 g0 = L.g0, g1 = L.g1;
      f32x4 x = bv;
#pragma unroll
      for (int q = 0; q < 4; ++q) { x = x + wv[2 * q] * bflo(g0[q]) + wv[2 * q + 1] * bfhi(g0[q]); }
#pragma unroll
      for (int q = 0; q < 4; ++q) { x = x + wv[8 + 2 * q] * bflo(g1[q]) + wv[8 + 2 * q + 1] * bfhi(g1[q]); }
      u32x2 o; o.x = pk2(logsig(x.x) * (1.f / 16.f), logsig(x.y) * (1.f / 16.f)); o.y = pk2(logsig(x.z) * (1.f / 16.f), logsig(x.w) * (1.f / 16.f));
      *((u32x2*)((bf16*)(ws + WS_LG) + (size_t)m * 256) + lane) = o; }
}
__device__ __forceinline__ void cache_row(const Args& A, int l, int r, int lane) {
    const int b = r >> 11, p = r & (PAST - 1); const size_t dr = (size_t)b * SKV + p;
    const f32x4 v = *((const f32x4*)(A.cckv + ((size_t)l * DEC_B * PAST + r) * 256) + lane);
    u32x2 o; o.x = pk2(v.x, v.y); o.y = pk2(v.z, v.w); *((u32x2*)((bf16*)(A.ws + WS_CKVS) + dr * 256) + lane) = o;
    if (lane < 32) ((bf16*)(A.ws + WS_KRS))[dr * 32 + lane] = (bf16)f2bf(A.ckr[((size_t)l * DEC_B * PAST + r) * 32 + lane]);
}

struct GlaItem { int tok0, L, hd, sb; bool sample; };
__device__ __forceinline__ GlaItem gla_decode(int it) {
    GlaItem g;
    if (it < NITEM_P) { g.hd = it & 3; const int bc = it >> 2; g.tok0 = bc * 64; g.L = 64; g.sample = false; g.sb = 0; }
    else { const int j = it - NITEM_P; g.hd = j & 3; g.sb = j >> 2; g.tok0 = NP + g.sb * 32; g.L = 32; g.sample = true; }
    return g;
}
typedef float f32x2_t __attribute__((ext_vector_type(2))); typedef __bf16 bf16x2_t __attribute__((ext_vector_type(2)));
__device__ __forceinline__ unsigned cvtpk(float lo, float hi) { f32x2_t v = {lo, hi}; bf16x2_t b = __builtin_convertvector(v, bf16x2_t); return __builtin_bit_cast(unsigned, b); }
__device__ __forceinline__ float gate_lg(const float (&ga)[16], const float (&w)[16], float bias, int p, const float* g_GA_base) { return 0.f; }
constexpr int KT_PITCH = 72;
template <bool SAMPLE> __device__ __forceinline__ void gla_g1(const Args& A, int l, int it, LAS unsigned char* wl, int lane) {
    const GlaItem g = gla_decode(it); unsigned char* ws = A.ws; constexpr int L = SAMPLE ? 32 : 64;
    const int col = g.hd * 64 + lane, r32 = lane & 31, hi = lane >> 5;
    const float* GA = (const float*)(ws + WS_GA); const bf16* GK = (const bf16*)(ws + WS_Z + 4 * T256); const bf16* GVT = (const bf16*)(ws + WS_GVT);
    LAS bf16* kT = (LAS bf16*)wl; LAS float* dsm = (LAS float*)(wl + 64 * KT_PITCH * 2);
    float w[16], ga[16];
#pragma unroll
    for (int r = 0; r < 16; ++r) w[r] = A.w_a2[(size_t)l * 16 * 256 + r * 256 + col];
    const float bias = A.b_a2[l * 256 + col];
    { const int pl = lane < L ? lane : L - 1;
#pragma unroll
      for (int q = 0; q < 4; ++q) { const f32x4 v = *(const f32x4*)(GA + (size_t)(g.tok0 + pl) * 16 + 4 * q); ga[4 * q] = v.x; ga[4 * q + 1] = v.y; ga[4 * q + 2] = v.z; ga[4 * q + 3] = v.w; } }
    float blast = 0.f; float lgv[L];
#pragma unroll
    for (int p = 0; p < L; ++p) { lgv[p] = bf2f(((const bf16*)(ws + WS_LG))[(size_t)(g.tok0 + p) * 256 + col]); blast += lgv[p]; }
    float bc = 0.f;
#pragma unroll
    for (int p = 0; p < L; ++p) { bc += lgv[p];
        const float kk = bf2f(GK[(size_t)(g.tok0 + p) * 256 + col]) * __expf(blast - bc);
        kT[lane * KT_PITCH + p] = (bf16)(cvtpk(kk, kk) & 0xffffu); }
    const float decay = __expf(blast);
    if (!SAMPLE) ((float*)(ws + WS_DECAY))[(size_t)it * 64 + lane] = decay;
    dsm[lane] = decay;
    LDS_WAIT(); asm volatile("" ::: "memory");
#pragma unroll 1
    for (int nb = 0; nb < 4; ++nb) {
        f32x16 acc[2]; acc[0] = (f32x16){}; acc[1] = (f32x16){};
#pragma unroll
        for (int s = 0; s < L / 16; ++s) {
            const bf16x8 bfr = *(const bf16x8*)(GVT + (size_t)(g.hd * 128 + 32 * nb + r32) * NTOK + g.tok0 + 16 * s + 8 * hi);
#pragma unroll
            for (int mb = 0; mb < 2; ++mb) { const bf16x8 af = *(const LAS bf16x8*)(kT + (32 * mb + r32) * KT_PITCH + 16 * s + 8 * hi); acc[mb] = MFMA32(af, bfr, acc[mb]); }
        }
        const int dv = 32 * nb + r32;
#ifdef DS_OLD
        if (!SAMPLE) { float* dsp = (float*)(ws + WS_DS) + (size_t)it * 8192 + dv;
#pragma unroll
            for (int mb = 0; mb < 2; ++mb)
#pragma unroll
                for (int r = 0; r < 16; ++r) dsp[(32 * mb + crow(r, hi)) * 128] = acc[mb][r]; }
#else
        if (!SAMPLE) { float* dsp = (float*)(ws + WS_DS) + (size_t)it * 8192 + dv * 64 + 4 * hi;
#pragma unroll
            for (int mb = 0; mb < 2; ++mb)
#pragma unroll
                for (int q = 0; q < 4; ++q) *(f32x4*)(dsp + 32 * mb + 8 * q) = (f32x4){acc[mb][4 * q], acc[mb][4 * q + 1], acc[mb][4 * q + 2], acc[mb][4 * q + 3]}; }
#endif
        else { const size_t so = (((size_t)l * DEC_B + g.sb) * 4 + g.hd) * 8192 + dv;
#pragma unroll
            for (int mb = 0; mb < 2; ++mb) {
#pragma unroll
                for (int r = 0; r < 16; ++r) { const int dk = 32 * mb + crow(r, hi); A.out[O_GLAS + so + dk * 128] = dsm[dk] * A.sgla[so + dk * 128] + acc[mb][r]; } } }
    }
    LDS_WAIT(); asm volatile("" ::: "memory");
}
constexpr int NSCAN = 128, NSAMPWG = 16;
#ifdef DS_OLD
__device__ __forceinline__ void gla_scan(const Args& A, int l, int sblock, int tid) {
    const int gth = sblock * 512 + tid;
    const int seq = gth >> 12, e0 = (gth & 4095) * 2;
    const int b = seq >> 2, hd = seq & 3, dk = e0 >> 7;
    float* DS = (float*)(A.ws + WS_DS); const float* DEC = (const float*)(A.ws + WS_DECAY);
    float s0 = 0.f, s1 = 0.f;
    for (int c0 = 0; c0 < 256; c0 += 8) {
        float2 ds[8]; float dc[8];
#pragma unroll
        for (int j = 0; j < 8; ++j) { const size_t it = (size_t)((b * 256 + c0 + j) * 4 + hd); ds[j] = *(const float2*)(DS + it * 8192 + e0); dc[j] = DEC[it * 64 + dk]; }
#pragma unroll
        for (int j = 0; j < 8; ++j) { const size_t it = (size_t)((b * 256 + c0 + j) * 4 + hd); *(float2*)(DS + it * 8192 + e0) = make_float2(s0, s1);
            s0 = dc[j] * s0 + ds[j].x; s1 = dc[j] * s1 + ds[j].y; }
    }
    *(float2*)(A.out + O_GLAP + (((size_t)l * NBATCH + b) * 4 + hd) * 8192 + e0) = make_float2(s0, s1);
}
#else
__device__ __forceinline__ void gla_scan(const Args& A, int l, int sblock, int tid) {
    const int seq = sblock >> 4, e0 = (sblock & 15) * 512 + tid;
    const int b = seq >> 2, hd = seq & 3, dv = e0 >> 6, dk = e0 & 63;
    float* DS = (float*)(A.ws + WS_DS); const float* DEC = (const float*)(A.ws + WS_DECAY);
    float s0 = 0.f;
#pragma unroll 1
    for (int c0 = 0; c0 < 256; c0 += 32) {
        float ds[32], dc[32];
#pragma unroll
        for (int j = 0; j < 32; ++j) { const size_t it = (size_t)((b * 256 + c0 + j) * 4 + hd); ds[j] = DS[it * 8192 + e0]; dc[j] = DEC[it * 64 + dk]; }
#pragma unroll
        for (int j = 0; j < 32; ++j) { const size_t it = (size_t)((b * 256 + c0 + j) * 4 + hd); DS[it * 8192 + e0] = s0; s0 = dc[j] * s0 + ds[j]; }
    }
    A.out[O_GLAP + (((size_t)l * NBATCH + b) * 4 + hd) * 8192 + dk * 128 + dv] = s0;
}
#endif
constexpr int BS_PITCH = 65;
template <bool SAMPLE> __device__ __forceinline__ void gla_g3(const Args& A, int l, int it, LAS unsigned char* wl, int lane) {
    const GlaItem g = gla_decode(it); unsigned char* ws = A.ws; constexpr int L = SAMPLE ? 32 : 64, NIB = L / 32;
    const int col = g.hd * 64 + lane, r32 = lane & 31, hi = lane >> 5;
    const float* GA = (const float*)(ws + WS_GA); const bf16* GQ = (const bf16*)(ws + WS_Z + 3 * T256); const bf16* GK = (const bf16*)(ws + WS_Z + 4 * T256);
    const bf16* GG = (const bf16*)(ws + WS_Z + 5 * T256); const bf16* GVT = (const bf16*)(ws + WS_GVT); bf16* CAT = (bf16*)(ws + WS_H);
    LAS float* bsm = (LAS float*)wl;
    {   float w[16], ga[16];
#pragma unroll
        for (int r = 0; r < 16; ++r) w[r] = A.w_a2[(size_t)l * 16 * 256 + r * 256 + col];
        const float bias = A.b_a2[l * 256 + col];
        { const int pl = lane < L ? lane : L - 1;
#pragma unroll
          for (int q = 0; q < 4; ++q) { const f32x4 v = *(const f32x4*)(GA + (size_t)(g.tok0 + pl) * 16 + 4 * q); ga[4 * q] = v.x; ga[4 * q + 1] = v.y; ga[4 * q + 2] = v.z; ga[4 * q + 3] = v.w; } }
        float bc = 0.f;
#pragma unroll 16
        for (int p = 0; p < L; ++p) { bc += bf2f(((const bf16*)(ws + WS_LG))[(size_t)(g.tok0 + p) * 256 + col]); bsm[p * BS_PITCH + lane] = bc; }
    }
    LDS_WAIT(); asm volatile("" ::: "memory");
    bf16x8 qf[NIB][4], kf[NIB][4];
#pragma unroll
    for (int ib = 0; ib < NIB; ++ib)
#pragma unroll
        for (int s = 0; s < 4; ++s) {
            const int i = 32 * ib + r32, dk0 = 16 * s + 8 * hi;
            const u32x4 rq = *(const u32x4*)(GQ + (size_t)(g.tok0 + i) * 256 + g.hd * 64 + dk0);
            const u32x4 rk = *(const u32x4*)(GK + (size_t)(g.tok0 + i) * 256 + g.hd * 64 + dk0);
            u32x4 oq, ok;
#pragma unroll
            for (int jj = 0; jj < 4; ++jj) { const float b0 = bsm[i * BS_PITCH + dk0 + 2 * jj], b1 = bsm[i * BS_PITCH + dk0 + 2 * jj + 1];
                const float e0 = __expf(b0), e1 = __expf(b1);
                oq[jj] = cvtpk(bflo(rq[jj]) * 0.125f * e0, bfhi(rq[jj]) * 0.125f * e1);
                ok[jj] = cvtpk(bflo(rk[jj]) * __expf(-b0), bfhi(rk[jj]) * __expf(-b1)); }
            qf[ib][s] = __builtin_bit_cast(bf16x8, oq); kf[ib][s] = __builtin_bit_cast(bf16x8, ok);
        }
    bf16x8 xp[NIB][NIB][2];
#pragma unroll
    for (int jb = 0; jb < NIB; ++jb)
#pragma unroll
        for (int ib = 0; ib < NIB; ++ib) {
            if (jb > ib) { xp[jb][ib][0] = (bf16x8){}; xp[jb][ib][1] = (bf16x8){}; continue; }
            f32x16 X = (f32x16){};
#pragma unroll
            for (int s = 0; s < 4; ++s) X = MFMA32(kf[jb][s], qf[ib][s], X);
            if (jb == ib) {
#pragma unroll
                for (int r = 0; r < 16; ++r) if (crow(r, hi) > r32) X[r] = 0.f; }
#pragma unroll
            for (int s2 = 0; s2 < 2; ++s2) { u32x4 pw;
#pragma unroll
                for (int jj = 0; jj < 4; ++jj) pw[jj] = cvtpk(X[8 * s2 + 2 * jj], X[8 * s2 + 2 * jj + 1]);
                xp[jb][ib][s2] = __builtin_bit_cast(bf16x8, pw); }
        }
    const float* Sp = SAMPLE ? A.sgla + (((size_t)l * DEC_B + g.sb) * 4 + g.hd) * 8192 : (const float*)(ws + WS_DS) + (size_t)it * 8192;
#pragma unroll
    for (int ib = 0; ib < NIB; ++ib) {
        f32x16 o[4];
#pragma unroll
        for (int nb = 0; nb < 4; ++nb) {
            const int dv = 32 * nb + r32;
            o[nb] = (f32x16){};
#pragma unroll
            for (int s = 0; s < 4; ++s) { u32x4 pw;
#ifdef DS_OLD
                if (true) {
#else
                if (SAMPLE) {
#endif
#pragma unroll
                    for (int jj = 0; jj < 4; ++jj) pw[jj] = cvtpk(Sp[(16 * s + 8 * hi + 2 * jj) * 128 + dv], Sp[(16 * s + 8 * hi + 2 * jj + 1) * 128 + dv]); }
                else { const f32x4 sa = *(const f32x4*)(Sp + dv * 64 + 16 * s + 8 * hi), sb = *(const f32x4*)(Sp + dv * 64 + 16 * s + 8 * hi + 4);
                    pw = (u32x4){cvtpk(sa.x, sa.y), cvtpk(sa.z, sa.w), cvtpk(sb.x, sb.y), cvtpk(sb.z, sb.w)}; }
                o[nb] = MFMA32(__builtin_bit_cast(bf16x8, pw), qf[ib][s], o[nb]); }
#pragma unroll
            for (int jb = 0; jb <= ib; ++jb)
#pragma unroll
                for (int s2 = 0; s2 < 2; ++s2) { const bf16* vp = GVT + (size_t)(g.hd * 128 + dv) * NTOK + g.tok0 + 32 * jb + 16 * s2 + 4 * hi;
                    const u32x2 lo = *(const u32x2*)vp, hi8 = *(const u32x2*)(vp + 8);
                    o[nb] = MFMA32(__builtin_bit_cast(bf16x8, (u32x4){lo.x, lo.y, hi8.x, hi8.y}), xp[jb][ib][s2], o[nb]); }
        }
        float ss = 0.f;
#pragma unroll
        for (int nb = 0; nb < 4; ++nb)
#pragma unroll
            for (int r = 0; r < 16; ++r) ss += o[nb][r] * o[nb][r];
        ss += __shfl_xor(ss, 32);
        const float rstd = 1.0f / sqrtf(ss * (1.f / 128) + EPS);
        const int tok = g.tok0 + 32 * ib + r32;
#pragma unroll
        for (int nb = 0; nb < 4; ++nb)
#pragma unroll
            for (int q = 0; q < 4; ++q) { const int dv0 = 32 * nb + 8 * q + 4 * hi; const int gc = g.hd * 128 + dv0;
                const u32x2 gw = *(const u32x2*)(GG + (size_t)(gc >> 8) * ((size_t)NTOK * 256) + (size_t)tok * 256 + (gc & 255));
                const f32x4 gon = *(const f32x4*)(A.g_on + l * 128 + dv0);
                const float g0 = bflo(gw.x), g1 = bfhi(gw.x), g2 = bflo(gw.y), g3 = bfhi(gw.y);
                const float v0 = o[nb][4 * q + 0] * rstd * gon.x * g0 * __builtin_amdgcn_rcpf(1.0f + __expf(-g0));
                const float v1 = o[nb][4 * q + 1] * rstd * gon.y * g1 * __builtin_amdgcn_rcpf(1.0f + __expf(-g1));
                const float v2 = o[nb][4 * q + 2] * rstd * gon.z * g2 * __builtin_amdgcn_rcpf(1.0f + __expf(-g2));
                const float v3 = o[nb][4 * q + 3] * rstd * gon.w * g3 * __builtin_amdgcn_rcpf(1.0f + __expf(-g3));
                u32x2 ow; ow.x = cvtpk(v0, v1); ow.y = cvtpk(v2, v3);
                *(u32x2*)(CAT + (size_t)tok * 1024 + 512 + g.hd * 128 + dv0) = ow; }
        asm volatile("" ::: "memory");
    }
    LDS_WAIT(); asm volatile("" ::: "memory");
}

__device__ __forceinline__ float max3f(float a, float b, float c) { return fmaxf(fmaxf(a, b), c); }
constexpr float ATT_THR = 8.0f;
template <class LD> __device__ __forceinline__ void attn_tile(const LD& ld, const bf16x8 (&qr)[6], f32x16 (&o)[2], float& m, float& l, bool half_only, bool first) {
    f32x16 negm;
#pragma unroll
    for (int r = 0; r < 16; ++r) negm[r] = -m;
    f32x16 p0 = negm, p1 = negm;
#pragma unroll
    for (int s = 0; s < 6; ++s) p0 = MFMA32(ld.k(0, s), qr[s], p0);
    if (!half_only) {
#pragma unroll
        for (int s = 0; s < 6; ++s) p1 = MFMA32(ld.k(1, s), qr[s], p1); }
    float mx = max3f(p0[0], p0[1], p0[2]);
#pragma unroll
    for (int r = 3; r < 15; r += 2) mx = max3f(mx, p0[r], p0[r + 1]);
    mx = fmaxf(mx, p0[15]);
    if (!half_only) {
#pragma unroll
        for (int r = 0; r < 16; r += 2) mx = max3f(mx, p1[r], p1[r + 1]); }
    mx = fmaxf(mx, __shfl_xor(mx, 32));
    if (first || __any(mx > ATT_THR)) {
        const float d = first ? mx : fmaxf(mx, 0.f);
        m += d;
        const float f = first ? 0.f : __builtin_amdgcn_exp2f(-d);
        l *= f;
#pragma unroll
        for (int r = 0; r < 16; ++r) { p0[r] -= d; p1[r] -= d; o[0][r] *= f; o[1][r] *= f; }
    }
    float rs = 0.f, rs1 = 0.f;
#pragma unroll
    for (int r = 0; r < 16; ++r) { p0[r] = __builtin_amdgcn_exp2f(p0[r]); rs += p0[r]; }
    if (!half_only) {
#pragma unroll
        for (int r = 0; r < 16; ++r) { p1[r] = __builtin_amdgcn_exp2f(p1[r]); rs1 += p1[r]; } }
    l += rs + rs1;
    bf16x8 pa[4];
#pragma unroll
    for (int s = 0; s < 2; ++s) { u32x4 w0, w1;
#pragma unroll
        for (int jj = 0; jj < 4; ++jj) { w0[jj] = cvtpk(p0[8 * s + 2 * jj], p0[8 * s + 2 * jj + 1]); w1[jj] = cvtpk(p1[8 * s + 2 * jj], p1[8 * s + 2 * jj + 1]); }
        pa[s] = __builtin_bit_cast(bf16x8, w0); pa[2 + s] = __builtin_bit_cast(bf16x8, w1); }
#pragma unroll
    for (int db = 0; db < 2; ++db) {
#pragma unroll
        for (int s = 0; s < 2; ++s) o[db] = MFMA32(ld.v(db, s), pa[s], o[db]);
        if (!half_only) {
#pragma unroll
            for (int s = 2; s < 4; ++s) o[db] = MFMA32(ld.v(db, s), pa[s], o[db]); }
    }
}
constexpr int K_PITCH = 208, V_PITCH = 136, KBUF = 64 * K_PITCH, VBUF = 64 * V_PITCH, ABUF = KBUF + VBUF;
struct LdsLoader {
    LAS const unsigned char* kb; LAS const unsigned char* vb; int r32, hi;
    __device__ __forceinline__ bf16x8 k(int half, int s) const { return *(LAS const bf16x8*)(kb + (r32 + 32 * half) * K_PITCH + s * 32 + hi * 16); }
    __device__ __forceinline__ bf16x8 v(int db, int s) const { LAS const unsigned char* p = vb + (r32 + 32 * db) * V_PITCH + s * 32 + hi * 8;
        const u32x2 lo = *(LAS const u32x2*)p, h8 = *(LAS const u32x2*)(p + 16); return __builtin_bit_cast(bf16x8, (u32x4){lo.x, lo.y, h8.x, h8.y}); }
};
struct GlbLoader {
    const bf16* kn; const bf16* kr; const bf16* vt; int r32, hi;
    __device__ __forceinline__ bf16x8 k(int half, int s) const { const int kv = r32 + 32 * half;
        return (s < 4) ? *(const bf16x8*)(kn + (size_t)kv * 512 + 16 * s + 8 * hi) : *(const bf16x8*)(kr + (size_t)kv * 32 + 16 * (s - 4) + 8 * hi); }
    __device__ __forceinline__ bf16x8 v(int db, int s) const { const bf16* p = vt + (size_t)(r32 + 32 * db) * NKVS + 16 * s + 4 * hi;
        const u32x2 lo = *(const u32x2*)p, h8 = *(const u32x2*)(p + 8); return __builtin_bit_cast(bf16x8, (u32x4){lo.x, lo.y, h8.x, h8.y}); }
};
__device__ __forceinline__ void load_q(bf16x8 (&qr)[6], const bf16* qp, const float* rope_row, int hi) {
#pragma unroll
    for (int s = 0; s < 6; ++s) qr[s] = *(const bf16x8*)(qp + 16 * s + 8 * hi);
    const u32x4 a = __builtin_bit_cast(u32x4, qr[4]), b = __builtin_bit_cast(u32x4, qr[5]); u32x4 oa, ob;
    const f32x4 c0 = *(const f32x4*)(rope_row + 8 * hi), c1 = *(const f32x4*)(rope_row + 8 * hi + 4), s0 = *(const f32x4*)(rope_row + 16 + 8 * hi), s1 = *(const f32x4*)(rope_row + 16 + 8 * hi + 4);
#pragma unroll
    for (int jj = 0; jj < 4; ++jj) {
        const float x1l = bflo(a[jj]), x1h = bfhi(a[jj]), x2l = bflo(b[jj]), x2h = bfhi(b[jj]);
        const float cl = (jj < 2) ? c0[2 * jj] : c1[2 * jj - 4], ch = (jj < 2) ? c0[2 * jj + 1] : c1[2 * jj - 3];
        const float sl = (jj < 2) ? s0[2 * jj] : s1[2 * jj - 4], sh = (jj < 2) ? s0[2 * jj + 1] : s1[2 * jj - 3];
        oa[jj] = pk2(x1l * cl - x2l * sl, x1h * ch - x2h * sh); ob[jj] = pk2(x1l * sl + x2l * cl, x1h * sh + x2h * ch); }
    qr[4] = __builtin_bit_cast(bf16x8, oa); qr[5] = __builtin_bit_cast(bf16x8, ob);
}
__device__ __forceinline__ float halfmax(float x) { auto rr = __builtin_amdgcn_permlane32_swap(__float_as_uint(x), __float_as_uint(x), false, false); return fmaxf(__uint_as_float(rr[0]), __uint_as_float(rr[1])); }
__device__ __forceinline__ float halfsum(float x) { auto rr = __builtin_amdgcn_permlane32_swap(__float_as_uint(x), __float_as_uint(x), false, false); return __uint_as_float(rr[0]) + __uint_as_float(rr[1]); }
__device__ __forceinline__ float rowmax32(const f32x16& c0, const f32x16& c1) {
    float mx = max3f(c0[0], c0[1], c0[2]);
#pragma unroll
    for (int r = 3; r < 15; r += 2) mx = max3f(mx, c0[r], c0[r + 1]);
    mx = fmaxf(mx, c0[15]);
#pragma unroll
    for (int r = 0; r < 16; r += 2) mx = max3f(mx, c1[r], c1[r + 1]);
    return halfmax(mx);
}
__device__ __forceinline__ void attn_qk(const LdsLoader& ld, const bf16x8 (&qr)[6], float m, f32x16& c0, f32x16& c1) {
    f32x16 negm;
#pragma unroll
    for (int r = 0; r < 16; ++r) negm[r] = -m;
    c0 = negm; c1 = negm;
#pragma unroll
    for (int s = 0; s < 6; ++s) { c0 = MFMA32(ld.k(0, s), qr[s], c0); c1 = MFMA32(ld.k(1, s), qr[s], c1); }
}
__device__ __forceinline__ void attn_prompt_unit(const Args& A, const Ctx& C, int b, int hd, int qb) {
    int tid_ = threadIdx.x; asm volatile("" : "+v"(tid_));
    unsigned char* ws = A.ws; const int tid = tid_, lane = tid & 63, wid = C.wave, r32 = lane & 31, hi = lane >> 5;
    const bf16* Q = (const bf16*)(ws + WS_Z); const bf16* KN = (const bf16*)(ws + WS_KN); const bf16* KR = (const bf16*)(ws + WS_KR); const bf16* VT = (const bf16*)(ws + WS_VT);
    bf16* CAT = (bf16*)(ws + WS_H); const float* ROPE = (const float*)(ws + WS_ROPE);
    const int pos = qb * 256 + wid * 32 + r32; const size_t qrow = (size_t)b * SEQ + pos;
    bf16x8 qr[6]; load_q(qr, Q + qrow * 768 + hd * 96, ROPE + (size_t)pos * 32, hi);
    const int ntiles = 4 * qb + 4, my_last = 4 * qb + (wid >> 1);
    const int krow = tid >> 3, kch = tid & 7, rrow = (tid & 255) >> 2, rch = tid & 3;
    const char* kn_base = (const char*)(KN + (size_t)b * SEQ * 512 + hd * 64); const char* kr_base = (const char*)(KR + (size_t)b * SEQ * 32);
    const char* vt_base = (const char*)(VT + (size_t)(hd * 64) * NP + (size_t)b * SEQ);
    const unsigned kn_off = (unsigned)(krow * 512 + kch * 8) * 2u, kr_off = (unsigned)(rrow * 32 + rch * 8) * 2u, vt_off = (unsigned)(krow * NP + kch * 8) * 2u;
    const int kn_dst = krow * K_PITCH + kch * 16, kr_dst = rrow * K_PITCH + 128 + rch * 16, vt_dst = KBUF + krow * V_PITCH + kch * 16;
    u32x4 sk, sr, sv;
#define ATT_GLOAD(tt) do { sk = *(const u32x4*)(kn_base + (size_t)(tt) * (64 * 512 * 2) + kn_off); sv = *(const u32x4*)(vt_base + (size_t)(tt) * 128 + vt_off); if (tid < 256) sr = *(const u32x4*)(kr_base + (size_t)(tt) * (64 * 32 * 2) + kr_off); } while (0)
#define ATT_LSTORE(slot_) do { LAS unsigned char* bufp = C.lds + (slot_) * ABUF; *(LAS u32x4*)(bufp + kn_dst) = sk; if (tid < 256) *(LAS u32x4*)(bufp + kr_dst) = sr; \
        *(LAS u32x2*)(bufp + vt_dst) = (u32x2){sv.x, sv.y}; *(LAS u32x2*)(bufp + vt_dst + 8) = (u32x2){sv.z, sv.w}; } while (0)
    { u32x4 sk1, sv1, sr1;
      sk1 = *(const u32x4*)(kn_base + (size_t)(64 * 512 * 2) + kn_off); sv1 = *(const u32x4*)(vt_base + (size_t)128 + vt_off); if (tid < 256) sr1 = *(const u32x4*)(kr_base + (size_t)(64 * 32 * 2) + kr_off);
      ATT_GLOAD(0); ATT_LSTORE(0);
      sk = sk1; sv = sv1; sr = sr1; ATT_LSTORE(1); }
    __syncthreads();
    f32x16 o[2]; o[0] = zero16(); o[1] = zero16(); float m = o[0][0], l = m;
    f32x16 c0, c1;
    { const LdsLoader ld0{C.lds, C.lds + KBUF, r32, hi}; attn_qk(ld0, qr, m, c0, c1); }
    int slot = 0;
    for (int t = 0; t < ntiles; ++t) {
        const int s1 = (slot == 2) ? 0 : slot + 1, s2 = (s1 == 2) ? 0 : s1 + 1;
        const bool more = (t + 2 < ntiles);
        if (more) ATT_GLOAD(t + 2);
        if (t <= my_last) {
            bf16x8 kf[12];
            { const LdsLoader ldn{C.lds + s1 * ABUF, C.lds + s1 * ABUF + KBUF, r32, hi};
#pragma unroll
              for (int s = 0; s < 6; ++s) { kf[2 * s] = ldn.k(0, s); kf[2 * s + 1] = ldn.k(1, s); } }
            const float mx = rowmax32(c0, c1);
            const bool first = (t == 0);
            if (first || __any(mx > ATT_THR)) {
                const float d = first ? mx : fmaxf(mx, 0.f);
                m += d; const float f = first ? 0.f : __builtin_amdgcn_exp2f(-d); l *= f;
#pragma unroll
                for (int r = 0; r < 16; ++r) { c0[r] -= d; c1[r] -= d; o[0][r] *= f; o[1][r] *= f; }
            }
            f32x16 n0, n1;
            { f32x16 negm;
#pragma unroll
              for (int r = 0; r < 16; ++r) negm[r] = -m;
              n0 = negm; n1 = negm;
#pragma unroll
              for (int s = 0; s < 6; ++s) { n0 = MFMA32(kf[2 * s], qr[s], n0); n1 = MFMA32(kf[2 * s + 1], qr[s], n1); } }
            float rs0 = 0.f, rs1 = 0.f;
#pragma unroll
            for (int r = 0; r < 16; ++r) { c0[r] = __builtin_amdgcn_exp2f(c0[r]); rs0 += c0[r]; c1[r] = __builtin_amdgcn_exp2f(c1[r]); rs1 += c1[r]; }
            l += rs0 + rs1;
            bf16x8 pa[4];
#pragma unroll
            for (int s = 0; s < 2; ++s) { u32x4 w0, w1;
#pragma unroll
                for (int jj = 0; jj < 4; ++jj) { w0[jj] = cvtpk(c0[8 * s + 2 * jj], c0[8 * s + 2 * jj + 1]); w1[jj] = cvtpk(c1[8 * s + 2 * jj], c1[8 * s + 2 * jj + 1]); }
                pa[s] = __builtin_bit_cast(bf16x8, w0); pa[2 + s] = __builtin_bit_cast(bf16x8, w1); }
            { const LdsLoader ldv{C.lds + slot * ABUF, C.lds + slot * ABUF + KBUF, r32, hi};
#pragma unroll
              for (int s = 0; s < 4; ++s) { o[0] = MFMA32(ldv.v(0, s), pa[s], o[0]); o[1] = MFMA32(ldv.v(1, s), pa[s], o[1]); } }
            c0 = n0; c1 = n1;
#ifdef ATT_SGB
#pragma unroll
            for (int i = 0; i < 20; ++i) { __builtin_amdgcn_sched_group_barrier(0x008, 1, 0); __builtin_amdgcn_sched_group_barrier(0x100, 2, 0); __builtin_amdgcn_sched_group_barrier(0x002, 4, 0); }
#endif
        }
        if (more) ATT_LSTORE(s2);
        slot = s1;
        __syncthreads();
    }
#undef ATT_GLOAD
#undef ATT_LSTORE
    const float lt = halfsum(l); const float inv = 1.0f / lt;
    bf16* orow = CAT + qrow * 1024 + hd * 64;
#pragma unroll
    for (int db = 0; db < 2; ++db)
#pragma unroll
        for (int q = 0; q < 4; ++q) { u32x2 w; w.x = cvtpk(o[db][4 * q] * inv, o[db][4 * q + 1] * inv); w.y = cvtpk(o[db][4 * q + 2] * inv, o[db][4 * q + 3] * inv);
            *(u32x2*)(orow + 32 * db + 8 * q + 4 * hi) = w; }
}
__device__ __forceinline__ void attn_sample_unit(const Args& A, const Ctx& C, int b, int hd) {
    unsigned char* ws = A.ws; const int tid = C.tid, lane = C.lane, wid = C.wave, r32 = lane & 31, hi = lane >> 5;
    const bf16* Q = (const bf16*)(ws + WS_Z); const bf16* KNS = (const bf16*)(ws + WS_KNS); const bf16* KRS = (const bf16*)(ws + WS_KRS); const bf16* VTS = (const bf16*)(ws + WS_VTS);
    bf16* CAT = (bf16*)(ws + WS_H); const float* ROPE = (const float*)(ws + WS_ROPE);
    const size_t qrow = (size_t)NP + b * 32 + r32;
    bf16x8 qr[6]; load_q(qr, Q + qrow * 768 + hd * 96, ROPE + (size_t)(PAST + r32) * 32, hi);
    f32x16 o[2]; o[0] = (f32x16){}; o[1] = (f32x16){}; float m = 0.f, l = 0.f;
    for (int t = wid; t < 33; t += 8) {
        const size_t key0 = (size_t)b * SKV + 64 * t;
        GlbLoader ld{KNS + key0 * 512 + hd * 64, KRS + key0 * 32, VTS + (size_t)(hd * 64) * NKVS + key0, r32, hi};
        attn_tile(ld, qr, o, m, l, t == 32, t == wid);
    }
    const float lt = l + __shfl_xor(l, 32);
    LAS float* cm = (LAS float*)C.lds; LAS float* cl = cm + 256; LAS float* co = cm + 512;
    if (hi == 0) { cm[wid * 32 + r32] = m; cl[wid * 32 + r32] = lt; }
#pragma unroll
    for (int db = 0; db < 2; ++db)
#pragma unroll
        for (int r = 0; r < 16; ++r) co[(wid * 64 + 32 * db + crow(r, hi)) * 32 + r32] = o[db][r];
    __syncthreads();
    { const int q = tid & 31, d0 = (tid >> 5) * 4;
      float M = cm[q];
#pragma unroll
      for (int w = 1; w < 8; ++w) M = fmaxf(M, cm[w * 32 + q]);
      float L = 0.f, acc[4] = {0.f, 0.f, 0.f, 0.f};
#pragma unroll
      for (int w = 0; w < 8; ++w) { const float f = __builtin_amdgcn_exp2f(cm[w * 32 + q] - M); L += cl[w * 32 + q] * f;
#pragma unroll
          for (int i = 0; i < 4; ++i) acc[i] += co[(w * 64 + d0 + i) * 32 + q] * f; }
      const float inv = 1.0f / L;
      u32x2 wv; wv.x = pk2(acc[0] * inv, acc[1] * inv); wv.y = pk2(acc[2] * inv, acc[3] * inv);
      *(u32x2*)(CAT + ((size_t)NP + b * 32 + q) * 1024 + hd * 64 + d0) = wv; }
    __syncthreads();
}

#define XB_TMO      128
#define XB_XCNT(j)  (256  + 64 * (j))
#define XB_XSUB(j)  (1280 + 64 * (j))
#define XB_XGEN(j)  (2304 + 64 * (j))
#define XB_TOP      3328
#define XB_TOPGEN   3392
#define XCD_BAR_WORDS 3456
#define XB_SPIN_CAP (1u << 23)

__device__ __forceinline__ unsigned xb_ld(unsigned* p)              { return __hip_atomic_load(p, __ATOMIC_RELAXED, __HIP_MEMORY_SCOPE_AGENT); }
__device__ __forceinline__ unsigned xb_add(unsigned* p, unsigned v) { return __hip_atomic_fetch_add(p, v, __ATOMIC_RELAXED, __HIP_MEMORY_SCOPE_AGENT); }
__device__ __forceinline__ unsigned xb_xcc_id() { return (unsigned)__builtin_amdgcn_s_getreg((3 << 11) | 20) & 0xFu; }
#define XB_SPIN(cond, bar) do { unsigned _sp = 0; while (cond) { __builtin_amdgcn_s_sleep(1); \
    if ((++_sp & 255u) == 0u) { if (xb_ld(&(bar)[XB_TMO])) break; if (_sp > XB_SPIN_CAP) { atomicAdd(&(bar)[XB_TMO], 1u); break; } } } } while (0)

struct XcdBarrier {
    unsigned* bar; unsigned x;
    volatile LAS unsigned* st;
};

__device__ __forceinline__ XcdBarrier xcd_barrier_post(unsigned* bar, volatile LAS unsigned* st) {
    XcdBarrier b; b.bar = bar; b.x = xb_xcc_id(); b.st = st;
    if (threadIdx.x == 0) (void)xb_add(&bar[XB_XCNT(b.x)], 1u);
    return b;
}
__device__ __forceinline__ void xcd_barrier_complete(unsigned* bar, unsigned x, unsigned& nloc, unsigned& nx) {
    const unsigned G = gridDim.x * gridDim.y * gridDim.z;
    unsigned sum, cnt, mine, sp = 0u;
    for (;;) {
        sum = 0u; cnt = 0u; mine = 0u;
#pragma unroll
        for (unsigned j = 0; j < 16; ++j) { const unsigned c = xb_ld(&bar[XB_XCNT(j)]); sum += c; cnt += (c > 0u) ? 1u : 0u; mine = (j == x) ? c : mine; }
        if (sum == G) break;
        __builtin_amdgcn_s_sleep(1);
        if ((++sp & 255u) == 0u) { if (xb_ld(&bar[XB_TMO])) break; if (sp > XB_SPIN_CAP) { atomicAdd(&bar[XB_TMO], 1u); break; } }
    }
    nloc = mine > 0u ? mine : 1u; nx = cnt > 0u ? cnt : 1u;
}

__device__ __forceinline__ void xcd_barrier(const XcdBarrier& b) {
    asm volatile("s_waitcnt vmcnt(0)" ::: "memory");
    __syncthreads();
    if (threadIdx.x == 0) {
        unsigned* bar = b.bar;
        __builtin_amdgcn_s_waitcnt(0);
        unsigned nloc = b.st[0], nx = b.st[1];
        if (nloc == 0u) { xcd_barrier_complete(bar, b.x, nloc, nx); b.st[0] = nloc; b.st[1] = nx; }
        const unsigned old = xb_add(&bar[XB_XSUB(b.x)], 1u);
        const unsigned gen = old / nloc;
        if (old + 1u == (gen + 1u) * nloc) {
            __builtin_amdgcn_fence(__ATOMIC_RELEASE, "agent");
            asm volatile("s_waitcnt vmcnt(0)" ::: "memory");
            const unsigned og = xb_add(&bar[XB_TOP], 1u);
            const unsigned tg = og / nx;
            if (og + 1u == (tg + 1u) * nx) xb_add(&bar[XB_TOPGEN], 1u);
            else XB_SPIN(xb_ld(&bar[XB_TOPGEN]) == tg, bar);
            __builtin_amdgcn_fence(__ATOMIC_ACQUIRE, "agent");
            xb_add(&bar[XB_XGEN(b.x)], 1u);
            asm volatile("s_waitcnt vmcnt(0)" ::: "memory");
        } else {
            XB_SPIN(xb_ld(&bar[XB_XGEN(b.x)]) == gen, bar);
            __builtin_amdgcn_fence(__ATOMIC_ACQUIRE, "agent");
            asm volatile("s_waitcnt vmcnt(0)" ::: "memory");
        }
    }
    __syncthreads();
}

__global__ void __launch_bounds__(512, 2) fwd_mega(Args A) {
    extern __shared__ __attribute__((aligned(16))) unsigned char lds_raw[];
    cg::grid_group grid = cg::this_grid();
    volatile LAS unsigned* bst = (volatile LAS unsigned*)((LAS unsigned char*)lds_raw + LDS_BYTES - 64);
    if (threadIdx.x < 16) bst[threadIdx.x] = 0u;
    __syncthreads();
    XcdBarrier xbar = xcd_barrier_post((unsigned*)(A.ws + WS_CTL), bst);
#ifdef PROBE_SYNC2
#define GSYNC() do { xcd_barrier(xbar); xcd_barrier(xbar); } while (0)
#else
#define GSYNC() xcd_barrier(xbar)
#endif
    Ctx C; C.lds = (LAS unsigned char*)lds_raw; C.tid = threadIdx.x; C.lane = C.tid & 63; C.wave = __builtin_amdgcn_readfirstlane(C.tid >> 6);
    C.G = gridDim.x; { const int bx = blockIdx.x; C.vcu = (C.G % 8 == 0) ? (bx % 8) * (C.G / 8) + bx / 8 : bx; }
    C.gw = blockIdx.x * 8 + C.wave; C.NGW = C.G * 8;
    unsigned char* ws = A.ws;
    float* X = A.out + O_Y;
    { float* ROPE = (float*)(ws + WS_ROPE);
      for (int e = blockIdx.x * 512 + C.tid; e < SEQ * 16; e += C.G * 512) { const int p = e >> 4, i = e & 15;
          const double base = (i & 3) == 0 ? 1.0 : (i & 3) == 1 ? 0.5623413251903491 : (i & 3) == 2 ? 0.31622776601683794 : 0.1778279410038923;
          const double sc = (i >> 2) == 0 ? 1.0 : (i >> 2) == 1 ? 0.1 : (i >> 2) == 2 ? 0.01 : 0.001;
          const float inv = (float)(base * sc); const float ang = (float)p * inv;
          const double rev = (double)ang * 0.15915494309189535; const float fr = (float)(rev - __builtin_rint(rev));
          ROPE[p * 32 + i] = __builtin_amdgcn_cosf(fr); ROPE[p * 32 + 16 + i] = __builtin_amdgcn_sinf(fr); } }
#ifdef TP_SEL
    unsigned long long tp_acc = 0, tp_last = __builtin_amdgcn_s_memrealtime();
#define TP_MARK(id) do { const unsigned long long now_ = __builtin_amdgcn_s_memrealtime(); if ((TP_SEL >> (id)) & 1) tp_acc += now_ - tp_last; tp_last = now_; } while (0)
#else
#define TP_MARK(id) do { } while (0)
#endif
#define REFRESH() do { int t_ = threadIdx.x; asm volatile("" : "+v"(t_)); C.tid = t_; C.lane = t_ & 63; C.wave = __builtin_amdgcn_readfirstlane(t_ >> 6); C.gw = blockIdx.x * 8 + C.wave; } while (0)
#ifdef PROBE_ALL2
#pragma unroll 1
    for (int rep = 0; rep < 2; ++rep) {
#endif
#pragma unroll 1
    for (int l = 0; l < DEPTH; ++l) {
        REFRESH();
#ifdef PROBE_P1
        for (int rep = 0; rep < 2; ++rep) {
#endif
        convert_weights(C, A, l);
        { f32x4 gv[4];
#pragma unroll
          for (int j = 0; j < 4; ++j) gv[j] = ((const f32x4*)(A.g_attn + l * DM) + C.lane)[64 * j];
          for (int mrow = C.gw; mrow < NTOK; mrow += 2 * C.NGW) {
            const int m1 = mrow + C.NGW; const bool has1 = m1 < NTOK; const int m1c = has1 ? m1 : mrow;
            const float* x0 = (l == 0) ? (mrow < NP ? A.xp + (size_t)mrow * DM : A.xs + (size_t)(mrow - NP) * DM) : X + (size_t)mrow * DM;
            const float* x1 = (l == 0) ? (m1c < NP ? A.xp + (size_t)m1c * DM : A.xs + (size_t)(m1c - NP) * DM) : X + (size_t)m1c * DM;
            norm_row2(x0, x1, gv, (bf16*)(ws + WS_H) + (size_t)mrow * DM, (bf16*)(ws + WS_H) + (size_t)m1c * DM, has1, C.lane); } }
        for (int r0 = C.gw; r0 < DEC_B * PAST; r0 += 4 * C.NGW) {
            f32x4 cv[4]; float kv[4]; int rr[4];
#pragma unroll
            for (int q = 0; q < 4; ++q) { const int r = r0 + q * C.NGW; rr[q] = r < DEC_B * PAST ? r : r0;
                cv[q] = *((const f32x4*)(A.cckv + ((size_t)l * DEC_B * PAST + rr[q]) * 256) + C.lane); kv[q] = A.ckr[((size_t)l * DEC_B * PAST + rr[q]) * 32 + (C.lane & 31)]; }
#pragma unroll
            for (int q = 0; q < 4; ++q) { if (r0 + q * C.NGW < DEC_B * PAST) { const int b = rr[q] >> 11, pp = rr[q] & (PAST - 1); const size_t dr = (size_t)b * SKV + pp;
                u32x2 o; o.x = pk2(cv[q].x, cv[q].y); o.y = pk2(cv[q].z, cv[q].w); *((u32x2*)((bf16*)(ws + WS_CKVS) + dr * 256) + C.lane) = o;
                if (C.lane < 32) ((bf16*)(ws + WS_KRS))[dr * 32 + C.lane] = (bf16)f2bf(kv[q]); } }
        }
#ifdef PROBE_P1
        }
#endif
        if (A.ws == nullptr) grid.sync();
        GSYNC(); TP_MARK(0);
#ifndef NO_P2
#ifdef PROBE_P2
        for (int rep = 0; rep < 2; ++rep) {
#endif
        { pg8::EpiBf16 E{(pg8::bf16_t*)(ws + WS_Z), 256, 256, (size_t)NTOK * 256};
          pg8::Gemm g{(const pg8::bf16_t*)(ws + WS_H), (const pg8::bf16_t*)(ws + WS_WIN), NTOK, 1792, DM}; pg8::StaticOrder S; S.init(NTOK, 1792, C.G, (int)blockIdx.x);
          pg8::gemm_phase<pg8::EpiBf16, pg8::StaticOrder, true, true>(C.lds, g, S, E); }
        if (C.G == 256) {
            const bool hiq = (int)blockIdx.x >= 142; const int ct0 = hiq ? 0 : 114, nct = hiq ? 114 : 16, g2 = hiq ? 114 : 32, c2 = hiq ? (int)blockIdx.x - 142 : (int)blockIdx.x;
            if (hiq || (int)blockIdx.x < 32) {
                pg8::EpiBf16 E{(pg8::bf16_t*)(ws + WS_GVT) + (size_t)ct0 * 256, NTOK, 0, 0};
                pg8::Gemm g{(const pg8::bf16_t*)(ws + WS_WGV), (const pg8::bf16_t*)(ws + WS_H) + (size_t)ct0 * 256 * DM, 512, nct * 256, DM}; pg8::StaticOrder S; S.init(512, nct * 256, g2, c2);
                pg8::gemm_phase<pg8::EpiBf16, pg8::StaticOrder, true, true>(C.lds, g, S, E); }
        } else {
            pg8::EpiBf16 E{(pg8::bf16_t*)(ws + WS_GVT), NTOK, 0, 0};
            pg8::Gemm g{(const pg8::bf16_t*)(ws + WS_WGV), (const pg8::bf16_t*)(ws + WS_H), 512, NTOK, DM}; pg8::StaticOrder S; S.init(512, NTOK, C.G, (int)((blockIdx.x + 146) % C.G));
            pg8::gemm_phase<pg8::EpiBf16, pg8::StaticOrder, true, true>(C.lds, g, S, E); }
#ifdef PROBE_P2
        }
#endif
        GSYNC(); TP_MARK(1);
#endif
        REFRESH();
#ifdef PROBE_THIN
        for (int rep = 0; rep < 2; ++rep)
#endif
        { f32x4 wv[16];
#pragma unroll
          for (int r = 0; r < 16; ++r) wv[r] = *((const f32x4*)(A.w_a2 + (size_t)l * 16 * 256 + r * 256) + C.lane);
          const f32x4 bv = *((const f32x4*)(A.b_a2 + l * 256) + C.lane);
          const f32x4 gq = *((const f32x4*)(A.g_qn + l * 256) + C.lane), gkv = *((const f32x4*)(A.g_kvn + l * 256) + C.lane);
          for (int mrow = C.gw; mrow < NTOK; mrow += 4 * C.NGW) {
              int mm[4]; P3Loads LL[4];
#pragma unroll
              for (int q = 0; q < 4; ++q) { const int m = mrow + q * C.NGW; mm[q] = m < NTOK ? m : mrow; LL[q] = p3_load(A, mm[q], C.lane); }
#pragma unroll
              for (int q = 0; q < 4; ++q) { if (mrow + q * C.NGW < NTOK) p3_token(A, l, mm[q], C.lane, wv, bv, gq, gkv, LL[q]); } } }
        GSYNC(); TP_MARK(2);
        for (int it = C.gw; it < NITEM_P; it += C.NGW) gla_g1<false>(A, l, it, C.lds + C.wave * 16384, C.lane);
#ifdef SAMP_OLDPLACE
        if (C.gw < 64) gla_g1<true>(A, l, NITEM_P + C.gw, C.lds + C.wave * 16384, C.lane);
#endif
        GSYNC(); TP_MARK(3);
#ifndef NO_P4
        if ((int)blockIdx.x < NSCAN) {
            gla_scan(A, l, blockIdx.x, C.tid);
            asm volatile("s_waitcnt vmcnt(0)" ::: "memory"); __syncthreads();
            if (C.tid == 0) { unsigned* cnt = (unsigned*)(ws + WS_CTL) + 8192;
                __builtin_amdgcn_fence(__ATOMIC_RELEASE, "agent"); asm volatile("s_waitcnt vmcnt(0)" ::: "memory");
                __hip_atomic_fetch_add(cnt, 1u, __ATOMIC_RELAXED, __HIP_MEMORY_SCOPE_AGENT);
                const unsigned want = (unsigned)NSCAN * (unsigned)(l + 1); unsigned sp = 0;
                while (__hip_atomic_load(cnt, __ATOMIC_RELAXED, __HIP_MEMORY_SCOPE_AGENT) < want) { __builtin_amdgcn_s_sleep(2); if (++sp > (1u << 24)) break; }
                __builtin_amdgcn_fence(__ATOMIC_ACQUIRE, "agent"); asm volatile("s_waitcnt vmcnt(0)" ::: "memory"); }
            __syncthreads();
            { const int it = blockIdx.x * 8 + C.wave; if (it < NITEM_P / 2) gla_g3<false>(A, l, it, C.lds + C.wave * 17408, C.lane); }
        }
#ifndef SAMP_OLDPLACE
        else if ((int)blockIdx.x < NSCAN + NSAMPWG) { const int it = NITEM_P + ((int)blockIdx.x - NSCAN) * 4 + (C.wave & 3);
            if (C.wave < 4) gla_g1<true>(A, l, it, C.lds + C.wave * 17408, C.lane); else gla_g3<true>(A, l, it, C.lds + C.wave * 17408, C.lane); }
#else
        else if ((int)blockIdx.x < NSCAN + NSAMPWG) { }
#endif
        else {
            const int G2 = C.G - NSCAN - NSAMPWG, c2 = blockIdx.x - NSCAN - NSAMPWG;
#ifdef PROBE_P4G
            for (int rep = 0; rep < 2; ++rep)
#endif
#pragma unroll 1
            for (int gi = 0; gi < 5; ++gi) {
                pg8::Gemm g; pg8::EpiBf16 E; int M_, N_;
                if (gi == 0) { g = pg8::Gemm{(const pg8::bf16_t*)(ws + WS_CQN), (const pg8::bf16_t*)(ws + WS_WUQ), NTOK, 768, 256}; E = pg8::EpiBf16{(pg8::bf16_t*)(ws + WS_Z), 768, 0, 0}; M_ = NTOK; N_ = 768; }
                else if (gi == 1) { g = pg8::Gemm{(const pg8::bf16_t*)(ws + WS_CKVN), (const pg8::bf16_t*)(ws + WS_WUK), NP, 512, 256}; E = pg8::EpiBf16{(pg8::bf16_t*)(ws + WS_KN), 512, 0, 0}; M_ = NP; N_ = 512; }
                else if (gi == 2) { g = pg8::Gemm{(const pg8::bf16_t*)(ws + WS_WUV), (const pg8::bf16_t*)(ws + WS_CKVN), 512, NP, 256}; E = pg8::EpiBf16{(pg8::bf16_t*)(ws + WS_VT), NP, 0, 0}; M_ = 512; N_ = NP; }
                else if (gi == 3) { g = pg8::Gemm{(const pg8::bf16_t*)(ws + WS_CKVS), (const pg8::bf16_t*)(ws + WS_WUK), NKVS, 512, 256}; E = pg8::EpiBf16{(pg8::bf16_t*)(ws + WS_KNS), 512, 0, 0}; M_ = NKVS; N_ = 512; }
                else { g = pg8::Gemm{(const pg8::bf16_t*)(ws + WS_WUV), (const pg8::bf16_t*)(ws + WS_CKVS), 512, NKVS, 256}; E = pg8::EpiBf16{(pg8::bf16_t*)(ws + WS_VTS), NKVS, 0, 0}; M_ = 512; N_ = NKVS; }
                pg8::StaticOrder S; S.init(M_, N_, G2, (c2 + gi * 37) % G2);
                pg8::gemm_phase<pg8::EpiBf16, pg8::StaticOrder, true, true>(C.lds, g, S, E);
            }
        }
        GSYNC(); TP_MARK(4);
#endif
        REFRESH();
#ifdef SAMP_OLDPLACE
        if (C.gw < 64) gla_g3<true>(A, l, NITEM_P + C.gw, C.lds + C.wave * 17408, C.lane);
#endif
        if (C.vcu < C.G - 128) { for (int it = NITEM_P / 2 + C.vcu * 8 + C.wave; it < NITEM_P; it += (C.G - 128) * 8) gla_g3<false>(A, l, it, C.lds + C.wave * 17408, C.lane); }
        __syncthreads();
#ifdef PROBE_SAMP
#pragma unroll 1
        for (int rep = 0; rep < 2; ++rep)
#endif
#ifndef NO_SAMP
        if (C.vcu >= C.G - 128 && C.vcu < C.G) { const int u = C.vcu - (C.G - 128); attn_sample_unit(A, C, u >> 3, u & 7); }
#endif
#ifndef NO_ATTN
#ifdef PROBE_ATTN2
        for (int rep = 0; rep < 2; ++rep)
#endif
        for (int u = C.vcu; u < 1024; u += C.G) {
            const int bh = (u % 256) >> 4, s = u & 15, i = u >> 8; const int qb = (i == 0) ? 63 - s : (i == 1) ? 32 + s : (i == 2) ? 31 - s : s;
            attn_prompt_unit(A, C, bh >> 3, bh & 7, qb); }
#endif
        GSYNC(); TP_MARK(5);
#ifndef NO_P6
        if (l == 0) { pg8::EpiResB E{X, A.xp, A.xs, NP, DM};
          pg8::Gemm g{(const pg8::bf16_t*)(ws + WS_H), (const pg8::bf16_t*)(ws + WS_WO), NTOK, DM, DM}; pg8::StaticOrder S; S.init(NTOK, DM, C.G, (int)blockIdx.x);
          pg8::gemm_phase<pg8::EpiResB, pg8::StaticOrder, true, true>(C.lds, g, S, E); }
        else { pg8::EpiRes E{X, DM};
          pg8::Gemm g{(const pg8::bf16_t*)(ws + WS_H), (const pg8::bf16_t*)(ws + WS_WO), NTOK, DM, DM}; pg8::StaticOrder S; S.init(NTOK, DM, C.G, (int)blockIdx.x);
          pg8::gemm_phase<pg8::EpiRes, pg8::StaticOrder, true, true>(C.lds, g, S, E); }
        GSYNC(); TP_MARK(6);
#endif
        REFRESH();
#ifdef PROBE_THIN
        for (int rep = 0; rep < 2; ++rep)
#endif
        { f32x4 gv[4];
#pragma unroll
          for (int j = 0; j < 4; ++j) gv[j] = ((const f32x4*)(A.g_ffn + l * DM) + C.lane)[64 * j];
          for (int mrow = C.gw; mrow < NTOK; mrow += 2 * C.NGW) { const int m1 = mrow + C.NGW; const bool has1 = m1 < NTOK; const int m1c = has1 ? m1 : mrow;
            norm_row2(X + (size_t)mrow * DM, X + (size_t)m1c * DM, gv, (bf16*)(ws + WS_H) + (size_t)mrow * DM, (bf16*)(ws + WS_H) + (size_t)m1c * DM, has1, C.lane); } }
        GSYNC(); TP_MARK(7);
#ifndef NO_P8
#ifdef PROBE_P8
        for (int rep = 0; rep < 2; ++rep)
#endif
        { pg8::EpiSwiglu E{(pg8::bf16_t*)(ws + WS_ACT), DFF};
          pg8::Gemm g{(const pg8::bf16_t*)(ws + WS_H), (const pg8::bf16_t*)(ws + WS_WGU), NTOK, 2 * DFF, DM}; pg8::StaticOrder S; S.init(NTOK, 2 * DFF, C.G, (int)blockIdx.x);
          pg8::gemm_phase<pg8::EpiSwiglu, pg8::StaticOrder, true, true>(C.lds, g, S, E); }
        GSYNC(); TP_MARK(8);
#endif
#ifndef NO_P9
        { pg8::EpiRes E{X, DM};
          pg8::Gemm g{(const pg8::bf16_t*)(ws + WS_ACT), (const pg8::bf16_t*)(ws + WS_WD), NTOK, DM, DFF}; pg8::StaticOrder S; S.init(NTOK, DM, C.G, (int)blockIdx.x);
          pg8::gemm_phase<pg8::EpiRes, pg8::StaticOrder, true, true>(C.lds, g, S, E); }
        GSYNC(); TP_MARK(9);
#endif
    }
    REFRESH();
    { f32x4 gv[4];
#pragma unroll
      for (int j = 0; j < 4; ++j) gv[j] = ((const f32x4*)A.g_final + C.lane)[64 * j];
      for (int mrow = C.gw; mrow < NTOK; mrow += 2 * C.NGW) { const int m1 = mrow + C.NGW; const bool has1 = m1 < NTOK; const int m1c = has1 ? m1 : mrow;
        final_norm_row2(X + (size_t)mrow * DM, X + (size_t)m1c * DM, gv, has1, C.lane); } }
#ifdef TP_SEL
    if (blockIdx.x == 0) { const unsigned long long t0_ = __builtin_amdgcn_s_memrealtime(); while (__builtin_amdgcn_s_memrealtime() - t0_ < 8ull * tp_acc) __builtin_amdgcn_s_sleep(8); }
#endif
#ifdef PROBE_ALL2
    GSYNC();
    }
#endif
}

extern "C" void kernel_launch(void* const* d_in, const int* in_sizes, int n_in, void* d_out, int out_size, void* d_ws, size_t ws_size, hipStream_t stream) {
    static int grid = 0;
    if (grid == 0) {
        if (n_in != 19 || (size_t)out_size != O_END || ws_size < WS_END) { fprintf(stderr, "kernel_launch: unexpected shapes: n_in %d out %d ws %zu (need %zu)\n", n_in, out_size, ws_size, (size_t)WS_END); grid = -1; return; }
        int dev = 0, cus = 0, per_cu = 0;
        hipGetDevice(&dev); hipDeviceGetAttribute(&cus, hipDeviceAttributeMultiprocessorCount, dev);
        if (hipFuncSetAttribute((const void*)fwd_mega, hipFuncAttributeMaxDynamicSharedMemorySize, LDS_BYTES) != hipSuccess) { fprintf(stderr, "kernel_launch: hipFuncSetAttribute failed\n"); grid = -1; return; }
        if (hipOccupancyMaxActiveBlocksPerMultiprocessor(&per_cu, (const void*)fwd_mega, 512, LDS_BYTES) != hipSuccess || per_cu < 1) { fprintf(stderr, "kernel_launch: occupancy query says %d\n", per_cu); per_cu = 1; }
        (void)hipGetLastError();
        grid = cus;
    }
    if (grid < 0) return;
    Args a{};
    a.xp = (const float*)d_in[0]; a.xs = (const float*)d_in[1]; a.cckv = (const float*)d_in[2]; a.ckr = (const float*)d_in[3]; a.sgla = (const float*)d_in[4];
    a.g_attn = (const float*)d_in[5]; a.w_in = (const float*)d_in[6]; a.g_qn = (const float*)d_in[7]; a.w_uq = (const float*)d_in[8]; a.g_kvn = (const float*)d_in[9];
    a.w_ukv = (const float*)d_in[10]; a.w_a2 = (const float*)d_in[11]; a.b_a2 = (const float*)d_in[12]; a.g_on = (const float*)d_in[13]; a.w_o = (const float*)d_in[14];
    a.g_ffn = (const float*)d_in[15]; a.w_gu = (const float*)d_in[16]; a.w_down = (const float*)d_in[17]; a.g_final = (const float*)d_in[18];
    a.out = (float*)d_out; a.ws = (unsigned char*)d_ws;
    if (hipMemsetAsync((char*)d_ws + WS_CTL, 0, CTL_BYTES, stream) != hipSuccess) { fprintf(stderr, "kernel_launch: memset failed\n"); return; }
    void* args[] = {&a};
    hipError_t e = hipLaunchCooperativeKernel((const void*)fwd_mega, dim3(grid), dim3(512), args, LDS_BYTES, stream);
    if (e != hipSuccess) fprintf(stderr, "kernel_launch: cooperative launch failed: %s (grid %d)\n", hipGetErrorString(e), grid);
}
```

```cpp
#include <hip/hip_runtime.h>
#include <hip/hip_cooperative_groups.h>
#include <cstdio>
#include <cstdint>
namespace cg = cooperative_groups;
namespace pg8 {
#define PG8_LAS __attribute__((address_space(3)))
typedef unsigned short bf16_t;
typedef short bf16x8 __attribute__((ext_vector_type(8)));
typedef float f32x4 __attribute__((ext_vector_type(4)));
typedef unsigned u32x4 __attribute__((ext_vector_type(4)));
constexpr int BM = 256, BK = 64, HALF = 128, HTB = HALF * BK * 2  , STAGE_BYTES = 8 * HTB, NXCD = 8, WGM = 8;

__host__ __device__ __forceinline__ int lds_byte(int r, int c) { const int st = (r >> 4) * 2 + (c >> 5), rr = r & 15, cc = c & 31, ob = rr * 64 + cc * 2; return st * 1024 + (ob ^ (((ob >> 9) & 1) << 5)); }
__host__ __device__ __forceinline__ void stage_rc(int b, int& R, int& C) { const int st = b / 1024, sb = b % 1024, swz = sb ^ (((sb >> 9) & 1) << 5); R = (st >> 1) * 16 + swz / 64; C = (st & 1) * 32 + (swz % 64) / 2; }
__host__ __device__ __forceinline__ int perm32(int rho) { const int n = rho >> 4, i = rho & 15; return 8 * (i >> 2) + 4 * n + (i & 3); }

struct Unit { int pm, pn; };
struct Gemm { const bf16_t* A; const bf16_t* Bt; int M, N, K; };

struct StaticOrder {
    int nM, nN, nwg, G, c;
    __host__ __device__ void init(int M, int N, int G_, int c_) { nM = M / BM; nN = N / BM; nwg = nM * nN; G = G_; c = c_; }
    __host__ __device__ bool next(int i, Unit& u) const {
        const long L = (long)i * G + c; if (L >= nwg) return false;
        int wgid = (int)L; { const int q = nwg / NXCD, r = nwg % NXCD, xcd = wgid % NXCD, off = wgid / NXCD; wgid = (xcd < r ? xcd * (q + 1) : r * (q + 1) + (xcd - r) * q) + off; }
        const int nig = WGM * nN, gid = wgid / nig, fm = gid * WGM, gsz = (nM - fm) < WGM ? (nM - fm) : WGM;
        u.pm = fm + ((wgid % nig) % gsz); u.pn = (wgid % nig) / gsz; return true;
    }
    __device__ __forceinline__ void a_ready(const Unit&) const {}
    __device__ __forceinline__ void done(const Unit&) const {}
};

__device__ __forceinline__ unsigned cvt_pk_bf16(float lo, float hi) { unsigned r; asm volatile("v_cvt_pk_bf16_f32 %0, %1, %2" : "=v"(r) : "v"(lo), "v"(hi)); return r; }
typedef float f32x2 __attribute__((ext_vector_type(2)));
typedef float f32x2m_t __attribute__((ext_vector_type(2))); typedef __bf16 bf16x2m_t __attribute__((ext_vector_type(2)));
__device__ __forceinline__ unsigned cvt_pk_m(float lo, float hi) { f32x2m_t v = {lo, hi}; bf16x2m_t b = __builtin_convertvector(v, bf16x2m_t); return __builtin_bit_cast(unsigned, b); }
struct EpiBf16 {
    static constexpr bool PERM = true, AFTER_DRAIN = false;
    bf16_t* O; int ldc; int split_cols; size_t split_stride;
    __device__ __forceinline__ void operator()(const f32x4 (&acc)[2][2][4][2], const Unit& u, int wr, int wc, int fr, int fq) const {
        const int row0 = u.pm * BM + wr * 64 + fr; int colt = u.pn * BM; bf16_t* base = O;
        if (split_cols) { const int t = colt / split_cols; base += (size_t)t * split_stride; colt -= t * split_cols; }
        const int col0 = colt + wc * 32 + 8 * fq;
#pragma unroll
        for (int ai = 0; ai < 2; ++ai)
#pragma unroll
            for (int m = 0; m < 4; ++m) { bf16_t* rowp = base + (size_t)(row0 + ai * HALF + m * 16) * ldc + col0;
#pragma unroll
                for (int bj = 0; bj < 2; ++bj) { const f32x4 v0 = acc[ai][bj][m][0], v1 = acc[ai][bj][m][1];
                    u32x4 w; w.x = cvt_pk_m(v0[0], v0[1]); w.y = cvt_pk_m(v0[2], v0[3]); w.z = cvt_pk_m(v1[0], v1[1]); w.w = cvt_pk_m(v1[2], v1[3]);
                    *(u32x4*)(rowp + bj * HALF) = w; } }
    }
};
struct EpiSwiglu {
    static constexpr bool PERM = true, AFTER_DRAIN = false;
    bf16_t* O; int ldc;
    __device__ __forceinline__ void operator()(const f32x4 (&acc)[2][2][4][2], const Unit& u, int wr, int wc, int fr, int fq) const {
        const int row0 = u.pm * BM + wr * 64 + fr; const int col0 = u.pn * HALF + wc * 32 + 8 * fq;
#pragma unroll
        for (int ai = 0; ai < 2; ++ai)
#pragma unroll
            for (int m = 0; m < 4; ++m) { bf16_t* rowp = O + (size_t)(row0 + ai * HALF + m * 16) * ldc + col0;
                float r[8];
#pragma unroll
                for (int n = 0; n < 2; ++n)
#pragma unroll
                    for (int i = 0; i < 4; ++i) { const float a = acc[ai][0][m][n][i], uu = acc[ai][1][m][n][i];
                        r[n * 4 + i] = a * __builtin_amdgcn_rcpf(1.0f + __expf(-a)) * uu; }
                u32x4 w; w.x = cvt_pk_m(r[0], r[1]); w.y = cvt_pk_m(r[2], r[3]); w.z = cvt_pk_m(r[4], r[5]); w.w = cvt_pk_m(r[6], r[7]);
                *(u32x4*)rowp = w; }
    }
};
struct EpiRes {
    static constexpr bool PERM = false, AFTER_DRAIN = false;
    float* X; int ldc;
    __device__ __forceinline__ void operator()(const f32x4 (&acc)[2][2][4][2], const Unit& u, int wr, int wc, int fr, int fq) const {
        const int col0 = u.pn * BM + wc * 32 + 4 * fq;
#pragma unroll
        for (int ai = 0; ai < 2; ++ai)
#pragma unroll
            for (int m = 0; m < 4; ++m) { float* rowp = X + (size_t)(u.pm * BM + ai * HALF + wr * 64 + m * 16 + fr) * ldc + col0;
#pragma unroll
                for (int bj = 0; bj < 2; ++bj)
#pragma unroll
                    for (int n = 0; n < 2; ++n) { f32x4* p = (f32x4*)(rowp + bj * HALF + n * 16); *p = *p + acc[ai][bj][m][n]; }
                asm volatile("" ::: "memory"); }
    }
};
struct EpiNone {
    static constexpr bool PERM = false, AFTER_DRAIN = false;
    float* sink;
    __device__ __forceinline__ void operator()(const f32x4 (&acc)[2][2][4][2], const Unit& u, int wr, int wc, int fr, int fq) const {
        float t = 0.f;
#pragma unroll
        for (int ai = 0; ai < 2; ++ai)
#pragma unroll
            for (int bj = 0; bj < 2; ++bj)
#pragma unroll
                for (int m = 0; m < 4; ++m)
#pragma unroll
                    for (int n = 0; n < 2; ++n) t += acc[ai][bj][m][n][0] + acc[ai][bj][m][n][1] + acc[ai][bj][m][n][2] + acc[ai][bj][m][n][3];
        if (t == 123456.789f) sink[0] = t;
    }
};
struct EpiResB {
    static constexpr bool PERM = false, AFTER_DRAIN = false;
    float* X; const float* xp; const float* xs; int np; int ldc;
    __device__ __forceinline__ void operator()(const f32x4 (&acc)[2][2][4][2], const Unit& u, int wr, int wc, int fr, int fq) const {
        const int col0 = u.pn * BM + wc * 32 + 4 * fq;
        const float* bbase = (u.pm * BM < np) ? xp : xs - (size_t)np * ldc;
#pragma unroll
        for (int ai = 0; ai < 2; ++ai)
#pragma unroll
            for (int m = 0; m < 4; ++m) { const size_t off = (size_t)(u.pm * BM + ai * HALF + wr * 64 + m * 16 + fr) * ldc + col0;
#pragma unroll
                for (int bj = 0; bj < 2; ++bj)
#pragma unroll
                    for (int n = 0; n < 2; ++n) *(f32x4*)(X + off + bj * HALF + n * 16) = *(const f32x4*)(bbase + off + bj * HALF + n * 16) + acc[ai][bj][m][n];
                asm volatile("" ::: "memory"); }
    }
};
template <class Epi, class Sched, bool ALIGN_EPI = false, bool SP2 = false>
__device__ __forceinline__ void gemm_phase(PG8_LAS unsigned char* lds, const Gemm g, const Sched& S, const Epi& E) {
    int tid_ = threadIdx.x; asm volatile("" : "+v"(tid_));
    const int tid = tid_, wid = __builtin_amdgcn_readfirstlane(tid >> 6), lane = tid & 63, wr = wid >> 2, wc = wid & 3, fr = lane & 15, fq = lane >> 4;
    const int K = g.K, nt = K / BK;
    unsigned voffA[2], voffB[2];
#pragma unroll
    for (int i = 0; i < 2; ++i) { int R, C; stage_rc(tid * 16 + i * 8192, R, C); const int Rb = Epi::PERM ? ((R & ~31) + perm32(R & 31)) : R;
        voffA[i] = (unsigned)(R * K + C) * 2u; voffB[i] = (unsigned)(Rb * K + C) * 2u; }
    const size_t kstep = (size_t)(BK * 2);
    const size_t hstep = (size_t)HALF * K * 2;
    const size_t tstep = 2 * hstep;
    const unsigned ldsw = (unsigned)wid * 1024u;
    const int aoff = lds_byte(wr * 64 + fr, fq * 8), boff = lds_byte(wc * 32 + fr, fq * 8);
#define PG8_SA(b, h) (((b) * 2 + (h)) * HTB)
#define PG8_SB(b, h) ((4 + (b) * 2 + (h)) * HTB)
#define PG8_STAGE(bufoff, gbase, voff) do { _Pragma("unroll") for (int _i = 0; _i < 2; ++_i) \
        __builtin_amdgcn_global_load_lds((const unsigned*)((const char*)(gbase) + (voff)[_i]), (PG8_LAS unsigned*)(lds + (bufoff) + ldsw + _i * 8192), 16, 0, 0); } while (0)
#define PG8_LDA(dst, b, h) do { _Pragma("unroll") for (int m = 0; m < 4; ++m) _Pragma("unroll") for (int k = 0; k < 2; ++k) dst[m][k] = *(const PG8_LAS bf16x8*)(lds + PG8_SA(b, h) + aoff + m * 2048 + k * 1024); } while (0)
#define PG8_LDB(dst, b, h) do { _Pragma("unroll") for (int n = 0; n < 2; ++n) _Pragma("unroll") for (int k = 0; k < 2; ++k) dst[n][k] = *(const PG8_LAS bf16x8*)(lds + PG8_SB(b, h) + boff + n * 2048 + k * 1024); } while (0)
#define PG8_MMA(ai, bj, At, Bt) do { __builtin_amdgcn_s_setprio(1); _Pragma("unroll") for (int m = 0; m < 4; ++m) _Pragma("unroll") for (int n = 0; n < 2; ++n) _Pragma("unroll") for (int k = 0; k < 2; ++k) \
        acc[ai][bj][m][n] = __builtin_amdgcn_mfma_f32_16x16x32_bf16(Bt[n][k], At[m][k], acc[ai][bj][m][n], 0, 0, 0); __builtin_amdgcn_s_setprio(0); } while (0)
#define PG8_WAIT_V(n) asm volatile("s_waitcnt vmcnt(" #n ")" ::: "memory")
#define PG8_WAIT_L(n) asm volatile("s_waitcnt lgkmcnt(" #n ")" ::: "memory")
#define PG8_BAR __builtin_amdgcn_s_barrier()
#define PG8_SCHED __builtin_amdgcn_sched_barrier(0)
    Unit cur, nxt; int ui = 0;
    if (!S.next(0, cur)) return;
    f32x4 acc[2][2][4][2];
#pragma unroll
    for (int a = 0; a < 2; ++a)
#pragma unroll
        for (int b = 0; b < 2; ++b)
#pragma unroll
            for (int m = 0; m < 4; ++m)
#pragma unroll
                for (int n = 0; n < 2; ++n) acc[a][b][m][n] = (f32x4){0.f, 0.f, 0.f, 0.f};
    bf16x8 At[4][2], B0[2][2], B1[2][2];
    const char* cA = (const char*)g.A + (size_t)cur.pm * tstep; const char* cB = (const char*)g.Bt + (size_t)cur.pn * tstep;
    S.a_ready(cur);
    if constexpr (SP2) {
        PG8_STAGE(PG8_SB(0, 0), cB, voffB); PG8_STAGE(PG8_SB(0, 1), cB + hstep, voffB); PG8_STAGE(PG8_SA(0, 0), cA, voffA); PG8_STAGE(PG8_SA(0, 1), cA + hstep, voffA);
        if (wr == 1) PG8_BAR;
        PG8_WAIT_V(2); PG8_BAR;
        PG8_STAGE(PG8_SB(1, 0), cB + kstep, voffB); PG8_STAGE(PG8_SA(1, 0), cA + kstep, voffA); PG8_STAGE(PG8_SB(1, 1), cB + hstep + kstep, voffB);
        PG8_WAIT_V(6); PG8_BAR;
    } else {
        PG8_STAGE(PG8_SB(0, 0), cB, voffB); PG8_STAGE(PG8_SA(0, 0), cA, voffA); PG8_STAGE(PG8_SB(0, 1), cB + hstep, voffB); PG8_STAGE(PG8_SA(0, 1), cA + hstep, voffA);
        if (wr == 1) PG8_BAR;
        PG8_WAIT_V(4); PG8_BAR;
        PG8_STAGE(PG8_SB(1, 0), cB + kstep, voffB); PG8_STAGE(PG8_SA(1, 0), cA + kstep, voffA); PG8_STAGE(PG8_SB(1, 1), cB + hstep + kstep, voffB);
        PG8_WAIT_V(6); PG8_BAR;
    }
    for (;;) {
        const bool has_next = S.next(ui + 1, nxt);
        const char* nA = has_next ? (const char*)g.A + (size_t)nxt.pm * tstep : cA; const char* nB = has_next ? (const char*)g.Bt + (size_t)nxt.pn * tstep : cB;
        for (int t = 0; t < nt; t += 2) {
            const bool last = (t == nt - 2);
            const char* a1 = cA + (size_t)(t + 1) * kstep;
            const char* a2 = last ? nA : cA + (size_t)(t + 2) * kstep; const char* b2 = last ? nB : cB + (size_t)(t + 2) * kstep;
            const char* a3 = a2 + kstep; const char* b3 = b2 + kstep;
            if (last && has_next) S.a_ready(nxt);
            if constexpr (SP2) {
            PG8_LDB(B0, 0, 0); PG8_LDB(B1, 0, 1); PG8_SCHED; PG8_LDA(At, 0, 0); PG8_STAGE(PG8_SA(1, 1), a1 + hstep, voffA);
            PG8_WAIT_V(8); PG8_WAIT_L(0); PG8_BAR; PG8_MMA(0, 0, At, B0); PG8_MMA(0, 1, At, B1); PG8_BAR; PG8_SCHED;
            PG8_LDA(At, 0, 1); PG8_STAGE(PG8_SB(0, 0), b2, voffB); PG8_STAGE(PG8_SB(0, 1), b2 + hstep, voffB); PG8_STAGE(PG8_SA(0, 0), a2, voffA);
            PG8_WAIT_V(8); PG8_WAIT_L(0); PG8_BAR; PG8_MMA(1, 0, At, B0); PG8_MMA(1, 1, At, B1); PG8_BAR; PG8_SCHED;
            PG8_LDB(B0, 1, 0); PG8_LDB(B1, 1, 1); PG8_SCHED; PG8_LDA(At, 1, 0); PG8_STAGE(PG8_SA(0, 1), a2 + hstep, voffA);
            PG8_WAIT_V(8); PG8_WAIT_L(0); PG8_BAR; PG8_MMA(0, 0, At, B0); PG8_MMA(0, 1, At, B1); PG8_BAR; PG8_SCHED;
            PG8_LDA(At, 1, 1); PG8_STAGE(PG8_SB(1, 0), b3, voffB); PG8_STAGE(PG8_SB(1, 1), b3 + hstep, voffB); PG8_STAGE(PG8_SA(1, 0), a3, voffA);
            PG8_WAIT_V(8); PG8_WAIT_L(0); PG8_BAR; PG8_MMA(1, 0, At, B0); PG8_MMA(1, 1, At, B1); PG8_BAR; PG8_SCHED;
            } else {
            PG8_LDB(B0, 0, 0); PG8_SCHED; PG8_LDA(At, 0, 0); PG8_STAGE(PG8_SA(1, 1), a1 + hstep, voffA);
            PG8_WAIT_L(8); PG8_BAR; PG8_WAIT_L(0); PG8_MMA(0, 0, At, B0); PG8_BAR; PG8_SCHED;
            PG8_LDB(B1, 0, 1); PG8_STAGE(PG8_SB(0, 0), b2, voffB);
            PG8_BAR; PG8_WAIT_L(0); PG8_MMA(0, 1, At, B1); PG8_BAR;
            PG8_LDA(At, 0, 1); PG8_STAGE(PG8_SA(0, 0), a2, voffA);
            PG8_BAR; PG8_WAIT_L(0); PG8_MMA(1, 0, At, B0); PG8_BAR; PG8_SCHED;
            PG8_STAGE(PG8_SB(0, 1), b2 + hstep, voffB);
            PG8_WAIT_V(6); PG8_BAR; PG8_MMA(1, 1, At, B1); PG8_BAR;
            PG8_LDB(B0, 1, 0); PG8_SCHED; PG8_LDA(At, 1, 0); PG8_STAGE(PG8_SA(0, 1), a2 + hstep, voffA);
            PG8_WAIT_L(8); PG8_BAR; PG8_WAIT_L(0); PG8_MMA(0, 0, At, B0); PG8_BAR; PG8_SCHED;
            PG8_LDB(B1, 1, 1); PG8_STAGE(PG8_SB(1, 0), b3, voffB);
            PG8_BAR; PG8_WAIT_L(0); PG8_MMA(0, 1, At, B1); PG8_BAR;
            PG8_LDA(At, 1, 1); PG8_STAGE(PG8_SA(1, 0), a3, voffA);
            PG8_BAR; PG8_WAIT_L(0); PG8_MMA(1, 0, At, B0); PG8_BAR; PG8_SCHED;
            PG8_STAGE(PG8_SB(1, 1), b3 + hstep, voffB);
            PG8_WAIT_V(6); PG8_BAR; PG8_MMA(1, 1, At, B1); PG8_BAR;
            }
        }
        if constexpr (ALIGN_EPI) { if (wr == 0) PG8_BAR; }
        if constexpr (!Epi::AFTER_DRAIN) { E(acc, cur, wr, wc, fr, fq); S.done(cur); }
        if (!has_next) break;
#pragma unroll
        for (int a = 0; a < 2; ++a)
#pragma unroll
            for (int b = 0; b < 2; ++b)
#pragma unroll
                for (int m = 0; m < 4; ++m)
#pragma unroll
                    for (int n = 0; n < 2; ++n) acc[a][b][m][n] = (f32x4){0.f, 0.f, 0.f, 0.f};
        cur = nxt; cA = nA; cB = nB; ++ui;
        if constexpr (ALIGN_EPI) { if (wr == 1) PG8_BAR; }
    }
    PG8_WAIT_V(0);
    if constexpr (!ALIGN_EPI) { if (wr == 0) PG8_BAR; }
    PG8_BAR;
    if constexpr (Epi::AFTER_DRAIN) { E.fused(acc, cur, wr, wc, fr, fq, lds, wid, lane); S.done(cur); }
#undef PG8_SA
#undef PG8_SB
#undef PG8_STAGE
#undef PG8_LDA
#undef PG8_LDB
#undef PG8_MMA
#undef PG8_WAIT_V
#undef PG8_WAIT_L
#undef PG8_BAR
#undef PG8_SCHED
}
}
constexpr int DM = 1024, SEQ = 16384, NBATCH = 2, NP = NBATCH * SEQ, DEC_B = 16, DEC_T = 32, PAST = 2048, SKV = PAST + DEC_T;
constexpr int NSQ = DEC_B * DEC_T, NTOK = NP + NSQ, NKVS = DEC_B * SKV;
constexpr int DFF = 2816, INW = 2096, DEPTH = 2;
constexpr float EPS = 1e-6f;
constexpr float QSCALE = 0.10206207261596575f * 1.4426950408889634f;
constexpr int NITEM_P = NBATCH * 256 * 4, NITEM = NITEM_P + DEC_B * 4;

typedef unsigned short bf16;
typedef short bf16x8 __attribute__((ext_vector_type(8)));
typedef float f32x4 __attribute__((ext_vector_type(4)));
typedef float f32x16 __attribute__((ext_vector_type(16)));
typedef unsigned u32x4 __attribute__((ext_vector_type(4)));
typedef unsigned u32x2 __attribute__((ext_vector_type(2)));
#define LAS __attribute__((address_space(3)))

constexpr size_t T256 = (size_t)NTOK * 256 * 2;
constexpr size_t al(size_t x) { return (x + 4095) & ~(size_t)4095; }
constexpr size_t WS_CTL = 0, CTL_BYTES = 65536;
constexpr size_t WS_ROPE = 65536;
constexpr size_t WS_GA = al(WS_ROPE + (size_t)SEQ * 32 * 4);
constexpr size_t WS_DECAY = al(WS_GA + (size_t)NTOK * 16 * 4);
constexpr size_t WS_WIN = al(WS_DECAY + (size_t)NITEM * 64 * 4);
constexpr size_t WS_WGV = al(WS_WIN + (size_t)1792 * 1024 * 2);
constexpr size_t WS_WUQ = al(WS_WGV + (size_t)512 * 1024 * 2);
constexpr size_t WS_WUK = al(WS_WUQ + (size_t)768 * 256 * 2);
constexpr size_t WS_WUV = al(WS_WUK + (size_t)512 * 256 * 2);
constexpr size_t WS_WO = al(WS_WUV + (size_t)512 * 256 * 2);
constexpr size_t WS_WGU = al(WS_WO + (size_t)1024 * 1024 * 2);
constexpr size_t WS_WD = al(WS_WGU + (size_t)5632 * 1024 * 2);
constexpr size_t WS_H = al(WS_WD + (size_t)1024 * 2816 * 2);
constexpr size_t WS_Z = al(WS_H + (size_t)NTOK * 1024 * 2);
constexpr size_t WS_GVT = al(WS_Z + 7 * T256);
constexpr size_t WS_CQN = al(WS_GVT + (size_t)512 * NTOK * 2);
constexpr size_t WS_CKVN = al(WS_CQN + T256);
constexpr size_t WS_CKVS = al(WS_CKVN + (size_t)NP * 256 * 2);
constexpr size_t WS_KR = al(WS_CKVS + (size_t)NKVS * 256 * 2);
constexpr size_t WS_KRS = al(WS_KR + (size_t)NP * 32 * 2);
constexpr size_t WS_KN = al(WS_KRS + (size_t)NKVS * 32 * 2);
constexpr size_t WS_VT = al(WS_KN + (size_t)NP * 512 * 2);
constexpr size_t WS_KNS = al(WS_VT + (size_t)512 * NP * 2);
constexpr size_t WS_VTS = al(WS_KNS + (size_t)NKVS * 512 * 2);
constexpr size_t WS_DS = al(WS_VTS + (size_t)512 * NKVS * 2);
constexpr size_t WS_LG = al(WS_DS + (size_t)NITEM_P * 8192 * 4);
constexpr size_t WS_END = al(WS_LG + (size_t)NTOK * 256 * 2);
constexpr size_t WS_ACT = WS_Z;
static_assert(WS_ACT + (size_t)NTOK * DFF * 2 <= WS_END, "ACT overlay");
static_assert(WS_END <= (size_t)536870912, "ws budget");

constexpr size_t O_Y = 0, O_CKVP = (size_t)NTOK * DM, O_KRP = O_CKVP + (size_t)DEPTH * NP * 256, O_GLAP = O_KRP + (size_t)DEPTH * NP * 32,
                 O_CKVS = O_GLAP + (size_t)DEPTH * NBATCH * 4 * 8192, O_KRS = O_CKVS + (size_t)DEPTH * NSQ * 256, O_GLAS = O_KRS + (size_t)DEPTH * NSQ * 32,
                 O_END = O_GLAS + (size_t)DEPTH * DEC_B * 4 * 8192;

constexpr int LDS_BYTES = 147456;

struct Args {
    const float *xp, *xs, *cckv, *ckr, *sgla, *g_attn, *w_in, *g_qn, *w_uq, *g_kvn, *w_ukv, *w_a2, *b_a2, *g_on, *w_o, *g_ffn, *w_gu, *w_down, *g_final;
    float* out; unsigned char* ws;
};

__device__ __forceinline__ unsigned f2bf(float f) { unsigned u = __builtin_bit_cast(unsigned, f); return (u + 0x7fffu + ((u >> 16) & 1u)) >> 16; }
__device__ __forceinline__ unsigned pk2(float lo, float hi) { return f2bf(lo) | (f2bf(hi) << 16); }
__device__ __forceinline__ float bf2f(unsigned short b) { return __builtin_bit_cast(float, (unsigned)b << 16); }
__device__ __forceinline__ float bflo(unsigned w) { return __builtin_bit_cast(float, w << 16); }
__device__ __forceinline__ float bfhi(unsigned w) { return __builtin_bit_cast(float, w & 0xffff0000u); }
__device__ __forceinline__ float wave_sum(float v) {
#pragma unroll
    for (int o = 1; o < 64; o <<= 1) v += __shfl_xor(v, o);
    return v;
}
__device__ __forceinline__ int crow(int r, int hi) { return (r & 3) + 8 * (r >> 2) + 4 * hi; }
__device__ __forceinline__ float logsig(float x) { return fminf(x, 0.f) - __logf(1.0f + __expf(-fabsf(x))); }
#define LDS_WAIT() asm volatile("s_waitcnt lgkmcnt(0)" ::: "memory")
#define MFMA32(a, b, c) __builtin_amdgcn_mfma_f32_32x32x16_bf16((a), (b), (c), 0, 0, 0)
__device__ __forceinline__ f32x16 zero16() { float z = 0.f; asm volatile("" : "+v"(z)); f32x16 v;
#pragma unroll
    for (int r = 0; r < 16; ++r) v[r] = z;
    return v; }

struct Ctx {
    int tid, lane, wave, G, vcu, gw, NGW;
    LAS unsigned char* lds;
};

__device__ __forceinline__ void tr_item(const float* W, int K, int N, int k0, int src0, int nvalid, bf16* WT, int dst_row0, float scale, LAS float* scr, int lane) {
#pragma unroll 32
    for (int i = 0; i < 32; ++i) { const int kk = 2 * i + (lane >> 5), c = lane & 31;
        float v = 0.f; if (c < nvalid) v = W[(size_t)(k0 + kk) * N + src0 + c] * scale;
        scr[kk * 33 + c] = v; }
    LDS_WAIT(); asm volatile("" ::: "memory");
    const int c8 = lane & 7;
#pragma unroll
    for (int j = 0; j < 4; ++j) { const int n = (lane >> 3) + 8 * j; const LAS float* s = scr + (8 * c8) * 33 + n;
        u32x4 o; o.x = pk2(s[0 * 33], s[1 * 33]); o.y = pk2(s[2 * 33], s[3 * 33]); o.z = pk2(s[4 * 33], s[5 * 33]); o.w = pk2(s[6 * 33], s[7 * 33]);
        *(u32x4*)(WT + (size_t)(dst_row0 + n) * K + k0 + 8 * c8) = o; }
    LDS_WAIT(); asm volatile("" ::: "memory");
}
__device__ __forceinline__ void convert_weights(const Ctx& C, const Args& A, int l) {
    LAS float* scr = (LAS float*)(C.lds + C.wave * 16384);
    unsigned char* ws = A.ws;
    const float* w_in = A.w_in + (size_t)l * DM * INW; const float* w_uq = A.w_uq + (size_t)l * 256 * 768; const float* w_ukv = A.w_ukv + (size_t)l * 256 * 1024;
    const float* w_o = A.w_o + (size_t)l * DM * DM; const float* w_gu = A.w_gu + (size_t)l * DM * 2 * DFF; const float* w_d = A.w_down + (size_t)l * DFF * DM;
    constexpr int I0 = 56 * 16, I1 = 16 * 16, I2 = 24 * 4, I3 = 16 * 4, I4 = 16 * 4, I5 = 32 * 16, I6 = 176 * 16, I7 = 32 * 44;
    constexpr int NIT = I0 + I1 + I2 + I3 + I4 + I5 + I6 + I7;
    for (int it = C.gw; it < NIT; it += C.NGW) {
        int r = it;
        if (r < I0) { const int db = r >> 4, kb = r & 15; int src = 0, nv = 32;
            if (db < 16) src = 32 * db; else if (db == 16) src = 512; else if (db == 17) { src = 2080; nv = 16; } else if (db < 24) { src = 0; nv = 0; }
            else if (db < 32) src = 544 + 32 * (db - 24); else if (db < 40) src = 800 + 32 * (db - 32); else src = 1568 + 32 * (db - 40);
            tr_item(w_in, DM, INW, 64 * kb, src, nv, (bf16*)(ws + WS_WIN), 32 * db, 1.f, scr, C.lane); continue; } r -= I0;
        if (r < I1) { const int db = r >> 4, kb = r & 15; tr_item(w_in, DM, INW, 64 * kb, 1056 + 32 * db, 32, (bf16*)(ws + WS_WGV), 32 * db, 1.f, scr, C.lane); continue; } r -= I1;
        if (r < I2) { const int db = r >> 2, kb = r & 3; tr_item(w_uq, 256, 768, 64 * kb, 32 * db, 32, (bf16*)(ws + WS_WUQ), 32 * db, QSCALE, scr, C.lane); continue; } r -= I2;
        if (r < I3) { const int db = r >> 2, kb = r & 3; tr_item(w_ukv, 256, 1024, 64 * kb, (db >> 1) * 128 + (db & 1) * 32, 32, (bf16*)(ws + WS_WUK), 32 * db, 1.f, scr, C.lane); continue; } r -= I3;
        if (r < I4) { const int db = r >> 2, kb = r & 3; tr_item(w_ukv, 256, 1024, 64 * kb, (db >> 1) * 128 + 64 + (db & 1) * 32, 32, (bf16*)(ws + WS_WUV), 32 * db, 1.f, scr, C.lane); continue; } r -= I4;
        if (r < I5) { const int db = r >> 4, kb = r & 15; tr_item(w_o, DM, DM, 64 * kb, 32 * db, 32, (bf16*)(ws + WS_WO), 32 * db, 1.f, scr, C.lane); continue; } r -= I5;
        if (r < I6) { const int db = r >> 4, kb = r & 15; const int pn = db >> 3, t = db & 7; const int src = (t < 4) ? 128 * pn + 32 * t : DFF + 128 * pn + 32 * (t - 4);
            tr_item(w_gu, DM, 2 * DFF, 64 * kb, src, 32, (bf16*)(ws + WS_WGU), 32 * db, 1.f, scr, C.lane); continue; } r -= I6;
        { const int db = r / 44, kb = r % 44; tr_item(w_d, DFF, DM, 64 * kb, 32 * db, 32, (bf16*)(ws + WS_WD), 32 * db, 1.f, scr, C.lane); }
    }
}

__device__ __forceinline__ void norm_row(const float* xrow, const float* g, bf16* orow, float* copy, int lane) {
    const f32x4* xr = (const f32x4*)xrow + lane; const f32x4* gr = (const f32x4*)g + lane;
    f32x4 v[4]; float s = 0.f;
#pragma unroll
    for (int j = 0; j < 4; ++j) { v[j] = xr[64 * j]; s += (v[j].x * v[j].x + v[j].y * v[j].y) + (v[j].z * v[j].z + v[j].w * v[j].w); }
    const float rstd = 1.0f / sqrtf(wave_sum(s) * (1.f / DM) + EPS);
    if (copy) {
#pragma unroll
        for (int j = 0; j < 4; ++j) ((f32x4*)copy + lane)[64 * j] = v[j]; }
    u32x2* o8 = (u32x2*)orow + lane;
#pragma unroll
    for (int j = 0; j < 4; ++j) { const f32x4 gg = gr[64 * j]; u32x2 w; w.x = pk2(v[j].x * rstd * gg.x, v[j].y * rstd * gg.y); w.y = pk2(v[j].z * rstd * gg.z, v[j].w * rstd * gg.w); o8[64 * j] = w; }
}
__device__ __forceinline__ void final_norm_row(float* xrow, const float* g, int lane) {
    f32x4* xr = (f32x4*)xrow + lane; const f32x4* gr = (const f32x4*)g + lane;
    f32x4 v[4]; float s = 0.f;
#pragma unroll
    for (int j = 0; j < 4; ++j) { v[j] = xr[64 * j]; s += (v[j].x * v[j].x + v[j].y * v[j].y) + (v[j].z * v[j].z + v[j].w * v[j].w); }
    const float rstd = 1.0f / sqrtf(wave_sum(s) * (1.f / DM) + EPS);
#pragma unroll
    for (int j = 0; j < 4; ++j) { const f32x4 gg = gr[64 * j]; xr[64 * j] = v[j] * rstd * gg; }
}

__device__ __forceinline__ void norm_row2(const float* x0, const float* x1, const f32x4 (&gv)[4], bf16* o0, bf16* o1, bool has1, int lane) {
    const f32x4* p0 = (const f32x4*)x0 + lane; const f32x4* p1 = (const f32x4*)x1 + lane;
    f32x4 v0[4], v1[4]; float s0 = 0.f, s1 = 0.f;
#pragma unroll
    for (int j = 0; j < 4; ++j) { v0[j] = p0[64 * j]; v1[j] = p1[64 * j]; }
#pragma unroll
    for (int j = 0; j < 4; ++j) { s0 += (v0[j].x * v0[j].x + v0[j].y * v0[j].y) + (v0[j].z * v0[j].z + v0[j].w * v0[j].w); s1 += (v1[j].x * v1[j].x + v1[j].y * v1[j].y) + (v1[j].z * v1[j].z + v1[j].w * v1[j].w); }
    const float r0 = 1.0f / sqrtf(wave_sum(s0) * (1.f / DM) + EPS), r1 = 1.0f / sqrtf(wave_sum(s1) * (1.f / DM) + EPS);
    u32x2* q0 = (u32x2*)o0 + lane; u32x2* q1 = (u32x2*)o1 + lane;
#pragma unroll
    for (int j = 0; j < 4; ++j) { u32x2 w; w.x = pk2(v0[j].x * r0 * gv[j].x, v0[j].y * r0 * gv[j].y); w.y = pk2(v0[j].z * r0 * gv[j].z, v0[j].w * r0 * gv[j].w); q0[64 * j] = w; }
    if (has1) {
#pragma unroll
        for (int j = 0; j < 4; ++j) { u32x2 w; w.x = pk2(v1[j].x * r1 * gv[j].x, v1[j].y * r1 * gv[j].y); w.y = pk2(v1[j].z * r1 * gv[j].z, v1[j].w * r1 * gv[j].w); q1[64 * j] = w; } }
}
__device__ __forceinline__ void final_norm_row2(float* x0, float* x1, const f32x4 (&gv)[4], bool has1, int lane) {
    f32x4* p0 = (f32x4*)x0 + lane; f32x4* p1 = (f32x4*)x1 + lane;
    f32x4 v0[4], v1[4]; float s0 = 0.f, s1 = 0.f;
#pragma unroll
    for (int j = 0; j < 4; ++j) { v0[j] = p0[64 * j]; v1[j] = p1[64 * j]; }
#pragma unroll
    for (int j = 0; j < 4; ++j) { s0 += (v0[j].x * v0[j].x + v0[j].y * v0[j].y) + (v0[j].z * v0[j].z + v0[j].w * v0[j].w); s1 += (v1[j].x * v1[j].x + v1[j].y * v1[j].y) + (v1[j].z * v1[j].z + v1[j].w * v1[j].w); }
    const float r0 = 1.0f / sqrtf(wave_sum(s0) * (1.f / DM) + EPS), r1 = 1.0f / sqrtf(wave_sum(s1) * (1.f / DM) + EPS);
#pragma unroll
    for (int j = 0; j < 4; ++j) p0[64 * j] = v0[j] * r0 * gv[j];
    if (has1) {
#pragma unroll
        for (int j = 0; j < 4; ++j) p1[64 * j] = v1[j] * r1 * gv[j]; }
}
struct P3Loads { u32x2 cq, ckv; u32x4 g0, g1; unsigned short x1r, x2r; float rc, rs; };
__device__ __forceinline__ int p3_pos(int m) { return (m < NP) ? (m & (SEQ - 1)) : PAST + ((m - NP) & 31); }
__device__ __forceinline__ P3Loads p3_load(const Args& A, int m, int lane) {
    unsigned char* ws = A.ws; P3Loads L;
    const bf16* CQ = (const bf16*)(ws + WS_Z); const bf16* CKV = (const bf16*)(ws + WS_Z + T256); const bf16* MISC = (const bf16*)(ws + WS_Z + 2 * T256);
    const float* ROPE = (const float*)(ws + WS_ROPE);
    L.cq = *((const u32x2*)(CQ + (size_t)m * 256) + lane); L.ckv = *((const u32x2*)(CKV + (size_t)m * 256) + lane);
    L.g0 = *(const u32x4*)(MISC + (size_t)m * 256 + 32); L.g1 = *(const u32x4*)(MISC + (size_t)m * 256 + 40);
    L.x1r = MISC[(size_t)m * 256 + lane]; L.x2r = MISC[(size_t)m * 256 + 16 + lane];
    const int pos = p3_pos(m); L.rc = ROPE[pos * 32 + (lane & 15)]; L.rs = ROPE[pos * 32 + 16 + (lane & 15)];
    return L;
}
__device__ __forceinline__ void p3_token(const Args& A, int l, int m, int lane, const f32x4 (&wv)[16], const f32x4& bv, const f32x4& gq, const f32x4& gkv, const P3Loads& L) {
    unsigned char* ws = A.ws;
    { const u32x2 w = L.cq; const float a = bflo(w.x), b = bfhi(w.x), c = bflo(w.y), d = bfhi(w.y);
      const float rstd = 1.0f / sqrtf(wave_sum((a * a + b * b) + (c * c + d * d)) * (1.f / 256) + EPS);
      u32x2 o; o.x = pk2(a * rstd * gq.x, b * rstd * gq.y); o.y = pk2(c * rstd * gq.z, d * rstd * gq.w);
      *((u32x2*)((bf16*)(ws + WS_CQN) + (size_t)m * 256) + lane) = o; }
    float* ockv; float* okr; bf16* bckv; bf16* bkr;
    if (m < NP) { ockv = A.out + O_CKVP + ((size_t)l * NP + m) * 256; okr = A.out + O_KRP + ((size_t)l * NP + m) * 32;
        bckv = (bf16*)(ws + WS_CKVN) + (size_t)m * 256; bkr = (bf16*)(ws + WS_KR) + (size_t)m * 32; }
    else { const int s = m - NP, b = s >> 5, t = s & 31; ockv = A.out + O_CKVS + ((size_t)l * NSQ + s) * 256; okr = A.out + O_KRS + ((size_t)l * NSQ + s) * 32;
        const size_t r = (size_t)b * SKV + PAST + t; bckv = (bf16*)(ws + WS_CKVS) + r * 256; bkr = (bf16*)(ws + WS_KRS) + r * 32; }
    { const u32x2 w = L.ckv; const float a = bflo(w.x), b = bfhi(w.x), c = bflo(w.y), d = bfhi(w.y);
      const float rstd = 1.0f / sqrtf(wave_sum((a * a + b * b) + (c * c + d * d)) * (1.f / 256) + EPS);
      const f32x4 o = (f32x4){a * rstd * gkv.x, b * rstd * gkv.y, c * rstd * gkv.z, d * rstd * gkv.w};
      *((f32x4*)ockv + lane) = o;
      u32x2 ob; ob.x = pk2(o.x, o.y); ob.y = pk2(o.z, o.w); *((u32x2*)bckv + lane) = ob; }
    if (lane < 16) { const float x1 = bf2f(L.x1r), x2 = bf2f(L.x2r); const float c = L.rc, s = L.rs;
        const float o1 = x1 * c - x2 * s, o2 = x1 * s + x2 * c;
        okr[lane] = o1; okr[16 + lane] = o2; bkr[lane] = (bf16)f2bf(o1); bkr[16 + lane] = (bf16)f2bf(o2); }
    else if (lane < 32) { ((float*)(ws + WS_GA))[(size_t)m * 16 + (lane - 16)] = bf2f(L.x2r); }
    { const u32x4 g0 = L.g0, g1 = L.g1;
      f32x4 x = bv;
#pragma unroll
      for (int q = 0; q < 4; ++q) { x = x + wv[2 * q] * bflo(g0[q]) + wv[2 * q + 1] * bfhi(g0[q]); }
#pragma unroll
      for (int q = 0; q < 4; ++q) { x = x + wv[8 + 2 * q] * bflo(g1[q]) + wv[8 + 2 * q + 1] * bfhi(g1[q]); }
      u32x2 o; o.x = pk2(logsig(x.x) * (1.f / 16.f), logsig(x.y) * (1.f / 16.f)); o.y = pk2(logsig(x.z) * (1.f / 16.f), logsig(x.w) * (1.f / 16.f));
      *((u32x2*)((bf16*)(ws + WS_LG) + (size_t)m * 256) + lane) = o; }
}
__device__ __forceinline__ void cache_row(const Args& A, int l, int r, int lane) {
    const int b = r >> 11, p = r & (PAST - 1); const size_t dr = (size_t)b * SKV + p;
    const f32x4 v = *((const f32x4*)(A.cckv + ((size_t)l * DEC_B * PAST + r) * 256) + lane);
    u32x2 o; o.x = pk2(v.x, v.y); o.y = pk2(v.z, v.w); *((u32x2*)((bf16*)(A.ws + WS_CKVS) + dr * 256) + lane) = o;
    if (lane < 32) ((bf16*)(A.ws + WS_KRS))[dr * 32 + lane] = (bf16)f2bf(A.ckr[((size_t)l * DEC_B * PAST + r) * 32 + lane]);
}

struct GlaItem { int tok0, L, hd, sb; bool sample; };
__device__ __forceinline__ GlaItem gla_decode(int it) {
    GlaItem g;
    if (it < NITEM_P) { g.hd = it & 3; const int bc = it >> 2; g.tok0 = bc * 64; g.L = 64; g.sample = false; g.sb = 0; }
    else { const int j = it - NITEM_P; g.hd = j & 3; g.sb = j >> 2; g.tok0 = NP + g.sb * 32; g.L = 32; g.sample = true; }
    return g;
}
typedef float f32x2_t __attribute__((ext_vector_type(2))); typedef __bf16 bf16x2_t __attribute__((ext_vector_type(2)));
__device__ __forceinline__ unsigned cvtpk(float lo, float hi) { f32x2_t v = {lo, hi}; bf16x2_t b = __builtin_convertvector(v, bf16x2_t); return __builtin_bit_cast(unsigned, b); }
__device__ __forceinline__ float gate_lg(const float (&ga)[16], const float (&w)[16], float bias, int p, const float* g_GA_base) { return 0.f; }
constexpr int KT_PITCH = 72;
template <bool SAMPLE> __device__ __forceinline__ void gla_g1(const Args& A, int l, int it, LAS unsigned char* wl, int lane) {
    const GlaItem g = gla_decode(it); unsigned char* ws = A.ws; constexpr int L = SAMPLE ? 32 : 64;
    const int col = g.hd * 64 + lane, r32 = lane & 31, hi = lane >> 5;
    const float* GA = (const float*)(ws + WS_GA); const bf16* GK = (const bf16*)(ws + WS_Z + 4 * T256); const bf16* GVT = (const bf16*)(ws + WS_GVT);
    LAS bf16* kT = (LAS bf16*)wl; LAS float* dsm = (LAS float*)(wl + 64 * KT_PITCH * 2);
    float w[16], ga[16];
#pragma unroll
    for (int r = 0; r < 16; ++r) w[r] = A.w_a2[(size_t)l * 16 * 256 + r * 256 + col];
    const float bias = A.b_a2[l * 256 + col];
    { const int pl = lane < L ? lane : L - 1;
#pragma unroll
      for (int q = 0; q < 4; ++q) { const f32x4 v = *(const f32x4*)(GA + (size_t)(g.tok0 + pl) * 16 + 4 * q); ga[4 * q] = v.x; ga[4 * q + 1] = v.y; ga[4 * q + 2] = v.z; ga[4 * q + 3] = v.w; } }
    float blast = 0.f; float lgv[L];
#pragma unroll
    for (int p = 0; p < L; ++p) { lgv[p] = bf2f(((const bf16*)(ws + WS_LG))[(size_t)(g.tok0 + p) * 256 + col]); blast += lgv[p]; }
    float bc = 0.f;
#pragma unroll
    for (int p = 0; p < L; ++p) { bc += lgv[p];
        const float kk = bf2f(GK[(size_t)(g.tok0 + p) * 256 + col]) * __expf(blast - bc);
        kT[lane * KT_PITCH + p] = (bf16)(cvtpk(kk, kk) & 0xffffu); }
    const float decay = __expf(blast);
    if (!SAMPLE) ((float*)(ws + WS_DECAY))[(size_t)it * 64 + lane] = decay;
    dsm[lane] = decay;
    LDS_WAIT(); asm volatile("" ::: "memory");
#pragma unroll 1
    for (int nb = 0; nb < 4; ++nb) {
        f32x16 acc[2]; acc[0] = (f32x16){}; acc[1] = (f32x16){};
#pragma unroll
        for (int s = 0; s < L / 16; ++s) {
            const bf16x8 bfr = *(const bf16x8*)(GVT + (size_t)(g.hd * 128 + 32 * nb + r32) * NTOK + g.tok0 + 16 * s + 8 * hi);
#pragma unroll
            for (int mb = 0; mb < 2; ++mb) { const bf16x8 af = *(const LAS bf16x8*)(kT + (32 * mb + r32) * KT_PITCH + 16 * s + 8 * hi); acc[mb] = MFMA32(af, bfr, acc[mb]); }
        }
        const int dv = 32 * nb + r32;
#ifdef DS_OLD
        if (!SAMPLE) { float* dsp = (float*)(ws + WS_DS) + (size_t)it * 8192 + dv;
#pragma unroll
            for (int mb = 0; mb < 2; ++mb)
#pragma unroll
                for (int r = 0; r < 16; ++r) dsp[(32 * mb + crow(r, hi)) * 128] = acc[mb][r]; }
#else
        if (!SAMPLE) { float* dsp = (float*)(ws + WS_DS) + (size_t)it * 8192 + dv * 64 + 4 * hi;
#pragma unroll
            for (int mb = 0; mb < 2; ++mb)
#pragma unroll
                for (int q = 0; q < 4; ++q) *(f32x4*)(dsp + 32 * mb + 8 * q) = (f32x4){acc[mb][4 * q], acc[mb][4 * q + 1], acc[mb][4 * q + 2], acc[mb][4 * q + 3]}; }
#endif
        else { const size_t so = (((size_t)l * DEC_B + g.sb) * 4 + g.hd) * 8192 + dv;
#pragma unroll
            for (int mb = 0; mb < 2; ++mb) {
#pragma unroll
                for (int r = 0; r < 16; ++r) { const int dk = 32 * mb + crow(r, hi); A.out[O_GLAS + so + dk * 128] = dsm[dk] * A.sgla[so + dk * 128] + acc[mb][r]; } } }
    }
    LDS_WAIT(); asm volatile("" ::: "memory");
}
constexpr int NSCAN = 128, NSAMPWG = 16;
#ifdef DS_OLD
__device__ __forceinline__ void gla_scan(const Args& A, int l, int sblock, int tid) {
    const int gth = sblock * 512 + tid;
    const int seq = gth >> 12, e0 = (gth & 4095) * 2;
    const int b = seq >> 2, hd = seq & 3, dk = e0 >> 7;
    float* DS = (float*)(A.ws + WS_DS); const float* DEC = (const float*)(A.ws + WS_DECAY);
    float s0 = 0.f, s1 = 0.f;
    for (int c0 = 0; c0 < 256; c0 += 8) {
        float2 ds[8]; float dc[8];
#pragma unroll
        for (int j = 0; j < 8; ++j) { const size_t it = (size_t)((b * 256 + c0 + j) * 4 + hd); ds[j] = *(const float2*)(DS + it * 8192 + e0); dc[j] = DEC[it * 64 + dk]; }
#pragma unroll
        for (int j = 0; j < 8; ++j) { const size_t it = (size_t)((b * 256 + c0 + j) * 4 + hd); *(float2*)(DS + it * 8192 + e0) = make_float2(s0, s1);
            s0 = dc[j] * s0 + ds[j].x; s1 = dc[j] * s1 + ds[j].y; }
    }
    *(float2*)(A.out + O_GLAP + (((size_t)l * NBATCH + b) * 4 + hd) * 8192 + e0) = make_float2(s0, s1);
}
#else
__device__ __forceinline__ void gla_scan(const Args& A, int l, int sblock, int tid) {
    const int seq = sblock >> 4, e0 = (sblock & 15) * 512 + tid;
    const int b = seq >> 2, hd = seq & 3, dv = e0 >> 6, dk = e0 & 63;
    float* DS = (float*)(A.ws + WS_DS); const float* DEC = (const float*)(A.ws + WS_DECAY);
    float s0 = 0.f;
#pragma unroll 1
    for (int c0 = 0; c0 < 256; c0 += 32) {
        float ds[32], dc[32];
#pragma unroll
        for (int j = 0; j < 32; ++j) { const size_t it = (size_t)((b * 256 + c0 + j) * 4 + hd); ds[j] = DS[it * 8192 + e0]; dc[j] = DEC[it * 64 + dk]; }
#pragma unroll
        for (int j = 0; j < 32; ++j) { const size_t it = (size_t)((b * 256 + c0 + j) * 4 + hd); DS[it * 8192 + e0] = s0; s0 = dc[j] * s0 + ds[j]; }
    }
    A.out[O_GLAP + (((size_t)l * NBATCH + b) * 4 + hd) * 8192 + dk * 128 + dv] = s0;
}
#endif
constexpr int BS_PITCH = 65;
template <bool SAMPLE> __device__ __forceinline__ void gla_g3(const Args& A, int l, int it, LAS unsigned char* wl, int lane) {
    const GlaItem g = gla_decode(it); unsigned char* ws = A.ws; constexpr int L = SAMPLE ? 32 : 64, NIB = L / 32;
    const int col = g.hd * 64 + lane, r32 = lane & 31, hi = lane >> 5;
    const float* GA = (const float*)(ws + WS_GA); const bf16* GQ = (const bf16*)(ws + WS_Z + 3 * T256); const bf16* GK = (const bf16*)(ws + WS_Z + 4 * T256);
    const bf16* GG = (const bf16*)(ws + WS_Z + 5 * T256); const bf16* GVT = (const bf16*)(ws + WS_GVT); bf16* CAT = (bf16*)(ws + WS_H);
    LAS float* bsm = (LAS float*)wl;
    u32x4 rqv[NIB][4], rkv[NIB][4];
#pragma unroll
    for (int ib = 0; ib < NIB; ++ib)
#pragma unroll
        for (int s = 0; s < 4; ++s) { const int i = 32 * ib + r32, dk0 = 16 * s + 8 * hi;
            rqv[ib][s] = *(const u32x4*)(GQ + (size_t)(g.tok0 + i) * 256 + g.hd * 64 + dk0); rkv[ib][s] = *(const u32x4*)(GK + (size_t)(g.tok0 + i) * 256 + g.hd * 64 + dk0); }
    {   float w[16], ga[16];
#pragma unroll
        for (int r = 0; r < 16; ++r) w[r] = A.w_a2[(size_t)l * 16 * 256 + r * 256 + col];
        const float bias = A.b_a2[l * 256 + col];
        { const int pl = lane < L ? lane : L - 1;
#pragma unroll
          for (int q = 0; q < 4; ++q) { const f32x4 v = *(const f32x4*)(GA + (size_t)(g.tok0 + pl) * 16 + 4 * q); ga[4 * q] = v.x; ga[4 * q + 1] = v.y; ga[4 * q + 2] = v.z; ga[4 * q + 3] = v.w; } }
        float bc = 0.f;
#pragma unroll
        for (int p = 0; p < L; ++p) { bc += bf2f(((const bf16*)(ws + WS_LG))[(size_t)(g.tok0 + p) * 256 + col]); bsm[p * BS_PITCH + lane] = bc; }
    }
    LDS_WAIT(); asm volatile("" ::: "memory");
    bf16x8 qf[NIB][4], kf[NIB][4];
#pragma unroll
    for (int ib = 0; ib < NIB; ++ib)
#pragma unroll
        for (int s = 0; s < 4; ++s) {
            const int i = 32 * ib + r32, dk0 = 16 * s + 8 * hi;
            const u32x4 rq = rqv[ib][s], rk = rkv[ib][s];
            u32x4 oq, ok;
#pragma unroll
            for (int jj = 0; jj < 4; ++jj) { const float b0 = bsm[i * BS_PITCH + dk0 + 2 * jj], b1 = bsm[i * BS_PITCH + dk0 + 2 * jj + 1];
                const float e0 = __expf(b0), e1 = __expf(b1);
                oq[jj] = cvtpk(bflo(rq[jj]) * 0.125f * e0, bfhi(rq[jj]) * 0.125f * e1);
                ok[jj] = cvtpk(bflo(rk[jj]) * __expf(-b0), bfhi(rk[jj]) * __expf(-b1)); }
            qf[ib][s] = __builtin_bit_cast(bf16x8, oq); kf[ib][s] = __builtin_bit_cast(bf16x8, ok);
        }
    bf16x8 xp[NIB][NIB][2];
#pragma unroll
    for (int jb = 0; jb < NIB; ++jb)
#pragma unroll
        for (int ib = 0; ib < NIB; ++ib) {
            if (jb > ib) { xp[jb][ib][0] = (bf16x8){}; xp[jb][ib][1] = (bf16x8){}; continue; }
            f32x16 X = (f32x16){};
#pragma unroll
            for (int s = 0; s < 4; ++s) X = MFMA32(kf[jb][s], qf[ib][s], X);
            if (jb == ib) {
#pragma unroll
                for (int r = 0; r < 16; ++r) if (crow(r, hi) > r32) X[r] = 0.f; }
#pragma unroll
            for (int s2 = 0; s2 < 2; ++s2) { u32x4 pw;
#pragma unroll
                for (int jj = 0; jj < 4; ++jj) pw[jj] = cvtpk(X[8 * s2 + 2 * jj], X[8 * s2 + 2 * jj + 1]);
                xp[jb][ib][s2] = __builtin_bit_cast(bf16x8, pw); }
        }
    const float* Sp = SAMPLE ? A.sgla + (((size_t)l * DEC_B + g.sb) * 4 + g.hd) * 8192 : (const float*)(ws + WS_DS) + (size_t)it * 8192;
#pragma unroll
    for (int ib = 0; ib < NIB; ++ib) {
        f32x16 o[4];
#pragma unroll
        for (int nb = 0; nb < 4; ++nb) {
            const int dv = 32 * nb + r32;
            o[nb] = (f32x16){};
#pragma unroll
            for (int s = 0; s < 4; ++s) { u32x4 pw;
#ifdef DS_OLD
                if (true) {
#else
                if (SAMPLE) {
#endif
#pragma unroll
                    for (int jj = 0; jj < 4; ++jj) pw[jj] = cvtpk(Sp[(16 * s + 8 * hi + 2 * jj) * 128 + dv], Sp[(16 * s + 8 * hi + 2 * jj + 1) * 128 + dv]); }
                else { const f32x4 sa = *(const f32x4*)(Sp + dv * 64 + 16 * s + 8 * hi), sb = *(const f32x4*)(Sp + dv * 64 + 16 * s + 8 * hi + 4);
                    pw = (u32x4){cvtpk(sa.x, sa.y), cvtpk(sa.z, sa.w), cvtpk(sb.x, sb.y), cvtpk(sb.z, sb.w)}; }
                o[nb] = MFMA32(__builtin_bit_cast(bf16x8, pw), qf[ib][s], o[nb]); }
#pragma unroll
            for (int jb = 0; jb <= ib; ++jb)
#pragma unroll
                for (int s2 = 0; s2 < 2; ++s2) { const bf16* vp = GVT + (size_t)(g.hd * 128 + dv) * NTOK + g.tok0 + 32 * jb + 16 * s2 + 4 * hi;
                    const u32x2 lo = *(const u32x2*)vp, hi8 = *(const u32x2*)(vp + 8);
                    o[nb] = MFMA32(__builtin_bit_cast(bf16x8, (u32x4){lo.x, lo.y, hi8.x, hi8.y}), xp[jb][ib][s2], o[nb]); }
        }
        float ss = 0.f;
#pragma unroll
        for (int nb = 0; nb < 4; ++nb)
#pragma unroll
            for (int r = 0; r < 16; ++r) ss += o[nb][r] * o[nb][r];
        ss += __shfl_xor(ss, 32);
        const float rstd = 1.0f / sqrtf(ss * (1.f / 128) + EPS);
        const int tok = g.tok0 + 32 * ib + r32;
#pragma unroll
        for (int nb = 0; nb < 4; ++nb)
#pragma unroll
            for (int q = 0; q < 4; ++q) { const int dv0 = 32 * nb + 8 * q + 4 * hi; const int gc = g.hd * 128 + dv0;
                const u32x2 gw = *(const u32x2*)(GG + (size_t)(gc >> 8) * ((size_t)NTOK * 256) + (size_t)tok * 256 + (gc & 255));
                const f32x4 gon = *(const f32x4*)(A.g_on + l * 128 + dv0);
                const float g0 = bflo(gw.x), g1 = bfhi(gw.x), g2 = bflo(gw.y), g3 = bfhi(gw.y);
                const float v0 = o[nb][4 * q + 0] * rstd * gon.x * g0 * __builtin_amdgcn_rcpf(1.0f + __expf(-g0));
                const float v1 = o[nb][4 * q + 1] * rstd * gon.y * g1 * __builtin_amdgcn_rcpf(1.0f + __expf(-g1));
                const float v2 = o[nb][4 * q + 2] * rstd * gon.z * g2 * __builtin_amdgcn_rcpf(1.0f + __expf(-g2));
                const float v3 = o[nb][4 * q + 3] * rstd * gon.w * g3 * __builtin_amdgcn_rcpf(1.0f + __expf(-g3));
                u32x2 ow; ow.x = cvtpk(v0, v1); ow.y = cvtpk(v2, v3);
                *(u32x2*)(CAT + (size_t)tok * 1024 + 512 + g.hd * 128 + dv0) = ow; }
        asm volatile("" ::: "memory");
    }
    LDS_WAIT(); asm volatile("" ::: "memory");
}

__device__ __forceinline__ float max3f(float a, float b, float c) { return fmaxf(fmaxf(a, b), c); }
constexpr float ATT_THR = 8.0f;
template <class LD> __device__ __forceinline__ void attn_tile(const LD& ld, const bf16x8 (&qr)[6], f32x16 (&o)[2], float& m, float& l, bool half_only, bool first) {
    f32x16 negm;
#pragma unroll
    for (int r = 0; r < 16; ++r) negm[r] = -m;
    f32x16 p0 = negm, p1 = negm;
#pragma unroll
    for (int s = 0; s < 6; ++s) p0 = MFMA32(ld.k(0, s), qr[s], p0);
    if (!half_only) {
#pragma unroll
        for (int s = 0; s < 6; ++s) p1 = MFMA32(ld.k(1, s), qr[s], p1); }
    float mx = max3f(p0[0], p0[1], p0[2]);
#pragma unroll
    for (int r = 3; r < 15; r += 2) mx = max3f(mx, p0[r], p0[r + 1]);
    mx = fmaxf(mx, p0[15]);
    if (!half_only) {
#pragma unroll
        for (int r = 0; r < 16; r += 2) mx = max3f(mx, p1[r], p1[r + 1]); }
    mx = fmaxf(mx, __shfl_xor(mx, 32));
    if (first || __any(mx > ATT_THR)) {
        const float d = first ? mx : fmaxf(mx, 0.f);
        m += d;
        const float f = first ? 0.f : __builtin_amdgcn_exp2f(-d);
        l *= f;
#pragma unroll
        for (int r = 0; r < 16; ++r) { p0[r] -= d; p1[r] -= d; o[0][r] *= f; o[1][r] *= f; }
    }
    float rs = 0.f, rs1 = 0.f;
#pragma unroll
    for (int r = 0; r < 16; ++r) { p0[r] = __builtin_amdgcn_exp2f(p0[r]); rs += p0[r]; }
    if (!half_only) {
#pragma unroll
        for (int r = 0; r < 16; ++r) { p1[r] = __builtin_amdgcn_exp2f(p1[r]); rs1 += p1[r]; } }
    l += rs + rs1;
    bf16x8 pa[4];
#pragma unroll
    for (int s = 0; s < 2; ++s) { u32x4 w0, w1;
#pragma unroll
        for (int jj = 0; jj < 4; ++jj) { w0[jj] = cvtpk(p0[8 * s + 2 * jj], p0[8 * s + 2 * jj + 1]); w1[jj] = cvtpk(p1[8 * s + 2 * jj], p1[8 * s + 2 * jj + 1]); }
        pa[s] = __builtin_bit_cast(bf16x8, w0); pa[2 + s] = __builtin_bit_cast(bf16x8, w1); }
#pragma unroll
    for (int db = 0; db < 2; ++db) {
#pragma unroll
        for (int s = 0; s < 2; ++s) o[db] = MFMA32(ld.v(db, s), pa[s], o[db]);
        if (!half_only) {
#pragma unroll
            for (int s = 2; s < 4; ++s) o[db] = MFMA32(ld.v(db, s), pa[s], o[db]); }
    }
}
constexpr int K_PITCH = 208, V_PITCH = 136, KBUF = 64 * K_PITCH, VBUF = 64 * V_PITCH, ABUF = KBUF + VBUF;
struct LdsLoader {
    LAS const unsigned char* kb; LAS const unsigned char* vb; int r32, hi;
    __device__ __forceinline__ bf16x8 k(int half, int s) const { return *(LAS const bf16x8*)(kb + (r32 + 32 * half) * K_PITCH + s * 32 + hi * 16); }
    __device__ __forceinline__ bf16x8 v(int db, int s) const { LAS const unsigned char* p = vb + (r32 + 32 * db) * V_PITCH + s * 32 + hi * 8;
        const u32x2 lo = *(LAS const u32x2*)p, h8 = *(LAS const u32x2*)(p + 16); return __builtin_bit_cast(bf16x8, (u32x4){lo.x, lo.y, h8.x, h8.y}); }
};
struct GlbLoader {
    const bf16* kn; const bf16* kr; const bf16* vt; int r32, hi;
    __device__ __forceinline__ bf16x8 k(int half, int s) const { const int kv = r32 + 32 * half;
        return (s < 4) ? *(const bf16x8*)(kn + (size_t)kv * 512 + 16 * s + 8 * hi) : *(const bf16x8*)(kr + (size_t)kv * 32 + 16 * (s - 4) + 8 * hi); }
    __device__ __forceinline__ bf16x8 v(int db, int s) const { const bf16* p = vt + (size_t)(r32 + 32 * db) * NKVS + 16 * s + 4 * hi;
        const u32x2 lo = *(const u32x2*)p, h8 = *(const u32x2*)(p + 8); return __builtin_bit_cast(bf16x8, (u32x4){lo.x, lo.y, h8.x, h8.y}); }
};
__device__ __forceinline__ void load_q(bf16x8 (&qr)[6], const bf16* qp, const float* rope_row, int hi) {
#pragma unroll
    for (int s = 0; s < 6; ++s) qr[s] = *(const bf16x8*)(qp + 16 * s + 8 * hi);
    const u32x4 a = __builtin_bit_cast(u32x4, qr[4]), b = __builtin_bit_cast(u32x4, qr[5]); u32x4 oa, ob;
    const f32x4 c0 = *(const f32x4*)(rope_row + 8 * hi), c1 = *(const f32x4*)(rope_row + 8 * hi + 4), s0 = *(const f32x4*)(rope_row + 16 + 8 * hi), s1 = *(const f32x4*)(rope_row + 16 + 8 * hi + 4);
#pragma unroll
    for (int jj = 0; jj < 4; ++jj) {
        const float x1l = bflo(a[jj]), x1h = bfhi(a[jj]), x2l = bflo(b[jj]), x2h = bfhi(b[jj]);
        const float cl = (jj < 2) ? c0[2 * jj] : c1[2 * jj - 4], ch = (jj < 2) ? c0[2 * jj + 1] : c1[2 * jj - 3];
        const float sl = (jj < 2) ? s0[2 * jj] : s1[2 * jj - 4], sh = (jj < 2) ? s0[2 * jj + 1] : s1[2 * jj - 3];
        oa[jj] = pk2(x1l * cl - x2l * sl, x1h * ch - x2h * sh); ob[jj] = pk2(x1l * sl + x2l * cl, x1h * sh + x2h * ch); }
    qr[4] = __builtin_bit_cast(bf16x8, oa); qr[5] = __builtin_bit_cast(bf16x8, ob);
}
__device__ __forceinline__ float halfmax(float x) { auto rr = __builtin_amdgcn_permlane32_swap(__float_as_uint(x), __float_as_uint(x), false, false); return fmaxf(__uint_as_float(rr[0]), __uint_as_float(rr[1])); }
__device__ __forceinline__ float halfsum(float x) { auto rr = __builtin_amdgcn_permlane32_swap(__float_as_uint(x), __float_as_uint(x), false, false); return __uint_as_float(rr[0]) + __uint_as_float(rr[1]); }
__device__ __forceinline__ float rowmax32(const f32x16& c0, const f32x16& c1) {
    float mx = max3f(c0[0], c0[1], c0[2]);
#pragma unroll
    for (int r = 3; r < 15; r += 2) mx = max3f(mx, c0[r], c0[r + 1]);
    mx = fmaxf(mx, c0[15]);
#pragma unroll
    for (int r = 0; r < 16; r += 2) mx = max3f(mx, c1[r], c1[r + 1]);
    return halfmax(mx);
}
__device__ __forceinline__ void attn_qk(const LdsLoader& ld, const bf16x8 (&qr)[6], float m, f32x16& c0, f32x16& c1) {
    f32x16 negm;
#pragma unroll
    for (int r = 0; r < 16; ++r) negm[r] = -m;
    c0 = negm; c1 = negm;
#pragma unroll
    for (int s = 0; s < 6; ++s) { c0 = MFMA32(ld.k(0, s), qr[s], c0); c1 = MFMA32(ld.k(1, s), qr[s], c1); }
}
__device__ __forceinline__ void attn_prompt_unit(const Args& A, const Ctx& C, int b, int hd, int qb) {
    int tid_ = threadIdx.x; asm volatile("" : "+v"(tid_));
    unsigned char* ws = A.ws; const int tid = tid_, lane = tid & 63, wid = C.wave, r32 = lane & 31, hi = lane >> 5;
    const bf16* Q = (const bf16*)(ws + WS_Z); const bf16* KN = (const bf16*)(ws + WS_KN); const bf16* KR = (const bf16*)(ws + WS_KR); const bf16* VT = (const bf16*)(ws + WS_VT);
    bf16* CAT = (bf16*)(ws + WS_H); const float* ROPE = (const float*)(ws + WS_ROPE);
    const int pos = qb * 256 + wid * 32 + r32; const size_t qrow = (size_t)b * SEQ + pos;
    bf16x8 qr[6]; load_q(qr, Q + qrow * 768 + hd * 96, ROPE + (size_t)pos * 32, hi);
    const int ntiles = 4 * qb + 4, my_last = 4 * qb + (wid >> 1);
    const int krow = tid >> 3, kch = tid & 7, rrow = (tid & 255) >> 2, rch = tid & 3;
    const char* kn_base = (const char*)(KN + (size_t)b * SEQ * 512 + hd * 64); const char* kr_base = (const char*)(KR + (size_t)b * SEQ * 32);
    const char* vt_base = (const char*)(VT + (size_t)(hd * 64) * NP + (size_t)b * SEQ);
    const unsigned kn_off = (unsigned)(krow * 512 + kch * 8) * 2u, kr_off = (unsigned)(rrow * 32 + rch * 8) * 2u, vt_off = (unsigned)(krow * NP + kch * 8) * 2u;
    const int kn_dst = krow * K_PITCH + kch * 16, kr_dst = rrow * K_PITCH + 128 + rch * 16, vt_dst = KBUF + krow * V_PITCH + kch * 16;
    u32x4 sk, sr, sv;
#define ATT_GLOAD(tt) do { sk = *(const u32x4*)(kn_base + (size_t)(tt) * (64 * 512 * 2) + kn_off); sv = *(const u32x4*)(vt_base + (size_t)(tt) * 128 + vt_off); if (tid < 256) sr = *(const u32x4*)(kr_base + (size_t)(tt) * (64 * 32 * 2) + kr_off); } while (0)
#define ATT_LSTORE(slot_) do { LAS unsigned char* bufp = C.lds + (slot_) * ABUF; *(LAS u32x4*)(bufp + kn_dst) = sk; if (tid < 256) *(LAS u32x4*)(bufp + kr_dst) = sr; \
        *(LAS u32x2*)(bufp + vt_dst) = (u32x2){sv.x, sv.y}; *(LAS u32x2*)(bufp + vt_dst + 8) = (u32x2){sv.z, sv.w}; } while (0)
    ATT_GLOAD(0); ATT_LSTORE(0); ATT_GLOAD(1); ATT_LSTORE(1);
    __syncthreads();
    f32x16 o[2]; o[0] = zero16(); o[1] = zero16(); float m = o[0][0], l = m;
    f32x16 c0, c1;
    { const LdsLoader ld0{C.lds, C.lds + KBUF, r32, hi}; attn_qk(ld0, qr, m, c0, c1); }
    int slot = 0;
    for (int t = 0; t < ntiles; ++t) {
        const int s1 = (slot == 2) ? 0 : slot + 1, s2 = (s1 == 2) ? 0 : s1 + 1;
        const bool more = (t + 2 < ntiles);
        if (more) ATT_GLOAD(t + 2);
        if (t <= my_last) {
            bf16x8 kf[12];
            { const LdsLoader ldn{C.lds + s1 * ABUF, C.lds + s1 * ABUF + KBUF, r32, hi};
#pragma unroll
              for (int s = 0; s < 6; ++s) { kf[2 * s] = ldn.k(0, s); kf[2 * s + 1] = ldn.k(1, s); } }
            const float mx = rowmax32(c0, c1);
            const bool first = (t == 0);
            if (first || __any(mx > ATT_THR)) {
                const float d = first ? mx : fmaxf(mx, 0.f);
                m += d; const float f = first ? 0.f : __builtin_amdgcn_exp2f(-d); l *= f;
#pragma unroll
                for (int r = 0; r < 16; ++r) { c0[r] -= d; c1[r] -= d; o[0][r] *= f; o[1][r] *= f; }
            }
            f32x16 n0, n1;
            { f32x16 negm;
#pragma unroll
              for (int r = 0; r < 16; ++r) negm[r] = -m;
              n0 = negm; n1 = negm;
#pragma unroll
              for (int s = 0; s < 6; ++s) { n0 = MFMA32(kf[2 * s], qr[s], n0); n1 = MFMA32(kf[2 * s + 1], qr[s], n1); } }
            float rs0 = 0.f, rs1 = 0.f;
#pragma unroll
            for (int r = 0; r < 16; ++r) { c0[r] = __builtin_amdgcn_exp2f(c0[r]); rs0 += c0[r]; c1[r] = __builtin_amdgcn_exp2f(c1[r]); rs1 += c1[r]; }
            l += rs0 + rs1;
            bf16x8 pa[4];
#pragma unroll
            for (int s = 0; s < 2; ++s) { u32x4 w0, w1;
#pragma unroll
                for (int jj = 0; jj < 4; ++jj) { w0[jj] = cvtpk(c0[8 * s + 2 * jj], c0[8 * s + 2 * jj + 1]); w1[jj] = cvtpk(c1[8 * s + 2 * jj], c1[8 * s + 2 * jj + 1]); }
                pa[s] = __builtin_bit_cast(bf16x8, w0); pa[2 + s] = __builtin_bit_cast(bf16x8, w1); }
            { const LdsLoader ldv{C.lds + slot * ABUF, C.lds + slot * ABUF + KBUF, r32, hi};
#pragma unroll
              for (int s = 0; s < 4; ++s) { o[0] = MFMA32(ldv.v(0, s), pa[s], o[0]); o[1] = MFMA32(ldv.v(1, s), pa[s], o[1]); } }
            c0 = n0; c1 = n1;
#ifdef ATT_SGB
#pragma unroll
            for (int i = 0; i < 20; ++i) { __builtin_amdgcn_sched_group_barrier(0x008, 1, 0); __builtin_amdgcn_sched_group_barrier(0x100, 2, 0); __builtin_amdgcn_sched_group_barrier(0x002, 4, 0); }
#endif
        }
        if (more) ATT_LSTORE(s2);
        slot = s1;
        __syncthreads();
    }
#undef ATT_GLOAD
#undef ATT_LSTORE
    const float lt = halfsum(l); const float inv = 1.0f / lt;
    bf16* orow = CAT + qrow * 1024 + hd * 64;
#pragma unroll
    for (int db = 0; db < 2; ++db)
#pragma unroll
        for (int q = 0; q < 4; ++q) { u32x2 w; w.x = cvtpk(o[db][4 * q] * inv, o[db][4 * q + 1] * inv); w.y = cvtpk(o[db][4 * q + 2] * inv, o[db][4 * q + 3] * inv);
            *(u32x2*)(orow + 32 * db + 8 * q + 4 * hi) = w; }
}
__device__ __forceinline__ void attn_sample_unit(const Args& A, const Ctx& C, int b, int hd) {
    unsigned char* ws = A.ws; const int tid = C.tid, lane = C.lane, wid = C.wave, r32 = lane & 31, hi = lane >> 5;
    const bf16* Q = (const bf16*)(ws + WS_Z); const bf16* KNS = (const bf16*)(ws + WS_KNS); const bf16* KRS = (const bf16*)(ws + WS_KRS); const bf16* VTS = (const bf16*)(ws + WS_VTS);
    bf16* CAT = (bf16*)(ws + WS_H); const float* ROPE = (const float*)(ws + WS_ROPE);
    const size_t qrow = (size_t)NP + b * 32 + r32;
    bf16x8 qr[6]; load_q(qr, Q + qrow * 768 + hd * 96, ROPE + (size_t)(PAST + r32) * 32, hi);
    f32x16 o[2]; o[0] = (f32x16){}; o[1] = (f32x16){}; float m = 0.f, l = 0.f;
    for (int t = wid; t < 33; t += 8) {
        const size_t key0 = (size_t)b * SKV + 64 * t;
        GlbLoader ld{KNS + key0 * 512 + hd * 64, KRS + key0 * 32, VTS + (size_t)(hd * 64) * NKVS + key0, r32, hi};
        attn_tile(ld, qr, o, m, l, t == 32, t == wid);
    }
    const float lt = l + __shfl_xor(l, 32);
    LAS float* cm = (LAS float*)C.lds; LAS float* cl = cm + 256; LAS float* co = cm + 512;
    if (hi == 0) { cm[wid * 32 + r32] = m; cl[wid * 32 + r32] = lt; }
#pragma unroll
    for (int db = 0; db < 2; ++db)
#pragma unroll
        for (int r = 0; r < 16; ++r) co[(wid * 64 + 32 * db + crow(r, hi)) * 32 + r32] = o[db][r];
    __syncthreads();
    { const int q = tid & 31, d0 = (tid >> 5) * 4;
      float M = cm[q];
#pragma unroll
      for (int w = 1; w < 8; ++w) M = fmaxf(M, cm[w * 32 + q]);
      float L = 0.f, acc[4] = {0.f, 0.f, 0.f, 0.f};
#pragma unroll
      for (int w = 0; w < 8; ++w) { const float f = __builtin_amdgcn_exp2f(cm[w * 32 + q] - M); L += cl[w * 32 + q] * f;
#pragma unroll
          for (int i = 0; i < 4; ++i) acc[i] += co[(w * 64 + d0 + i) * 32 + q] * f; }
      const float inv = 1.0f / L;
      u32x2 wv; wv.x = pk2(acc[0] * inv, acc[1] * inv); wv.y = pk2(acc[2] * inv, acc[3] * inv);
      *(u32x2*)(CAT + ((size_t)NP + b * 32 + q) * 1024 + hd * 64 + d0) = wv; }
    __syncthreads();
}

#define XB_TMO      128
#define XB_XCNT(j)  (256  + 64 * (j))
#define XB_XSUB(j)  (1280 + 64 * (j))
#define XB_XGEN(j)  (2304 + 64 * (j))
#define XB_TOP      3328
#define XB_TOPGEN   3392
#define XCD_BAR_WORDS 3456
#define XB_SPIN_CAP (1u << 23)

__device__ __forceinline__ unsigned xb_ld(unsigned* p)              { return __hip_atomic_load(p, __ATOMIC_RELAXED, __HIP_MEMORY_SCOPE_AGENT); }
__device__ __forceinline__ unsigned xb_add(unsigned* p, unsigned v) { return __hip_atomic_fetch_add(p, v, __ATOMIC_RELAXED, __HIP_MEMORY_SCOPE_AGENT); }
__device__ __forceinline__ unsigned xb_xcc_id() { return (unsigned)__builtin_amdgcn_s_getreg((3 << 11) | 20) & 0xFu; }
#define XB_SPIN(cond, bar) do { unsigned _sp = 0; while (cond) { __builtin_amdgcn_s_sleep(1); \
    if ((++_sp & 255u) == 0u) { if (xb_ld(&(bar)[XB_TMO])) break; if (_sp > XB_SPIN_CAP) { atomicAdd(&(bar)[XB_TMO], 1u); break; } } } } while (0)

struct XcdBarrier {
    unsigned* bar; unsigned x;
    volatile LAS unsigned* st;
};

__device__ __forceinline__ XcdBarrier xcd_barrier_post(unsigned* bar, volatile LAS unsigned* st) {
    XcdBarrier b; b.bar = bar; b.x = xb_xcc_id(); b.st = st;
    if (threadIdx.x == 0) (void)xb_add(&bar[XB_XCNT(b.x)], 1u);
    return b;
}
__device__ __forceinline__ void xcd_barrier_complete(unsigned* bar, unsigned x, unsigned& nloc, unsigned& nx) {
    const unsigned G = gridDim.x * gridDim.y * gridDim.z;
    unsigned sum, cnt, mine, sp = 0u;
    for (;;) {
        sum = 0u; cnt = 0u; mine = 0u;
#pragma unroll
        for (unsigned j = 0; j < 16; ++j) { const unsigned c = xb_ld(&bar[XB_XCNT(j)]); sum += c; cnt += (c > 0u) ? 1u : 0u; mine = (j == x) ? c : mine; }
        if (sum == G) break;
        __builtin_amdgcn_s_sleep(1);
        if ((++sp & 255u) == 0u) { if (xb_ld(&bar[XB_TMO])) break; if (sp > XB_SPIN_CAP) { atomicAdd(&bar[XB_TMO], 1u); break; } }
    }
    nloc = mine > 0u ? mine : 1u; nx = cnt > 0u ? cnt : 1u;
}

__device__ __forceinline__ void xcd_barrier(const XcdBarrier& b) {
    asm volatile("s_waitcnt vmcnt(0)" ::: "memory");
    __syncthreads();
    if (threadIdx.x == 0) {
        unsigned* bar = b.bar;
        __builtin_amdgcn_s_waitcnt(0);
        unsigned nloc = b.st[0], nx = b.st[1];
        if (nloc == 0u) { xcd_barrier_complete(bar, b.x, nloc, nx); b.st[0] = nloc; b.st[1] = nx; }
        const unsigned old = xb_add(&bar[XB_XSUB(b.x)], 1u);
        const unsigned gen = old / nloc;
        if (old + 1u == (gen + 1u) * nloc) {
            __builtin_amdgcn_fence(__ATOMIC_RELEASE, "agent");
            asm volatile("s_waitcnt vmcnt(0)" ::: "memory");
            const unsigned og = xb_add(&bar[XB_TOP], 1u);
            const unsigned tg = og / nx;
            if (og + 1u == (tg + 1u) * nx) xb_add(&bar[XB_TOPGEN], 1u);
            else XB_SPIN(xb_ld(&bar[XB_TOPGEN]) == tg, bar);
            __builtin_amdgcn_fence(__ATOMIC_ACQUIRE, "agent");
            xb_add(&bar[XB_XGEN(b.x)], 1u);
            asm volatile("s_waitcnt vmcnt(0)" ::: "memory");
        } else {
            XB_SPIN(xb_ld(&bar[XB_XGEN(b.x)]) == gen, bar);
            __builtin_amdgcn_fence(__ATOMIC_ACQUIRE, "agent");
            asm volatile("s_waitcnt vmcnt(0)" ::: "memory");
        }
    }
    __syncthreads();
}

__global__ void __launch_bounds__(512, 2) fwd_mega(Args A) {
    extern __shared__ __attribute__((aligned(16))) unsigned char lds_raw[];
    cg::grid_group grid = cg::this_grid();
    volatile LAS unsigned* bst = (volatile LAS unsigned*)((LAS unsigned char*)lds_raw + LDS_BYTES - 64);
    if (threadIdx.x < 16) bst[threadIdx.x] = 0u;
    __syncthreads();
    XcdBarrier xbar = xcd_barrier_post((unsigned*)(A.ws + WS_CTL), bst);
#ifdef PROBE_SYNC2
#define GSYNC() do { xcd_barrier(xbar); xcd_barrier(xbar); } while (0)
#else
#define GSYNC() xcd_barrier(xbar)
#endif
    Ctx C; C.lds = (LAS unsigned char*)lds_raw; C.tid = threadIdx.x; C.lane = C.tid & 63; C.wave = __builtin_amdgcn_readfirstlane(C.tid >> 6);
    C.G = gridDim.x; { const int bx = blockIdx.x; C.vcu = (C.G % 8 == 0) ? (bx % 8) * (C.G / 8) + bx / 8 : bx; }
    C.gw = blockIdx.x * 8 + C.wave; C.NGW = C.G * 8;
    unsigned char* ws = A.ws;
    float* X = A.out + O_Y;
    { float* ROPE = (float*)(ws + WS_ROPE);
      for (int e = blockIdx.x * 512 + C.tid; e < SEQ * 16; e += C.G * 512) { const int p = e >> 4, i = e & 15;
          const double base = (i & 3) == 0 ? 1.0 : (i & 3) == 1 ? 0.5623413251903491 : (i & 3) == 2 ? 0.31622776601683794 : 0.1778279410038923;
          const double sc = (i >> 2) == 0 ? 1.0 : (i >> 2) == 1 ? 0.1 : (i >> 2) == 2 ? 0.01 : 0.001;
          const float inv = (float)(base * sc); const float ang = (float)p * inv;
          const double rev = (double)ang * 0.15915494309189535; const float fr = (float)(rev - __builtin_rint(rev));
          ROPE[p * 32 + i] = __builtin_amdgcn_cosf(fr); ROPE[p * 32 + 16 + i] = __builtin_amdgcn_sinf(fr); } }
#ifdef TP_SEL
    unsigned long long tp_acc = 0, tp_last = __builtin_amdgcn_s_memrealtime();
#define TP_MARK(id) do { const unsigned long long now_ = __builtin_amdgcn_s_memrealtime(); if ((TP_SEL >> (id)) & 1) tp_acc += now_ - tp_last; tp_last = now_; } while (0)
#else
#define TP_MARK(id) do { } while (0)
#endif
#define REFRESH() do { int t_ = threadIdx.x; asm volatile("" : "+v"(t_)); C.tid = t_; C.lane = t_ & 63; C.wave = __builtin_amdgcn_readfirstlane(t_ >> 6); C.gw = blockIdx.x * 8 + C.wave; } while (0)
#ifdef PROBE_ALL2
#pragma unroll 1
    for (int rep = 0; rep < 2; ++rep) {
#endif
#pragma unroll 1
    for (int l = 0; l < DEPTH; ++l) {
        REFRESH();
#ifdef PROBE_P1
        for (int rep = 0; rep < 2; ++rep) {
#endif
        convert_weights(C, A, l);
        { f32x4 gv[4];
#pragma unroll
          for (int j = 0; j < 4; ++j) gv[j] = ((const f32x4*)(A.g_attn + l * DM) + C.lane)[64 * j];
          for (int mrow = C.gw; mrow < NTOK; mrow += 2 * C.NGW) {
            const int m1 = mrow + C.NGW; const bool has1 = m1 < NTOK; const int m1c = has1 ? m1 : mrow;
            const float* x0 = (l == 0) ? (mrow < NP ? A.xp + (size_t)mrow * DM : A.xs + (size_t)(mrow - NP) * DM) : X + (size_t)mrow * DM;
            const float* x1 = (l == 0) ? (m1c < NP ? A.xp + (size_t)m1c * DM : A.xs + (size_t)(m1c - NP) * DM) : X + (size_t)m1c * DM;
            norm_row2(x0, x1, gv, (bf16*)(ws + WS_H) + (size_t)mrow * DM, (bf16*)(ws + WS_H) + (size_t)m1c * DM, has1, C.lane); } }
        for (int r0 = C.gw; r0 < DEC_B * PAST; r0 += 4 * C.NGW) {
            f32x4 cv[4]; float kv[4]; int rr[4];
#pragma unroll
            for (int q = 0; q < 4; ++q) { const int r = r0 + q * C.NGW; rr[q] = r < DEC_B * PAST ? r : r0;
                cv[q] = *((const f32x4*)(A.cckv + ((size_t)l * DEC_B * PAST + rr[q]) * 256) + C.lane); kv[q] = A.ckr[((size_t)l * DEC_B * PAST + rr[q]) * 32 + (C.lane & 31)]; }
#pragma unroll
            for (int q = 0; q < 4; ++q) { if (r0 + q * C.NGW < DEC_B * PAST) { const int b = rr[q] >> 11, pp = rr[q] & (PAST - 1); const size_t dr = (size_t)b * SKV + pp;
                u32x2 o; o.x = pk2(cv[q].x, cv[q].y); o.y = pk2(cv[q].z, cv[q].w); *((u32x2*)((bf16*)(ws + WS_CKVS) + dr * 256) + C.lane) = o;
                if (C.lane < 32) ((bf16*)(ws + WS_KRS))[dr * 32 + C.lane] = (bf16)f2bf(kv[q]); } }
        }
#ifdef PROBE_P1
        }
#endif
        if (A.ws == nullptr) grid.sync();
        GSYNC(); TP_MARK(0);
#ifndef NO_P2
#ifdef PROBE_P2
        for (int rep = 0; rep < 2; ++rep) {
#endif
        { pg8::EpiBf16 E{(pg8::bf16_t*)(ws + WS_Z), 256, 256, (size_t)NTOK * 256};
          pg8::Gemm g{(const pg8::bf16_t*)(ws + WS_H), (const pg8::bf16_t*)(ws + WS_WIN), NTOK, 1792, DM}; pg8::StaticOrder S; S.init(NTOK, 1792, C.G, (int)blockIdx.x);
          pg8::gemm_phase<pg8::EpiBf16, pg8::StaticOrder, true, true>(C.lds, g, S, E); }
        if (C.G == 256) {
            const bool hiq = (int)blockIdx.x >= 142; const int ct0 = hiq ? 0 : 114, nct = hiq ? 114 : 16, g2 = hiq ? 114 : 32, c2 = hiq ? (int)blockIdx.x - 142 : (int)blockIdx.x;
            if (hiq || (int)blockIdx.x < 32) {
                pg8::EpiBf16 E{(pg8::bf16_t*)(ws + WS_GVT) + (size_t)ct0 * 256, NTOK, 0, 0};
                pg8::Gemm g{(const pg8::bf16_t*)(ws + WS_WGV), (const pg8::bf16_t*)(ws + WS_H) + (size_t)ct0 * 256 * DM, 512, nct * 256, DM}; pg8::StaticOrder S; S.init(512, nct * 256, g2, c2);
                pg8::gemm_phase<pg8::EpiBf16, pg8::StaticOrder, true, true>(C.lds, g, S, E); }
        } else {
            pg8::EpiBf16 E{(pg8::bf16_t*)(ws + WS_GVT), NTOK, 0, 0};
            pg8::Gemm g{(const pg8::bf16_t*)(ws + WS_WGV), (const pg8::bf16_t*)(ws + WS_H), 512, NTOK, DM}; pg8::StaticOrder S; S.init(512, NTOK, C.G, (int)((blockIdx.x + 146) % C.G));
            pg8::gemm_phase<pg8::EpiBf16, pg8::StaticOrder, true, true>(C.lds, g, S, E); }
#ifdef PROBE_P2
        }
#endif
        GSYNC(); TP_MARK(1);
#endif
        REFRESH();
#ifdef PROBE_THIN
        for (int rep = 0; rep < 2; ++rep)
#endif
        { f32x4 wv[16];
#pragma unroll
          for (int r = 0; r < 16; ++r) wv[r] = *((const f32x4*)(A.w_a2 + (size_t)l * 16 * 256 + r * 256) + C.lane);
          const f32x4 bv = *((const f32x4*)(A.b_a2 + l * 256) + C.lane);
          const f32x4 gq = *((const f32x4*)(A.g_qn + l * 256) + C.lane), gkv = *((const f32x4*)(A.g_kvn + l * 256) + C.lane);
          for (int mrow = C.gw; mrow < NTOK; mrow += 4 * C.NGW) {
              int mm[4]; P3Loads LL[4];
#pragma unroll
              for (int q = 0; q < 4; ++q) { const int m = mrow + q * C.NGW; mm[q] = m < NTOK ? m : mrow; LL[q] = p3_load(A, mm[q], C.lane); }
#pragma unroll
              for (int q = 0; q < 4; ++q) { if (mrow + q * C.NGW < NTOK) p3_token(A, l, mm[q], C.lane, wv, bv, gq, gkv, LL[q]); } } }
        GSYNC(); TP_MARK(2);
        for (int it = C.gw; it < NITEM_P; it += C.NGW) gla_g1<false>(A, l, it, C.lds + C.wave * 16384, C.lane);
#ifdef SAMP_OLDPLACE
        if (C.gw < 64) gla_g1<true>(A, l, NITEM_P + C.gw, C.lds + C.wave * 16384, C.lane);
#endif
        GSYNC(); TP_MARK(3);
#ifndef NO_P4
        if ((int)blockIdx.x < NSCAN) {
            gla_scan(A, l, blockIdx.x, C.tid);
            asm volatile("s_waitcnt vmcnt(0)" ::: "memory"); __syncthreads();
            if (C.tid == 0) { unsigned* cnt = (unsigned*)(ws + WS_CTL) + 8192;
                __builtin_amdgcn_fence(__ATOMIC_RELEASE, "agent"); asm volatile("s_waitcnt vmcnt(0)" ::: "memory");
                __hip_atomic_fetch_add(cnt, 1u, __ATOMIC_RELAXED, __HIP_MEMORY_SCOPE_AGENT);
                const unsigned want = (unsigned)NSCAN * (unsigned)(l + 1); unsigned sp = 0;
                while (__hip_atomic_load(cnt, __ATOMIC_RELAXED, __HIP_MEMORY_SCOPE_AGENT) < want) { __builtin_amdgcn_s_sleep(2); if (++sp > (1u << 24)) break; }
                __builtin_amdgcn_fence(__ATOMIC_ACQUIRE, "agent"); asm volatile("s_waitcnt vmcnt(0)" ::: "memory"); }
            __syncthreads();
            { const int it = blockIdx.x * 8 + C.wave; if (it < NITEM_P / 2) gla_g3<false>(A, l, it, C.lds + C.wave * 17408, C.lane); }
        }
#ifndef SAMP_OLDPLACE
        else if ((int)blockIdx.x < NSCAN + NSAMPWG) { const int it = NITEM_P + ((int)blockIdx.x - NSCAN) * 4 + (C.wave & 3);
            if (C.wave < 4) gla_g1<true>(A, l, it, C.lds + C.wave * 17408, C.lane); else gla_g3<true>(A, l, it, C.lds + C.wave * 17408, C.lane); }
#else
        else if ((int)blockIdx.x < NSCAN + NSAMPWG) { }
#endif
        else {
            const int G2 = C.G - NSCAN - NSAMPWG, c2 = blockIdx.x - NSCAN - NSAMPWG;
#ifdef PROBE_P4G
            for (int rep = 0; rep < 2; ++rep)
#endif
#pragma unroll 1
            for (int gi = 0; gi < 5; ++gi) {
                pg8::Gemm g; pg8::EpiBf16 E; int M_, N_;
                if (gi == 0) { g = pg8::Gemm{(const pg8::bf16_t*)(ws + WS_CQN), (const pg8::bf16_t*)(ws + WS_WUQ), NTOK, 768, 256}; E = pg8::EpiBf16{(pg8::bf16_t*)(ws + WS_Z), 768, 0, 0}; M_ = NTOK; N_ = 768; }
                else if (gi == 1) { g = pg8::Gemm{(const pg8::bf16_t*)(ws + WS_CKVN), (const pg8::bf16_t*)(ws + WS_WUK), NP, 512, 256}; E = pg8::EpiBf16{(pg8::bf16_t*)(ws + WS_KN), 512, 0, 0}; M_ = NP; N_ = 512; }
                else if (gi == 2) { g = pg8::Gemm{(const pg8::bf16_t*)(ws + WS_WUV), (const pg8::bf16_t*)(ws + WS_CKVN), 512, NP, 256}; E = pg8::EpiBf16{(pg8::bf16_t*)(ws + WS_VT), NP, 0, 0}; M_ = 512; N_ = NP; }
                else if (gi == 3) { g = pg8::Gemm{(const pg8::bf16_t*)(ws + WS_CKVS), (const pg8::bf16_t*)(ws + WS_WUK), NKVS, 512, 256}; E = pg8::EpiBf16{(pg8::bf16_t*)(ws + WS_KNS), 512, 0, 0}; M_ = NKVS; N_ = 512; }
                else { g = pg8::Gemm{(const pg8::bf16_t*)(ws + WS_WUV), (const pg8::bf16_t*)(ws + WS_CKVS), 512, NKVS, 256}; E = pg8::EpiBf16{(pg8::bf16_t*)(ws + WS_VTS), NKVS, 0, 0}; M_ = 512; N_ = NKVS; }
                pg8::StaticOrder S; S.init(M_, N_, G2, (c2 + gi * 37) % G2);
                pg8::gemm_phase<pg8::EpiBf16, pg8::StaticOrder, true, true>(C.lds, g, S, E);
            }
        }
        GSYNC(); TP_MARK(4);
#endif
        REFRESH();
#ifdef SAMP_OLDPLACE
        if (C.gw < 64) gla_g3<true>(A, l, NITEM_P + C.gw, C.lds + C.wave * 17408, C.lane);
#endif
        if (C.vcu < C.G - 128) { for (int it = NITEM_P / 2 + C.vcu * 8 + C.wave; it < NITEM_P; it += (C.G - 128) * 8) gla_g3<false>(A, l, it, C.lds + C.wave * 17408, C.lane); }
        __syncthreads();
#ifdef PROBE_SAMP
#pragma unroll 1
        for (int rep = 0; rep < 2; ++rep)
#endif
#ifndef NO_SAMP
        if (C.vcu >= C.G - 128 && C.vcu < C.G) { const int u = C.vcu - (C.G - 128); attn_sample_unit(A, C, u >> 3, u & 7); }
#endif
#ifndef NO_ATTN
#ifdef PROBE_ATTN2
        for (int rep = 0; rep < 2; ++rep)
#endif
        for (int u = C.vcu; u < 1024; u += C.G) {
            const int bh = (u % 256) >> 4, s = u & 15, i = u >> 8; const int qb = (i == 0) ? 63 - s : (i == 1) ? 32 + s : (i == 2) ? 31 - s : s;
            attn_prompt_unit(A, C, bh >> 3, bh & 7, qb); }
#endif
        GSYNC(); TP_MARK(5);
#ifndef NO_P6
        if (l == 0) { pg8::EpiResB E{X, A.xp, A.xs, NP, DM};
          pg8::Gemm g{(const pg8::bf16_t*)(ws + WS_H), (const pg8::bf16_t*)(ws + WS_WO), NTOK, DM, DM}; pg8::StaticOrder S; S.init(NTOK, DM, C.G, (int)blockIdx.x);
          pg8::gemm_phase<pg8::EpiResB, pg8::StaticOrder, true, true>(C.lds, g, S, E); }
        else { pg8::EpiRes E{X, DM};
          pg8::Gemm g{(const pg8::bf16_t*)(ws + WS_H), (const pg8::bf16_t*)(ws + WS_WO), NTOK, DM, DM}; pg8::StaticOrder S; S.init(NTOK, DM, C.G, (int)blockIdx.x);
          pg8::gemm_phase<pg8::EpiRes, pg8::StaticOrder, true, true>(C.lds, g, S, E); }
        GSYNC(); TP_MARK(6);
#endif
        REFRESH();
#ifdef PROBE_THIN
        for (int rep = 0; rep < 2; ++rep)
#endif
        { f32x4 gv[4];
#pragma unroll
          for (int j = 0; j < 4; ++j) gv[j] = ((const f32x4*)(A.g_ffn + l * DM) + C.lane)[64 * j];
          for (int mrow = C.gw; mrow < NTOK; mrow += 2 * C.NGW) { const int m1 = mrow + C.NGW; const bool has1 = m1 < NTOK; const int m1c = has1 ? m1 : mrow;
            norm_row2(X + (size_t)mrow * DM, X + (size_t)m1c * DM, gv, (bf16*)(ws + WS_H) + (size_t)mrow * DM, (bf16*)(ws + WS_H) + (size_t)m1c * DM, has1, C.lane); } }
        GSYNC(); TP_MARK(7);
#ifndef NO_P8
#ifdef PROBE_P8
        for (int rep = 0; rep < 2; ++rep)
#endif
        { pg8::EpiSwiglu E{(pg8::bf16_t*)(ws + WS_ACT), DFF};
          pg8::Gemm g{(const pg8::bf16_t*)(ws + WS_H), (const pg8::bf16_t*)(ws + WS_WGU), NTOK, 2 * DFF, DM}; pg8::StaticOrder S; S.init(NTOK, 2 * DFF, C.G, (int)blockIdx.x);
          pg8::gemm_phase<pg8::EpiSwiglu, pg8::StaticOrder, true, true>(C.lds, g, S, E); }
        GSYNC(); TP_MARK(8);
#endif
#ifndef NO_P9
        { pg8::EpiRes E{X, DM};
          pg8::Gemm g{(const pg8::bf16_t*)(ws + WS_ACT), (const pg8::bf16_t*)(ws + WS_WD), NTOK, DM, DFF}; pg8::StaticOrder S; S.init(NTOK, DM, C.G, (int)blockIdx.x);
          pg8::gemm_phase<pg8::EpiRes, pg8::StaticOrder, true, true>(C.lds, g, S, E); }
        GSYNC(); TP_MARK(9);
#endif
    }
    REFRESH();
    { f32x4 gv[4];
#pragma unroll
      for (int j = 0; j < 4; ++j) gv[j] = ((const f32x4*)A.g_final + C.lane)[64 * j];
      for (int mrow = C.gw; mrow < NTOK; mrow += 2 * C.NGW) { const int m1 = mrow + C.NGW; const bool has1 = m1 < NTOK; const int m1c = has1 ? m1 : mrow;
        final_norm_row2(X + (size_t)mrow * DM, X + (size_t)m1c * DM, gv, has1, C.lane); } }
#ifdef TP_SEL
    if (blockIdx.x == 0) { const unsigned long long t0_ = __builtin_amdgcn_s_memrealtime(); while (__builtin_amdgcn_s_memrealtime() - t0_ < 8ull * tp_acc) __builtin_amdgcn_s_sleep(8); }
#endif
#ifdef PROBE_ALL2
    GSYNC();
    }
#endif
}

extern "C" void kernel_launch(void* const* d_in, const int* in_sizes, int n_in, void* d_out, int out_size, void* d_ws, size_t ws_size, hipStream_t stream) {
    static int grid = 0;
    if (grid == 0) {
        if (n_in != 19 || (size_t)out_size != O_END || ws_size < WS_END) { fprintf(stderr, "kernel_launch: unexpected shapes: n_in %d out %d ws %zu (need %zu)\n", n_in, out_size, ws_size, (size_t)WS_END); grid = -1; return; }
        int dev = 0, cus = 0, per_cu = 0;
        hipGetDevice(&dev); hipDeviceGetAttribute(&cus, hipDeviceAttributeMultiprocessorCount, dev);
        if (hipFuncSetAttribute((const void*)fwd_mega, hipFuncAttributeMaxDynamicSharedMemorySize, LDS_BYTES) != hipSuccess) { fprintf(stderr, "kernel_launch: hipFuncSetAttribute failed\n"); grid = -1; return; }
        if (hipOccupancyMaxActiveBlocksPerMultiprocessor(&per_cu, (const void*)fwd_mega, 512, LDS_BYTES) != hipSuccess || per_cu < 1) { fprintf(stderr, "kernel_launch: occupancy query says %d\n", per_cu); per_cu = 1; }
        (void)hipGetLastError();
        grid = cus;
    }
    if (grid < 0) return;
    Args a{};
    a.xp = (const float*)d_in[0]; a.xs = (const float*)d_in[1]; a.cckv = (const float*)d_in[2]; a.ckr = (const float*)d_in[3]; a.sgla = (const float*)d_in[4];
    a.g_attn = (const float*)d_in[5]; a.w_in = (const float*)d_in[6]; a.g_qn = (const float*)d_in[7]; a.w_uq = (const float*)d_in[8]; a.g_kvn = (const float*)d_in[9];
    a.w_ukv = (const float*)d_in[10]; a.w_a2 = (const float*)d_in[11]; a.b_a2 = (const float*)d_in[12]; a.g_on = (const float*)d_in[13]; a.w_o = (const float*)d_in[14];
    a.g_ffn = (const float*)d_in[15]; a.w_gu = (const float*)d_in[16]; a.w_down = (const float*)d_in[17]; a.g_final = (const float*)d_in[18];
    a.out = (float*)d_out; a.ws = (unsigned char*)d_ws;
    if (hipMemsetAsync((char*)d_ws + WS_CTL, 0, CTL_BYTES, stream) != hipSuccess) { fprintf(stderr, "kernel_launch: memset failed\n"); return; }
    void* args[] = {&a};
    hipError_t e = hipLaunchCooperativeKernel((const void*)fwd_mega, dim3(grid), dim3(512), args, LDS_BYTES, stream);
    if (e != hipSuccess) fprintf(stderr, "kernel_launch: cooperative launch failed: %s (grid %d)\n", hipGetErrorString(e), grid);
}
```
